# Optimizing an MI355X kernel written in HIP

```python
import jax, jax.numpy as jnp
from jax import lax
import numpy as np

D_MODEL = 1024
BATCH = 8
SEQ = 4096
DEPTH = 1

PLE_DIM = 256
D_LRU = 512
LRU_BLOCKS = 8
LRU_BW = D_LRU // LRU_BLOCKS
CONV_W = 4
LRU_C = 8.0
D_RET = 512
RET_HEADS = 4
RET_HD = D_RET // RET_HEADS
RET_CHUNK = 128
ROPE_BASE = 10000.0
D_MIX = D_LRU + D_RET
IN_COLS = 2 * D_LRU + 4 * D_RET
SPLITS = (D_LRU, 2 * D_LRU, 2 * D_LRU + D_RET, 2 * D_LRU + 2 * D_RET, 2 * D_LRU + 3 * D_RET)
N_GROUPS = 8
EXPERTS_PER_GROUP = 8
N_EXPERTS = N_GROUPS * EXPERTS_PER_GROUP
TOP_K = 2
D_EXPERT = 512
MOE_BLOCK = 128
EPS = 1e-6

kernel_name = "hymba_rglru_retention_hmoe_ple"

F32 = jnp.float32


def rms_norm(x, g):
    xf = x.astype(F32)
    y = xf * lax.rsqrt(jnp.mean(xf * xf, axis=-1, keepdims=True) + EPS)
    return (y * g.astype(F32)).astype(x.dtype)


def causal_depthwise_conv(x, w, b):
    S = x.shape[1]
    xp = jnp.pad(x, ((0, 0), (CONV_W - 1, 0), (0, 0)))
    y = b + xp[:, 0:S, :] * w[0]
    for k in range(1, CONV_W):
        y = y + xp[:, k:k + S, :] * w[k]
    return y


def rg_lru(x, w_a, b_a, w_x, b_x, lam):
    B, S, _ = x.shape
    xf = x.astype(F32)
    xb = xf.reshape(B, S, LRU_BLOCKS, LRU_BW)
    r = jax.nn.sigmoid(jnp.einsum('bshi,hij->bshj', xb, w_a.astype(F32)) + b_a.astype(F32)).reshape(B, S, D_LRU)
    i = jax.nn.sigmoid(jnp.einsum('bshi,hij->bshj', xb, w_x.astype(F32)) + b_x.astype(F32)).reshape(B, S, D_LRU)
    log_a = -LRU_C * r * jax.nn.softplus(-lam.astype(F32))
    a = jnp.exp(log_a)
    u = jnp.sqrt(-jnp.expm1(2.0 * log_a)) * (i * xf)

    def combine(left, right):
        a1, b1 = left
        a2, b2 = right
        return a1 * a2, a2 * b1 + b2

    _, h = lax.associative_scan(combine, (a, u), axis=1)
    return h.astype(x.dtype)


def rotary(x, pos):
    half = RET_HD // 2
    inv = ROPE_BASE ** (-jnp.arange(half, dtype=F32) / half)
    ang = pos.astype(F32)[:, None] * inv[None, :]
    cos = jnp.cos(ang).astype(x.dtype)
    sin = jnp.sin(ang).astype(x.dtype)
    x1, x2 = x[..., :half], x[..., half:]
    return jnp.concatenate([x1 * cos - x2 * sin, x1 * sin + x2 * cos], axis=-1)


def chunkwise_retention(q, k, v):
    B, H, S, Dh = q.shape
    C = RET_CHUNK
    N = S // C
    dt = q.dtype
    log_g = jnp.log(1.0 - 2.0 ** (-5.0 - jnp.arange(H, dtype=F32)))
    idx = jnp.arange(C, dtype=F32)
    diff = idx[:, None] - idx[None, :]
    decay = jnp.where(diff >= 0, jnp.exp(jnp.maximum(diff, 0.0)[None] * log_g[:, None, None]), 0.0)
    qc = q.reshape(B, H, N, C, Dh)
    kc = k.reshape(B, H, N, C, Dh)
    vc = v.reshape(B, H, N, C, Dh)
    scores = jnp.einsum('bhncd,bhnmd->bhncm', qc, kc) * decay[None, :, None].astype(dt)
    inner = jnp.einsum('bhncm,bhnme->bhnce', scores, vc)
    k_decay = jnp.exp((C - 1.0 - idx)[None, :] * log_g[:, None]).astype(dt)
    chunk_kv = jnp.einsum('bhncd,bhnce->bhnde', kc * k_decay[None, :, None, :, None], vc)
    chunk_decay = jnp.exp(C * log_g).astype(dt)[None, :, None, None]

    def step(state, kv):
        return state * chunk_decay + kv, state

    init = jnp.zeros((B, H, Dh, Dh), chunk_kv.dtype)
    _, prev = lax.scan(step, init, jnp.moveaxis(chunk_kv, 2, 0))
    prev = jnp.moveaxis(prev, 0, 2)
    q_decay = jnp.exp((idx + 1.0)[None, :] * log_g[:, None]).astype(dt)
    cross = jnp.einsum('bhncd,bhnde->bhnce', qc * q_decay[None, :, None, :, None], prev)
    return (inner + cross).reshape(B, H, S, Dh)


def head_group_norm(o):
    of = o.astype(F32)
    mu = jnp.mean(of, axis=-1, keepdims=True)
    var = jnp.mean(jnp.square(of - mu), axis=-1, keepdims=True)
    return ((of - mu) * lax.rsqrt(var + EPS)).astype(o.dtype)


def hierarchical_route(h, w_grp, b_grp, w_exp, b_exp):
    T = h.shape[0]
    hf = h.astype(F32)
    g_logits = hf @ w_grp.astype(F32) + b_grp.astype(F32)
    g_prob = jax.nn.softmax(g_logits, axis=-1)
    g_sel = jnp.argmax(g_logits, axis=-1)
    g_w = jnp.max(g_prob, axis=-1)
    e_logits = (hf @ w_exp.astype(F32) + b_exp.astype(F32)).reshape(T, N_GROUPS, EXPERTS_PER_GROUP)
    sel = jnp.broadcast_to(g_sel[:, None, None], (T, 1, EXPERTS_PER_GROUP))
    e_in = jnp.take_along_axis(e_logits, sel, axis=1)[:, 0]
    top_v, top_i = lax.top_k(e_in, TOP_K)
    top_w = jax.nn.softmax(top_v, axis=-1) * g_w[:, None]
    expert_id = g_sel[:, None].astype(jnp.int32) * EXPERTS_PER_GROUP + top_i.astype(jnp.int32)
    return expert_id, top_w


def sparse_moe(h, expert_id, weight, w1, w3, w2):
    T, D = h.shape
    A = T * TOP_K
    e_flat = expert_id.reshape(A)
    tok_flat = jnp.repeat(jnp.arange(T, dtype=jnp.int32), TOP_K)
    w_flat = weight.reshape(A)
    order = jnp.argsort(e_flat)
    e_s, tok_s, w_s = e_flat[order], tok_flat[order], w_flat[order]
    counts = jnp.bincount(e_flat, length=N_EXPERTS)
    padded = (counts + MOE_BLOCK - 1) // MOE_BLOCK * MOE_BLOCK
    pad_end = jnp.cumsum(padded)
    pad_start = pad_end - padded
    start = jnp.cumsum(counts) - counts
    dest = pad_start[e_s] + (jnp.arange(A, dtype=jnp.int32) - start[e_s])
    n_blocks = -(-A // MOE_BLOCK) + N_EXPERTS
    n_slots = n_blocks * MOE_BLOCK
    slot_tok = jnp.zeros((n_slots,), jnp.int32).at[dest].set(tok_s)
    slot_w = jnp.zeros((n_slots,), w_s.dtype).at[dest].set(w_s)
    block_start = jnp.arange(n_blocks, dtype=pad_end.dtype) * MOE_BLOCK
    block_exp = jnp.minimum(jnp.searchsorted(pad_end, block_start, side='right'), N_EXPERTS - 1)
    xs = h[slot_tok].reshape(n_blocks, MOE_BLOCK, D)

    def expert_block(args):
        xb, e = args
        return (jax.nn.silu(xb @ w1[e]) * (xb @ w3[e])) @ w2[e]

    ys = lax.map(expert_block, (xs, block_exp)).reshape(n_slots, D)
    return jnp.zeros_like(h).at[slot_tok].add(ys * slot_w.astype(ys.dtype)[:, None])


def setup_inputs(seed: int = 0) -> dict:
    key = jax.random.key(seed)
    ks = jax.random.split(key, 32)
    L, D = DEPTH, D_MODEL
    nrm = lambda k, shape, s: jax.random.normal(k, shape, F32) * s
    u = jax.random.uniform(ks[10], (L, D_LRU), F32, 0.9, 0.999)
    sig = u ** (1.0 / LRU_C)
    lam = jnp.log(sig) - jnp.log1p(-sig)
    return {
        "x": nrm(ks[0], (BATCH, SEQ, D), 1.0),
        "p": nrm(ks[1], (L, BATCH, SEQ, PLE_DIM), 1.0),
        "g_mix": 1.0 + nrm(ks[2], (L, D), 0.01),
        "w_in": nrm(ks[3], (L, D, IN_COLS), D ** -0.5),
        "conv_w": nrm(ks[4], (L, CONV_W, D_LRU), CONV_W ** -0.5),
        "conv_b": nrm(ks[5], (L, D_LRU), 0.01),
        "lru_wa": nrm(ks[6], (L, LRU_BLOCKS, LRU_BW, LRU_BW), LRU_BW ** -0.5),
        "lru_ba": nrm(ks[7], (L, LRU_BLOCKS, LRU_BW), 0.01),
        "lru_wx": nrm(ks[8], (L, LRU_BLOCKS, LRU_BW, LRU_BW), LRU_BW ** -0.5),
        "lru_bx": nrm(ks[9], (L, LRU_BLOCKS, LRU_BW), 0.01),
        "lru_lambda": lam,
        "w_out": nrm(ks[11], (L, D_MIX, D), D_MIX ** -0.5),
        "g_ffn": 1.0 + nrm(ks[12], (L, D), 0.01),
        "w_router_group": nrm(ks[13], (L, D, N_GROUPS), D ** -0.5),
        "b_router_group": nrm(ks[14], (L, N_GROUPS), 0.01),
        "w_router_expert": nrm(ks[15], (L, D, N_EXPERTS), D ** -0.5),
        "b_router_expert": nrm(ks[16], (L, N_EXPERTS), 0.01),
        "w1": nrm(ks[17], (L, N_EXPERTS, D, D_EXPERT), D ** -0.5),
        "w3": nrm(ks[18], (L, N_EXPERTS, D, D_EXPERT), D ** -0.5),
        "w2": nrm(ks[19], (L, N_EXPERTS, D_EXPERT, D), D_EXPERT ** -0.5),
        "g_ple": 1.0 + nrm(ks[20], (L, D), 0.01),
        "w_ple_gate": nrm(ks[21], (L, D, D), D ** -0.5),
        "b_ple_gate": nrm(ks[22], (L, D), 0.01),
        "w_ple_proj": nrm(ks[23], (L, PLE_DIM, D), PLE_DIM ** -0.5),
        "g_final": 1.0 + nrm(ks[24], (D,), 0.01),
    }


def reference(x, p, g_mix, w_in, conv_w, conv_b, lru_wa, lru_ba, lru_wx, lru_bx, lru_lambda, w_out,
              g_ffn, w_router_group, b_router_group, w_router_expert, b_router_expert, w1, w3, w2,
              g_ple, w_ple_gate, b_ple_gate, w_ple_proj, g_final):
    B, S, D = x.shape
    pos = jnp.arange(S, dtype=jnp.int32)
    for l in range(DEPTH):
        h = rms_norm(x, g_mix[l])
        proj = h @ w_in[l]
        xl, gl, q, k, v, gr = jnp.split(proj, SPLITS, axis=-1)
        xl = causal_depthwise_conv(xl, conv_w[l], conv_b[l])
        y_lru = rg_lru(xl, lru_wa[l], lru_ba[l], lru_wx[l], lru_bx[l], lru_lambda[l]) * jax.nn.gelu(gl)
        to_heads = lambda t: t.reshape(B, S, RET_HEADS, RET_HD).transpose(0, 2, 1, 3)
        qh = rotary(to_heads(q), pos)
        kh = rotary(to_heads(k), pos) * (RET_HD ** -0.5)
        o = chunkwise_retention(qh, kh, to_heads(v))
        o = head_group_norm(o).transpose(0, 2, 1, 3).reshape(B, S, D_RET)
        y_ret = jax.nn.silu(gr) * o
        x = x + jnp.concatenate([y_lru, y_ret], axis=-1) @ w_out[l]
        hf = rms_norm(x, g_ffn[l]).reshape(B * S, D)
        eid, ew = hierarchical_route(hf, w_router_group[l], b_router_group[l], w_router_expert[l], b_router_expert[l])
        x = x + sparse_moe(hf, eid, ew, w1[l], w3[l], w2[l]).reshape(B, S, D)
        gate = jax.nn.sigmoid(rms_norm(x, g_ple[l]) @ w_ple_gate[l] + b_ple_gate[l])
        x = x + gate * (p[l] @ w_ple_proj[l])
    return rms_norm(x, g_final)
```

```cpp
#include <hip/hip_runtime.h>
#include <stdint.h>

namespace gold {
constexpr int D = 1024, B = 8, S = 4096, T = B * S, PLE = 256, DL = 512, DR = 512, NH = 4, HD = 128, INC = 3072;
constexpr int NE = 64, DE = 512, NG = 8, EPG = 8;
constexpr float EPS = 1e-6f;

__device__ __forceinline__ float sigmoidf_(float x) { return 1.f / (1.f + expf(-x)); }
__device__ __forceinline__ float gelu_tanh(float x) { return 0.5f * x * (1.f + tanhf(0.7978845608028654f * (x + 0.044715f * x * x * x))); }
__device__ __forceinline__ float softplusf_(float x) { return x > 20.f ? x : log1pf(expf(x)); }

__global__ void __launch_bounds__(256) k_rmsnorm(const float* a, const float* __restrict__ y0, const float* __restrict__ y1, const float* __restrict__ g, float* sumout, float* __restrict__ normed) {
    const int row = blockIdx.x, tid = threadIdx.x;
    const size_t off = (size_t)row * D + tid * 4;
    float4 v = *(const float4*)(a + off);
    if (y0) { float4 u = *(const float4*)(y0 + off); v.x += u.x; v.y += u.y; v.z += u.z; v.w += u.w; }
    if (y1) { float4 u = *(const float4*)(y1 + off); v.x += u.x; v.y += u.y; v.z += u.z; v.w += u.w; }
    float s = v.x * v.x + v.y * v.y + v.z * v.z + v.w * v.w;
    for (int o = 32; o > 0; o >>= 1) s += __shfl_xor(s, o);
    __shared__ float red[4];
    if ((tid & 63) == 0) red[tid >> 6] = s;
    __syncthreads();
    s = red[0] + red[1] + red[2] + red[3];
    const float r = rsqrtf(s * (1.f / D) + EPS);
    if (sumout) *(float4*)(sumout + off) = v;
    const float4 gg = *(const float4*)(g + tid * 4);
    float4 o4 = {v.x * r * gg.x, v.y * r * gg.y, v.z * r * gg.z, v.w * r * gg.w};
    *(float4*)(normed + off) = o4;
}

__global__ void __launch_bounds__(256) k_final(const float* __restrict__ x2, const float* __restrict__ gate, const float* __restrict__ pp, const float* __restrict__ g, float* __restrict__ out) {
    const int row = blockIdx.x, tid = threadIdx.x;
    const size_t off = (size_t)row * D + tid * 4;
    float4 v = *(const float4*)(x2 + off); const float4 ga = *(const float4*)(gate + off); const float4 q = *(const float4*)(pp + off);
    v.x += ga.x * q.x; v.y += ga.y * q.y; v.z += ga.z * q.z; v.w += ga.w * q.w;
    float s = v.x * v.x + v.y * v.y + v.z * v.z + v.w * v.w;
    for (int o = 32; o > 0; o >>= 1) s += __shfl_xor(s, o);
    __shared__ float red[4];
    if ((tid & 63) == 0) red[tid >> 6] = s;
    __syncthreads();
    s = red[0] + red[1] + red[2] + red[3];
    const float r = rsqrtf(s * (1.f / D) + EPS);
    const float4 gg = *(const float4*)(g + tid * 4);
    float4 o4 = {v.x * r * gg.x, v.y * r * gg.y, v.z * r * gg.z, v.w * r * gg.w};
    *(float4*)(out + off) = o4;
}

template <int EPI>
__global__ void __launch_bounds__(256) k_sgemm(const float* __restrict__ A, int lda, const float* __restrict__ Bm, int ldb, float* __restrict__ C, int ldc, int N, int K, const float* __restrict__ R, const float* __restrict__ bias) {
    __shared__ float As[16][64 + 4], Bs[16][64 + 4];
    const int tid = threadIdx.x, tx = tid & 15, ty = tid >> 4;
    const int row0 = blockIdx.y * 64, col0 = blockIdx.x * 64;
    float acc[4][4] = {};
    for (int k0 = 0; k0 < K; k0 += 16) {
        { const int r = tid >> 2, kk = (tid & 3) * 4; const float4 v = *(const float4*)(A + (size_t)(row0 + r) * lda + k0 + kk);
          As[kk + 0][r] = v.x; As[kk + 1][r] = v.y; As[kk + 2][r] = v.z; As[kk + 3][r] = v.w; }
        { const int kk = tid >> 4, c = (tid & 15) * 4;
#pragma unroll
          for (int j = 0; j < 4; ++j) { const int col = col0 + c + j; Bs[kk][c + j] = col < N ? Bm[(size_t)(k0 + kk) * ldb + col] : 0.f; } }
        __syncthreads();
#pragma unroll
        for (int kk = 0; kk < 16; ++kk) {
            float a[4], b[4];
#pragma unroll
            for (int i = 0; i < 4; ++i) { a[i] = As[kk][ty * 4 + i]; b[i] = Bs[kk][tx * 4 + i]; }
#pragma unroll
            for (int i = 0; i < 4; ++i)
#pragma unroll
                for (int j = 0; j < 4; ++j) acc[i][j] += a[i] * b[j];
        }
        __syncthreads();
    }
#pragma unroll
    for (int i = 0; i < 4; ++i)
#pragma unroll
        for (int j = 0; j < 4; ++j) {
            const int row = row0 + ty * 4 + i, col = col0 + tx * 4 + j;
            if (col < N) {
                float v = acc[i][j];
                if (EPI == 1) v += R[(size_t)row * ldc + col];
                if (EPI == 2) v = sigmoidf_(v + bias[col]);
                C[(size_t)row * ldc + col] = v;
            }
        }
}

__global__ void __launch_bounds__(256) k_lru_gates(const float* __restrict__ proj, const float* __restrict__ conv_w, const float* __restrict__ conv_b, const float* __restrict__ wa, const float* __restrict__ ba,
                                                   const float* __restrict__ wx, const float* __restrict__ bx, const float* __restrict__ lam, float* __restrict__ aout, float* __restrict__ uout) {
    __shared__ float xc[4][64];
    const int tid = threadIdx.x, j = tid & 63, tt = tid >> 6, h = blockIdx.y;
    const int t = blockIdx.x * 4 + tt, s = t % S, c = h * 64 + j;
    float y = conv_b[c];
#pragma unroll
    for (int k = 0; k < 4; ++k) { const int sp = s - 3 + k; if (sp >= 0) y += conv_w[k * DL + c] * proj[(size_t)(t - 3 + k) * INC + c]; }
    xc[tt][j] = y;
    __syncthreads();
    float ra = ba[c], ri = bx[c];
    for (int i = 0; i < 64; ++i) { const float xv = xc[tt][i]; ra += xv * wa[(h * 64 + i) * 64 + j]; ri += xv * wx[(h * 64 + i) * 64 + j]; }
    const float r = sigmoidf_(ra), ig = sigmoidf_(ri);
    const float log_a = -8.0f * r * softplusf_(-lam[c]);
    const float a = expf(log_a);
    const float u = sqrtf(-expm1f(2.f * log_a)) * (ig * y);
    aout[(size_t)t * DL + c] = a; uout[(size_t)t * DL + c] = u;
}

__global__ void __launch_bounds__(64) k_lru_scan(const float* __restrict__ a, const float* __restrict__ u, const float* __restrict__ proj, float* __restrict__ mix) {
    const int idx = blockIdx.x * 64 + threadIdx.x;
    const int b = idx / DL, c = idx % DL;
    float h = 0.f;
    for (int s = 0; s < S; ++s) {
        const size_t t = (size_t)b * S + s;
        h = a[t * DL + c] * h + u[t * DL + c];
        mix[t * D + c] = h * gelu_tanh(proj[t * INC + DL + c]);
    }
}

__global__ void __launch_bounds__(256) k_retention(const float* __restrict__ proj, float* __restrict__ mix) {
    __shared__ float qs[128], ks[128], vs[128], po[2][128], stat[2];
    const int tid = threadIdx.x, b = blockIdx.x / NH, h = blockIdx.x % NH;
    const int e = tid & 127, dh = tid >> 7;
    const float gamma = 1.f - exp2f(-5.f - (float)h);
    float St[64];
#pragma unroll
    for (int i = 0; i < 64; ++i) St[i] = 0.f;
    const int dd = tid & 63;
    const float inv = exp2f(-(float)dd * (1.f / 64.f) * 13.287712379549449f);
    for (int s = 0; s < S; ++s) {
        const size_t t = (size_t)b * S + s;
        const float* row = proj + t * INC;
        if (tid < 128) {
            const float ang = (float)s * inv; const float cs = cosf(ang), sn = sinf(ang);
            const float q1 = row[1024 + h * HD + dd], q2 = row[1024 + h * HD + 64 + dd];
            const float k1 = row[1536 + h * HD + dd], k2 = row[1536 + h * HD + 64 + dd];
            if (tid < 64) { qs[dd] = q1 * cs - q2 * sn; ks[dd] = (k1 * cs - k2 * sn) * 0.08838834764831845f; }
            else { qs[64 + dd] = q1 * sn + q2 * cs; ks[64 + dd] = (k1 * sn + k2 * cs) * 0.08838834764831845f; }
        } else {
            vs[tid - 128] = row[2048 + h * HD + (tid - 128)];
        }
        __syncthreads();
        const float ve = vs[e]; float o = 0.f;
#pragma unroll
        for (int i = 0; i < 64; ++i) { const int d = dh * 64 + i; St[i] = gamma * St[i] + ks[d] * ve; o += qs[d] * St[i]; }
        po[dh][e] = o;
        __syncthreads();
        float ov = 0.f;
        if (tid < 128) {
            ov = po[0][tid] + po[1][tid];
            float sm = ov; for (int off = 32; off > 0; off >>= 1) sm += __shfl_xor(sm, off);
            if ((tid & 63) == 0) stat[tid >> 6] = sm;
        }
        __syncthreads();
        float mu = (stat[0] + stat[1]) * (1.f / 128.f);
        __syncthreads();
        if (tid < 128) {
            const float dv = ov - mu; float sq = dv * dv; for (int off = 32; off > 0; off >>= 1) sq += __shfl_xor(sq, off);
            if ((tid & 63) == 0) stat[tid >> 6] = sq;
        }
        __syncthreads();
        if (tid < 128) {
            const float var = (stat[0] + stat[1]) * (1.f / 128.f);
            const float on = (ov - mu) * rsqrtf(var + EPS);
            const float gr = row[2560 + h * HD + tid];
            mix[t * D + DL + h * HD + tid] = gr * sigmoidf_(gr) * on;
        }
        __syncthreads();
    }
}

__global__ void __launch_bounds__(256) k_route(const float* __restrict__ lg, const float* __restrict__ le, const float* __restrict__ bg, const float* __restrict__ be, int* __restrict__ eid, float* __restrict__ ew, int* __restrict__ counts) {
    const int t = blockIdx.x * 256 + threadIdx.x;
    float g[8]; float mx = -1e30f; int gs = 0;
#pragma unroll
    for (int i = 0; i < 8; ++i) { g[i] = lg[(size_t)t * 8 + i] + bg[i]; if (g[i] > mx) { mx = g[i]; gs = i; } }
    float den = 0.f;
#pragma unroll
    for (int i = 0; i < 8; ++i) den += expf(g[i] - mx);
    const float gw = 1.f / den;
    float v0 = -1e30f, v1 = -1e30f; int i0 = 0, i1 = 0;
    for (int i = 0; i < 8; ++i) {
        const float v = le[(size_t)t * 64 + gs * 8 + i] + be[gs * 8 + i];
        if (v > v0) { v1 = v0; i1 = i0; v0 = v; i0 = i; } else if (v > v1) { v1 = v; i1 = i; }
    }
    const float e1 = expf(v1 - v0), w0 = 1.f / (1.f + e1), w1 = e1 / (1.f + e1);
    eid[t * 2] = gs * 8 + i0; eid[t * 2 + 1] = gs * 8 + i1; ew[t * 2] = w0 * gw; ew[t * 2 + 1] = w1 * gw;
    atomicAdd(&counts[gs * 8 + i0], 1); atomicAdd(&counts[gs * 8 + i1], 1);
}
__global__ void k_offsets(const int* __restrict__ counts, int* __restrict__ offs, int* __restrict__ cursor) {
    if (threadIdx.x == 0) { int a = 0; for (int e = 0; e < NE; ++e) { offs[e] = a; cursor[e] = 0; a += counts[e]; } offs[NE] = a; }
}
__global__ void __launch_bounds__(256) k_fill(const int* __restrict__ eid, const int* __restrict__ offs, int* __restrict__ cursor, int* __restrict__ list) {
    const int a = blockIdx.x * 256 + threadIdx.x;
    const int e = eid[a]; const int pos = atomicAdd(&cursor[e], 1); list[offs[e] + pos] = a;
}
__global__ void __launch_bounds__(256) k_moe_up(const float* __restrict__ hf, const float* __restrict__ w1, const float* __restrict__ w3, const int* __restrict__ offs, const int* __restrict__ list, float* __restrict__ act) {
    const int e = blockIdx.z, beg = offs[e], cnt = offs[e + 1] - beg, r0 = blockIdx.y * 64;
    if (r0 >= cnt) return;
    __shared__ float As[16][64 + 4], B1[16][64 + 4], B3[16][64 + 4];
    const int tid = threadIdx.x, tx = tid & 15, ty = tid >> 4, col0 = blockIdx.x * 64;
    const float* W1 = w1 + (size_t)e * D * DE; const float* W3 = w3 + (size_t)e * D * DE;
    const int lr = tid >> 2; const int slotr = r0 + lr < cnt ? r0 + lr : cnt - 1; const int tok = list[beg + slotr] >> 1;
    float a1[4][4] = {}, a3[4][4] = {};
    for (int k0 = 0; k0 < D; k0 += 16) {
        { const int kk = (tid & 3) * 4; const float4 v = *(const float4*)(hf + (size_t)tok * D + k0 + kk);
          As[kk + 0][lr] = v.x; As[kk + 1][lr] = v.y; As[kk + 2][lr] = v.z; As[kk + 3][lr] = v.w; }
        { const int kk = tid >> 4, c = (tid & 15) * 4; const float4 u = *(const float4*)(W1 + (size_t)(k0 + kk) * DE + col0 + c); const float4 w = *(const float4*)(W3 + (size_t)(k0 + kk) * DE + col0 + c);
          B1[kk][c] = u.x; B1[kk][c + 1] = u.y; B1[kk][c + 2] = u.z; B1[kk][c + 3] = u.w; B3[kk][c] = w.x; B3[kk][c + 1] = w.y; B3[kk][c + 2] = w.z; B3[kk][c + 3] = w.w; }
        __syncthreads();
#pragma unroll
        for (int kk = 0; kk < 16; ++kk) {
            float a[4], b1[4], b3[4];
#pragma unroll
            for (int i = 0; i < 4; ++i) { a[i] = As[kk][ty * 4 + i]; b1[i] = B1[kk][tx * 4 + i]; b3[i] = B3[kk][tx * 4 + i]; }
#pragma unroll
            for (int i = 0; i < 4; ++i)
#pragma unroll
                for (int j = 0; j < 4; ++j) { a1[i][j] += a[i] * b1[j]; a3[i][j] += a[i] * b3[j]; }
        }
        __syncthreads();
    }
#pragma unroll
    for (int i = 0; i < 4; ++i) { const int r = r0 + ty * 4 + i; if (r < cnt) {
#pragma unroll
        for (int j = 0; j < 4; ++j) { const float h1 = a1[i][j]; act[(size_t)(beg + r) * DE + col0 + tx * 4 + j] = h1 * sigmoidf_(h1) * a3[i][j]; } } }
}
__global__ void __launch_bounds__(256) k_moe_down(const float* __restrict__ act, const float* __restrict__ w2, const int* __restrict__ offs, const int* __restrict__ list, const float* __restrict__ ew, float* __restrict__ Y0, float* __restrict__ Y1) {
    const int e = blockIdx.z, beg = offs[e], cnt = offs[e + 1] - beg, r0 = blockIdx.y * 64;
    if (r0 >= cnt) return;
    __shared__ float As[16][64 + 4], Bs[16][64 + 4];
    const int tid = threadIdx.x, tx = tid & 15, ty = tid >> 4, col0 = blockIdx.x * 64;
    const float* W2 = w2 + (size_t)e * DE * D;
    const int lr = tid >> 2; const int slotr = r0 + lr < cnt ? r0 + lr : cnt - 1;
    float acc[4][4] = {};
    for (int k0 = 0; k0 < DE; k0 += 16) {
        { const int kk = (tid & 3) * 4; const float4 v = *(const float4*)(act + (size_t)(beg + slotr) * DE + k0 + kk);
          As[kk + 0][lr] = v.x; As[kk + 1][lr] = v.y; As[kk + 2][lr] = v.z; As[kk + 3][lr] = v.w; }
        { const int kk = tid >> 4, c = (tid & 15) * 4; const float4 u = *(const float4*)(W2 + (size_t)(k0 + kk) * D + col0 + c);
          Bs[kk][c] = u.x; Bs[kk][c + 1] = u.y; Bs[kk][c + 2] = u.z; Bs[kk][c + 3] = u.w; }
        __syncthreads();
#pragma unroll
        for (int kk = 0; kk < 16; ++kk) {
            float a[4], b[4];
#pragma unroll
            for (int i = 0; i < 4; ++i) { a[i] = As[kk][ty * 4 + i]; b[i] = Bs[kk][tx * 4 + i]; }
#pragma unroll
            for (int i = 0; i < 4; ++i)
#pragma unroll
                for (int j = 0; j < 4; ++j) acc[i][j] += a[i] * b[j];
        }
        __syncthreads();
    }
#pragma unroll
    for (int i = 0; i < 4; ++i) { const int r = r0 + ty * 4 + i; if (r < cnt) {
        const int aid = list[beg + r]; const int tok = aid >> 1; float* Y = (aid & 1) ? Y1 : Y0; const float w = ew[aid];
#pragma unroll
        for (int j = 0; j < 4; ++j) Y[(size_t)tok * D + col0 + tx * 4 + j] = w * acc[i][j]; } }
}
}

extern "C" void kernel_launch(void* const* d_in, const int* in_sizes, int n_in, void* d_out, int out_size, void* d_ws, size_t ws_size, hipStream_t stream) {
    using namespace gold;
    const float* x = (const float*)d_in[0]; const float* p = (const float*)d_in[1]; const float* g_mix = (const float*)d_in[2]; const float* w_in = (const float*)d_in[3];
    const float* conv_w = (const float*)d_in[4]; const float* conv_b = (const float*)d_in[5]; const float* wa = (const float*)d_in[6]; const float* ba = (const float*)d_in[7];
    const float* wx = (const float*)d_in[8]; const float* bx = (const float*)d_in[9]; const float* lam = (const float*)d_in[10]; const float* w_out = (const float*)d_in[11];
    const float* g_ffn = (const float*)d_in[12]; const float* w_rg = (const float*)d_in[13]; const float* b_rg = (const float*)d_in[14]; const float* w_re = (const float*)d_in[15];
    const float* b_re = (const float*)d_in[16]; const float* w1 = (const float*)d_in[17]; const float* w3 = (const float*)d_in[18]; const float* w2 = (const float*)d_in[19];
    const float* g_ple = (const float*)d_in[20]; const float* w_pg = (const float*)d_in[21]; const float* b_pg = (const float*)d_in[22]; const float* w_pp = (const float*)d_in[23];
    const float* g_final = (const float*)d_in[24];
    float* out = (float*)d_out;
    const size_t X = (size_t)T * D;
    float* R0 = (float*)d_ws; float* R1 = R0 + X; float* R2 = R1 + X; float* R3 = R2 + X; float* R4 = R3 + X;
    float* lg = R4; float* le = lg + (size_t)T * 8; int* eid = (int*)(le + (size_t)T * 64); float* ew = (float*)(eid + T * 2);
    int* counts = (int*)(ew + T * 2); int* offs = counts + 64; int* cursor = offs + 80; int* list = cursor + 64;
    k_rmsnorm<<<T, 256, 0, stream>>>(x, nullptr, nullptr, g_mix, nullptr, R3);
    float* proj = R0;
    k_sgemm<0><<<dim3(INC / 64, T / 64), 256, 0, stream>>>(R3, D, w_in, INC, proj, INC, INC, D, nullptr, nullptr);
    float* mix = R3; float* aa = out; float* uu = out + (size_t)T * DL;
    k_lru_gates<<<dim3(T / 4, 8), 256, 0, stream>>>(proj, conv_w, conv_b, wa, ba, wx, bx, lam, aa, uu);
    k_lru_scan<<<B * DL / 64, 64, 0, stream>>>(aa, uu, proj, mix);
    k_retention<<<B * NH, 256, 0, stream>>>(proj, mix);
    float* x1 = R0;
    k_sgemm<1><<<dim3(D / 64, T / 64), 256, 0, stream>>>(mix, D, w_out, D, x1, D, D, D, x, nullptr);
    float* hf = R1;
    k_rmsnorm<<<T, 256, 0, stream>>>(x1, nullptr, nullptr, g_ffn, nullptr, hf);
    k_sgemm<0><<<dim3(1, T / 64), 256, 0, stream>>>(hf, D, w_rg, NG, lg, NG, NG, D, nullptr, nullptr);
    k_sgemm<0><<<dim3(1, T / 64), 256, 0, stream>>>(hf, D, w_re, NE, le, NE, NE, D, nullptr, nullptr);
    hipMemsetAsync(counts, 0, 64 * sizeof(int), stream);
    k_route<<<T / 256, 256, 0, stream>>>(lg, le, b_rg, b_re, eid, ew, counts);
    k_offsets<<<1, 64, 0, stream>>>(counts, offs, cursor);
    k_fill<<<2 * T / 256, 256, 0, stream>>>(eid, offs, cursor, list);
    float* act = out; float* Y0 = R2; float* Y1 = R3;
    const int maxTiles = 2 * T / 64;
    k_moe_up<<<dim3(DE / 64, maxTiles, NE), 256, 0, stream>>>(hf, w1, w3, offs, list, act);
    k_moe_down<<<dim3(D / 64, maxTiles, NE), 256, 0, stream>>>(act, w2, offs, list, ew, Y0, Y1);
    float* x2 = R0; float* hg = R1;
    k_rmsnorm<<<T, 256, 0, stream>>>(x1, Y0, Y1, g_ple, x2, hg);
    float* gate = R2; float* pp = R3;
    k_sgemm<2><<<dim3(D / 64, T / 64), 256, 0, stream>>>(hg, D, w_pg, D, gate, D, D, D, nullptr, b_pg);
    k_sgemm<0><<<dim3(D / 64, T / 64), 256, 0, stream>>>(p, PLE, w_pp, D, pp, D, D, PLE, nullptr, nullptr);
    k_final<<<T, 256, 0, stream>>>(x2, gate, pp, g_final, out);
}
```

```cpp
#include <hip/hip_runtime.h>
#include <stdint.h>
#include <stdio.h>
#include <string.h>

typedef unsigned short bf16;
namespace cfg {
constexpr int D = 1024, B = 8, S = 4096, T = B * S, PLE = 256, DL = 512, DR = 512, NH = 4, HD = 128, INC = 3072;
constexpr int NE = 64, DE = 512, NG = 8, EPG = 8, CH = 128, NCH = S / CH;
constexpr float EPS = 1e-6f;
constexpr size_t MiB = 1u << 20;
constexpr size_t WS_CTL = 0;
constexpr size_t WS_RSTD0 = 1 * MiB, WS_RSTD1 = WS_RSTD0 + 128 * 1024, WS_RSTD2 = WS_RSTD1 + 128 * 1024;
constexpr size_t WS_EID = 2 * MiB, WS_EW = WS_EID + 256 * 1024, WS_LIST = WS_EW + 256 * 1024, WS_CNT = WS_LIST + 256 * 1024;
constexpr size_t WS_LOGITS = 3 * MiB;
constexpr size_t WS_LRU = 13 * MiB;
constexpr size_t WS_WIN = 16 * MiB, WS_WOUT = 22 * MiB, WS_WPG = 24 * MiB, WS_WPP = 26 * MiB, WS_WRT = 26 * MiB + 512 * 1024, WS_LRUW = 27 * MiB;
constexpr size_t WS_W13 = 28 * MiB, WS_W2 = 156 * MiB, WS_PB = 220 * MiB;
constexpr size_t WS_R64 = 236 * MiB;
constexpr size_t WS_PROJ = 300 * MiB;
constexpr size_t WS_D1 = 300 * MiB, WS_X1B = 364 * MiB, WS_Y = 428 * MiB, WS_PP = 428 * MiB;
constexpr size_t WS_END = 556 * MiB;
}
using namespace cfg;

__device__ __forceinline__ float bf2f(bf16 v) { return __uint_as_float((unsigned)v << 16); }
__device__ __forceinline__ bf16 f2bf(float f) { unsigned u = __float_as_uint(f); return (bf16)((u + 0x7fffu + ((u >> 16) & 1u)) >> 16); }
__device__ __forceinline__ float ldv(const float* p, size_t i) { return p[i]; }
__device__ __forceinline__ float ldv(const bf16* p, size_t i) { return bf2f(p[i]); }
__device__ __forceinline__ void stv(float* p, size_t i, float v) { p[i] = v; }
__device__ __forceinline__ void stv(bf16* p, size_t i, float v) { p[i] = f2bf(v); }

#define GAS __attribute__((address_space(1)))
#define LAS __attribute__((address_space(3)))
typedef unsigned v4u __attribute__((ext_vector_type(4)));
typedef unsigned v2u __attribute__((ext_vector_type(2)));
typedef float f32x4 __attribute__((ext_vector_type(4)));
typedef float f32x2 __attribute__((ext_vector_type(2)));
typedef short bf16x8 __attribute__((ext_vector_type(8)));
typedef short bf16x4 __attribute__((ext_vector_type(4)));
typedef GAS unsigned gu32;
#define RLX_AGENT __ATOMIC_RELAXED, __HIP_MEMORY_SCOPE_AGENT
#define LDS_WAIT() asm volatile("s_waitcnt lgkmcnt(0)" ::: "memory")
#define VM_WAIT() asm volatile("s_waitcnt vmcnt(0)" ::: "memory")
__device__ __forceinline__ unsigned pk2(float lo, float hi) { return (unsigned)f2bf(lo) | ((unsigned)f2bf(hi) << 16); }
typedef __bf16 hwbf16x2 __attribute__((ext_vector_type(2)));
__device__ __forceinline__ unsigned cvt_pk_bf16(float lo, float hi) { f32x2 v = {lo, hi}; hwbf16x2 b = __builtin_convertvector(v, hwbf16x2); return __builtin_bit_cast(unsigned, b); }
__device__ __forceinline__ float bflo(unsigned w) { return __uint_as_float(w << 16); }
__device__ __forceinline__ float bfhi(unsigned w) { return __uint_as_float(w & 0xffff0000u); }
__device__ __forceinline__ float fast_sigmoid(float x) { return __builtin_amdgcn_rcpf(1.f + __builtin_amdgcn_exp2f(-1.4426950408889634f * x)); }

#define XB_TMO      128
#define XB_XCNT(j)  (256  + 64 * (j))
#define XB_XSUB(j)  (1280 + 64 * (j))
#define XB_XGEN(j)  (2304 + 64 * (j))
#define XB_TOP      3328
#define XB_TOPGEN   3392
#define XCD_BAR_WORDS 3456
#define XB_SPIN_CAP (1u << 18)
__device__ __forceinline__ unsigned xb_ld(unsigned* p)              { return __hip_atomic_load(p, __ATOMIC_RELAXED, __HIP_MEMORY_SCOPE_AGENT); }
__device__ __forceinline__ unsigned xb_add(unsigned* p, unsigned v) { return __hip_atomic_fetch_add(p, v, __ATOMIC_RELAXED, __HIP_MEMORY_SCOPE_AGENT); }
__device__ __forceinline__ unsigned xb_xcc_id() { return (unsigned)__builtin_amdgcn_s_getreg((3 << 11) | 20) & 0xFu; }
#define XB_SPIN(cond, bar) do { unsigned _sp = 0; while (cond) { __builtin_amdgcn_s_sleep(1); \
    if ((++_sp & 255u) == 0u) { if (xb_ld(&(bar)[XB_TMO])) break; if (_sp > XB_SPIN_CAP) { atomicAdd(&(bar)[XB_TMO], 1u); break; } } } } while (0)
struct XcdBarrier { unsigned* bar; unsigned x; volatile LAS unsigned* st; };
__device__ __forceinline__ XcdBarrier xcd_barrier_post(unsigned* bar, volatile LAS unsigned* st) {
    XcdBarrier b; b.bar = bar; b.x = xb_xcc_id(); b.st = st;
    if (threadIdx.x == 0) (void)xb_add(&bar[XB_XCNT(b.x)], 1u);
    return b;
}
__device__ __forceinline__ void xcd_barrier_complete(unsigned* bar, unsigned x, unsigned& nloc, unsigned& nx) {
    const unsigned G = gridDim.x * gridDim.y * gridDim.z;
    unsigned sum, cnt, mine, sp = 0u;
    for (;;) {
        sum = 0u; cnt = 0u; mine = 0u;
#pragma unroll
        for (unsigned j = 0; j < 16; ++j) { const unsigned c = xb_ld(&bar[XB_XCNT(j)]); sum += c; cnt += (c > 0u) ? 1u : 0u; mine = (j == x) ? c : mine; }
        if (sum == G) break;
        __builtin_amdgcn_s_sleep(1);
        if ((++sp & 255u) == 0u) { if (xb_ld(&bar[XB_TMO])) break; if (sp > XB_SPIN_CAP) { atomicAdd(&bar[XB_TMO], 1u); break; } }
    }
    nloc = mine > 0u ? mine : 1u; nx = cnt > 0u ? cnt : 1u;
}
__device__ __forceinline__ void xcd_barrier(const XcdBarrier& b) {
    asm volatile("s_waitcnt vmcnt(0)" ::: "memory");
    __syncthreads();
    if (threadIdx.x == 0) {
        unsigned* bar = b.bar;
        __builtin_amdgcn_s_waitcnt(0);
        unsigned nloc = b.st[0], nx = b.st[1];
        if (nloc == 0u) { xcd_barrier_complete(bar, b.x, nloc, nx); b.st[0] = nloc; b.st[1] = nx; }
        const unsigned old = xb_add(&bar[XB_XSUB(b.x)], 1u);
        const unsigned gen = old / nloc;
        if (old + 1u == (gen + 1u) * nloc) {
            __builtin_amdgcn_fence(__ATOMIC_RELEASE, "agent");
            asm volatile("s_waitcnt vmcnt(0)" ::: "memory");
            const unsigned og = xb_add(&bar[XB_TOP], 1u);
            const unsigned tg = og / nx;
            if (og + 1u == (tg + 1u) * nx) xb_add(&bar[XB_TOPGEN], 1u);
            else XB_SPIN(xb_ld(&bar[XB_TOPGEN]) == tg, bar);
            __builtin_amdgcn_fence(__ATOMIC_ACQUIRE, "agent");
            xb_add(&bar[XB_XGEN(b.x)], 1u);
            asm volatile("s_waitcnt vmcnt(0)" ::: "memory");
        } else {
            XB_SPIN(xb_ld(&bar[XB_XGEN(b.x)]) == gen, bar);
            __builtin_amdgcn_fence(__ATOMIC_ACQUIRE, "agent");
            asm volatile("s_waitcnt vmcnt(0)" ::: "memory");
        }
    }
    __syncthreads();
}

constexpr int NWAVES = 8, NTHR = NWAVES * 64;
constexpr int RING_OFF = 0, RING_BYTES = 131072;
constexpr int LDSCTL_OFF = RING_BYTES;
constexpr int UTAB_OFF = LDSCTL_OFF + 1024;
constexpr int MAXU = 6;
constexpr int UTABF_OFF = UTAB_OFF + MAXU * 1024;
constexpr int SCHED_OFF = UTABF_OFF + MAXU * 1024;
constexpr int LDS_BYTES = SCHED_OFF + 1024;
static_assert(LDS_BYTES <= 160 * 1024 && LDS_BYTES > 80 * 1024, "LDS map");
constexpr int CW_TMO = 0, CW_BAR = 4096;

namespace pg8 {
constexpr int BM = 256, BK = 64, HALF = 128, HTB = HALF * BK * 2, STAGE_BYTES = 8 * HTB;
__host__ __device__ __forceinline__ int lds_byte(int r, int c) { const int st = (r >> 4) * 2 + (c >> 5), rr = r & 15, cc = c & 31, ob = rr * 64 + cc * 2; return st * 1024 + (ob ^ (((ob >> 9) & 1) << 5)); }
__host__ __device__ __forceinline__ void stage_rc(int b, int& R, int& C) { const int st = b / 1024, sb = b % 1024, swz = sb ^ (((sb >> 9) & 1) << 5); R = (st >> 1) * 16 + swz / 64; C = (st & 1) * 32 + (swz % 64) / 2; }
__host__ __device__ __forceinline__ int perm32(int rho) { const int n = rho >> 4, i = rho & 15; return 8 * (i >> 2) + 4 * n + (i & 3); }

struct Unit { int pm, pn, e, rows, slot0, ui; };

struct PlainSched {
    static constexpr bool GATHER = false;
    const bf16* A; const bf16* Bt; int K; int nM, nN, nwg, G, c;
    __device__ void init(const bf16* A_, const bf16* Bt_, int M, int N, int K_, int G_, int c_) { A = A_; Bt = Bt_; K = K_; nM = M / BM; nN = N / BM; nwg = nM * nN; G = G_; c = c_; }
    __device__ __forceinline__ bool next(int i, Unit& u) const {
        const long L = (long)i * G + c; if (L >= nwg) return false;
        int wgid = (int)L; { const int q = nwg / 8, r = nwg % 8, xcd = wgid % 8, off = wgid / 8; wgid = (xcd < r ? xcd * (q + 1) : r * (q + 1) + (xcd - r) * q) + off; }
        const int nig = 8 * nN, gid = wgid / nig, fm = gid * 8, gsz = (nM - fm) < 8 ? (nM - fm) : 8;
        u.pm = fm + ((wgid % nig) % gsz); u.pn = (wgid % nig) / gsz; u.e = 0; u.rows = 256; u.slot0 = 0; u.ui = i; return true;
    }
    __device__ __forceinline__ const char* a_base(const Unit& u) const { return (const char*)A + (size_t)u.pm * (size_t)(BM * 2) * K; }
    __device__ __forceinline__ const char* b_base(const Unit& u) const { return (const char*)Bt + (size_t)u.pn * (size_t)(BM * 2) * K; }
    __device__ __forceinline__ unsigned a_rowoff(const Unit&, int r) const { return (unsigned)r * (unsigned)K * 2u; }
};

template <class Epi, class Sched>
__device__ __forceinline__ void gemm_phase(LAS unsigned char* lds, const Sched& S, const Epi& E) {
    const int tid = threadIdx.x, wid = __builtin_amdgcn_readfirstlane(tid >> 6), lane = tid & 63, wr = wid >> 2, wc = wid & 3, fr = lane & 15, fq = lane >> 4;
    const int K = S.K, nt = K / BK;
    int Rr[2], Cc[2]; unsigned voffB[2];
#pragma unroll
    for (int i = 0; i < 2; ++i) { stage_rc(tid * 16 + i * 8192, Rr[i], Cc[i]); const int Rb = (Rr[i] & ~31) + perm32(Rr[i] & 31); voffB[i] = (unsigned)(Rb * K + Cc[i]) * 2u; }
    const size_t kstep = (size_t)(BK * 2);
    const size_t hstep = (size_t)HALF * K * 2;
    const unsigned ldsw = (unsigned)wid * 1024u;
    const int aoff = lds_byte(wr * 64 + fr, fq * 8), boff = lds_byte(wc * 32 + fr, fq * 8);
#define PG8_SA(b, h) (((b) * 2 + (h)) * HTB)
#define PG8_SB(b, h) ((4 + (b) * 2 + (h)) * HTB)
#define PG8_STAGE(bufoff, gbase, voff) do { _Pragma("unroll") for (int _i = 0; _i < 2; ++_i) \
        __builtin_amdgcn_global_load_lds((const unsigned*)((const char*)(gbase) + (voff)[_i]), (LAS unsigned*)(lds + (bufoff) + ldsw + _i * 8192), 16, 0, 0); } while (0)
#define PG8_LDA(dst, b, h) do { _Pragma("unroll") for (int m = 0; m < 4; ++m) _Pragma("unroll") for (int k = 0; k < 2; ++k) dst[m][k] = *(const LAS bf16x8*)(lds + PG8_SA(b, h) + aoff + m * 2048 + k * 1024); } while (0)
#define PG8_LDB(dst, b, h) do { _Pragma("unroll") for (int n = 0; n < 2; ++n) _Pragma("unroll") for (int k = 0; k < 2; ++k) dst[n][k] = *(const LAS bf16x8*)(lds + PG8_SB(b, h) + boff + n * 2048 + k * 1024); } while (0)
#define PG8_MMA(ai, bj, At, Bt) do { __builtin_amdgcn_s_setprio(1); _Pragma("unroll") for (int m = 0; m < 4; ++m) _Pragma("unroll") for (int n = 0; n < 2; ++n) _Pragma("unroll") for (int k = 0; k < 2; ++k) \
        acc[ai][bj][m][n] = __builtin_amdgcn_mfma_f32_16x16x32_bf16(Bt[n][k], At[m][k], acc[ai][bj][m][n], 0, 0, 0); __builtin_amdgcn_s_setprio(0); } while (0)
#define PG8_WAIT_V(n) asm volatile("s_waitcnt vmcnt(" #n ")" ::: "memory")
#define PG8_WAIT_L(n) asm volatile("s_waitcnt lgkmcnt(" #n ")" ::: "memory")
#define PG8_BAR __builtin_amdgcn_s_barrier()
#define PG8_SCHED __builtin_amdgcn_sched_barrier(0)
#define PG8_VOFF(dst, u) do { _Pragma("unroll") for (int _h = 0; _h < 2; ++_h) _Pragma("unroll") for (int _i = 0; _i < 2; ++_i) dst[_h][_i] = S.a_rowoff(u, _h * HALF + Rr[_i]) + (unsigned)Cc[_i] * 2u; } while (0)
    Unit cur, nxt; int ui = 0;
    if (!S.next(0, cur)) return;
    f32x4 acc[2][2][4][2];
#pragma unroll
    for (int a = 0; a < 2; ++a)
#pragma unroll
        for (int b = 0; b < 2; ++b)
#pragma unroll
            for (int m = 0; m < 4; ++m)
#pragma unroll
                for (int n = 0; n < 2; ++n) acc[a][b][m][n] = (f32x4){0.f, 0.f, 0.f, 0.f};
    bf16x8 At[4][2], B0[2][2], B1[2][2];
    unsigned va[2][2], nva[2][2];
    PG8_VOFF(va, cur);
    const char* cA = S.a_base(cur); const char* cB = S.b_base(cur);
    PG8_STAGE(PG8_SB(0, 0), cB, voffB); PG8_STAGE(PG8_SB(0, 1), cB + hstep, voffB); PG8_STAGE(PG8_SA(0, 0), cA, va[0]); PG8_STAGE(PG8_SA(0, 1), cA, va[1]);
    if (wr == 1) PG8_BAR;
    PG8_WAIT_V(2); PG8_BAR;
    PG8_STAGE(PG8_SB(1, 0), cB + kstep, voffB); PG8_STAGE(PG8_SA(1, 0), cA + kstep, va[0]); PG8_STAGE(PG8_SB(1, 1), cB + hstep + kstep, voffB);
    PG8_WAIT_V(6); PG8_BAR;
    for (;;) {
        const bool has_next = S.next(ui + 1, nxt);
        const char* nA = has_next ? S.a_base(nxt) : cA; const char* nB = has_next ? S.b_base(nxt) : cB;
        if (has_next) { PG8_VOFF(nva, nxt); } else {
#pragma unroll
            for (int h = 0; h < 2; ++h)
#pragma unroll
                for (int i = 0; i < 2; ++i) nva[h][i] = va[h][i]; }
        for (int t = 0; t < nt; t += 2) {
            const bool last = (t == nt - 2);
            const char* a1 = cA + (size_t)(t + 1) * kstep;
            const char* a2 = last ? nA : cA + (size_t)(t + 2) * kstep; const char* b2 = last ? nB : cB + (size_t)(t + 2) * kstep;
            const char* a3 = a2 + kstep; const char* b3 = b2 + kstep;
            unsigned v2[2][2];
#pragma unroll
            for (int h = 0; h < 2; ++h)
#pragma unroll
                for (int i = 0; i < 2; ++i) v2[h][i] = last ? nva[h][i] : va[h][i];
            PG8_LDB(B0, 0, 0); PG8_LDB(B1, 0, 1); PG8_SCHED; PG8_LDA(At, 0, 0); PG8_STAGE(PG8_SA(1, 1), a1, va[1]);
            PG8_WAIT_V(8); PG8_WAIT_L(0); PG8_BAR; PG8_MMA(0, 0, At, B0); PG8_MMA(0, 1, At, B1); PG8_BAR; PG8_SCHED;
            PG8_LDA(At, 0, 1); PG8_STAGE(PG8_SB(0, 0), b2, voffB); PG8_STAGE(PG8_SB(0, 1), b2 + hstep, voffB); PG8_STAGE(PG8_SA(0, 0), a2, v2[0]);
            PG8_WAIT_V(8); PG8_WAIT_L(0); PG8_BAR; PG8_MMA(1, 0, At, B0); PG8_MMA(1, 1, At, B1); PG8_BAR; PG8_SCHED;
            PG8_LDB(B0, 1, 0); PG8_LDB(B1, 1, 1); PG8_SCHED; PG8_LDA(At, 1, 0); PG8_STAGE(PG8_SA(0, 1), a2, v2[1]);
            PG8_WAIT_V(8); PG8_WAIT_L(0); PG8_BAR; PG8_MMA(0, 0, At, B0); PG8_MMA(0, 1, At, B1); PG8_BAR; PG8_SCHED;
            PG8_LDA(At, 1, 1); PG8_STAGE(PG8_SB(1, 0), b3, voffB); PG8_STAGE(PG8_SB(1, 1), b3 + hstep, voffB); PG8_STAGE(PG8_SA(1, 0), a3, v2[0]);
            PG8_WAIT_V(8); PG8_WAIT_L(0); PG8_BAR; PG8_MMA(1, 0, At, B0); PG8_MMA(1, 1, At, B1); PG8_BAR; PG8_SCHED;
        }
        if (wr == 0) PG8_BAR;
        E(acc, cur, wr, wc, fr, fq);
        if (!has_next) break;
#pragma unroll
        for (int a = 0; a < 2; ++a)
#pragma unroll
            for (int b = 0; b < 2; ++b)
#pragma unroll
                for (int m = 0; m < 4; ++m)
#pragma unroll
                    for (int n = 0; n < 2; ++n) acc[a][b][m][n] = (f32x4){0.f, 0.f, 0.f, 0.f};
        cur = nxt; cA = nA; cB = nB; ++ui;
#pragma unroll
        for (int h = 0; h < 2; ++h)
#pragma unroll
            for (int i = 0; i < 2; ++i) va[h][i] = nva[h][i];
        if (wr == 1) PG8_BAR;
    }
    PG8_WAIT_V(0);
    PG8_BAR;
#undef PG8_SA
#undef PG8_SB
#undef PG8_STAGE
#undef PG8_LDA
#undef PG8_LDB
#undef PG8_MMA
#undef PG8_WAIT_V
#undef PG8_WAIT_L
#undef PG8_BAR
#undef PG8_SCHED
#undef PG8_VOFF
}

struct EpiRowScaleBf16 {
    bf16* O; int ldc; const float* rs;
    __device__ __forceinline__ void operator()(const f32x4 (&acc)[2][2][4][2], const Unit& u, int wr, int wc, int fr, int fq) const {
        const int row0 = u.pm * BM + wr * 64 + fr, col0 = u.pn * BM + wc * 32 + 8 * fq;
        float sc[2][4];
#pragma unroll
        for (int ai = 0; ai < 2; ++ai)
#pragma unroll
            for (int m = 0; m < 4; ++m) sc[ai][m] = rs[row0 + ai * HALF + m * 16];
#pragma unroll
        for (int ai = 0; ai < 2; ++ai)
#pragma unroll
            for (int m = 0; m < 4; ++m) { const int row = row0 + ai * HALF + m * 16; const float s = sc[ai][m]; bf16* rowp = O + (size_t)row * ldc + col0;
#pragma unroll
                for (int bj = 0; bj < 2; ++bj) { const f32x4 v0 = acc[ai][bj][m][0] * s, v1 = acc[ai][bj][m][1] * s;
                    v4u w; w.x = cvt_pk_bf16(v0[0], v0[1]); w.y = cvt_pk_bf16(v0[2], v0[3]); w.z = cvt_pk_bf16(v1[0], v1[1]); w.w = cvt_pk_bf16(v1[2], v1[3]);
                    *(v4u*)(rowp + bj * HALF) = w; } }
    }
};
struct EpiPlainBf16 {
    bf16* O; int ldc;
    __device__ __forceinline__ void operator()(const f32x4 (&acc)[2][2][4][2], const Unit& u, int wr, int wc, int fr, int fq) const {
        const int row0 = u.pm * BM + wr * 64 + fr, col0 = u.pn * BM + wc * 32 + 8 * fq;
#pragma unroll
        for (int ai = 0; ai < 2; ++ai)
#pragma unroll
            for (int m = 0; m < 4; ++m) { const int row = row0 + ai * HALF + m * 16; bf16* rowp = O + (size_t)row * ldc + col0;
#pragma unroll
                for (int bj = 0; bj < 2; ++bj) { const f32x4 v0 = acc[ai][bj][m][0], v1 = acc[ai][bj][m][1];
                    v4u w; w.x = cvt_pk_bf16(v0[0], v0[1]); w.y = cvt_pk_bf16(v0[2], v0[3]); w.z = cvt_pk_bf16(v1[0], v1[1]); w.w = cvt_pk_bf16(v1[2], v1[3]);
                    *(v4u*)(rowp + bj * HALF) = w; } }
    }
};
struct EpiGateBf16 {
    bf16* O; int ldc; const float* rs; const float* bias;
    __device__ __forceinline__ void operator()(const f32x4 (&acc)[2][2][4][2], const Unit& u, int wr, int wc, int fr, int fq) const {
        const int row0 = u.pm * BM + wr * 64 + fr, col0 = u.pn * BM + wc * 32 + 8 * fq;
        float sc[2][4]; f32x4 bv[2][2];
#pragma unroll
        for (int ai = 0; ai < 2; ++ai)
#pragma unroll
            for (int m = 0; m < 4; ++m) sc[ai][m] = rs[row0 + ai * HALF + m * 16];
#pragma unroll
        for (int bj = 0; bj < 2; ++bj)
#pragma unroll
            for (int n = 0; n < 2; ++n) bv[bj][n] = *(const f32x4*)(bias + col0 + bj * HALF + 4 * n);
#pragma unroll
        for (int ai = 0; ai < 2; ++ai)
#pragma unroll
            for (int m = 0; m < 4; ++m) { const int row = row0 + ai * HALF + m * 16; const float s = sc[ai][m]; bf16* rowp = O + (size_t)row * ldc + col0;
#pragma unroll
                for (int bj = 0; bj < 2; ++bj) { f32x4 v0 = acc[ai][bj][m][0] * s + bv[bj][0], v1 = acc[ai][bj][m][1] * s + bv[bj][1];
#pragma unroll
                    for (int q = 0; q < 4; ++q) { v0[q] = fast_sigmoid(v0[q]); v1[q] = fast_sigmoid(v1[q]); }
                    v4u w; w.x = cvt_pk_bf16(v0[0], v0[1]); w.y = cvt_pk_bf16(v0[2], v0[3]); w.z = cvt_pk_bf16(v1[0], v1[1]); w.w = cvt_pk_bf16(v1[2], v1[3]);
                    *(v4u*)(rowp + bj * HALF) = w; } }
    }
};
}

struct Args { const float* in[25]; float* out; unsigned char* ws; int ph_lo, ph_hi; };

struct Frame {
    LAS unsigned char* lds; volatile LAS unsigned* MISC; gu32* ctl; int tid, lane, wave, vcu, G;
};
__device__ __forceinline__ float wave_sum(float v) {
#pragma unroll
    for (int o = 1; o < 64; o <<= 1) v += __shfl_xor(v, o);
    return v;
}
template <int RM, bool HAS_CS>
__device__ __forceinline__ void p0_transpose_item(const float* __restrict__ W, int K, int N, bf16* __restrict__ WT, int row_off, const float* __restrict__ cs, LAS float* scr, int item, int lane) {
    const int nblk = N / 32, kb = item / nblk, nb = item % nblk, k0 = 64 * kb, n0 = 32 * nb;
    const int c = lane & 7;
    f32x4 s0 = {1.f, 1.f, 1.f, 1.f}, s1 = {1.f, 1.f, 1.f, 1.f};
    if (HAS_CS) { s0 = *(const f32x4*)(cs + k0 + 8 * c); s1 = *(const f32x4*)(cs + k0 + 8 * c + 4); }
#pragma unroll 8
    for (int i = 0; i < 32; ++i) { const int kk = 2 * i + (lane >> 5); scr[kk * 33 + (lane & 31)] = W[(size_t)(k0 + kk) * N + n0 + (lane & 31)]; }
    LDS_WAIT(); asm volatile("" ::: "memory");
#pragma unroll
    for (int j = 0; j < 4; ++j) { const int n = (lane >> 3) + 8 * j; const LAS float* s = scr + (8 * c) * 33 + n;
        v4u o; o.x = pk2(s[0 * 33] * s0.x, s[1 * 33] * s0.y); o.y = pk2(s[2 * 33] * s0.z, s[3 * 33] * s0.w); o.z = pk2(s[4 * 33] * s1.x, s[5 * 33] * s1.y); o.w = pk2(s[6 * 33] * s1.z, s[7 * 33] * s1.w);
        const int nn = n0 + n; const int orow = RM == 0 ? row_off + nn : (row_off + 8 * (nn >> 2) + (nn & 3) + (RM == 2 ? 4 : 0));
        *(GAS v4u*)(WT + (size_t)orow * K + k0 + 8 * c) = o; }
    LDS_WAIT(); asm volatile("" ::: "memory");
}
struct Ptrs {
    const float *x, *p, *g_mix, *w_in, *conv_w, *conv_b, *wa, *ba, *wx, *bx, *lam, *w_out, *g_ffn, *w_rg, *b_rg, *w_re, *b_re, *w1, *w3, *w2, *g_ple, *w_pg, *b_pg, *w_pp, *g_final;
    float* out; unsigned char* ws;
    float *rstd0, *rstd1, *rstd2; int* eid; float* ew; int* list; int* counts; int* goffs;
    bf16 *W_IN, *W_OUT, *W_PG, *W_PP, *WRT, *LRUW, *W13, *W2, *PB, *XB, *MIX, *ACT, *GATE, *PROJ, *D1, *X1B, *X2B, *Y, *PP;
};
__device__ __forceinline__ void make_ptrs(Ptrs& P, const Args& a) {
    P.x = a.in[0]; P.p = a.in[1]; P.g_mix = a.in[2]; P.w_in = a.in[3]; P.conv_w = a.in[4]; P.conv_b = a.in[5]; P.wa = a.in[6]; P.ba = a.in[7]; P.wx = a.in[8]; P.bx = a.in[9]; P.lam = a.in[10];
    P.w_out = a.in[11]; P.g_ffn = a.in[12]; P.w_rg = a.in[13]; P.b_rg = a.in[14]; P.w_re = a.in[15]; P.b_re = a.in[16]; P.w1 = a.in[17]; P.w3 = a.in[18]; P.w2 = a.in[19];
    P.g_ple = a.in[20]; P.w_pg = a.in[21]; P.b_pg = a.in[22]; P.w_pp = a.in[23]; P.g_final = a.in[24];
    P.out = a.out; P.ws = a.ws; unsigned char* ws = a.ws;
    P.rstd0 = (float*)(ws + WS_RSTD0); P.rstd1 = (float*)(ws + WS_RSTD1); P.rstd2 = (float*)(ws + WS_RSTD2);
    P.eid = (int*)(ws + WS_EID); P.ew = (float*)(ws + WS_EW); P.list = (int*)(ws + WS_LIST); P.counts = (int*)(ws + WS_CNT); P.goffs = P.counts + 256 * NE;
    P.W_IN = (bf16*)(ws + WS_WIN); P.W_OUT = (bf16*)(ws + WS_WOUT); P.W_PG = (bf16*)(ws + WS_WPG); P.W_PP = (bf16*)(ws + WS_WPP); P.WRT = (bf16*)(ws + WS_WRT); P.LRUW = (bf16*)(ws + WS_LRUW);
    P.W13 = (bf16*)(ws + WS_W13); P.W2 = (bf16*)(ws + WS_W2); P.PB = (bf16*)(ws + WS_PB);
    P.XB = (bf16*)(ws + WS_R64); P.MIX = (bf16*)(ws + WS_R64); P.ACT = (bf16*)(ws + WS_R64); P.GATE = (bf16*)(ws + WS_R64);
    P.PROJ = (bf16*)(ws + WS_PROJ); P.D1 = (bf16*)(ws + WS_D1); P.PP = (bf16*)(ws + WS_PP); P.X1B = (bf16*)(ws + WS_X1B); P.X2B = (bf16*)(ws + WS_X1B); P.Y = (bf16*)(ws + WS_Y);
}

__device__ __forceinline__ void p0_prologue(Frame& F, const Ptrs& P) {
    LAS float* scr = (LAS float*)(F.lds + RING_OFF + F.wave * 16384);
    const int gw = F.vcu * NWAVES + F.wave, NGW = F.G * NWAVES;
    constexpr int I_WIN = (D / 64) * (INC / 32), I_SQ = (D / 64) * (D / 32), I_WPP = (PLE / 64) * (D / 32), I_W1 = (D / 64) * (DE / 32), I_W2 = (DE / 64) * (D / 32);
    constexpr int NITEMS = I_WIN + 2 * I_SQ + I_WPP + NE * (2 * I_W1 + I_W2);
    for (int it = gw; it < NITEMS; it += NGW) {
        int r = it;
        if (r < I_WIN) { p0_transpose_item<0, true>(P.w_in, D, INC, P.W_IN, 0, P.g_mix, scr, r, F.lane); continue; } r -= I_WIN;
        if (r < I_SQ) { p0_transpose_item<0, false>(P.w_out, D, D, P.W_OUT, 0, nullptr, scr, r, F.lane); continue; } r -= I_SQ;
        if (r < I_SQ) { p0_transpose_item<0, true>(P.w_pg, D, D, P.W_PG, 0, P.g_ple, scr, r, F.lane); continue; } r -= I_SQ;
        if (r < I_WPP) { p0_transpose_item<0, false>(P.w_pp, PLE, D, P.W_PP, 0, nullptr, scr, r, F.lane); continue; } r -= I_WPP;
        const int per_e = 2 * I_W1 + I_W2, e = r / per_e; r -= e * per_e;
        if (r < I_W1) { p0_transpose_item<1, true>(P.w1 + (size_t)e * D * DE, D, DE, P.W13 + (size_t)e * D * D, 0, P.g_ffn, scr, r, F.lane); continue; } r -= I_W1;
        if (r < I_W1) { p0_transpose_item<2, true>(P.w3 + (size_t)e * D * DE, D, DE, P.W13 + (size_t)e * D * D, 0, P.g_ffn, scr, r, F.lane); continue; } r -= I_W1;
        p0_transpose_item<0, false>(P.w2 + (size_t)e * DE * D, DE, D, P.W2 + (size_t)e * D * DE, 0, nullptr, scr, r, F.lane);
    }
    for (int m = gw; m < T; m += NGW) {
        const GAS f32x4* xr = (const GAS f32x4*)(P.x + (size_t)m * D) + F.lane;
        f32x4 v[4]; float s = 0.f;
#pragma unroll
        for (int j = 0; j < 4; ++j) { v[j] = xr[64 * j]; s += (v[j].x * v[j].x + v[j].y * v[j].y) + (v[j].z * v[j].z + v[j].w * v[j].w); }
        s = wave_sum(s);
        GAS v2u* o8 = (GAS v2u*)(P.XB + (size_t)m * D) + F.lane;
#pragma unroll
        for (int j = 0; j < 4; ++j) { v2u w; w.x = pk2(v[j].x, v[j].y); w.y = pk2(v[j].z, v[j].w); o8[64 * j] = w; }
        if (F.lane == 0) P.rstd0[m] = 1.0f / sqrtf(s * (1.f / D) + EPS);
    }
    for (int m = gw; m < T; m += NGW) {
        const f32x4 v = *((const GAS f32x4*)(P.p + (size_t)m * PLE) + F.lane);
        v2u w; w.x = pk2(v.x, v.y); w.y = pk2(v.z, v.w); *((GAS v2u*)(P.PB + (size_t)m * PLE) + F.lane) = w;
    }
    for (int idx = (F.vcu * NTHR + F.tid); idx < 80 * D; idx += F.G * NTHR) {
        const int n = idx / D, k = idx % D; float v = 0.f;
        if (n < NG) v = P.w_rg[(size_t)k * NG + n] * P.g_ffn[k]; else if (n < NG + NE) v = P.w_re[(size_t)k * NE + (n - NG)] * P.g_ffn[k];
        const bf16 hi = f2bf(v); const bf16 lo = f2bf(v - bf2f(hi));
        P.WRT[idx] = hi; P.WRT[80 * D + idx] = lo;
    }
    for (int idx = (F.vcu * NTHR + F.tid); idx < 2 * 8 * 64 * 64; idx += F.G * NTHR) {
        const int g = idx >> 15, r = idx & 32767, hb = r >> 12, j = (r >> 6) & 63, i = r & 63;
        const float* w = g ? P.wx : P.wa;
        P.LRUW[idx] = f2bf(w[(hb * 64 + i) * 64 + j]);
    }
}


__device__ __forceinline__ f32x4 bf4(v2u w) { return (f32x4){bflo(w.x), bfhi(w.x), bflo(w.y), bfhi(w.y)}; }
__device__ __forceinline__ void p10_combine(Frame& F, const Ptrs& P) {
    const int gw = F.vcu * NWAVES + F.wave, NGW = F.G * NWAVES;
    for (int m = gw; m < T; m += NGW) {
        const size_t ro = (size_t)m * D;
        const GAS f32x4* xr = (const GAS f32x4*)(P.x + ro) + F.lane;
        const GAS v2u* d1 = (const GAS v2u*)(P.D1 + ro) + F.lane; const GAS v2u* y0 = (const GAS v2u*)(P.Y + ro) + F.lane; const GAS v2u* y1 = (const GAS v2u*)(P.Y + (size_t)T * D + ro) + F.lane;
        f32x4 v[4]; v2u a[4], b[4], c[4];
#pragma unroll
        for (int j = 0; j < 4; ++j) { v[j] = xr[64 * j]; a[j] = d1[64 * j]; b[j] = y0[64 * j]; c[j] = y1[64 * j]; }
        float s = 0.f;
#pragma unroll
        for (int j = 0; j < 4; ++j) { v[j] = (v[j] + bf4(a[j])) + (bf4(b[j]) + bf4(c[j])); s += (v[j].x * v[j].x + v[j].y * v[j].y) + (v[j].z * v[j].z + v[j].w * v[j].w); }
        s = wave_sum(s);
        GAS f32x4* o = (GAS f32x4*)(P.out + ro) + F.lane; GAS v2u* o8 = (GAS v2u*)(P.X2B + ro) + F.lane;
#pragma unroll
        for (int j = 0; j < 4; ++j) { o[64 * j] = v[j]; v2u w; w.x = pk2(v[j].x, v[j].y); w.y = pk2(v[j].z, v[j].w); o8[64 * j] = w; }
        if (F.lane == 0) P.rstd2[m] = 1.0f / sqrtf(s * (1.f / D) + EPS);
    }
}
__device__ __forceinline__ void p13_final(Frame& F, const Ptrs& P) {
    const int gw = F.vcu * NWAVES + F.wave, NGW = F.G * NWAVES;
    f32x4 gf[4];
#pragma unroll
    for (int j = 0; j < 4; ++j) gf[j] = *((const GAS f32x4*)P.g_final + F.lane + 64 * j);
    for (int m = gw; m < T; m += NGW) {
        const size_t ro = (size_t)m * D;
        GAS f32x4* xr = (GAS f32x4*)(P.out + ro) + F.lane;
        const GAS v2u* ga = (const GAS v2u*)(P.GATE + ro) + F.lane; const GAS v2u* pp = (const GAS v2u*)(P.PP + ro) + F.lane;
        f32x4 v[4]; v2u a[4], b[4];
#pragma unroll
        for (int j = 0; j < 4; ++j) { v[j] = xr[64 * j]; a[j] = ga[64 * j]; b[j] = pp[64 * j]; }
        float s = 0.f;
#pragma unroll
        for (int j = 0; j < 4; ++j) { v[j] = v[j] + bf4(a[j]) * bf4(b[j]); s += (v[j].x * v[j].x + v[j].y * v[j].y) + (v[j].z * v[j].z + v[j].w * v[j].w); }
        s = wave_sum(s);
        const float r = 1.0f / sqrtf(s * (1.f / D) + EPS);
#pragma unroll
        for (int j = 0; j < 4; ++j) xr[64 * j] = v[j] * r * gf[j];
    }
}
__device__ __forceinline__ LAS int* sched_offs(Frame& F) { return (LAS int*)(F.lds + SCHED_OFF); }
__device__ __forceinline__ LAS int* sched_tileb(Frame& F) { return (LAS int*)(F.lds + SCHED_OFF) + 72; }
__device__ __forceinline__ LAS int* sched_pre(Frame& F) { return (LAS int*)(F.lds + SCHED_OFF) + 144; }
__device__ __forceinline__ void sched_build(Frame& F, const Ptrs& P) {
    LAS int* offs = sched_offs(F); LAS int* tb = sched_tileb(F); LAS int* pre = sched_pre(F);
    LAS int* totv = (LAS int*)(F.lds + UTAB_OFF);
    if (F.tid < NE) {
        const int e = F.tid; int t = 0, p = 0;
#pragma unroll 8
        for (int w = 0; w < 256; ++w) { const int c = P.counts[w * NE + e]; t += c; p += (w < F.vcu) ? c : 0; }
        totv[e] = t; pre[e] = p;
    }
    __syncthreads();
    if (F.tid == 0) { int o = 0, tbv = 0; for (int e = 0; e < NE; ++e) { offs[e] = o; tb[e] = tbv; const int t = totv[e]; o += t; tbv += (t + 255) >> 8; } offs[NE] = o; tb[NE] = tbv; }
    __syncthreads();
}

__device__ __forceinline__ void p6_route(Frame& F, const Ptrs& P) {
    const int lane = F.lane, r = lane & 15, g = lane >> 4;
    const int tok = F.vcu * 128 + F.wave * 16 + r;
    LAS float* LG = (LAS float*)(F.lds + RING_OFF) + F.wave * (16 * 80);
    LAS float* SS = (LAS float*)(F.lds + RING_OFF + 65536) + F.wave * 16;
    LAS int* hist = (LAS int*)(F.lds + RING_OFF + 69632);
    if (F.tid < NE) hist[F.tid] = 0;
    f32x4 acc[5];
#pragma unroll
    for (int i = 0; i < 5; ++i) acc[i] = (f32x4){0.f, 0.f, 0.f, 0.f};
    float ssq = 0.f;
    const float* xrow = P.x + (size_t)tok * D + 8 * g; const bf16* drow = P.D1 + (size_t)tok * D + 8 * g; bf16* orow = P.X1B + (size_t)tok * D + 8 * g;
    const bf16* wh = P.WRT + (size_t)r * D + 8 * g; const bf16* wl = wh + 80 * D;
#pragma unroll 2
    for (int s = 0; s < 32; ++s) {
        const f32x4 xa = *(const f32x4*)(xrow + 32 * s), xb = *(const f32x4*)(xrow + 32 * s + 4);
        const v4u dd = *(const v4u*)(drow + 32 * s);
        float v[8];
        v[0] = xa[0] + bflo(dd.x); v[1] = xa[1] + bfhi(dd.x); v[2] = xa[2] + bflo(dd.y); v[3] = xa[3] + bfhi(dd.y);
        v[4] = xb[0] + bflo(dd.z); v[5] = xb[1] + bfhi(dd.z); v[6] = xb[2] + bflo(dd.w); v[7] = xb[3] + bfhi(dd.w);
        v4u hw, lw;
#pragma unroll
        for (int q = 0; q < 4; ++q) {
            ssq += v[2 * q] * v[2 * q] + v[2 * q + 1] * v[2 * q + 1];
            const unsigned h = cvt_pk_bf16(v[2 * q], v[2 * q + 1]);
            const unsigned l = cvt_pk_bf16(v[2 * q] - bflo(h), v[2 * q + 1] - bfhi(h));
            hw[q] = h; lw[q] = l;
        }
        *(v4u*)(orow + 32 * s) = hw;
        const bf16x8 ah = __builtin_bit_cast(bf16x8, hw), al = __builtin_bit_cast(bf16x8, lw);
#pragma unroll
        for (int nt = 0; nt < 5; ++nt) {
            const bf16x8 bh = *(const bf16x8*)(wh + (size_t)nt * 16 * D + 32 * s), bl = *(const bf16x8*)(wl + (size_t)nt * 16 * D + 32 * s);
            acc[nt] = __builtin_amdgcn_mfma_f32_16x16x32_bf16(ah, bh, acc[nt], 0, 0, 0);
            acc[nt] = __builtin_amdgcn_mfma_f32_16x16x32_bf16(al, bh, acc[nt], 0, 0, 0);
            acc[nt] = __builtin_amdgcn_mfma_f32_16x16x32_bf16(ah, bl, acc[nt], 0, 0, 0);
        }
    }
    ssq += __shfl_xor(ssq, 16); ssq += __shfl_xor(ssq, 32);
#pragma unroll
    for (int nt = 0; nt < 5; ++nt)
#pragma unroll
        for (int q = 0; q < 4; ++q) LG[(4 * g + q) * 80 + 16 * nt + r] = acc[nt][q];
    if (g == 0) SS[r] = ssq;
    __syncthreads();
    if (g == 0) {
        const float rs = 1.0f / sqrtf(SS[r] * (1.f / D) + EPS);
        const LAS float* L = LG + r * 80;
        float gl[8]; float mx = -3.0e38f; int gsel = 0;
#pragma unroll
        for (int i = 0; i < 8; ++i) { gl[i] = rs * L[i] + P.b_rg[i]; if (gl[i] > mx) { mx = gl[i]; gsel = i; } }
        float den = 0.f;
#pragma unroll
        for (int i = 0; i < 8; ++i) den += expf(gl[i] - mx);
        const float gw = 1.f / den;
        float v0 = -3.0e38f, v1 = -3.0e38f; int i0 = 0, i1 = 0;
        for (int i = 0; i < 8; ++i) {
            const float v = rs * L[8 + gsel * 8 + i] + P.b_re[gsel * 8 + i];
            if (v > v0) { v1 = v0; i1 = i0; v0 = v; i0 = i; } else if (v > v1) { v1 = v; i1 = i; }
        }
        const float e1 = expf(v1 - v0), w0 = 1.f / (1.f + e1), w1 = e1 / (1.f + e1);
        const int ea = gsel * 8 + i0, eb = gsel * 8 + i1;
        P.eid[tok * 2] = ea; P.eid[tok * 2 + 1] = eb; P.ew[tok * 2] = w0 * gw; P.ew[tok * 2 + 1] = w1 * gw; P.rstd1[tok] = rs;
        __hip_atomic_fetch_add(hist + ea, 1, __ATOMIC_RELAXED, __HIP_MEMORY_SCOPE_WORKGROUP); __hip_atomic_fetch_add(hist + eb, 1, __ATOMIC_RELAXED, __HIP_MEMORY_SCOPE_WORKGROUP);
    }
    __syncthreads();
    if (F.tid < NE) P.counts[F.vcu * NE + F.tid] = hist[F.tid];
}

__device__ __forceinline__ void p7_lists(Frame& F, const Ptrs& P) {
    sched_build(F, P);
    LAS int* offs = sched_offs(F); LAS int* pre = sched_pre(F);
    LAS int* eids = (LAS int*)(F.lds + RING_OFF);
    if (F.tid < 256) eids[F.tid] = P.eid[F.vcu * 256 + F.tid];
    __syncthreads();
    if (F.tid < NE) {
        const int e = F.tid; int pos = offs[e] + pre[e];
        for (int a = 0; a < 256; ++a) if (eids[a] == e) { P.list[pos] = F.vcu * 256 + a; ++pos; }
    }
    if (blockIdx.x == 0 && F.tid <= NE) P.goffs[F.tid] = offs[F.tid];
    __syncthreads();
}

namespace pg8 {
template <int MODE>
struct MoeSched {
    const char* Ab; const char* Bb; int K, G, c; LAS int* offs; LAS int* tb; LAS int* tab;
    __device__ __forceinline__ bool next(int i, Unit& u) const {
        const int L = i * G + c; const int ntile = __builtin_amdgcn_readfirstlane(tb[NE]);
        if (L >= 4 * ntile) return false;
        const int rt = L >> 2; int e = 0;
        for (int k = 1; k < NE; ++k) e += (tb[k] <= rt) ? 1 : 0;
        e = __builtin_amdgcn_readfirstlane(e);
        u.e = e; u.pm = rt - __builtin_amdgcn_readfirstlane(tb[e]); u.pn = L & 3; u.slot0 = __builtin_amdgcn_readfirstlane(offs[e]) + 256 * u.pm;
        const int left = __builtin_amdgcn_readfirstlane(offs[e + 1]) - u.slot0; u.rows = left < 256 ? left : 256; u.ui = i; return true;
    }
    __device__ __forceinline__ const char* a_base(const Unit& u) const { return MODE == 0 ? Ab : Ab + (size_t)u.slot0 * (size_t)(DE * 2); }
    __device__ __forceinline__ const char* b_base(const Unit& u) const { return Bb + ((size_t)u.e * D + (size_t)u.pn * BM) * (size_t)K * 2; }
    __device__ __forceinline__ unsigned a_rowoff(const Unit& u, int r) const { return MODE == 0 ? (unsigned)tab[u.ui * 256 + r] : (unsigned)r * (unsigned)(DE * 2); }
};
struct EpiAct {
    bf16* ACT; const LAS float* tabf;
    __device__ __forceinline__ void operator()(const f32x4 (&acc)[2][2][4][2], const Unit& u, int wr, int wc, int fr, int fq) const {
#pragma unroll
        for (int ai = 0; ai < 2; ++ai)
#pragma unroll
            for (int m = 0; m < 4; ++m) { const int r = ai * HALF + wr * 64 + m * 16 + fr;
                if (r < u.rows) { const float s = tabf[u.ui * 256 + r]; bf16* rowp = ACT + (size_t)(u.slot0 + r) * DE + u.pn * 128 + wc * 16 + 4 * fq;
#pragma unroll
                    for (int bj = 0; bj < 2; ++bj) { const f32x4 h1 = acc[ai][bj][m][0] * s, h3 = acc[ai][bj][m][1] * s; f32x4 a;
#pragma unroll
                        for (int q = 0; q < 4; ++q) a[q] = h1[q] * fast_sigmoid(h1[q]) * h3[q];
                        v2u w; w.x = cvt_pk_bf16(a[0], a[1]); w.y = cvt_pk_bf16(a[2], a[3]); *(v2u*)(rowp + bj * 64) = w; } } }
    }
};
struct EpiY {
    bf16* Y; const LAS int* tab; const LAS float* tabf;
    __device__ __forceinline__ void operator()(const f32x4 (&acc)[2][2][4][2], const Unit& u, int wr, int wc, int fr, int fq) const {
#pragma unroll
        for (int ai = 0; ai < 2; ++ai)
#pragma unroll
            for (int m = 0; m < 4; ++m) { const int r = ai * HALF + wr * 64 + m * 16 + fr; const int aid = tab[u.ui * 256 + r];
                if (aid >= 0) { const float s = tabf[u.ui * 256 + r]; bf16* rowp = Y + ((size_t)(aid & 1) * T + (size_t)(aid >> 1)) * D + u.pn * BM + wc * 32 + 8 * fq;
#pragma unroll
                    for (int bj = 0; bj < 2; ++bj) { const f32x4 v0 = acc[ai][bj][m][0] * s, v1 = acc[ai][bj][m][1] * s;
                        v4u w; w.x = cvt_pk_bf16(v0[0], v0[1]); w.y = cvt_pk_bf16(v0[2], v0[3]); w.z = cvt_pk_bf16(v1[0], v1[1]); w.w = cvt_pk_bf16(v1[2], v1[3]);
                        *(v4u*)(rowp + bj * HALF) = w; } } }
    }
};
}
template <int MODE>
__device__ __forceinline__ void moe_phase(Frame& F, const Ptrs& P) {
    sched_build(F, P);
    LAS int* tab = (LAS int*)(F.lds + UTAB_OFF); LAS float* tabf = (LAS float*)(F.lds + UTABF_OFF);
    pg8::MoeSched<MODE> S; S.Ab = MODE == 0 ? (const char*)P.X1B : (const char*)P.ACT; S.Bb = MODE == 0 ? (const char*)P.W13 : (const char*)P.W2; S.K = MODE == 0 ? D : DE; S.G = F.G; S.c = F.vcu;
    S.offs = sched_offs(F); S.tb = sched_tileb(F); S.tab = tab;
    for (int i = 0; i < MAXU; ++i) { pg8::Unit u; if (!S.next(i, u)) break;
        if (F.tid < 256) { const int r = F.tid; const bool valid = r < u.rows; const int aid = P.list[u.slot0 + (valid ? r : 0)];
            if (MODE == 0) { tab[i * 256 + r] = (aid >> 1) * (D * 2); tabf[i * 256 + r] = P.rstd1[aid >> 1]; }
            else { tab[i * 256 + r] = valid ? aid : -1; tabf[i * 256 + r] = P.ew[aid]; } } }
    __syncthreads();
    if (MODE == 0) { pg8::EpiAct E{P.ACT, tabf}; pg8::gemm_phase(F.lds + RING_OFF, S, E); }
    else { pg8::EpiY E{P.Y, tab, tabf}; pg8::gemm_phase(F.lds + RING_OFF, S, E); }
}
typedef short v4i16 __attribute__((ext_vector_type(4)));
__device__ __forceinline__ unsigned off_b(unsigned row, unsigned ch) { return 256u * row + 16u * (ch ^ (((row & 3u) << 2) | ((row >> 2) & 3u))); }
__device__ __forceinline__ unsigned row_read_addr_16(unsigned lane, unsigned rb, unsigned s) { return off_b((lane & 15u) + 16u * rb, 4u * s + (lane >> 4)); }
__device__ __forceinline__ unsigned tr_read_addr_16(unsigned lane, unsigned c, unsigned ks, unsigned t) {
    const unsigned g = lane >> 4, q = (lane & 15u) >> 2, p = lane & 3u;
    return off_b(32u * ks + 8u * g + 4u * t + q, 2u * c + (p >> 1)) + 8u * (p & 1u);
}
__device__ __forceinline__ bf16x8 tr_frag2(LAS unsigned char* p0, LAS unsigned char* p1) {
    const v4i16 a = __builtin_amdgcn_ds_read_tr16_b64_v4i16((LAS v4i16*)p0);
    const v4i16 b = __builtin_amdgcn_ds_read_tr16_b64_v4i16((LAS v4i16*)p1);
    return (bf16x8){a[0], a[1], a[2], a[3], b[0], b[1], b[2], b[3]};
}
__device__ __forceinline__ void wave_lds_fence() { asm volatile("s_waitcnt lgkmcnt(0)" ::: "memory"); __builtin_amdgcn_wave_barrier(); asm volatile("" ::: "memory"); }
__device__ __forceinline__ float gelu_tanh_fast(float x) {
    const float u = 0.7978845608028654f * (x + 0.044715f * x * x * x);
    return x * fast_sigmoid(2.f * u);
}
constexpr float LOG2_ROPE_OVER_64 = 13.287712379549449f / 64.f;
constexpr int MIX_K_OFF = 0, MIX_V_OFF = 32768, MIX_S_OFF = 65536, MIX_S_STRIDE = 272, MIX_S_WAVE = 16 * MIX_S_STRIDE;
constexpr int MIX_CW_OFF = 0, MIX_XC_OFF = 12288, MIX_XC_WAVE = 16 * 68 * 4;
static_assert(MIX_S_OFF + 8 * MIX_S_WAVE <= RING_BYTES && MIX_XC_OFF + 8 * MIX_XC_WAVE <= RING_BYTES, "mixing LDS map");

__device__ __forceinline__ void sincos_rev(float ang, float& sn, float& cs) {
    float rev = ang * 0.15915494309189535f; rev -= floorf(rev);
    sn = __builtin_amdgcn_sinf(rev); cs = __builtin_amdgcn_cosf(rev);
}
template <bool DECAY>
__device__ __forceinline__ void load_kv_tiles(Frame& F, const bf16* proj_t0, int h, int s0, float lg2) {
    LAS unsigned char* Kimg = F.lds + MIX_K_OFF; LAS unsigned char* Vimg = F.lds + MIX_V_OFF;
    const int dg = F.tid & 7;
    float inv[8];
#pragma unroll
    for (int j = 0; j < 8; ++j) inv[j] = __builtin_amdgcn_exp2f(-(float)(8 * dg + j) * LOG2_ROPE_OVER_64);
#pragma unroll
    for (int it = 0; it < 2; ++it) {
        const int c = (F.tid >> 3) + 64 * it;
        const bf16* row = proj_t0 + (size_t)c * INC + 1536 + h * HD + 8 * dg;
        const v4u k1 = *(const v4u*)row, k2 = *(const v4u*)(row + 64);
        const float sc = 0.08838834764831845f * (DECAY ? __builtin_amdgcn_exp2f((float)(127 - c) * lg2) : 1.f);
        const float pos = (float)(s0 + c);
        v4u o1, o2;
#pragma unroll
        for (int q = 0; q < 4; ++q) {
            float sn0, cs0, sn1, cs1; sincos_rev(pos * inv[2 * q], sn0, cs0); sincos_rev(pos * inv[2 * q + 1], sn1, cs1);
            const float a0 = bflo(k1[q]), a1 = bfhi(k1[q]), b0 = bflo(k2[q]), b1 = bfhi(k2[q]);
            o1[q] = cvt_pk_bf16((a0 * cs0 - b0 * sn0) * sc, (a1 * cs1 - b1 * sn1) * sc);
            o2[q] = cvt_pk_bf16((a0 * sn0 + b0 * cs0) * sc, (a1 * sn1 + b1 * cs1) * sc);
        }
        *(LAS v4u*)(Kimg + off_b(c, dg)) = o1; *(LAS v4u*)(Kimg + off_b(c, dg + 8)) = o2;
    }
#pragma unroll
    for (int it = 0; it < 4; ++it) {
        const int id = F.tid + 512 * it, c = id >> 4, ch = id & 15;
        *(LAS v4u*)(Vimg + off_b(c, ch)) = *(const v4u*)(proj_t0 + (size_t)c * INC + 2048 + h * HD + 8 * ch);
    }
}

template <bool FINAL>
__device__ __forceinline__ void lru_chunk(Frame& F, const Ptrs& P, int b, int n, int lane) {
    const int r = lane & 15, g = lane >> 4, hb = F.wave;
    const int t0 = b * S + n * CH;
    LAS float* CW = (LAS float*)(F.lds + MIX_CW_OFF);
    LAS float* XC = (LAS float*)(F.lds + MIX_XC_OFF + F.wave * MIX_XC_WAVE);
    for (int i = F.tid; i < 5 * DL; i += NTHR) CW[i] = i < 4 * DL ? P.conv_w[i] : P.conv_b[i - 4 * DL];
    __syncthreads();
    bf16x8 Wa[4][2], Wx[4][2];
#pragma unroll
    for (int jt = 0; jt < 4; ++jt)
#pragma unroll
        for (int ks = 0; ks < 2; ++ks) {
            Wa[jt][ks] = *(const bf16x8*)(P.LRUW + ((size_t)(0 * 8 + hb) * 64 + 16 * jt + r) * 64 + 32 * ks + 8 * g);
            Wx[jt][ks] = *(const bf16x8*)(P.LRUW + ((size_t)(1 * 8 + hb) * 64 + 16 * jt + r) * 64 + 32 * ks + 8 * g);
        }
    float ba[4], bx[4], sp8[4], St[4], At[4];
#pragma unroll
    for (int jt = 0; jt < 4; ++jt) { const int ch = hb * 64 + 16 * jt + r; ba[jt] = P.ba[ch]; bx[jt] = P.bx[ch];
        const float nl = -P.lam[ch]; sp8[jt] = 8.f * (nl > 20.f ? nl : log1pf(expf(nl)));
        St[jt] = FINAL ? ((const float*)(P.ws + WS_LRU))[2 * B * NCH * DL + (b * NCH + n) * DL + ch] : 0.f; At[jt] = 1.f; }
#pragma unroll 1
    for (int tt = 0; tt < 8; ++tt) {
        const int c = 16 * tt + r;
        bf16x8 fr[2];
#pragma unroll
        for (int ks = 0; ks < 2; ++ks) {
            const int chA = hb * 64 + 32 * ks + 8 * g;
            float xc[8];
            { const f32x4 b0 = *(const LAS f32x4*)(CW + 4 * DL + chA), b1 = *(const LAS f32x4*)(CW + 4 * DL + chA + 4);
              xc[0] = b0[0]; xc[1] = b0[1]; xc[2] = b0[2]; xc[3] = b0[3]; xc[4] = b1[0]; xc[5] = b1[1]; xc[6] = b1[2]; xc[7] = b1[3]; }
#pragma unroll
            for (int k = 0; k < 4; ++k) {
                const int sp = n * CH + c - 3 + k;
                v4u xv = {0u, 0u, 0u, 0u};
                if (sp >= 0) xv = *(const v4u*)(P.PROJ + (size_t)(t0 + c - 3 + k) * INC + chA);
                const f32x4 w0 = *(const LAS f32x4*)(CW + k * DL + chA), w1 = *(const LAS f32x4*)(CW + k * DL + chA + 4);
                xc[0] += w0[0] * bflo(xv.x); xc[1] += w0[1] * bfhi(xv.x); xc[2] += w0[2] * bflo(xv.y); xc[3] += w0[3] * bfhi(xv.y);
                xc[4] += w1[0] * bflo(xv.z); xc[5] += w1[1] * bfhi(xv.z); xc[6] += w1[2] * bflo(xv.w); xc[7] += w1[3] * bfhi(xv.w);
            }
            v4u pk; pk.x = cvt_pk_bf16(xc[0], xc[1]); pk.y = cvt_pk_bf16(xc[2], xc[3]); pk.z = cvt_pk_bf16(xc[4], xc[5]); pk.w = cvt_pk_bf16(xc[6], xc[7]);
            fr[ks] = __builtin_bit_cast(bf16x8, pk);
            *(LAS f32x4*)(XC + r * 68 + 32 * ks + 8 * g) = (f32x4){xc[0], xc[1], xc[2], xc[3]};
            *(LAS f32x4*)(XC + r * 68 + 32 * ks + 8 * g + 4) = (f32x4){xc[4], xc[5], xc[6], xc[7]};
        }
        wave_lds_fence();
#pragma unroll
        for (int jt = 0; jt < 4; ++jt) {
            f32x4 aa = {0.f, 0.f, 0.f, 0.f}, ax = {0.f, 0.f, 0.f, 0.f};
#pragma unroll
            for (int ks = 0; ks < 2; ++ks) { aa = __builtin_amdgcn_mfma_f32_16x16x32_bf16(fr[ks], Wa[jt][ks], aa, 0, 0, 0); ax = __builtin_amdgcn_mfma_f32_16x16x32_bf16(fr[ks], Wx[jt][ks], ax, 0, 0, 0); }
            float av[4], uv[4]; float Al = 1.f, Hl = 0.f;
#pragma unroll
            for (int q = 0; q < 4; ++q) {
                const float xcv = XC[(4 * g + q) * 68 + 16 * jt + r];
                const float rg = fast_sigmoid(aa[q] + ba[jt]), ig = fast_sigmoid(ax[q] + bx[jt]);
                const float la = -rg * sp8[jt];
                const float a = __builtin_amdgcn_exp2f(la * 1.4426950408889634f);
                const float x2 = 2.f * la;
                const float em = x2 > -0.25f ? -x2 * (1.f + x2 * (0.5f + x2 * (0.16666667f + x2 * (0.041666668f + x2 * (0.0083333333f + x2 * 0.0013888889f))))) : 1.f - a * a;
                const float u = sqrtf(em) * (ig * xcv);
                av[q] = a; uv[q] = u; Hl = a * Hl + u; Al *= a;
            }
            float Ap = 1.f, Hp = 0.f;
#pragma unroll
            for (int k = 3; k >= 1; --k) {
                const float Ao = __shfl(Al, lane - 16 * k), Ho = __shfl(Hl, lane - 16 * k);
                if (g >= k) { Hp = Ao * Hp + Ho; Ap *= Ao; }
            }
            float h = Ap * St[jt] + Hp;
            if (FINAL) {
#pragma unroll
                for (int q = 0; q < 4; ++q) {
                    h = av[q] * h + uv[q];
                    const size_t tok = (size_t)(t0 + 16 * tt + 4 * g + q);
                    const float gl = bf2f(P.PROJ[tok * INC + DL + hb * 64 + 16 * jt + r]);
                    P.MIX[tok * D + hb * 64 + 16 * jt + r] = f2bf(h * gelu_tanh_fast(gl));
                }
            } else {
                h = Al * h + Hl;
            }
            const float Atile = __shfl(Ap * Al, (lane & 15) + 48);
            St[jt] = __shfl(h, (lane & 15) + 48);
            At[jt] *= Atile;
        }
        wave_lds_fence();
    }
    if (!FINAL && g == 0) {
#pragma unroll
        for (int jt = 0; jt < 4; ++jt) { const int ch = hb * 64 + 16 * jt + r; float* AE = (float*)(P.ws + WS_LRU);
            AE[(b * NCH + n) * DL + ch] = At[jt]; AE[B * NCH * DL + (b * NCH + n) * DL + ch] = St[jt]; }
    }
}

__device__ __forceinline__ void p2_mix_summaries(Frame& F, const Ptrs& P) {
    const int w = F.wave;
#pragma unroll 1
    for (int u = F.vcu; u < B * NCH; u += F.G) {
        const int b = u / NCH, n = u % NCH; const int t0 = b * S + n * CH;
        __syncthreads();
        { int lane0 = F.lane; asm volatile("" : "+v"(lane0)); lru_chunk<false>(F, P, b, n, lane0); }
#pragma unroll 1
        for (int h = 0; h < NH; ++h) {
            int lane = F.lane; asm volatile("" : "+v"(lane));
            const int r = lane & 15, g = lane >> 4;
            unsigned trb[8][2];
#pragma unroll
            for (int c = 0; c < 8; ++c) { trb[c][0] = tr_read_addr_16(lane, c, 0, 0); trb[c][1] = tr_read_addr_16(lane, c, 0, 1); }
            const float lg2 = __builtin_amdgcn_logf(1.f - __builtin_amdgcn_exp2f(-5.f - (float)h));
            __syncthreads();
            load_kv_tiles<true>(F, P.PROJ + (size_t)t0 * INC, h, n * CH, lg2);
            __syncthreads();
            LAS unsigned char* Kimg = F.lds + MIX_K_OFF; LAS unsigned char* Vimg = F.lds + MIX_V_OFF;
            f32x4 acc[8];
#pragma unroll
            for (int dt = 0; dt < 8; ++dt) acc[dt] = (f32x4){0.f, 0.f, 0.f, 0.f};
            const unsigned ta0 = tr_read_addr_16(lane, w, 0, 0), ta1 = tr_read_addr_16(lane, w, 0, 1);
#pragma unroll 1
            for (int ks = 0; ks < 4; ++ks) {
                const bf16x8 Af = tr_frag2(Vimg + ta0 + 8192 * ks, Vimg + ta1 + 8192 * ks);
#pragma unroll
                for (int dt = 0; dt < 8; ++dt) { const bf16x8 Bf = tr_frag2(Kimg + trb[dt][0] + 8192 * ks, Kimg + trb[dt][1] + 8192 * ks); acc[dt] = __builtin_amdgcn_mfma_f32_16x16x32_bf16(Af, Bf, acc[dt], 0, 0, 0); }
            }
            float* KV = P.out + ((size_t)((b * NH + h) * NCH + n)) * (HD * HD);
#pragma unroll
            for (int dt = 0; dt < 8; ++dt)
#pragma unroll
                for (int q = 0; q < 4; ++q) KV[(16 * w + 4 * g + q) * HD + 16 * dt + r] = acc[dt][q];
        }
    }
}
__device__ __forceinline__ void p3_scans(Frame& F, const Ptrs& P) {
    const int idx = F.vcu * NTHR + F.tid;
    for (int id = idx; id < B * NH * (HD * HD / 4); id += F.G * NTHR) {
        const int bh = id >> 12, el = (id & 4095) * 4, h = bh & 3;
        const float lg2 = __builtin_amdgcn_logf(1.f - __builtin_amdgcn_exp2f(-5.f - (float)h));
        const float dec = __builtin_amdgcn_exp2f(128.f * lg2);
        const float* KV = P.out + (size_t)bh * NCH * (HD * HD) + el;
        bf16* PV = (bf16*)(P.out + (size_t)B * NH * NCH * (HD * HD)) + (size_t)bh * NCH * (HD * HD) + el;
        f32x4 st = {0.f, 0.f, 0.f, 0.f};
#pragma unroll 8
        for (int n = 0; n < NCH; ++n) {
            const f32x4 kv = *(const f32x4*)(KV + (size_t)n * (HD * HD));
            v2u w; w.x = cvt_pk_bf16(st[0], st[1]); w.y = cvt_pk_bf16(st[2], st[3]);
            *(v2u*)(PV + (size_t)n * (HD * HD)) = w;
            st = st * dec + kv;
        }
    }
    if (idx < B * DL) {
        const int b = idx / DL, ch = idx % DL; float* AE = (float*)(P.ws + WS_LRU);
        float carry = 0.f;
        for (int n = 0; n < NCH; ++n) {
            const float a = AE[(b * NCH + n) * DL + ch], e = AE[B * NCH * DL + (b * NCH + n) * DL + ch];
            AE[2 * B * NCH * DL + (b * NCH + n) * DL + ch] = carry;
            carry = a * carry + e;
        }
    }
}
__device__ __forceinline__ void p4_mix_outputs(Frame& F, const Ptrs& P) {
    const int w = F.wave;
#pragma unroll 1
    for (int u = F.vcu; u < B * NCH; u += F.G) {
        const int b = u / NCH, n = u % NCH; const int t0 = b * S + n * CH;
        __syncthreads();
        { int lane0 = F.lane; asm volatile("" : "+v"(lane0)); lru_chunk<true>(F, P, b, n, lane0); }
#pragma unroll 1
        for (int h = 0; h < NH; ++h) {
            int lane = F.lane; asm volatile("" : "+v"(lane));
            const int r = lane & 15, g = lane >> 4;
            unsigned trb[8][2], rrb[4];
#pragma unroll
            for (int c = 0; c < 8; ++c) { trb[c][0] = tr_read_addr_16(lane, c, 0, 0); trb[c][1] = tr_read_addr_16(lane, c, 0, 1); }
#pragma unroll
            for (int ks = 0; ks < 4; ++ks) rrb[ks] = row_read_addr_16(lane, 0, ks);
            const float lg2 = __builtin_amdgcn_logf(1.f - __builtin_amdgcn_exp2f(-5.f - (float)h));
            __syncthreads();
            load_kv_tiles<false>(F, P.PROJ + (size_t)t0 * INC, h, n * CH, lg2);
            bf16x8 Qf[4];
            {
                const bf16* qrow = P.PROJ + (size_t)(t0 + 16 * w + r) * INC + 1024 + h * HD + 8 * g;
                const float pos = (float)(n * CH + 16 * w + r);
#pragma unroll
                for (int ks = 0; ks < 2; ++ks) {
                    const v4u q1 = *(const v4u*)(qrow + 32 * ks), q2 = *(const v4u*)(qrow + 32 * ks + 64);
                    v4u o1, o2;
#pragma unroll
                    for (int q = 0; q < 4; ++q) {
                        const float i0 = __builtin_amdgcn_exp2f(-(float)(32 * ks + 8 * g + 2 * q) * LOG2_ROPE_OVER_64), i1 = __builtin_amdgcn_exp2f(-(float)(32 * ks + 8 * g + 2 * q + 1) * LOG2_ROPE_OVER_64);
                        float sn0, cs0, sn1, cs1; sincos_rev(pos * i0, sn0, cs0); sincos_rev(pos * i1, sn1, cs1);
                        const float a0 = bflo(q1[q]), a1 = bfhi(q1[q]), b0 = bflo(q2[q]), b1 = bfhi(q2[q]);
                        o1[q] = cvt_pk_bf16(a0 * cs0 - b0 * sn0, a1 * cs1 - b1 * sn1);
                        o2[q] = cvt_pk_bf16(a0 * sn0 + b0 * cs0, a1 * sn1 + b1 * cs1);
                    }
                    Qf[ks] = __builtin_bit_cast(bf16x8, o1); Qf[ks + 2] = __builtin_bit_cast(bf16x8, o2);
                }
            }
            __syncthreads();
            LAS unsigned char* Kimg = F.lds + MIX_K_OFF; LAS unsigned char* Vimg = F.lds + MIX_V_OFF; LAS unsigned char* Sst = F.lds + MIX_S_OFF + w * MIX_S_WAVE;
#pragma unroll 1
            for (int mt = 0; mt <= w; ++mt) {
                f32x4 sa = {0.f, 0.f, 0.f, 0.f};
#pragma unroll
                for (int ks = 0; ks < 4; ++ks) { const bf16x8 Kf = *(const LAS bf16x8*)(Kimg + rrb[ks] + 4096 * mt); sa = __builtin_amdgcn_mfma_f32_16x16x32_bf16(Qf[ks], Kf, sa, 0, 0, 0); }
#pragma unroll
                for (int q = 0; q < 4; ++q) {
                    const int dlt = (16 * w + 4 * g + q) - (16 * mt + r);
                    const float v = dlt >= 0 ? sa[q] * __builtin_amdgcn_exp2f((float)dlt * lg2) : 0.f;
                    *(LAS bf16*)(Sst + (4 * g + q) * MIX_S_STRIDE + (16 * mt + r) * 2) = f2bf(v);
                }
            }
            if ((w & 1) == 0) {
#pragma unroll
                for (int q = 0; q < 4; ++q) *(LAS bf16*)(Sst + (4 * g + q) * MIX_S_STRIDE + (16 * (w + 1) + r) * 2) = 0;
            }
            wave_lds_fence();
            f32x4 acc[8];
            {
                const bf16* PV = (const bf16*)(P.out + (size_t)B * NH * NCH * (HD * HD)) + ((size_t)((b * NH + h) * NCH + n)) * (HD * HD);
#pragma unroll
                for (int et = 0; et < 8; ++et) {
                    f32x4 a = {0.f, 0.f, 0.f, 0.f};
#pragma unroll
                    for (int ks = 0; ks < 4; ++ks) { const bf16x8 Pf = *(const bf16x8*)(PV + (size_t)(16 * et + r) * HD + 32 * ks + 8 * g); a = __builtin_amdgcn_mfma_f32_16x16x32_bf16(Qf[ks], Pf, a, 0, 0, 0); }
#pragma unroll
                    for (int q = 0; q < 4; ++q) a[q] *= __builtin_amdgcn_exp2f((float)(16 * w + 4 * g + q + 1) * lg2);
                    acc[et] = a;
                }
            }
#pragma unroll 1
            for (int ks = 0; ks <= (w >> 1); ++ks) {
                const bf16x8 Sf = *(const LAS bf16x8*)(Sst + r * MIX_S_STRIDE + (32 * ks + 8 * g) * 2);
#pragma unroll
                for (int et = 0; et < 8; ++et) { const bf16x8 Vf = tr_frag2(Vimg + trb[et][0] + 8192 * ks, Vimg + trb[et][1] + 8192 * ks); acc[et] = __builtin_amdgcn_mfma_f32_16x16x32_bf16(Sf, Vf, acc[et], 0, 0, 0); }
            }
            float mu[4], rs[4];
#pragma unroll
            for (int q = 0; q < 4; ++q) {
                float s = 0.f;
#pragma unroll
                for (int et = 0; et < 8; ++et) s += acc[et][q];
                s += __shfl_xor(s, 1); s += __shfl_xor(s, 2); s += __shfl_xor(s, 4); s += __shfl_xor(s, 8);
                const float m = s * (1.f / 128.f); float v = 0.f;
#pragma unroll
                for (int et = 0; et < 8; ++et) { const float d = acc[et][q] - m; v += d * d; }
                v += __shfl_xor(v, 1); v += __shfl_xor(v, 2); v += __shfl_xor(v, 4); v += __shfl_xor(v, 8);
                mu[q] = m; rs[q] = 1.0f / sqrtf(v * (1.f / 128.f) + EPS);
            }
#pragma unroll
            for (int et = 0; et < 8; ++et)
#pragma unroll
                for (int q = 0; q < 4; ++q) {
                    const size_t tok = (size_t)(t0 + 16 * w + 4 * g + q);
                    const float gr = bf2f(P.PROJ[tok * INC + 2560 + h * HD + 16 * et + r]);
                    P.MIX[tok * D + DL + h * HD + 16 * et + r] = f2bf(gr * fast_sigmoid(gr) * (acc[et][q] - mu[q]) * rs[q]);
                }
        }
    }
}
__global__ void __launch_bounds__(NTHR, 2) mk_fwd(Args args) {
    extern __shared__ __attribute__((aligned(16))) unsigned char lds_raw[];
    Frame F;
    F.lds = (LAS unsigned char*)lds_raw;
    F.MISC = (volatile LAS unsigned*)(F.lds + LDSCTL_OFF);
    F.tid = threadIdx.x; F.lane = F.tid & 63; F.wave = __builtin_amdgcn_readfirstlane(F.tid >> 6);
    F.G = gridDim.x; { const int bx = blockIdx.x; F.vcu = (F.G % 8 == 0) ? (bx % 8) * (F.G / 8) + bx / 8 : bx; }
    F.ctl = (gu32*)(args.ws + WS_CTL);
    Ptrs P; make_ptrs(P, args);
    for (int u = F.tid; u < 256; u += NTHR) ((LAS unsigned*)(F.lds + LDSCTL_OFF))[u] = 0u;
    __syncthreads();
    XcdBarrier bar = xcd_barrier_post((unsigned*)(F.ctl + CW_BAR) + args.ph_lo * XCD_BAR_WORDS, F.MISC + 8);
    const int lo = args.ph_lo, hi = args.ph_hi;
#define IN(k) (lo <= (k) && (k) < hi)
#define SEAM(k) do { if (IN(k) && IN((k) + 1)) xcd_barrier(bar); } while (0)
    if (IN(0)) { p0_prologue(F, P); }
    SEAM(0);
    if (IN(1)) {
        pg8::PlainSched S; S.init(P.XB, P.W_IN, T, INC, D, F.G, (int)blockIdx.x);
        pg8::EpiRowScaleBf16 E{P.PROJ, INC, P.rstd0};
        pg8::gemm_phase(F.lds + RING_OFF, S, E);
    }
    SEAM(1);
    if (IN(2)) p2_mix_summaries(F, P);
    SEAM(2);
    if (IN(3)) p3_scans(F, P);
    SEAM(3);
    if (IN(4)) p4_mix_outputs(F, P);
    SEAM(4);
    if (IN(5)) {
        pg8::PlainSched S; S.init(P.MIX, P.W_OUT, T, D, D, F.G, (int)blockIdx.x);
        pg8::EpiPlainBf16 E{P.D1, D};
        pg8::gemm_phase(F.lds + RING_OFF, S, E);
    }
    SEAM(5);
    if (IN(6)) p6_route(F, P);
    SEAM(6);
    if (IN(7)) p7_lists(F, P);
    SEAM(7);
    if (IN(8)) moe_phase<0>(F, P);
    SEAM(8);
    if (IN(9)) moe_phase<1>(F, P);
    SEAM(9);
    if (IN(10)) p10_combine(F, P);
    SEAM(10);
    if (IN(11)) {
        pg8::PlainSched S; S.init(P.X2B, P.W_PG, T, D, D, F.G, (int)blockIdx.x);
        pg8::EpiGateBf16 E{P.GATE, D, P.rstd2, P.b_pg};
        pg8::gemm_phase(F.lds + RING_OFF, S, E);
    }
    if (IN(12)) {
        pg8::PlainSched S; S.init(P.PB, P.W_PP, T, D, PLE, F.G, (int)blockIdx.x);
        pg8::EpiPlainBf16 E{P.PP, D};
        pg8::gemm_phase(F.lds + RING_OFF, S, E);
    }
    SEAM(12);
    if (IN(13)) p13_final(F, P);
#undef IN
#undef SEAM
}

static int mk_grid = 0;
static void mk_launch(void* const* d_in, void* d_out, void* d_ws, int lo, int hi, hipStream_t stream) {
    if (mk_grid == 0) {
        int dev = 0, cus = 0;
        if (hipGetDevice(&dev) != hipSuccess || hipDeviceGetAttribute(&cus, hipDeviceAttributeMultiprocessorCount, dev) != hipSuccess) { mk_grid = -1; return; }
        if (hipFuncSetAttribute((const void*)mk_fwd, hipFuncAttributeMaxDynamicSharedMemorySize, LDS_BYTES) != hipSuccess) { fprintf(stderr, "mk: hipFuncSetAttribute failed\n"); mk_grid = -1; return; }
        int per_cu = 0;
        if (hipOccupancyMaxActiveBlocksPerMultiprocessor(&per_cu, (const void*)mk_fwd, NTHR, LDS_BYTES) != hipSuccess || per_cu < 1) { fprintf(stderr, "mk: occupancy query says %d\n", per_cu); (void)hipGetLastError(); }
        mk_grid = cus;
    }
    if (mk_grid < 0) return;
    Args a; memset(&a, 0, sizeof a);
    for (int i = 0; i < 25; ++i) a.in[i] = (const float*)d_in[i];
    a.out = (float*)d_out; a.ws = (unsigned char*)d_ws; a.ph_lo = lo; a.ph_hi = hi;
    hipLaunchKernelGGL(mk_fwd, dim3(mk_grid), dim3(NTHR), LDS_BYTES, stream, a);
}
extern "C" void kernel_launch(void* const* d_in, const int* in_sizes, int n_in, void* d_out, int out_size, void* d_ws, size_t ws_size, hipStream_t stream) {
    if (n_in != 25 || ws_size < WS_END || out_size != T * D) { fprintf(stderr, "kernel_launch: n_in %d, workspace %zu (need %zu), out_size %d: nothing launched\n", n_in, ws_size, (size_t)WS_END, out_size); return; }
    (void)hipMemsetAsync((unsigned char*)d_ws + WS_CTL, 0, 1 * MiB, stream);
    mk_launch(d_in, d_out, d_ws, 0, 14, stream);
}
```

```cpp
#include <hip/hip_runtime.h>
#include <stdint.h>
#include <stdio.h>
#include <string.h>

typedef unsigned short bf16;
namespace cfg {
constexpr int D = 1024, B = 8, S = 4096, T = B * S, PLE = 256, DL = 512, DR = 512, NH = 4, HD = 128, INC = 3072;
constexpr int NE = 64, DE = 512, NG = 8, EPG = 8, CH = 128, NCH = S / CH;
constexpr float EPS = 1e-6f;
constexpr size_t MiB = 1u << 20;
constexpr size_t WS_CTL = 0;
constexpr size_t WS_RSTD0 = 1 * MiB, WS_RSTD1 = WS_RSTD0 + 128 * 1024, WS_RSTD2 = WS_RSTD1 + 128 * 1024;
constexpr size_t WS_EID = 2 * MiB, WS_EW = WS_EID + 256 * 1024, WS_LIST = WS_EW + 256 * 1024, WS_CNT = WS_LIST + 256 * 1024;
constexpr size_t WS_LOGITS = 3 * MiB;
constexpr size_t WS_LRU = 13 * MiB;
constexpr size_t WS_WIN = 16 * MiB, WS_WOUT = 22 * MiB, WS_WPG = 24 * MiB, WS_WPP = 26 * MiB, WS_WRT = 26 * MiB + 512 * 1024, WS_LRUW = 27 * MiB;
constexpr size_t WS_W13 = 28 * MiB, WS_W2 = 156 * MiB, WS_PB = 220 * MiB;
constexpr size_t WS_R64 = 236 * MiB;
constexpr size_t WS_PROJ = 300 * MiB;
constexpr size_t WS_D1 = 300 * MiB, WS_X1B = 364 * MiB, WS_Y = 428 * MiB, WS_PP = 428 * MiB;
constexpr size_t WS_END = 556 * MiB;
}
using namespace cfg;

__device__ __forceinline__ float bf2f(bf16 v) { return __uint_as_float((unsigned)v << 16); }
__device__ __forceinline__ bf16 f2bf(float f) { unsigned u = __float_as_uint(f); return (bf16)((u + 0x7fffu + ((u >> 16) & 1u)) >> 16); }
__device__ __forceinline__ float ldv(const float* p, size_t i) { return p[i]; }
__device__ __forceinline__ float ldv(const bf16* p, size_t i) { return bf2f(p[i]); }
__device__ __forceinline__ void stv(float* p, size_t i, float v) { p[i] = v; }
__device__ __forceinline__ void stv(bf16* p, size_t i, float v) { p[i] = f2bf(v); }

#define GAS __attribute__((address_space(1)))
#define LAS __attribute__((address_space(3)))
typedef unsigned v4u __attribute__((ext_vector_type(4)));
typedef unsigned v2u __attribute__((ext_vector_type(2)));
typedef float f32x4 __attribute__((ext_vector_type(4)));
typedef float f32x2 __attribute__((ext_vector_type(2)));
typedef short bf16x8 __attribute__((ext_vector_type(8)));
typedef short bf16x4 __attribute__((ext_vector_type(4)));
typedef GAS unsigned gu32;
#define RLX_AGENT __ATOMIC_RELAXED, __HIP_MEMORY_SCOPE_AGENT
#define LDS_WAIT() asm volatile("s_waitcnt lgkmcnt(0)" ::: "memory")
#define VM_WAIT() asm volatile("s_waitcnt vmcnt(0)" ::: "memory")
__device__ __forceinline__ unsigned pk2(float lo, float hi) { return (unsigned)f2bf(lo) | ((unsigned)f2bf(hi) << 16); }
typedef __bf16 hwbf16x2 __attribute__((ext_vector_type(2)));
__device__ __forceinline__ unsigned cvt_pk_bf16(float lo, float hi) { f32x2 v = {lo, hi}; hwbf16x2 b = __builtin_convertvector(v, hwbf16x2); return __builtin_bit_cast(unsigned, b); }
__device__ __forceinline__ float bflo(unsigned w) { return __uint_as_float(w << 16); }
__device__ __forceinline__ float bfhi(unsigned w) { return __uint_as_float(w & 0xffff0000u); }
__device__ __forceinline__ float fast_sigmoid(float x) { return __builtin_amdgcn_rcpf(1.f + __builtin_amdgcn_exp2f(-1.4426950408889634f * x)); }

#define XB_TMO      128
#define XB_XCNT(j)  (256  + 64 * (j))
#define XB_XSUB(j)  (1280 + 64 * (j))
#define XB_XGEN(j)  (2304 + 64 * (j))
#define XB_TOP      3328
#define XB_TOPGEN   3392
#define XCD_BAR_WORDS 3456
#define XB_SPIN_CAP (1u << 18)
__device__ __forceinline__ unsigned xb_ld(unsigned* p)              { return __hip_atomic_load(p, __ATOMIC_RELAXED, __HIP_MEMORY_SCOPE_AGENT); }
__device__ __forceinline__ unsigned xb_add(unsigned* p, unsigned v) { return __hip_atomic_fetch_add(p, v, __ATOMIC_RELAXED, __HIP_MEMORY_SCOPE_AGENT); }
__device__ __forceinline__ unsigned xb_xcc_id() { return (unsigned)__builtin_amdgcn_s_getreg((3 << 11) | 20) & 0xFu; }
#define XB_SPIN(cond, bar) do { unsigned _sp = 0; while (cond) { __builtin_amdgcn_s_sleep(1); \
    if ((++_sp & 255u) == 0u) { if (xb_ld(&(bar)[XB_TMO])) break; if (_sp > XB_SPIN_CAP) { atomicAdd(&(bar)[XB_TMO], 1u); break; } } } } while (0)
struct XcdBarrier { unsigned* bar; unsigned x; volatile LAS unsigned* st; };
__device__ __forceinline__ XcdBarrier xcd_barrier_post(unsigned* bar, volatile LAS unsigned* st) {
    XcdBarrier b; b.bar = bar; b.x = xb_xcc_id(); b.st = st;
    if (threadIdx.x == 0) (void)xb_add(&bar[XB_XCNT(b.x)], 1u);
    return b;
}
__device__ __forceinline__ void xcd_barrier_complete(unsigned* bar, unsigned x, unsigned& nloc, unsigned& nx) {
    const unsigned G = gridDim.x * gridDim.y * gridDim.z;
    unsigned sum, cnt, mine, sp = 0u;
    for (;;) {
        sum = 0u; cnt = 0u; mine = 0u;
#pragma unroll
        for (unsigned j = 0; j < 16; ++j) { const unsigned c = xb_ld(&bar[XB_XCNT(j)]); sum += c; cnt += (c > 0u) ? 1u : 0u; mine = (j == x) ? c : mine; }
        if (sum == G) break;
        __builtin_amdgcn_s_sleep(1);
        if ((++sp & 255u) == 0u) { if (xb_ld(&bar[XB_TMO])) break; if (sp > XB_SPIN_CAP) { atomicAdd(&bar[XB_TMO], 1u); break; } }
    }
    nloc = mine > 0u ? mine : 1u; nx = cnt > 0u ? cnt : 1u;
}
__device__ __forceinline__ void xcd_barrier(const XcdBarrier& b) {
    asm volatile("s_waitcnt vmcnt(0)" ::: "memory");
    __syncthreads();
    if (threadIdx.x == 0) {
        unsigned* bar = b.bar;
        __builtin_amdgcn_s_waitcnt(0);
        unsigned nloc = b.st[0], nx = b.st[1];
        if (nloc == 0u) { xcd_barrier_complete(bar, b.x, nloc, nx); b.st[0] = nloc; b.st[1] = nx; }
        const unsigned old = xb_add(&bar[XB_XSUB(b.x)], 1u);
        const unsigned gen = old / nloc;
        if (old + 1u == (gen + 1u) * nloc) {
            __builtin_amdgcn_fence(__ATOMIC_RELEASE, "agent");
            asm volatile("s_waitcnt vmcnt(0)" ::: "memory");
            const unsigned og = xb_add(&bar[XB_TOP], 1u);
            const unsigned tg = og / nx;
            if (og + 1u == (tg + 1u) * nx) xb_add(&bar[XB_TOPGEN], 1u);
            else XB_SPIN(xb_ld(&bar[XB_TOPGEN]) == tg, bar);
            __builtin_amdgcn_fence(__ATOMIC_ACQUIRE, "agent");
            xb_add(&bar[XB_XGEN(b.x)], 1u);
            asm volatile("s_waitcnt vmcnt(0)" ::: "memory");
        } else {
            XB_SPIN(xb_ld(&bar[XB_XGEN(b.x)]) == gen, bar);
            __builtin_amdgcn_fence(__ATOMIC_ACQUIRE, "agent");
            asm volatile("s_waitcnt vmcnt(0)" ::: "memory");
        }
    }
    __syncthreads();
}

constexpr int NWAVES = 8, NTHR = NWAVES * 64;
constexpr int RING_OFF = 0, RING_BYTES = 131072;
constexpr int LDSCTL_OFF = RING_BYTES;
constexpr int UTAB_OFF = LDSCTL_OFF + 1024;
constexpr int MAXU = 6;
constexpr int UTABF_OFF = UTAB_OFF + MAXU * 1024;
constexpr int SCHED_OFF = UTABF_OFF + MAXU * 1024;
constexpr int LDS_BYTES = SCHED_OFF + 1024;
static_assert(LDS_BYTES <= 160 * 1024 && LDS_BYTES > 80 * 1024, "LDS map");
constexpr int CW_TMO = 0, CW_BAR = 4096;

namespace pg8 {
constexpr int BM = 256, BK = 64, HALF = 128, HTB = HALF * BK * 2, STAGE_BYTES = 8 * HTB;
__host__ __device__ __forceinline__ int lds_byte(int r, int c) { const int st = (r >> 4) * 2 + (c >> 5), rr = r & 15, cc = c & 31, ob = rr * 64 + cc * 2; return st * 1024 + (ob ^ (((ob >> 9) & 1) << 5)); }
__host__ __device__ __forceinline__ void stage_rc(int b, int& R, int& C) { const int st = b / 1024, sb = b % 1024, swz = sb ^ (((sb >> 9) & 1) << 5); R = (st >> 1) * 16 + swz / 64; C = (st & 1) * 32 + (swz % 64) / 2; }
__host__ __device__ __forceinline__ int perm32(int rho) { const int n = rho >> 4, i = rho & 15; return 8 * (i >> 2) + 4 * n + (i & 3); }

struct Unit { int pm, pn, e, rows, slot0, ui; };

struct PlainSched {
    static constexpr bool GATHER = false;
    const bf16* A; const bf16* Bt; int K; int nM, nN, nwg, G, c;
    __device__ void init(const bf16* A_, const bf16* Bt_, int M, int N, int K_, int G_, int c_) { A = A_; Bt = Bt_; K = K_; nM = M / BM; nN = N / BM; nwg = nM * nN; G = G_; c = c_; }
    __device__ __forceinline__ bool next(int i, Unit& u) const {
        const long L = (long)i * G + c; if (L >= nwg) return false;
        int wgid = (int)L; { const int q = nwg / 8, r = nwg % 8, xcd = wgid % 8, off = wgid / 8; wgid = (xcd < r ? xcd * (q + 1) : r * (q + 1) + (xcd - r) * q) + off; }
        const int nig = 8 * nN, gid = wgid / nig, fm = gid * 8, gsz = (nM - fm) < 8 ? (nM - fm) : 8;
        u.pm = fm + ((wgid % nig) % gsz); u.pn = (wgid % nig) / gsz; u.e = 0; u.rows = 256; u.slot0 = 0; u.ui = i; return true;
    }
    __device__ __forceinline__ const char* a_base(const Unit& u) const { return (const char*)A + (size_t)u.pm * (size_t)(BM * 2) * K; }
    __device__ __forceinline__ const char* b_base(const Unit& u) const { return (const char*)Bt + (size_t)u.pn * (size_t)(BM * 2) * K; }
    __device__ __forceinline__ unsigned a_rowoff(const Unit&, int r) const { return (unsigned)r * (unsigned)K * 2u; }
};

template <class Epi, class Sched>
__device__ __forceinline__ void gemm_phase(LAS unsigned char* lds, const Sched& S, const Epi& E) {
    const int tid = threadIdx.x, wid = __builtin_amdgcn_readfirstlane(tid >> 6), lane = tid & 63, wr = wid >> 2, wc = wid & 3, fr = lane & 15, fq = lane >> 4;
    const int K = S.K, nt = K / BK;
    int Rr[2], Cc[2]; unsigned voffB[2];
#pragma unroll
    for (int i = 0; i < 2; ++i) { stage_rc(tid * 16 + i * 8192, Rr[i], Cc[i]); const int Rb = (Rr[i] & ~31) + perm32(Rr[i] & 31); voffB[i] = (unsigned)(Rb * K + Cc[i]) * 2u; }
    const size_t kstep = (size_t)(BK * 2);
    const size_t hstep = (size_t)HALF * K * 2;
    const unsigned ldsw = (unsigned)wid * 1024u;
    const int aoff = lds_byte(wr * 64 + fr, fq * 8), boff = lds_byte(wc * 32 + fr, fq * 8);
#define PG8_SA(b, h) (((b) * 2 + (h)) * HTB)
#define PG8_SB(b, h) ((4 + (b) * 2 + (h)) * HTB)
#define PG8_STAGE(bufoff, gbase, voff) do { _Pragma("unroll") for (int _i = 0; _i < 2; ++_i) \
        __builtin_amdgcn_global_load_lds((const unsigned*)((const char*)(gbase) + (voff)[_i]), (LAS unsigned*)(lds + (bufoff) + ldsw + _i * 8192), 16, 0, 0); } while (0)
#define PG8_LDA(dst, b, h) do { _Pragma("unroll") for (int m = 0; m < 4; ++m) _Pragma("unroll") for (int k = 0; k < 2; ++k) dst[m][k] = *(const LAS bf16x8*)(lds + PG8_SA(b, h) + aoff + m * 2048 + k * 1024); } while (0)
#define PG8_LDB(dst, b, h) do { _Pragma("unroll") for (int n = 0; n < 2; ++n) _Pragma("unroll") for (int k = 0; k < 2; ++k) dst[n][k] = *(const LAS bf16x8*)(lds + PG8_SB(b, h) + boff + n * 2048 + k * 1024); } while (0)
#define PG8_MMA(ai, bj, At, Bt) do { __builtin_amdgcn_s_setprio(1); _Pragma("unroll") for (int m = 0; m < 4; ++m) _Pragma("unroll") for (int n = 0; n < 2; ++n) _Pragma("unroll") for (int k = 0; k < 2; ++k) \
        acc[ai][bj][m][n] = __builtin_amdgcn_mfma_f32_16x16x32_bf16(Bt[n][k], At[m][k], acc[ai][bj][m][n], 0, 0, 0); __builtin_amdgcn_s_setprio(0); } while (0)
#define PG8_WAIT_V(n) asm volatile("s_waitcnt vmcnt(" #n ")" ::: "memory")
#define PG8_WAIT_L(n) asm volatile("s_waitcnt lgkmcnt(" #n ")" ::: "memory")
#define PG8_BAR __builtin_amdgcn_s_barrier()
#define PG8_SCHED __builtin_amdgcn_sched_barrier(0)
#define PG8_VOFF(dst, u) do { _Pragma("unroll") for (int _h = 0; _h < 2; ++_h) _Pragma("unroll") for (int _i = 0; _i < 2; ++_i) dst[_h][_i] = S.a_rowoff(u, _h * HALF + Rr[_i]) + (unsigned)Cc[_i] * 2u; } while (0)
    Unit cur, nxt; int ui = 0;
    if (!S.next(0, cur)) return;
    f32x4 acc[2][2][4][2];
#pragma unroll
    for (int a = 0; a < 2; ++a)
#pragma unroll
        for (int b = 0; b < 2; ++b)
#pragma unroll
            for (int m = 0; m < 4; ++m)
#pragma unroll
                for (int n = 0; n < 2; ++n) acc[a][b][m][n] = (f32x4){0.f, 0.f, 0.f, 0.f};
    bf16x8 At[4][2], B0[2][2], B1[2][2];
    unsigned va[2][2], nva[2][2];
    PG8_VOFF(va, cur);
    const char* cA = S.a_base(cur); const char* cB = S.b_base(cur);
    PG8_STAGE(PG8_SB(0, 0), cB, voffB); PG8_STAGE(PG8_SB(0, 1), cB + hstep, voffB); PG8_STAGE(PG8_SA(0, 0), cA, va[0]); PG8_STAGE(PG8_SA(0, 1), cA, va[1]);
    if (wr == 1) PG8_BAR;
    PG8_WAIT_V(2); PG8_BAR;
    PG8_STAGE(PG8_SB(1, 0), cB + kstep, voffB); PG8_STAGE(PG8_SA(1, 0), cA + kstep, va[0]); PG8_STAGE(PG8_SB(1, 1), cB + hstep + kstep, voffB);
    PG8_WAIT_V(6); PG8_BAR;
    for (;;) {
        const bool has_next = S.next(ui + 1, nxt);
        const char* nA = has_next ? S.a_base(nxt) : cA; const char* nB = has_next ? S.b_base(nxt) : cB;
        if (has_next) { PG8_VOFF(nva, nxt); } else {
#pragma unroll
            for (int h = 0; h < 2; ++h)
#pragma unroll
                for (int i = 0; i < 2; ++i) nva[h][i] = va[h][i]; }
        for (int t = 0; t < nt; t += 2) {
            const bool last = (t == nt - 2);
            const char* a1 = cA + (size_t)(t + 1) * kstep;
            const char* a2 = last ? nA : cA + (size_t)(t + 2) * kstep; const char* b2 = last ? nB : cB + (size_t)(t + 2) * kstep;
            const char* a3 = a2 + kstep; const char* b3 = b2 + kstep;
            unsigned v2[2][2];
#pragma unroll
            for (int h = 0; h < 2; ++h)
#pragma unroll
                for (int i = 0; i < 2; ++i) v2[h][i] = last ? nva[h][i] : va[h][i];
            PG8_LDB(B0, 0, 0); PG8_LDB(B1, 0, 1); PG8_SCHED; PG8_LDA(At, 0, 0); PG8_STAGE(PG8_SA(1, 1), a1, va[1]);
            PG8_WAIT_V(8); PG8_WAIT_L(0); PG8_BAR; PG8_MMA(0, 0, At, B0); PG8_MMA(0, 1, At, B1); PG8_BAR; PG8_SCHED;
            PG8_LDA(At, 0, 1); PG8_STAGE(PG8_SB(0, 0), b2, voffB); PG8_STAGE(PG8_SB(0, 1), b2 + hstep, voffB); PG8_STAGE(PG8_SA(0, 0), a2, v2[0]);
            PG8_WAIT_V(8); PG8_WAIT_L(0); PG8_BAR; PG8_MMA(1, 0, At, B0); PG8_MMA(1, 1, At, B1); PG8_BAR; PG8_SCHED;
            PG8_LDB(B0, 1, 0); PG8_LDB(B1, 1, 1); PG8_SCHED; PG8_LDA(At, 1, 0); PG8_STAGE(PG8_SA(0, 1), a2, v2[1]);
            PG8_WAIT_V(8); PG8_WAIT_L(0); PG8_BAR; PG8_MMA(0, 0, At, B0); PG8_MMA(0, 1, At, B1); PG8_BAR; PG8_SCHED;
            PG8_LDA(At, 1, 1); PG8_STAGE(PG8_SB(1, 0), b3, voffB); PG8_STAGE(PG8_SB(1, 1), b3 + hstep, voffB); PG8_STAGE(PG8_SA(1, 0), a3, v2[0]);
            PG8_WAIT_V(8); PG8_WAIT_L(0); PG8_BAR; PG8_MMA(1, 0, At, B0); PG8_MMA(1, 1, At, B1); PG8_BAR; PG8_SCHED;
        }
        if (wr == 0) PG8_BAR;
        E(acc, cur, wr, wc, fr, fq);
        if (!has_next) break;
#pragma unroll
        for (int a = 0; a < 2; ++a)
#pragma unroll
            for (int b = 0; b < 2; ++b)
#pragma unroll
                for (int m = 0; m < 4; ++m)
#pragma unroll
                    for (int n = 0; n < 2; ++n) acc[a][b][m][n] = (f32x4){0.f, 0.f, 0.f, 0.f};
        cur = nxt; cA = nA; cB = nB; ++ui;
#pragma unroll
        for (int h = 0; h < 2; ++h)
#pragma unroll
            for (int i = 0; i < 2; ++i) va[h][i] = nva[h][i];
        if (wr == 1) PG8_BAR;
    }
    PG8_WAIT_V(0);
    PG8_BAR;
#undef PG8_SA
#undef PG8_SB
#undef PG8_STAGE
#undef PG8_LDA
#undef PG8_LDB
#undef PG8_MMA
#undef PG8_WAIT_V
#undef PG8_WAIT_L
#undef PG8_BAR
#undef PG8_SCHED
#undef PG8_VOFF
}

struct EpiRowScaleBf16 {
    bf16* O; int ldc; const float* rs;
    __device__ __forceinline__ void operator()(const f32x4 (&acc)[2][2][4][2], const Unit& u, int wr, int wc, int fr, int fq) const {
        const int row0 = u.pm * BM + wr * 64 + fr, col0 = u.pn * BM + wc * 32 + 8 * fq;
        float sc[2][4];
#pragma unroll
        for (int ai = 0; ai < 2; ++ai)
#pragma unroll
            for (int m = 0; m < 4; ++m) sc[ai][m] = rs[row0 + ai * HALF + m * 16];
#pragma unroll
        for (int ai = 0; ai < 2; ++ai)
#pragma unroll
            for (int m = 0; m < 4; ++m) { const int row = row0 + ai * HALF + m * 16; const float s = sc[ai][m]; bf16* rowp = O + (size_t)row * ldc + col0;
#pragma unroll
                for (int bj = 0; bj < 2; ++bj) { const f32x4 v0 = acc[ai][bj][m][0] * s, v1 = acc[ai][bj][m][1] * s;
                    v4u w; w.x = cvt_pk_bf16(v0[0], v0[1]); w.y = cvt_pk_bf16(v0[2], v0[3]); w.z = cvt_pk_bf16(v1[0], v1[1]); w.w = cvt_pk_bf16(v1[2], v1[3]);
                    *(v4u*)(rowp + bj * HALF) = w; } }
    }
};
struct EpiPlainBf16 {
    bf16* O; int ldc;
    __device__ __forceinline__ void operator()(const f32x4 (&acc)[2][2][4][2], const Unit& u, int wr, int wc, int fr, int fq) const {
        const int row0 = u.pm * BM + wr * 64 + fr, col0 = u.pn * BM + wc * 32 + 8 * fq;
#pragma unroll
        for (int ai = 0; ai < 2; ++ai)
#pragma unroll
            for (int m = 0; m < 4; ++m) { const int row = row0 + ai * HALF + m * 16; bf16* rowp = O + (size_t)row * ldc + col0;
#pragma unroll
                for (int bj = 0; bj < 2; ++bj) { const f32x4 v0 = acc[ai][bj][m][0], v1 = acc[ai][bj][m][1];
                    v4u w; w.x = cvt_pk_bf16(v0[0], v0[1]); w.y = cvt_pk_bf16(v0[2], v0[3]); w.z = cvt_pk_bf16(v1[0], v1[1]); w.w = cvt_pk_bf16(v1[2], v1[3]);
                    *(v4u*)(rowp + bj * HALF) = w; } }
    }
};
struct EpiGateBf16 {
    bf16* O; int ldc; const float* rs; const float* bias;
    __device__ __forceinline__ void operator()(const f32x4 (&acc)[2][2][4][2], const Unit& u, int wr, int wc, int fr, int fq) const {
        const int row0 = u.pm * BM + wr * 64 + fr, col0 = u.pn * BM + wc * 32 + 8 * fq;
        float sc[2][4]; f32x4 bv[2][2];
#pragma unroll
        for (int ai = 0; ai < 2; ++ai)
#pragma unroll
            for (int m = 0; m < 4; ++m) sc[ai][m] = rs[row0 + ai * HALF + m * 16];
#pragma unroll
        for (int bj = 0; bj < 2; ++bj)
#pragma unroll
            for (int n = 0; n < 2; ++n) bv[bj][n] = *(const f32x4*)(bias + col0 + bj * HALF + 4 * n);
#pragma unroll
        for (int ai = 0; ai < 2; ++ai)
#pragma unroll
            for (int m = 0; m < 4; ++m) { const int row = row0 + ai * HALF + m * 16; const float s = sc[ai][m]; bf16* rowp = O + (size_t)row * ldc + col0;
#pragma unroll
                for (int bj = 0; bj < 2; ++bj) { f32x4 v0 = acc[ai][bj][m][0] * s + bv[bj][0], v1 = acc[ai][bj][m][1] * s + bv[bj][1];
#pragma unroll
                    for (int q = 0; q < 4; ++q) { v0[q] = fast_sigmoid(v0[q]); v1[q] = fast_sigmoid(v1[q]); }
                    v4u w; w.x = cvt_pk_bf16(v0[0], v0[1]); w.y = cvt_pk_bf16(v0[2], v0[3]); w.z = cvt_pk_bf16(v1[0], v1[1]); w.w = cvt_pk_bf16(v1[2], v1[3]);
                    *(v4u*)(rowp + bj * HALF) = w; } }
    }
};
}

struct Args { const float* in[25]; float* out; unsigned char* ws; int ph_lo, ph_hi; };

struct Frame {
    LAS unsigned char* lds; volatile LAS unsigned* MISC; gu32* ctl; int tid, lane, wave, vcu, G;
};
__device__ __forceinline__ float wave_sum(float v) {
#pragma unroll
    for (int o = 1; o < 64; o <<= 1) v += __shfl_xor(v, o);
    return v;
}
template <int RM, bool HAS_CS>
__device__ __forceinline__ void p0_transpose_item(const float* __restrict__ W, int K, int N, bf16* __restrict__ WT, int row_off, const float* __restrict__ cs, LAS float* scr, int item, int lane) {
    const int nblk = N / 32, kb = item / nblk, nb = item % nblk, k0 = 64 * kb, n0 = 32 * nb;
    const int c = lane & 7;
    f32x4 s0 = {1.f, 1.f, 1.f, 1.f}, s1 = {1.f, 1.f, 1.f, 1.f};
    if (HAS_CS) { s0 = *(const f32x4*)(cs + k0 + 8 * c); s1 = *(const f32x4*)(cs + k0 + 8 * c + 4); }
#pragma unroll 8
    for (int i = 0; i < 32; ++i) { const int kk = 2 * i + (lane >> 5); scr[kk * 33 + (lane & 31)] = W[(size_t)(k0 + kk) * N + n0 + (lane & 31)]; }
    LDS_WAIT(); asm volatile("" ::: "memory");
#pragma unroll
    for (int j = 0; j < 4; ++j) { const int n = (lane >> 3) + 8 * j; const LAS float* s = scr + (8 * c) * 33 + n;
        v4u o; o.x = pk2(s[0 * 33] * s0.x, s[1 * 33] * s0.y); o.y = pk2(s[2 * 33] * s0.z, s[3 * 33] * s0.w); o.z = pk2(s[4 * 33] * s1.x, s[5 * 33] * s1.y); o.w = pk2(s[6 * 33] * s1.z, s[7 * 33] * s1.w);
        const int nn = n0 + n; const int orow = RM == 0 ? row_off + nn : (row_off + 8 * (nn >> 2) + (nn & 3) + (RM == 2 ? 4 : 0));
        *(GAS v4u*)(WT + (size_t)orow * K + k0 + 8 * c) = o; }
    LDS_WAIT(); asm volatile("" ::: "memory");
}
struct Ptrs {
    const float *x, *p, *g_mix, *w_in, *conv_w, *conv_b, *wa, *ba, *wx, *bx, *lam, *w_out, *g_ffn, *w_rg, *b_rg, *w_re, *b_re, *w1, *w3, *w2, *g_ple, *w_pg, *b_pg, *w_pp, *g_final;
    float* out; unsigned char* ws;
    float *rstd0, *rstd1, *rstd2; int* eid; float* ew; int* list; int* counts; int* goffs;
    bf16 *W_IN, *W_OUT, *W_PG, *W_PP, *WRT, *LRUW, *W13, *W2, *PB, *XB, *MIX, *ACT, *GATE, *PROJ, *D1, *X1B, *X2B, *Y, *PP;
};
__device__ __forceinline__ void make_ptrs(Ptrs& P, const Args& a) {
    P.x = a.in[0]; P.p = a.in[1]; P.g_mix = a.in[2]; P.w_in = a.in[3]; P.conv_w = a.in[4]; P.conv_b = a.in[5]; P.wa = a.in[6]; P.ba = a.in[7]; P.wx = a.in[8]; P.bx = a.in[9]; P.lam = a.in[10];
    P.w_out = a.in[11]; P.g_ffn = a.in[12]; P.w_rg = a.in[13]; P.b_rg = a.in[14]; P.w_re = a.in[15]; P.b_re = a.in[16]; P.w1 = a.in[17]; P.w3 = a.in[18]; P.w2 = a.in[19];
    P.g_ple = a.in[20]; P.w_pg = a.in[21]; P.b_pg = a.in[22]; P.w_pp = a.in[23]; P.g_final = a.in[24];
    P.out = a.out; P.ws = a.ws; unsigned char* ws = a.ws;
    P.rstd0 = (float*)(ws + WS_RSTD0); P.rstd1 = (float*)(ws + WS_RSTD1); P.rstd2 = (float*)(ws + WS_RSTD2);
    P.eid = (int*)(ws + WS_EID); P.ew = (float*)(ws + WS_EW); P.list = (int*)(ws + WS_LIST); P.counts = (int*)(ws + WS_CNT); P.goffs = P.counts + 256 * NE;
    P.W_IN = (bf16*)(ws + WS_WIN); P.W_OUT = (bf16*)(ws + WS_WOUT); P.W_PG = (bf16*)(ws + WS_WPG); P.W_PP = (bf16*)(ws + WS_WPP); P.WRT = (bf16*)(ws + WS_WRT); P.LRUW = (bf16*)(ws + WS_LRUW);
    P.W13 = (bf16*)(ws + WS_W13); P.W2 = (bf16*)(ws + WS_W2); P.PB = (bf16*)(ws + WS_PB);
    P.XB = (bf16*)(ws + WS_R64); P.MIX = (bf16*)(ws + WS_R64); P.ACT = (bf16*)(ws + WS_R64); P.GATE = (bf16*)(ws + WS_R64);
    P.PROJ = (bf16*)(ws + WS_PROJ); P.D1 = (bf16*)(ws + WS_D1); P.PP = (bf16*)(ws + WS_PP); P.X1B = (bf16*)(ws + WS_X1B); P.X2B = (bf16*)(ws + WS_X1B); P.Y = (bf16*)(ws + WS_Y);
}

__device__ __forceinline__ void p0_prologue(Frame& F, const Ptrs& P) {
    LAS float* scr = (LAS float*)(F.lds + RING_OFF + F.wave * 16384);
    const int gw = F.vcu * NWAVES + F.wave, NGW = F.G * NWAVES;
    constexpr int I_WIN = (D / 64) * (INC / 32), I_SQ = (D / 64) * (D / 32), I_WPP = (PLE / 64) * (D / 32), I_W1 = (D / 64) * (DE / 32), I_W2 = (DE / 64) * (D / 32);
    constexpr int NITEMS = I_WIN + 2 * I_SQ + I_WPP + NE * (2 * I_W1 + I_W2);
    for (int it = gw; it < NITEMS; it += NGW) {
        int r = it;
        if (r < I_WIN) { p0_transpose_item<0, true>(P.w_in, D, INC, P.W_IN, 0, P.g_mix, scr, r, F.lane); continue; } r -= I_WIN;
        if (r < I_SQ) { p0_transpose_item<0, false>(P.w_out, D, D, P.W_OUT, 0, nullptr, scr, r, F.lane); continue; } r -= I_SQ;
        if (r < I_SQ) { p0_transpose_item<0, true>(P.w_pg, D, D, P.W_PG, 0, P.g_ple, scr, r, F.lane); continue; } r -= I_SQ;
        if (r < I_WPP) { p0_transpose_item<0, false>(P.w_pp, PLE, D, P.W_PP, 0, nullptr, scr, r, F.lane); continue; } r -= I_WPP;
        const int per_e = 2 * I_W1 + I_W2, e = r / per_e; r -= e * per_e;
        if (r < I_W1) { p0_transpose_item<1, true>(P.w1 + (size_t)e * D * DE, D, DE, P.W13 + (size_t)e * D * D, 0, P.g_ffn, scr, r, F.lane); continue; } r -= I_W1;
        if (r < I_W1) { p0_transpose_item<2, true>(P.w3 + (size_t)e * D * DE, D, DE, P.W13 + (size_t)e * D * D, 0, P.g_ffn, scr, r, F.lane); continue; } r -= I_W1;
        p0_transpose_item<0, false>(P.w2 + (size_t)e * DE * D, DE, D, P.W2 + (size_t)e * D * DE, 0, nullptr, scr, r, F.lane);
    }
    for (int m = gw; m < T; m += NGW) {
        const GAS f32x4* xr = (const GAS f32x4*)(P.x + (size_t)m * D) + F.lane;
        f32x4 v[4]; float s = 0.f;
#pragma unroll
        for (int j = 0; j < 4; ++j) { v[j] = xr[64 * j]; s += (v[j].x * v[j].x + v[j].y * v[j].y) + (v[j].z * v[j].z + v[j].w * v[j].w); }
        s = wave_sum(s);
        GAS v2u* o8 = (GAS v2u*)(P.XB + (size_t)m * D) + F.lane;
#pragma unroll
        for (int j = 0; j < 4; ++j) { v2u w; w.x = pk2(v[j].x, v[j].y); w.y = pk2(v[j].z, v[j].w); o8[64 * j] = w; }
        if (F.lane == 0) P.rstd0[m] = 1.0f / sqrtf(s * (1.f / D) + EPS);
    }
    for (int m = gw; m < T; m += NGW) {
        const f32x4 v = *((const GAS f32x4*)(P.p + (size_t)m * PLE) + F.lane);
        v2u w; w.x = pk2(v.x, v.y); w.y = pk2(v.z, v.w); *((GAS v2u*)(P.PB + (size_t)m * PLE) + F.lane) = w;
    }
    for (int idx = (F.vcu * NTHR + F.tid); idx < 80 * D; idx += F.G * NTHR) {
        const int n = idx / D, k = idx % D; float v = 0.f;
        if (n < NG) v = P.w_rg[(size_t)k * NG + n] * P.g_ffn[k]; else if (n < NG + NE) v = P.w_re[(size_t)k * NE + (n - NG)] * P.g_ffn[k];
        const bf16 hi = f2bf(v); const bf16 lo = f2bf(v - bf2f(hi));
        P.WRT[idx] = hi; P.WRT[80 * D + idx] = lo;
    }
    for (int idx = (F.vcu * NTHR + F.tid); idx < 2 * 8 * 64 * 64; idx += F.G * NTHR) {
        const int g = idx >> 15, r = idx & 32767, hb = r >> 12, j = (r >> 6) & 63, i = r & 63;
        const float* w = g ? P.wx : P.wa;
        P.LRUW[idx] = f2bf(w[(hb * 64 + i) * 64 + j]);
    }
}


__device__ __forceinline__ f32x4 bf4(v2u w) { return (f32x4){bflo(w.x), bfhi(w.x), bflo(w.y), bfhi(w.y)}; }
__device__ __forceinline__ void p10_combine(Frame& F, const Ptrs& P) {
    const int gw = F.vcu * NWAVES + F.wave, NGW = F.G * NWAVES;
    for (int m = gw; m < T; m += NGW) {
        const size_t ro = (size_t)m * D;
        const GAS f32x4* xr = (const GAS f32x4*)(P.x + ro) + F.lane;
        const GAS v2u* d1 = (const GAS v2u*)(P.D1 + ro) + F.lane; const GAS v2u* y0 = (const GAS v2u*)(P.Y + ro) + F.lane; const GAS v2u* y1 = (const GAS v2u*)(P.Y + (size_t)T * D + ro) + F.lane;
        f32x4 v[4]; v2u a[4], b[4], c[4];
#pragma unroll
        for (int j = 0; j < 4; ++j) { v[j] = xr[64 * j]; a[j] = d1[64 * j]; b[j] = y0[64 * j]; c[j] = y1[64 * j]; }
        float s = 0.f;
#pragma unroll
        for (int j = 0; j < 4; ++j) { v[j] = (v[j] + bf4(a[j])) + (bf4(b[j]) + bf4(c[j])); s += (v[j].x * v[j].x + v[j].y * v[j].y) + (v[j].z * v[j].z + v[j].w * v[j].w); }
        s = wave_sum(s);
        GAS f32x4* o = (GAS f32x4*)(P.out + ro) + F.lane; GAS v2u* o8 = (GAS v2u*)(P.X2B + ro) + F.lane;
#pragma unroll
        for (int j = 0; j < 4; ++j) { o[64 * j] = v[j]; v2u w; w.x = pk2(v[j].x, v[j].y); w.y = pk2(v[j].z, v[j].w); o8[64 * j] = w; }
        if (F.lane == 0) P.rstd2[m] = 1.0f / sqrtf(s * (1.f / D) + EPS);
    }
}
__device__ __forceinline__ void p13_final(Frame& F, const Ptrs& P) {
    const int gw = F.vcu * NWAVES + F.wave, NGW = F.G * NWAVES;
    f32x4 gf[4];
#pragma unroll
    for (int j = 0; j < 4; ++j) gf[j] = *((const GAS f32x4*)P.g_final + F.lane + 64 * j);
    for (int m = gw; m < T; m += NGW) {
        const size_t ro = (size_t)m * D;
        GAS f32x4* xr = (GAS f32x4*)(P.out + ro) + F.lane;
        const GAS v2u* ga = (const GAS v2u*)(P.GATE + ro) + F.lane; const GAS v2u* pp = (const GAS v2u*)(P.PP + ro) + F.lane;
        f32x4 v[4]; v2u a[4], b[4];
#pragma unroll
        for (int j = 0; j < 4; ++j) { v[j] = xr[64 * j]; a[j] = ga[64 * j]; b[j] = pp[64 * j]; }
        float s = 0.f;
#pragma unroll
        for (int j = 0; j < 4; ++j) { v[j] = v[j] + bf4(a[j]) * bf4(b[j]); s += (v[j].x * v[j].x + v[j].y * v[j].y) + (v[j].z * v[j].z + v[j].w * v[j].w); }
        s = wave_sum(s);
        const float r = 1.0f / sqrtf(s * (1.f / D) + EPS);
#pragma unroll
        for (int j = 0; j < 4; ++j) xr[64 * j] = v[j] * r * gf[j];
    }
}
__device__ __forceinline__ LAS int* sched_offs(Frame& F) { return (LAS int*)(F.lds + SCHED_OFF); }
__device__ __forceinline__ LAS int* sched_tileb(Frame& F) { return (LAS int*)(F.lds + SCHED_OFF) + 72; }
__device__ __forceinline__ LAS int* sched_pre(Frame& F) { return (LAS int*)(F.lds + SCHED_OFF) + 144; }
__device__ __forceinline__ void sched_build(Frame& F, const Ptrs& P) {
    LAS int* offs = sched_offs(F); LAS int* tb = sched_tileb(F); LAS int* pre = sched_pre(F);
    LAS int* part = (LAS int*)(F.lds + UTAB_OFF);
    {
        const int e = F.tid & 63, pt = F.tid >> 6; int t = 0, p = 0; int cv[32];
#pragma unroll
        for (int j = 0; j < 32; ++j) cv[j] = P.counts[(pt * 32 + j) * NE + e];
#pragma unroll
        for (int j = 0; j < 32; ++j) { t += cv[j]; p += (pt * 32 + j < F.vcu) ? cv[j] : 0; }
        part[(pt * 64 + e) * 2] = t; part[(pt * 64 + e) * 2 + 1] = p;
    }
    __syncthreads();
    if (F.tid < NE) { int t = 0, p = 0;
#pragma unroll
        for (int pt = 0; pt < 8; ++pt) { t += part[(pt * 64 + F.tid) * 2]; p += part[(pt * 64 + F.tid) * 2 + 1]; }
        pre[F.tid] = p; part[1024 + F.tid] = t; }
    __syncthreads();
    if (F.tid == 0) { int o = 0, tbv = 0; for (int e = 0; e < NE; ++e) { offs[e] = o; tb[e] = tbv; const int t = part[1024 + e]; o += t; tbv += (t + 255) >> 8; } offs[NE] = o; tb[NE] = tbv; }
    __syncthreads();
}

constexpr int P6_BROW = 272, P6_BHL = 80 * P6_BROW, P6_BBUF = 2 * P6_BHL, P6_LG_OFF = 90112;
static_assert(2 * P6_BBUF <= P6_LG_OFF && P6_LG_OFF + 8 * 16 * 80 * 4 <= RING_BYTES, "P6 LDS map");
__device__ __forceinline__ void p6_route(Frame& F, const Ptrs& P) {
    const int lane = F.lane, r = lane & 15, g = lane >> 4;
    const int tok = F.vcu * 128 + F.wave * 16 + r;
    LAS unsigned char* BS = F.lds + RING_OFF;
    LAS float* LG = (LAS float*)(F.lds + RING_OFF + P6_LG_OFF) + F.wave * (16 * 80);
    LAS float* SS = (LAS float*)(F.lds + UTAB_OFF) + F.wave * 16;
    LAS int* hist = (LAS int*)(F.lds + UTAB_OFF + 1024);
    if (F.tid < NE) hist[F.tid] = 0;
    f32x4 acc[5];
#pragma unroll
    for (int i = 0; i < 5; ++i) acc[i] = (f32x4){0.f, 0.f, 0.f, 0.f};
    float ssq = 0.f;
    const float* xrow = P.x + (size_t)tok * D + 8 * g; const bf16* drow = P.D1 + (size_t)tok * D + 8 * g; bf16* orow = P.X1B + (size_t)tok * D + 8 * g;
    unsigned bsrc[5], bdst[5];
#pragma unroll
    for (int i = 0; i < 5; ++i) { const int id = F.tid + 512 * i, hl = id / 1280, rem = id % 1280, row = rem >> 4, ch = rem & 15;
        bsrc[i] = (unsigned)((hl * 80 + row) * D + 8 * ch) * 2u; bdst[i] = (unsigned)(hl * P6_BHL + row * P6_BROW + ch * 16); }
    v4u breg[5]; f32x4 xa[4], xb[4]; v4u dd[4];
#pragma unroll
    for (int i = 0; i < 5; ++i) breg[i] = *(const v4u*)((const char*)P.WRT + bsrc[i]);
#pragma unroll
    for (int s = 0; s < 4; ++s) { xa[s] = *(const f32x4*)(xrow + 32 * s); xb[s] = *(const f32x4*)(xrow + 32 * s + 4); dd[s] = *(const v4u*)(drow + 32 * s); }
#pragma unroll 1
    for (int sl = 0; sl < 8; ++sl) {
        LAS unsigned char* bb = BS + (sl & 1) * P6_BBUF;
#pragma unroll
        for (int i = 0; i < 5; ++i) *(LAS v4u*)(bb + bdst[i]) = breg[i];
        __syncthreads();
        f32x4 cxa[4], cxb[4]; v4u cdd[4];
#pragma unroll
        for (int s = 0; s < 4; ++s) { cxa[s] = xa[s]; cxb[s] = xb[s]; cdd[s] = dd[s]; }
        if (sl < 7) {
#pragma unroll
            for (int i = 0; i < 5; ++i) breg[i] = *(const v4u*)((const char*)P.WRT + bsrc[i] + (sl + 1) * 256);
#pragma unroll
            for (int s = 0; s < 4; ++s) { xa[s] = *(const f32x4*)(xrow + 128 * (sl + 1) + 32 * s); xb[s] = *(const f32x4*)(xrow + 128 * (sl + 1) + 32 * s + 4); dd[s] = *(const v4u*)(drow + 128 * (sl + 1) + 32 * s); }
        }
#pragma unroll
        for (int s = 0; s < 4; ++s) {
            float v[8];
            v[0] = cxa[s][0] + bflo(cdd[s].x); v[1] = cxa[s][1] + bfhi(cdd[s].x); v[2] = cxa[s][2] + bflo(cdd[s].y); v[3] = cxa[s][3] + bfhi(cdd[s].y);
            v[4] = cxb[s][0] + bflo(cdd[s].z); v[5] = cxb[s][1] + bfhi(cdd[s].z); v[6] = cxb[s][2] + bflo(cdd[s].w); v[7] = cxb[s][3] + bfhi(cdd[s].w);
            v4u hw, lw;
#pragma unroll
            for (int q = 0; q < 4; ++q) {
                ssq += v[2 * q] * v[2 * q] + v[2 * q + 1] * v[2 * q + 1];
                const unsigned h = cvt_pk_bf16(v[2 * q], v[2 * q + 1]);
                const unsigned l = cvt_pk_bf16(v[2 * q] - bflo(h), v[2 * q + 1] - bfhi(h));
                hw[q] = h; lw[q] = l;
            }
            *(v4u*)(orow + 128 * sl + 32 * s) = hw;
            const bf16x8 ah = __builtin_bit_cast(bf16x8, hw), al = __builtin_bit_cast(bf16x8, lw);
#pragma unroll
            for (int nt = 0; nt < 5; ++nt) {
                const bf16x8 bh = *(const LAS bf16x8*)(bb + (16 * nt + r) * P6_BROW + (32 * s + 8 * g) * 2), bl = *(const LAS bf16x8*)(bb + P6_BHL + (16 * nt + r) * P6_BROW + (32 * s + 8 * g) * 2);
                acc[nt] = __builtin_amdgcn_mfma_f32_16x16x32_bf16(ah, bh, acc[nt], 0, 0, 0);
                acc[nt] = __builtin_amdgcn_mfma_f32_16x16x32_bf16(al, bh, acc[nt], 0, 0, 0);
                acc[nt] = __builtin_amdgcn_mfma_f32_16x16x32_bf16(ah, bl, acc[nt], 0, 0, 0);
            }
        }
    }
    ssq += __shfl_xor(ssq, 16); ssq += __shfl_xor(ssq, 32);
#pragma unroll
    for (int nt = 0; nt < 5; ++nt)
#pragma unroll
        for (int q = 0; q < 4; ++q) LG[(4 * g + q) * 80 + 16 * nt + r] = acc[nt][q];
    if (g == 0) SS[r] = ssq;
    __syncthreads();
    if (g == 0) {
        const float rs = 1.0f / sqrtf(SS[r] * (1.f / D) + EPS);
        const LAS float* L = LG + r * 80;
        float gl[8]; float mx = -3.0e38f; int gsel = 0;
#pragma unroll
        for (int i = 0; i < 8; ++i) { gl[i] = rs * L[i] + P.b_rg[i]; if (gl[i] > mx) { mx = gl[i]; gsel = i; } }
        float den = 0.f;
#pragma unroll
        for (int i = 0; i < 8; ++i) den += expf(gl[i] - mx);
        const float gw = 1.f / den;
        float v0 = -3.0e38f, v1 = -3.0e38f; int i0 = 0, i1 = 0;
        for (int i = 0; i < 8; ++i) {
            const float v = rs * L[8 + gsel * 8 + i] + P.b_re[gsel * 8 + i];
            if (v > v0) { v1 = v0; i1 = i0; v0 = v; i0 = i; } else if (v > v1) { v1 = v; i1 = i; }
        }
        const float e1 = expf(v1 - v0), w0 = 1.f / (1.f + e1), w1 = e1 / (1.f + e1);
        const int ea = gsel * 8 + i0, eb = gsel * 8 + i1;
        P.eid[tok * 2] = ea; P.eid[tok * 2 + 1] = eb; P.ew[tok * 2] = w0 * gw; P.ew[tok * 2 + 1] = w1 * gw; P.rstd1[tok] = rs;
        __hip_atomic_fetch_add(hist + ea, 1, __ATOMIC_RELAXED, __HIP_MEMORY_SCOPE_WORKGROUP); __hip_atomic_fetch_add(hist + eb, 1, __ATOMIC_RELAXED, __HIP_MEMORY_SCOPE_WORKGROUP);
    }
    __syncthreads();
    if (F.tid < NE) P.counts[F.vcu * NE + F.tid] = hist[F.tid];
}

__device__ __forceinline__ void p7_lists(Frame& F, const Ptrs& P) {
    sched_build(F, P);
    LAS int* offs = sched_offs(F); LAS int* pre = sched_pre(F);
    LAS int* eids = (LAS int*)(F.lds + RING_OFF);
    if (F.tid < 256) eids[F.tid] = P.eid[F.vcu * 256 + F.tid];
    __syncthreads();
    if (F.tid < NE) {
        const int e = F.tid; int pos = offs[e] + pre[e];
        for (int a = 0; a < 256; ++a) if (eids[a] == e) { P.list[pos] = F.vcu * 256 + a; ++pos; }
    }
    if (blockIdx.x == 0 && F.tid <= NE) P.goffs[F.tid] = offs[F.tid];
    __syncthreads();
}

namespace pg8 {
template <int MODE>
struct MoeSched {
    const char* Ab; const char* Bb; int K, G, c; LAS int* offs; LAS int* tb; LAS int* tab;
    __device__ __forceinline__ bool next(int i, Unit& u) const {
        const int L = i * G + c; const int ntile = __builtin_amdgcn_readfirstlane(tb[NE]);
        if (L >= 4 * ntile) return false;
        const int rt = L >> 2; int e = 0;
        for (int k = 1; k < NE; ++k) e += (tb[k] <= rt) ? 1 : 0;
        e = __builtin_amdgcn_readfirstlane(e);
        u.e = e; u.pm = rt - __builtin_amdgcn_readfirstlane(tb[e]); u.pn = L & 3; u.slot0 = __builtin_amdgcn_readfirstlane(offs[e]) + 256 * u.pm;
        const int left = __builtin_amdgcn_readfirstlane(offs[e + 1]) - u.slot0; u.rows = left < 256 ? left : 256; u.ui = i; return true;
    }
    __device__ __forceinline__ const char* a_base(const Unit& u) const { return MODE == 0 ? Ab : Ab + (size_t)u.slot0 * (size_t)(DE * 2); }
    __device__ __forceinline__ const char* b_base(const Unit& u) const { return Bb + ((size_t)u.e * D + (size_t)u.pn * BM) * (size_t)K * 2; }
    __device__ __forceinline__ unsigned a_rowoff(const Unit& u, int r) const { return MODE == 0 ? (unsigned)tab[u.ui * 256 + r] : (unsigned)r * (unsigned)(DE * 2); }
};
struct EpiAct {
    bf16* ACT; const LAS float* tabf;
    __device__ __forceinline__ void operator()(const f32x4 (&acc)[2][2][4][2], const Unit& u, int wr, int wc, int fr, int fq) const {
#pragma unroll
        for (int ai = 0; ai < 2; ++ai)
#pragma unroll
            for (int m = 0; m < 4; ++m) { const int r = ai * HALF + wr * 64 + m * 16 + fr;
                if (r < u.rows) { const float s = tabf[u.ui * 256 + r]; bf16* rowp = ACT + (size_t)(u.slot0 + r) * DE + u.pn * 128 + wc * 16 + 4 * fq;
#pragma unroll
                    for (int bj = 0; bj < 2; ++bj) { const f32x4 h1 = acc[ai][bj][m][0] * s, h3 = acc[ai][bj][m][1] * s; f32x4 a;
#pragma unroll
                        for (int q = 0; q < 4; ++q) a[q] = h1[q] * fast_sigmoid(h1[q]) * h3[q];
                        v2u w; w.x = cvt_pk_bf16(a[0], a[1]); w.y = cvt_pk_bf16(a[2], a[3]); *(v2u*)(rowp + bj * 64) = w; } } }
    }
};
struct EpiY {
    bf16* Y; const LAS int* tab; const LAS float* tabf;
    __device__ __forceinline__ void operator()(const f32x4 (&acc)[2][2][4][2], const Unit& u, int wr, int wc, int fr, int fq) const {
#pragma unroll
        for (int ai = 0; ai < 2; ++ai)
#pragma unroll
            for (int m = 0; m < 4; ++m) { const int r = ai * HALF + wr * 64 + m * 16 + fr; const int aid = tab[u.ui * 256 + r];
                if (aid >= 0) { const float s = tabf[u.ui * 256 + r]; bf16* rowp = Y + ((size_t)(aid & 1) * T + (size_t)(aid >> 1)) * D + u.pn * BM + wc * 32 + 8 * fq;
#pragma unroll
                    for (int bj = 0; bj < 2; ++bj) { const f32x4 v0 = acc[ai][bj][m][0] * s, v1 = acc[ai][bj][m][1] * s;
                        v4u w; w.x = cvt_pk_bf16(v0[0], v0[1]); w.y = cvt_pk_bf16(v0[2], v0[3]); w.z = cvt_pk_bf16(v1[0], v1[1]); w.w = cvt_pk_bf16(v1[2], v1[3]);
                        *(v4u*)(rowp + bj * HALF) = w; } } }
    }
};
}
template <int MODE>
__device__ __forceinline__ void moe_phase(Frame& F, const Ptrs& P, bool rebuild) {
    if (rebuild) sched_build(F, P);
    LAS int* tab = (LAS int*)(F.lds + UTAB_OFF); LAS float* tabf = (LAS float*)(F.lds + UTABF_OFF);
    LAS int* uinfo = (LAS int*)(F.lds + SCHED_OFF) + 208;
    pg8::MoeSched<MODE> S; S.Ab = MODE == 0 ? (const char*)P.X1B : (const char*)P.ACT; S.Bb = MODE == 0 ? (const char*)P.W13 : (const char*)P.W2; S.K = MODE == 0 ? D : DE; S.G = F.G; S.c = F.vcu;
    S.offs = sched_offs(F); S.tb = sched_tileb(F); S.tab = tab;
    if (F.tid < 64) {
#pragma unroll
        for (int i = 0; i < MAXU; ++i) { pg8::Unit u; const bool ok = S.next(i, u); if (F.tid == 0) { uinfo[2 * i] = ok ? u.slot0 : 0; uinfo[2 * i + 1] = ok ? u.rows : 0; } }
    }
    __syncthreads();
    {
        const int r = F.tid & 255, i0 = F.tid >> 8; int aid[3]; bool val[3], act[3];
#pragma unroll
        for (int it = 0; it < 3; ++it) { const int i = i0 + 2 * it; const int s0 = uinfo[2 * i], rows = uinfo[2 * i + 1]; act[it] = rows > 0; val[it] = r < rows; aid[it] = act[it] ? P.list[s0 + (val[it] ? r : 0)] : 0; }
        float fv[3];
#pragma unroll
        for (int it = 0; it < 3; ++it) fv[it] = act[it] ? (MODE == 0 ? P.rstd1[aid[it] >> 1] : P.ew[aid[it]]) : 0.f;
#pragma unroll
        for (int it = 0; it < 3; ++it) if (act[it]) { const int i = i0 + 2 * it;
            if (MODE == 0) tab[i * 256 + r] = (aid[it] >> 1) * (D * 2); else tab[i * 256 + r] = val[it] ? aid[it] : -1;
            tabf[i * 256 + r] = fv[it]; }
    }
    __syncthreads();
    if (MODE == 0) { pg8::EpiAct E{P.ACT, tabf}; pg8::gemm_phase(F.lds + RING_OFF, S, E); }
    else { pg8::EpiY E{P.Y, tab, tabf}; pg8::gemm_phase(F.lds + RING_OFF, S, E); }
}
typedef short v4i16 __attribute__((ext_vector_type(4)));
__device__ __forceinline__ unsigned off_b(unsigned row, unsigned ch) { return 256u * row + 16u * (ch ^ (((row & 3u) << 2) | ((row >> 2) & 3u))); }
__device__ __forceinline__ unsigned row_read_addr_16(unsigned lane, unsigned rb, unsigned s) { return off_b((lane & 15u) + 16u * rb, 4u * s + (lane >> 4)); }
__device__ __forceinline__ unsigned tr_read_addr_16(unsigned lane, unsigned c, unsigned ks, unsigned t) {
    const unsigned g = lane >> 4, q = (lane & 15u) >> 2, p = lane & 3u;
    return off_b(32u * ks + 8u * g + 4u * t + q, 2u * c + (p >> 1)) + 8u * (p & 1u);
}
__device__ __forceinline__ bf16x8 tr_frag2(LAS unsigned char* p0, LAS unsigned char* p1) {
    const v4i16 a = __builtin_amdgcn_ds_read_tr16_b64_v4i16((LAS v4i16*)p0);
    const v4i16 b = __builtin_amdgcn_ds_read_tr16_b64_v4i16((LAS v4i16*)p1);
    return (bf16x8){a[0], a[1], a[2], a[3], b[0], b[1], b[2], b[3]};
}
__device__ __forceinline__ void wave_lds_fence() { asm volatile("s_waitcnt lgkmcnt(0)" ::: "memory"); __builtin_amdgcn_wave_barrier(); asm volatile("" ::: "memory"); }
__device__ __forceinline__ float gelu_tanh_fast(float x) {
    const float u = 0.7978845608028654f * (x + 0.044715f * x * x * x);
    return x * fast_sigmoid(2.f * u);
}
constexpr float LOG2_ROPE_OVER_64 = 13.287712379549449f / 64.f;
constexpr int MIX_K_OFF = 0, MIX_V_OFF = 32768, MIX_S_OFF = 65536, MIX_S_STRIDE = 272, MIX_S_WAVE = 16 * MIX_S_STRIDE;
constexpr int MIX_CW_OFF = 0, MIX_XC_OFF = 12288, MIX_XC_WAVE = 16 * 68 * 4;
static_assert(MIX_S_OFF + 8 * MIX_S_WAVE <= RING_BYTES && MIX_XC_OFF + 8 * MIX_XC_WAVE <= RING_BYTES, "mixing LDS map");

__device__ __forceinline__ void sincos_rev(float ang, float& sn, float& cs) {
    float rev = ang * 0.15915494309189535f; rev -= floorf(rev);
    sn = __builtin_amdgcn_sinf(rev); cs = __builtin_amdgcn_cosf(rev);
}
template <bool DECAY>
__device__ __forceinline__ void load_kv_tiles(Frame& F, const bf16* proj_t0, int h, int s0, float lg2) {
    LAS unsigned char* Kimg = F.lds + MIX_K_OFF; LAS unsigned char* Vimg = F.lds + MIX_V_OFF;
    const int dg = F.tid & 7;
    float inv[8];
#pragma unroll
    for (int j = 0; j < 8; ++j) inv[j] = __builtin_amdgcn_exp2f(-(float)(8 * dg + j) * LOG2_ROPE_OVER_64);
#pragma unroll
    for (int it = 0; it < 2; ++it) {
        const int c = (F.tid >> 3) + 64 * it;
        const bf16* row = proj_t0 + (size_t)c * INC + 1536 + h * HD + 8 * dg;
        const v4u k1 = *(const v4u*)row, k2 = *(const v4u*)(row + 64);
        const float sc = 0.08838834764831845f * (DECAY ? __builtin_amdgcn_exp2f((float)(127 - c) * lg2) : 1.f);
        const float pos = (float)(s0 + c);
        v4u o1, o2;
#pragma unroll
        for (int q = 0; q < 4; ++q) {
            float sn0, cs0, sn1, cs1; sincos_rev(pos * inv[2 * q], sn0, cs0); sincos_rev(pos * inv[2 * q + 1], sn1, cs1);
            const float a0 = bflo(k1[q]), a1 = bfhi(k1[q]), b0 = bflo(k2[q]), b1 = bfhi(k2[q]);
            o1[q] = cvt_pk_bf16((a0 * cs0 - b0 * sn0) * sc, (a1 * cs1 - b1 * sn1) * sc);
            o2[q] = cvt_pk_bf16((a0 * sn0 + b0 * cs0) * sc, (a1 * sn1 + b1 * cs1) * sc);
        }
        *(LAS v4u*)(Kimg + off_b(c, dg)) = o1; *(LAS v4u*)(Kimg + off_b(c, dg + 8)) = o2;
    }
#pragma unroll
    for (int it = 0; it < 4; ++it) {
        const int id = F.tid + 512 * it, c = id >> 4, ch = id & 15;
        *(LAS v4u*)(Vimg + off_b(c, ch)) = *(const v4u*)(proj_t0 + (size_t)c * INC + 2048 + h * HD + 8 * ch);
    }
}

template <bool FINAL>
__device__ __forceinline__ void lru_chunk(Frame& F, const Ptrs& P, int b, int n, int lane) {
    const int r = lane & 15, g = lane >> 4, hb = F.wave;
    const int t0 = b * S + n * CH;
    LAS float* CW = (LAS float*)(F.lds + MIX_CW_OFF);
    LAS float* XC = (LAS float*)(F.lds + MIX_XC_OFF + F.wave * MIX_XC_WAVE);
    for (int i = F.tid; i < 5 * DL; i += NTHR) CW[i] = i < 4 * DL ? P.conv_w[i] : P.conv_b[i - 4 * DL];
    __syncthreads();
    bf16x8 Wa[4][2], Wx[4][2];
#pragma unroll
    for (int jt = 0; jt < 4; ++jt)
#pragma unroll
        for (int ks = 0; ks < 2; ++ks) {
            Wa[jt][ks] = *(const bf16x8*)(P.LRUW + ((size_t)(0 * 8 + hb) * 64 + 16 * jt + r) * 64 + 32 * ks + 8 * g);
            Wx[jt][ks] = *(const bf16x8*)(P.LRUW + ((size_t)(1 * 8 + hb) * 64 + 16 * jt + r) * 64 + 32 * ks + 8 * g);
        }
    float ba[4], bx[4], sp8[4], St[4], At[4];
#pragma unroll
    for (int jt = 0; jt < 4; ++jt) { const int ch = hb * 64 + 16 * jt + r; ba[jt] = P.ba[ch]; bx[jt] = P.bx[ch];
        const float nl = -P.lam[ch]; sp8[jt] = 8.f * (nl > 20.f ? nl : log1pf(expf(nl)));
        St[jt] = FINAL ? ((const float*)(P.ws + WS_LRU))[2 * B * NCH * DL + (b * NCH + n) * DL + ch] : 0.f; At[jt] = 1.f; }
#pragma unroll 1
    for (int tt = 0; tt < 8; ++tt) {
        const int c = 16 * tt + r;
        bf16 glv[4][4];
        if (FINAL) {
#pragma unroll
            for (int jt = 0; jt < 4; ++jt)
#pragma unroll
                for (int q = 0; q < 4; ++q) glv[jt][q] = P.PROJ[(size_t)(t0 + 16 * tt + 4 * g + q) * INC + DL + hb * 64 + 16 * jt + r];
        }
        bf16x8 fr[2];
#pragma unroll
        for (int ks = 0; ks < 2; ++ks) {
            const int chA = hb * 64 + 32 * ks + 8 * g;
            float xc[8];
            { const f32x4 b0 = *(const LAS f32x4*)(CW + 4 * DL + chA), b1 = *(const LAS f32x4*)(CW + 4 * DL + chA + 4);
              xc[0] = b0[0]; xc[1] = b0[1]; xc[2] = b0[2]; xc[3] = b0[3]; xc[4] = b1[0]; xc[5] = b1[1]; xc[6] = b1[2]; xc[7] = b1[3]; }
#pragma unroll
            for (int k = 0; k < 4; ++k) {
                const int sp = n * CH + c - 3 + k;
                v4u xv = {0u, 0u, 0u, 0u};
                if (sp >= 0) xv = *(const v4u*)(P.PROJ + (size_t)(t0 + c - 3 + k) * INC + chA);
                const f32x4 w0 = *(const LAS f32x4*)(CW + k * DL + chA), w1 = *(const LAS f32x4*)(CW + k * DL + chA + 4);
                xc[0] += w0[0] * bflo(xv.x); xc[1] += w0[1] * bfhi(xv.x); xc[2] += w0[2] * bflo(xv.y); xc[3] += w0[3] * bfhi(xv.y);
                xc[4] += w1[0] * bflo(xv.z); xc[5] += w1[1] * bfhi(xv.z); xc[6] += w1[2] * bflo(xv.w); xc[7] += w1[3] * bfhi(xv.w);
            }
            v4u pk; pk.x = cvt_pk_bf16(xc[0], xc[1]); pk.y = cvt_pk_bf16(xc[2], xc[3]); pk.z = cvt_pk_bf16(xc[4], xc[5]); pk.w = cvt_pk_bf16(xc[6], xc[7]);
            fr[ks] = __builtin_bit_cast(bf16x8, pk);
            *(LAS f32x4*)(XC + r * 68 + 32 * ks + 8 * g) = (f32x4){xc[0], xc[1], xc[2], xc[3]};
            *(LAS f32x4*)(XC + r * 68 + 32 * ks + 8 * g + 4) = (f32x4){xc[4], xc[5], xc[6], xc[7]};
        }
        wave_lds_fence();
#pragma unroll
        for (int jt = 0; jt < 4; ++jt) {
            f32x4 aa = {0.f, 0.f, 0.f, 0.f}, ax = {0.f, 0.f, 0.f, 0.f};
#pragma unroll
            for (int ks = 0; ks < 2; ++ks) { aa = __builtin_amdgcn_mfma_f32_16x16x32_bf16(fr[ks], Wa[jt][ks], aa, 0, 0, 0); ax = __builtin_amdgcn_mfma_f32_16x16x32_bf16(fr[ks], Wx[jt][ks], ax, 0, 0, 0); }
            float av[4], uv[4]; float Al = 1.f, Hl = 0.f;
#pragma unroll
            for (int q = 0; q < 4; ++q) {
                const float xcv = XC[(4 * g + q) * 68 + 16 * jt + r];
                const float rg = fast_sigmoid(aa[q] + ba[jt]), ig = fast_sigmoid(ax[q] + bx[jt]);
                const float la = -rg * sp8[jt];
                const float a = __builtin_amdgcn_exp2f(la * 1.4426950408889634f);
                const float x2 = 2.f * la;
                const float em = x2 > -0.25f ? -x2 * (1.f + x2 * (0.5f + x2 * (0.16666667f + x2 * (0.041666668f + x2 * (0.0083333333f + x2 * 0.0013888889f))))) : 1.f - a * a;
                const float u = sqrtf(em) * (ig * xcv);
                av[q] = a; uv[q] = u; Hl = a * Hl + u; Al *= a;
            }
            float Ap = 1.f, Hp = 0.f;
#pragma unroll
            for (int k = 3; k >= 1; --k) {
                const float Ao = __shfl(Al, lane - 16 * k), Ho = __shfl(Hl, lane - 16 * k);
                if (g >= k) { Hp = Ao * Hp + Ho; Ap *= Ao; }
            }
            float h = Ap * St[jt] + Hp;
            if (FINAL) {
#pragma unroll
                for (int q = 0; q < 4; ++q) {
                    h = av[q] * h + uv[q];
                    const size_t tok = (size_t)(t0 + 16 * tt + 4 * g + q);
                    const float gl = bf2f(glv[jt][q]);
                    P.MIX[tok * D + hb * 64 + 16 * jt + r] = f2bf(h * gelu_tanh_fast(gl));
                }
            } else {
                h = Al * h + Hl;
            }
            const float Atile = __shfl(Ap * Al, (lane & 15) + 48);
            St[jt] = __shfl(h, (lane & 15) + 48);
            At[jt] *= Atile;
        }
        wave_lds_fence();
    }
    if (!FINAL && g == 0) {
#pragma unroll
        for (int jt = 0; jt < 4; ++jt) { const int ch = hb * 64 + 16 * jt + r; float* AE = (float*)(P.ws + WS_LRU);
            AE[(b * NCH + n) * DL + ch] = At[jt]; AE[B * NCH * DL + (b * NCH + n) * DL + ch] = St[jt]; }
    }
}

__device__ __forceinline__ void p2_mix_summaries(Frame& F, const Ptrs& P) {
    const int w = F.wave;
#pragma unroll 1
    for (int u = F.vcu; u < B * NCH; u += F.G) {
        const int b = u / NCH, n = u % NCH; const int t0 = b * S + n * CH;
        __syncthreads();
        { int lane0 = F.lane; asm volatile("" : "+v"(lane0)); lru_chunk<false>(F, P, b, n, lane0); }
#pragma unroll 1
        for (int h = 0; h < NH; ++h) {
            int lane = F.lane; asm volatile("" : "+v"(lane));
            const int r = lane & 15, g = lane >> 4;
            unsigned trb[8][2];
#pragma unroll
            for (int c = 0; c < 8; ++c) { trb[c][0] = tr_read_addr_16(lane, c, 0, 0); trb[c][1] = tr_read_addr_16(lane, c, 0, 1); }
            const float lg2 = __builtin_amdgcn_logf(1.f - __builtin_amdgcn_exp2f(-5.f - (float)h));
            __syncthreads();
            load_kv_tiles<true>(F, P.PROJ + (size_t)t0 * INC, h, n * CH, lg2);
            __syncthreads();
            LAS unsigned char* Kimg = F.lds + MIX_K_OFF; LAS unsigned char* Vimg = F.lds + MIX_V_OFF;
            f32x4 acc[8];
#pragma unroll
            for (int dt = 0; dt < 8; ++dt) acc[dt] = (f32x4){0.f, 0.f, 0.f, 0.f};
            const unsigned ta0 = tr_read_addr_16(lane, w, 0, 0), ta1 = tr_read_addr_16(lane, w, 0, 1);
#pragma unroll 1
            for (int ks = 0; ks < 4; ++ks) {
                const bf16x8 Af = tr_frag2(Vimg + ta0 + 8192 * ks, Vimg + ta1 + 8192 * ks);
#pragma unroll
                for (int dt = 0; dt < 8; ++dt) { const bf16x8 Bf = tr_frag2(Kimg + trb[dt][0] + 8192 * ks, Kimg + trb[dt][1] + 8192 * ks); acc[dt] = __builtin_amdgcn_mfma_f32_16x16x32_bf16(Af, Bf, acc[dt], 0, 0, 0); }
            }
            float* KV = P.out + ((size_t)((b * NH + h) * NCH + n)) * (HD * HD);
#pragma unroll
            for (int dt = 0; dt < 8; ++dt)
#pragma unroll
                for (int q = 0; q < 4; ++q) KV[(16 * w + 4 * g + q) * HD + 16 * dt + r] = acc[dt][q];
        }
    }
}
__device__ __forceinline__ void p3_scans(Frame& F, const Ptrs& P) {
    const int idx = F.vcu * NTHR + F.tid;
    for (int id = idx; id < B * NH * (HD * HD / 4); id += F.G * NTHR) {
        const int bh = id >> 12, el = (id & 4095) * 4, h = bh & 3;
        const float lg2 = __builtin_amdgcn_logf(1.f - __builtin_amdgcn_exp2f(-5.f - (float)h));
        const float dec = __builtin_amdgcn_exp2f(128.f * lg2);
        const float* KV = P.out + (size_t)bh * NCH * (HD * HD) + el;
        bf16* PV = (bf16*)(P.out + (size_t)B * NH * NCH * (HD * HD)) + (size_t)bh * NCH * (HD * HD) + el;
        f32x4 st = {0.f, 0.f, 0.f, 0.f};
#pragma unroll 8
        for (int n = 0; n < NCH; ++n) {
            const f32x4 kv = *(const f32x4*)(KV + (size_t)n * (HD * HD));
            v2u w; w.x = cvt_pk_bf16(st[0], st[1]); w.y = cvt_pk_bf16(st[2], st[3]);
            *(v2u*)(PV + (size_t)n * (HD * HD)) = w;
            st = st * dec + kv;
        }
    }
    if (idx < B * DL) {
        const int b = idx / DL, ch = idx % DL; float* AE = (float*)(P.ws + WS_LRU);
        float carry = 0.f;
        for (int n = 0; n < NCH; ++n) {
            const float a = AE[(b * NCH + n) * DL + ch], e = AE[B * NCH * DL + (b * NCH + n) * DL + ch];
            AE[2 * B * NCH * DL + (b * NCH + n) * DL + ch] = carry;
            carry = a * carry + e;
        }
    }
}
__device__ __forceinline__ void p4_mix_outputs(Frame& F, const Ptrs& P) {
    const int w = F.wave;
#pragma unroll 1
    for (int u = F.vcu; u < B * NCH; u += F.G) {
        const int b = u / NCH, n = u % NCH; const int t0 = b * S + n * CH;
        __syncthreads();
        { int lane0 = F.lane; asm volatile("" : "+v"(lane0)); lru_chunk<true>(F, P, b, n, lane0); }
#pragma unroll 1
        for (int h = 0; h < NH; ++h) {
            int lane = F.lane; asm volatile("" : "+v"(lane));
            const int r = lane & 15, g = lane >> 4;
            unsigned trb[8][2], rrb[4];
#pragma unroll
            for (int c = 0; c < 8; ++c) { trb[c][0] = tr_read_addr_16(lane, c, 0, 0); trb[c][1] = tr_read_addr_16(lane, c, 0, 1); }
#pragma unroll
            for (int ks = 0; ks < 4; ++ks) rrb[ks] = row_read_addr_16(lane, 0, ks);
            const float lg2 = __builtin_amdgcn_logf(1.f - __builtin_amdgcn_exp2f(-5.f - (float)h));
            __syncthreads();
            load_kv_tiles<false>(F, P.PROJ + (size_t)t0 * INC, h, n * CH, lg2);
            bf16x8 Qf[4];
            {
                const bf16* qrow = P.PROJ + (size_t)(t0 + 16 * w + r) * INC + 1024 + h * HD + 8 * g;
                const float pos = (float)(n * CH + 16 * w + r);
#pragma unroll
                for (int ks = 0; ks < 2; ++ks) {
                    const v4u q1 = *(const v4u*)(qrow + 32 * ks), q2 = *(const v4u*)(qrow + 32 * ks + 64);
                    v4u o1, o2;
#pragma unroll
                    for (int q = 0; q < 4; ++q) {
                        const float i0 = __builtin_amdgcn_exp2f(-(float)(32 * ks + 8 * g + 2 * q) * LOG2_ROPE_OVER_64), i1 = __builtin_amdgcn_exp2f(-(float)(32 * ks + 8 * g + 2 * q + 1) * LOG2_ROPE_OVER_64);
                        float sn0, cs0, sn1, cs1; sincos_rev(pos * i0, sn0, cs0); sincos_rev(pos * i1, sn1, cs1);
                        const float a0 = bflo(q1[q]), a1 = bfhi(q1[q]), b0 = bflo(q2[q]), b1 = bfhi(q2[q]);
                        o1[q] = cvt_pk_bf16(a0 * cs0 - b0 * sn0, a1 * cs1 - b1 * sn1);
                        o2[q] = cvt_pk_bf16(a0 * sn0 + b0 * cs0, a1 * sn1 + b1 * cs1);
                    }
                    Qf[ks] = __builtin_bit_cast(bf16x8, o1); Qf[ks + 2] = __builtin_bit_cast(bf16x8, o2);
                }
            }
            __syncthreads();
            LAS unsigned char* Kimg = F.lds + MIX_K_OFF; LAS unsigned char* Vimg = F.lds + MIX_V_OFF; LAS unsigned char* Sst = F.lds + MIX_S_OFF + w * MIX_S_WAVE;
            const bf16* PV = (const bf16*)(P.out + (size_t)B * NH * NCH * (HD * HD)) + ((size_t)((b * NH + h) * NCH + n)) * (HD * HD);
            bf16 grv[8][4];
#pragma unroll
            for (int et = 0; et < 8; ++et)
#pragma unroll
                for (int q = 0; q < 4; ++q) grv[et][q] = P.PROJ[(size_t)(t0 + 16 * w + 4 * g + q) * INC + 2560 + h * HD + 16 * et + r];
            bf16x8 Pf[4][4];
#pragma unroll
            for (int et = 0; et < 4; ++et)
#pragma unroll
                for (int ks = 0; ks < 4; ++ks) Pf[et][ks] = *(const bf16x8*)(PV + (size_t)(16 * et + r) * HD + 32 * ks + 8 * g);
#pragma unroll 1
            for (int mt = 0; mt <= w; ++mt) {
                f32x4 sa = {0.f, 0.f, 0.f, 0.f};
#pragma unroll
                for (int ks = 0; ks < 4; ++ks) { const bf16x8 Kf = *(const LAS bf16x8*)(Kimg + rrb[ks] + 4096 * mt); sa = __builtin_amdgcn_mfma_f32_16x16x32_bf16(Qf[ks], Kf, sa, 0, 0, 0); }
#pragma unroll
                for (int q = 0; q < 4; ++q) {
                    const int dlt = (16 * w + 4 * g + q) - (16 * mt + r);
                    const float v = dlt >= 0 ? sa[q] * __builtin_amdgcn_exp2f((float)dlt * lg2) : 0.f;
                    *(LAS bf16*)(Sst + (4 * g + q) * MIX_S_STRIDE + (16 * mt + r) * 2) = f2bf(v);
                }
            }
            if ((w & 1) == 0) {
#pragma unroll
                for (int q = 0; q < 4; ++q) *(LAS bf16*)(Sst + (4 * g + q) * MIX_S_STRIDE + (16 * (w + 1) + r) * 2) = 0;
            }
            wave_lds_fence();
            f32x4 acc[8];
            float rsc[4];
#pragma unroll
            for (int q = 0; q < 4; ++q) rsc[q] = __builtin_amdgcn_exp2f((float)(16 * w + 4 * g + q + 1) * lg2);
#pragma unroll
            for (int hf = 0; hf < 2; ++hf) {
                if (hf == 1) {
#pragma unroll
                    for (int et = 0; et < 4; ++et)
#pragma unroll
                        for (int ks = 0; ks < 4; ++ks) Pf[et][ks] = *(const bf16x8*)(PV + (size_t)(16 * (et + 4) + r) * HD + 32 * ks + 8 * g);
                }
#pragma unroll
                for (int et = 0; et < 4; ++et) {
                    f32x4 a = {0.f, 0.f, 0.f, 0.f};
#pragma unroll
                    for (int ks = 0; ks < 4; ++ks) a = __builtin_amdgcn_mfma_f32_16x16x32_bf16(Qf[ks], Pf[et][ks], a, 0, 0, 0);
#pragma unroll
                    for (int q = 0; q < 4; ++q) a[q] *= rsc[q];
                    acc[4 * hf + et] = a;
                }
            }
#pragma unroll 1
            for (int ks = 0; ks <= (w >> 1); ++ks) {
                const bf16x8 Sf = *(const LAS bf16x8*)(Sst + r * MIX_S_STRIDE + (32 * ks + 8 * g) * 2);
#pragma unroll
                for (int et = 0; et < 8; ++et) { const bf16x8 Vf = tr_frag2(Vimg + trb[et][0] + 8192 * ks, Vimg + trb[et][1] + 8192 * ks); acc[et] = __builtin_amdgcn_mfma_f32_16x16x32_bf16(Sf, Vf, acc[et], 0, 0, 0); }
            }
            float mu[4], rs[4];
#pragma unroll
            for (int q = 0; q < 4; ++q) {
                float s = 0.f;
#pragma unroll
                for (int et = 0; et < 8; ++et) s += acc[et][q];
                s += __shfl_xor(s, 1); s += __shfl_xor(s, 2); s += __shfl_xor(s, 4); s += __shfl_xor(s, 8);
                const float m = s * (1.f / 128.f); float v = 0.f;
#pragma unroll
                for (int et = 0; et < 8; ++et) { const float d = acc[et][q] - m; v += d * d; }
                v += __shfl_xor(v, 1); v += __shfl_xor(v, 2); v += __shfl_xor(v, 4); v += __shfl_xor(v, 8);
                mu[q] = m; rs[q] = 1.0f / sqrtf(v * (1.f / 128.f) + EPS);
            }
#pragma unroll
            for (int et = 0; et < 8; ++et)
#pragma unroll
                for (int q = 0; q < 4; ++q) {
                    const size_t tok = (size_t)(t0 + 16 * w + 4 * g + q);
                    const float gr = bf2f(grv[et][q]);
                    P.MIX[tok * D + DL + h * HD + 16 * et + r] = f2bf(gr * fast_sigmoid(gr) * (acc[et][q] - mu[q]) * rs[q]);
                }
        }
    }
}
__global__ void __launch_bounds__(NTHR, 2) mk_fwd(Args args) {
    extern __shared__ __attribute__((aligned(16))) unsigned char lds_raw[];
    Frame F;
    F.lds = (LAS unsigned char*)lds_raw;
    F.MISC = (volatile LAS unsigned*)(F.lds + LDSCTL_OFF);
    F.tid = threadIdx.x; F.lane = F.tid & 63; F.wave = __builtin_amdgcn_readfirstlane(F.tid >> 6);
    F.G = gridDim.x; { const int bx = blockIdx.x; F.vcu = (F.G % 8 == 0) ? (bx % 8) * (F.G / 8) + bx / 8 : bx; }
    F.ctl = (gu32*)(args.ws + WS_CTL);
    Ptrs P; make_ptrs(P, args);
    for (int u = F.tid; u < 256; u += NTHR) ((LAS unsigned*)(F.lds + LDSCTL_OFF))[u] = 0u;
    __syncthreads();
    XcdBarrier bar = xcd_barrier_post((unsigned*)(F.ctl + CW_BAR) + args.ph_hi * XCD_BAR_WORDS, F.MISC + 8);
    const int lo = args.ph_lo, hi = args.ph_hi;
#define IN(k) (lo <= (k) && (k) < hi)
#define SEAM(k) do { if (IN(k) && IN((k) + 1)) xcd_barrier(bar); } while (0)
    if (IN(0)) { p0_prologue(F, P); }
    SEAM(0);
    if (IN(1)) {
        pg8::PlainSched S; S.init(P.XB, P.W_IN, T, INC, D, F.G, (int)blockIdx.x);
        pg8::EpiRowScaleBf16 E{P.PROJ, INC, P.rstd0};
        pg8::gemm_phase(F.lds + RING_OFF, S, E);
    }
    SEAM(1);
    if (IN(2)) p2_mix_summaries(F, P);
    SEAM(2);
    if (IN(3)) p3_scans(F, P);
    SEAM(3);
    if (IN(4)) p4_mix_outputs(F, P);
    SEAM(4);
    if (IN(5)) {
        pg8::PlainSched S; S.init(P.MIX, P.W_OUT, T, D, D, F.G, (int)blockIdx.x);
        pg8::EpiPlainBf16 E{P.D1, D};
        pg8::gemm_phase(F.lds + RING_OFF, S, E);
    }
    SEAM(5);
    if (IN(6)) p6_route(F, P);
    SEAM(6);
    if (IN(7)) p7_lists(F, P);
    SEAM(7);
    if (IN(8)) moe_phase<0>(F, P, lo == 8);
    SEAM(8);
    if (IN(9)) moe_phase<1>(F, P, lo == 9);
    SEAM(9);
    if (IN(10)) p10_combine(F, P);
    SEAM(10);
    if (IN(11)) {
        pg8::PlainSched S; S.init(P.X2B, P.W_PG, T, D, D, F.G, (int)blockIdx.x);
        pg8::EpiGateBf16 E{P.GATE, D, P.rstd2, P.b_pg};
        pg8::gemm_phase(F.lds + RING_OFF, S, E);
    }
    if (IN(12)) {
        pg8::PlainSched S; S.init(P.PB, P.W_PP, T, D, PLE, F.G, (int)blockIdx.x);
        pg8::EpiPlainBf16 E{P.PP, D};
        pg8::gemm_phase(F.lds + RING_OFF, S, E);
    }
    SEAM(12);
    if (IN(13)) p13_final(F, P);
#undef IN
#undef SEAM
}

static int mk_grid = 0;
static void mk_launch(void* const* d_in, void* d_out, void* d_ws, int lo, int hi, hipStream_t stream) {
    if (mk_grid == 0) {
        int dev = 0, cus = 0;
        if (hipGetDevice(&dev) != hipSuccess || hipDeviceGetAttribute(&cus, hipDeviceAttributeMultiprocessorCount, dev) != hipSuccess) { mk_grid = -1; return; }
        if (hipFuncSetAttribute((const void*)mk_fwd, hipFuncAttributeMaxDynamicSharedMemorySize, LDS_BYTES) != hipSuccess) { fprintf(stderr, "mk: hipFuncSetAttribute failed\n"); mk_grid = -1; return; }
        int per_cu = 0;
        if (hipOccupancyMaxActiveBlocksPerMultiprocessor(&per_cu, (const void*)mk_fwd, NTHR, LDS_BYTES) != hipSuccess || per_cu < 1) { fprintf(stderr, "mk: occupancy query says %d\n", per_cu); (void)hipGetLastError(); }
        mk_grid = cus;
    }
    if (mk_grid < 0) return;
    Args a; memset(&a, 0, sizeof a);
    for (int i = 0; i < 25; ++i) a.in[i] = (const float*)d_in[i];
    a.out = (float*)d_out; a.ws = (unsigned char*)d_ws; a.ph_lo = lo; a.ph_hi = hi;
    hipLaunchKernelGGL(mk_fwd, dim3(mk_grid), dim3(NTHR), LDS_BYTES, stream, a);
}
extern "C" void kernel_launch(void* const* d_in, const int* in_sizes, int n_in, void* d_out, int out_size, void* d_ws, size_t ws_size, hipStream_t stream) {
    if (n_in != 25 || ws_size < WS_END || out_size != T * D) { fprintf(stderr, "kernel_launch: n_in %d, workspace %zu (need %zu), out_size %d: nothing launched\n", n_in, ws_size, (size_t)WS_END, out_size); return; }
    (void)hipMemsetAsync((unsigned char*)d_ws + WS_CTL, 0, 1 * MiB, stream);
    mk_launch(d_in, d_out, d_ws, 0, 14, stream);
}
```

```cpp
#include <hip/hip_runtime.h>
#include <stdint.h>
#include <stdio.h>
#include <string.h>

typedef unsigned short bf16;
namespace cfg {
constexpr int D = 1024, B = 8, S = 4096, T = B * S, PLE = 256, DL = 512, DR = 512, NH = 4, HD = 128, INC = 3072;
constexpr int NE = 64, DE = 512, NG = 8, EPG = 8, CH = 128, NCH = S / CH;
constexpr float EPS = 1e-6f;
constexpr float MOE_SX = 8.f, MOE_SW1 = 64.f, MOE_SA = 8.f, MOE_SW2 = 32.f;
constexpr size_t MiB = 1u << 20;
constexpr size_t WS_CTL = 0;
constexpr size_t WS_RSTD0 = 1 * MiB, WS_RSTD1 = WS_RSTD0 + 128 * 1024, WS_RSTD2 = WS_RSTD1 + 128 * 1024;
constexpr size_t WS_EID = 2 * MiB, WS_EW = WS_EID + 256 * 1024, WS_LIST = WS_EW + 256 * 1024, WS_CNT = WS_LIST + 256 * 1024;
constexpr size_t WS_LOGITS = 3 * MiB;
constexpr size_t WS_LRU = 13 * MiB;
constexpr size_t WS_WIN = 16 * MiB, WS_WOUT = 22 * MiB, WS_WPG = 24 * MiB, WS_WPP = 26 * MiB, WS_WRT = 26 * MiB + 512 * 1024, WS_LRUW = 27 * MiB;
constexpr size_t WS_W13 = 28 * MiB, WS_W2 = 156 * MiB, WS_PB = 220 * MiB;
constexpr size_t WS_R64 = 236 * MiB;
constexpr size_t WS_PROJ = 300 * MiB;
constexpr size_t WS_D1 = 300 * MiB, WS_X1B = 364 * MiB, WS_Y = 428 * MiB, WS_PP = 428 * MiB;
constexpr size_t WS_END = 556 * MiB;
}
using namespace cfg;

__device__ __forceinline__ float bf2f(bf16 v) { return __uint_as_float((unsigned)v << 16); }
__device__ __forceinline__ bf16 f2bf(float f) { unsigned u = __float_as_uint(f); return (bf16)((u + 0x7fffu + ((u >> 16) & 1u)) >> 16); }
__device__ __forceinline__ float ldv(const float* p, size_t i) { return p[i]; }
__device__ __forceinline__ float ldv(const bf16* p, size_t i) { return bf2f(p[i]); }
__device__ __forceinline__ void stv(float* p, size_t i, float v) { p[i] = v; }
__device__ __forceinline__ void stv(bf16* p, size_t i, float v) { p[i] = f2bf(v); }

#define GAS __attribute__((address_space(1)))
#define LAS __attribute__((address_space(3)))
typedef unsigned v4u __attribute__((ext_vector_type(4)));
typedef unsigned v2u __attribute__((ext_vector_type(2)));
typedef float f32x4 __attribute__((ext_vector_type(4)));
typedef float f32x2 __attribute__((ext_vector_type(2)));
typedef short bf16x8 __attribute__((ext_vector_type(8)));
typedef short bf16x4 __attribute__((ext_vector_type(4)));
typedef GAS unsigned gu32;
#define RLX_AGENT __ATOMIC_RELAXED, __HIP_MEMORY_SCOPE_AGENT
#define LDS_WAIT() asm volatile("s_waitcnt lgkmcnt(0)" ::: "memory")
#define VM_WAIT() asm volatile("s_waitcnt vmcnt(0)" ::: "memory")
__device__ __forceinline__ unsigned pk2(float lo, float hi) { return (unsigned)f2bf(lo) | ((unsigned)f2bf(hi) << 16); }
typedef __bf16 hwbf16x2 __attribute__((ext_vector_type(2)));
__device__ __forceinline__ unsigned cvt_pk_bf16(float lo, float hi) { f32x2 v = {lo, hi}; hwbf16x2 b = __builtin_convertvector(v, hwbf16x2); return __builtin_bit_cast(unsigned, b); }
__device__ __forceinline__ float bflo(unsigned w) { return __uint_as_float(w << 16); }
__device__ __forceinline__ float bfhi(unsigned w) { return __uint_as_float(w & 0xffff0000u); }
__device__ __forceinline__ float fast_sigmoid(float x) { return __builtin_amdgcn_rcpf(1.f + __builtin_amdgcn_exp2f(-1.4426950408889634f * x)); }

#define XB_TMO      128
#define XB_XCNT(j)  (256  + 64 * (j))
#define XB_XSUB(j)  (1280 + 64 * (j))
#define XB_XGEN(j)  (2304 + 64 * (j))
#define XB_TOP      3328
#define XB_TOPGEN   3392
#define XCD_BAR_WORDS 3456
#define XB_SPIN_CAP (1u << 18)
__device__ __forceinline__ unsigned xb_ld(unsigned* p)              { return __hip_atomic_load(p, __ATOMIC_RELAXED, __HIP_MEMORY_SCOPE_AGENT); }
__device__ __forceinline__ unsigned xb_add(unsigned* p, unsigned v) { return __hip_atomic_fetch_add(p, v, __ATOMIC_RELAXED, __HIP_MEMORY_SCOPE_AGENT); }
__device__ __forceinline__ unsigned xb_xcc_id() { return (unsigned)__builtin_amdgcn_s_getreg((3 << 11) | 20) & 0xFu; }
#define XB_SPIN(cond, bar) do { unsigned _sp = 0; while (cond) { __builtin_amdgcn_s_sleep(1); \
    if ((++_sp & 255u) == 0u) { if (xb_ld(&(bar)[XB_TMO])) break; if (_sp > XB_SPIN_CAP) { atomicAdd(&(bar)[XB_TMO], 1u); break; } } } } while (0)
struct XcdBarrier { unsigned* bar; unsigned x; volatile LAS unsigned* st; };
__device__ __forceinline__ XcdBarrier xcd_barrier_post(unsigned* bar, volatile LAS unsigned* st) {
    XcdBarrier b; b.bar = bar; b.x = xb_xcc_id(); b.st = st;
    if (threadIdx.x == 0) (void)xb_add(&bar[XB_XCNT(b.x)], 1u);
    return b;
}
__device__ __forceinline__ void xcd_barrier_complete(unsigned* bar, unsigned x, unsigned& nloc, unsigned& nx) {
    const unsigned G = gridDim.x * gridDim.y * gridDim.z;
    unsigned sum, cnt, mine, sp = 0u;
    for (;;) {
        sum = 0u; cnt = 0u; mine = 0u;
#pragma unroll
        for (unsigned j = 0; j < 16; ++j) { const unsigned c = xb_ld(&bar[XB_XCNT(j)]); sum += c; cnt += (c > 0u) ? 1u : 0u; mine = (j == x) ? c : mine; }
        if (sum == G) break;
        __builtin_amdgcn_s_sleep(1);
        if ((++sp & 255u) == 0u) { if (xb_ld(&bar[XB_TMO])) break; if (sp > XB_SPIN_CAP) { atomicAdd(&bar[XB_TMO], 1u); break; } }
    }
    nloc = mine > 0u ? mine : 1u; nx = cnt > 0u ? cnt : 1u;
}
__device__ __forceinline__ void xcd_barrier(const XcdBarrier& b) {
    asm volatile("s_waitcnt vmcnt(0)" ::: "memory");
    __syncthreads();
    if (threadIdx.x == 0) {
        unsigned* bar = b.bar;
        __builtin_amdgcn_s_waitcnt(0);
        unsigned nloc = b.st[0], nx = b.st[1];
        if (nloc == 0u) { xcd_barrier_complete(bar, b.x, nloc, nx); b.st[0] = nloc; b.st[1] = nx; }
        const unsigned old = xb_add(&bar[XB_XSUB(b.x)], 1u);
        const unsigned gen = old / nloc;
        if (old + 1u == (gen + 1u) * nloc) {
            __builtin_amdgcn_fence(__ATOMIC_RELEASE, "agent");
            asm volatile("s_waitcnt vmcnt(0)" ::: "memory");
            const unsigned og = xb_add(&bar[XB_TOP], 1u);
            const unsigned tg = og / nx;
            if (og + 1u == (tg + 1u) * nx) xb_add(&bar[XB_TOPGEN], 1u);
            else XB_SPIN(xb_ld(&bar[XB_TOPGEN]) == tg, bar);
            __builtin_amdgcn_fence(__ATOMIC_ACQUIRE, "agent");
            xb_add(&bar[XB_XGEN(b.x)], 1u);
            asm volatile("s_waitcnt vmcnt(0)" ::: "memory");
        } else {
            XB_SPIN(xb_ld(&bar[XB_XGEN(b.x)]) == gen, bar);
            __builtin_amdgcn_fence(__ATOMIC_ACQUIRE, "agent");
            asm volatile("s_waitcnt vmcnt(0)" ::: "memory");
        }
    }
    __syncthreads();
}

constexpr int NWAVES = 8, NTHR = NWAVES * 64;
constexpr int RING_OFF = 0, RING_BYTES = 131072;
constexpr int LDSCTL_OFF = RING_BYTES;
constexpr int UTAB_OFF = LDSCTL_OFF + 1024;
constexpr int MAXU = 6;
constexpr int UTABF_OFF = UTAB_OFF + MAXU * 1024;
constexpr int SCHED_OFF = UTABF_OFF + MAXU * 1024;
constexpr int LDS_BYTES = SCHED_OFF + 2048;
static_assert(LDS_BYTES <= 160 * 1024 && LDS_BYTES > 80 * 1024, "LDS map");
constexpr int CW_TMO = 0, CW_BAR = 4096;

namespace pg8 {
constexpr int BM = 256, BK = 64, HALF = 128, HTB = HALF * BK * 2, STAGE_BYTES = 8 * HTB;
__host__ __device__ __forceinline__ int lds_byte(int r, int c) { const int st = (r >> 4) * 2 + (c >> 5), rr = r & 15, cc = c & 31, ob = rr * 64 + cc * 2; return st * 1024 + (ob ^ (((ob >> 9) & 1) << 5)); }
__host__ __device__ __forceinline__ void stage_rc(int b, int& R, int& C) { const int st = b / 1024, sb = b % 1024, swz = sb ^ (((sb >> 9) & 1) << 5); R = (st >> 1) * 16 + swz / 64; C = (st & 1) * 32 + (swz % 64) / 2; }
__host__ __device__ __forceinline__ int perm32(int rho) { const int n = rho >> 4, i = rho & 15; return 8 * (i >> 2) + 4 * n + (i & 3); }

struct Unit { int pm, pn, e, rows, slot0, ui; };

struct PlainSched {
    static constexpr bool GATHER = false;
    const bf16* A; const bf16* Bt; int K; int nM, nN, nwg, G, c;
    __device__ void init(const bf16* A_, const bf16* Bt_, int M, int N, int K_, int G_, int c_) { A = A_; Bt = Bt_; K = K_; nM = M / BM; nN = N / BM; nwg = nM * nN; G = G_; c = c_; }
    __device__ __forceinline__ bool next(int i, Unit& u) const {
        const long L = (long)i * G + c; if (L >= nwg) return false;
        int wgid = (int)L; { const int q = nwg / 8, r = nwg % 8, xcd = wgid % 8, off = wgid / 8; wgid = (xcd < r ? xcd * (q + 1) : r * (q + 1) + (xcd - r) * q) + off; }
        const int nig = 8 * nN, gid = wgid / nig, fm = gid * 8, gsz = (nM - fm) < 8 ? (nM - fm) : 8;
        u.pm = fm + ((wgid % nig) % gsz); u.pn = (wgid % nig) / gsz; u.e = 0; u.rows = 256; u.slot0 = 0; u.ui = i; return true;
    }
    __device__ __forceinline__ const char* a_base(const Unit& u) const { return (const char*)A + (size_t)u.pm * (size_t)(BM * 2) * K; }
    __device__ __forceinline__ const char* b_base(const Unit& u) const { return (const char*)Bt + (size_t)u.pn * (size_t)(BM * 2) * K; }
    __device__ __forceinline__ unsigned a_rowoff(const Unit&, int r) const { return (unsigned)r * (unsigned)K * 2u; }
};

typedef long i64x2 __attribute__((ext_vector_type(2)));
template <class Epi, class Sched, bool FP8 = false>
__device__ __forceinline__ void gemm_phase(LAS unsigned char* lds, const Sched& S, const Epi& E) {
    const int tid = threadIdx.x, wid = __builtin_amdgcn_readfirstlane(tid >> 6), lane = tid & 63, wr = wid >> 2, wc = wid & 3, fr = lane & 15, fq = lane >> 4;
    const int K = S.K, nt = K / BK;
    int Rr[2], Cc[2]; unsigned voffB[2];
#pragma unroll
    for (int i = 0; i < 2; ++i) { stage_rc(tid * 16 + i * 8192, Rr[i], Cc[i]); const int Rb = (Rr[i] & ~31) + perm32(Rr[i] & 31); voffB[i] = (unsigned)(Rb * K + Cc[i]) * 2u; }
    const size_t kstep = (size_t)(BK * 2);
    const size_t hstep = (size_t)HALF * K * 2;
    const unsigned ldsw = (unsigned)wid * 1024u;
    const int aoff = lds_byte(wr * 64 + fr, fq * 8), boff = lds_byte(wc * 32 + fr, fq * 8);
#define PG8_SA(b, h) (((b) * 2 + (h)) * HTB)
#define PG8_SB(b, h) ((4 + (b) * 2 + (h)) * HTB)
#define PG8_STAGE(bufoff, gbase, voff) do { _Pragma("unroll") for (int _i = 0; _i < 2; ++_i) \
        __builtin_amdgcn_global_load_lds((const unsigned*)((const char*)(gbase) + (voff)[_i]), (LAS unsigned*)(lds + (bufoff) + ldsw + _i * 8192), 16, 0, 0); } while (0)
#define PG8_LDA(dst, b, h) do { _Pragma("unroll") for (int m = 0; m < 4; ++m) _Pragma("unroll") for (int k = 0; k < 2; ++k) dst[m][k] = *(const LAS bf16x8*)(lds + PG8_SA(b, h) + aoff + m * 2048 + k * 1024); } while (0)
#define PG8_LDB(dst, b, h) do { _Pragma("unroll") for (int n = 0; n < 2; ++n) _Pragma("unroll") for (int k = 0; k < 2; ++k) dst[n][k] = *(const LAS bf16x8*)(lds + PG8_SB(b, h) + boff + n * 2048 + k * 1024); } while (0)
#define PG8_MMA(ai, bj, At, Bt) do { __builtin_amdgcn_s_setprio(1); _Pragma("unroll") for (int m = 0; m < 4; ++m) _Pragma("unroll") for (int n = 0; n < 2; ++n) _Pragma("unroll") for (int k = 0; k < 2; ++k) { \
        if constexpr (FP8) { const i64x2 a8_ = __builtin_bit_cast(i64x2, At[m][k]), b8_ = __builtin_bit_cast(i64x2, Bt[n][k]); \
            acc[ai][bj][m][n] = __builtin_amdgcn_mfma_f32_16x16x32_fp8_fp8(b8_[0], a8_[0], acc[ai][bj][m][n], 0, 0, 0); acc[ai][bj][m][n] = __builtin_amdgcn_mfma_f32_16x16x32_fp8_fp8(b8_[1], a8_[1], acc[ai][bj][m][n], 0, 0, 0); } \
        else acc[ai][bj][m][n] = __builtin_amdgcn_mfma_f32_16x16x32_bf16(Bt[n][k], At[m][k], acc[ai][bj][m][n], 0, 0, 0); } __builtin_amdgcn_s_setprio(0); } while (0)
#define PG8_WAIT_V(n) asm volatile("s_waitcnt vmcnt(" #n ")" ::: "memory")
#define PG8_WAIT_L(n) asm volatile("s_waitcnt lgkmcnt(" #n ")" ::: "memory")
#define PG8_BAR __builtin_amdgcn_s_barrier()
#define PG8_SCHED __builtin_amdgcn_sched_barrier(0)
#define PG8_VOFF(dst, u) do { _Pragma("unroll") for (int _h = 0; _h < 2; ++_h) _Pragma("unroll") for (int _i = 0; _i < 2; ++_i) dst[_h][_i] = S.a_rowoff(u, _h * HALF + Rr[_i]) + (unsigned)Cc[_i] * 2u; } while (0)
    Unit cur, nxt; int ui = 0;
    if (!S.next(0, cur)) return;
    f32x4 acc[2][2][4][2];
#pragma unroll
    for (int a = 0; a < 2; ++a)
#pragma unroll
        for (int b = 0; b < 2; ++b)
#pragma unroll
            for (int m = 0; m < 4; ++m)
#pragma unroll
                for (int n = 0; n < 2; ++n) acc[a][b][m][n] = (f32x4){0.f, 0.f, 0.f, 0.f};
    bf16x8 At[4][2], B0[2][2], B1[2][2];
    unsigned va[2][2], nva[2][2];
    PG8_VOFF(va, cur);
    const char* cA = S.a_base(cur); const char* cB = S.b_base(cur);
    PG8_STAGE(PG8_SB(0, 0), cB, voffB); PG8_STAGE(PG8_SB(0, 1), cB + hstep, voffB); PG8_STAGE(PG8_SA(0, 0), cA, va[0]); PG8_STAGE(PG8_SA(0, 1), cA, va[1]);
    if (wr == 1) PG8_BAR;
    PG8_WAIT_V(2); PG8_BAR;
    PG8_STAGE(PG8_SB(1, 0), cB + kstep, voffB); PG8_STAGE(PG8_SA(1, 0), cA + kstep, va[0]); PG8_STAGE(PG8_SB(1, 1), cB + hstep + kstep, voffB);
    PG8_WAIT_V(6); PG8_BAR;
    for (;;) {
        const bool has_next = S.next(ui + 1, nxt);
        const bool mma0 = cur.rows > 64 * wr, mma1 = cur.rows > HALF + 64 * wr;
        const char* nA = has_next ? S.a_base(nxt) : cA; const char* nB = has_next ? S.b_base(nxt) : cB;
        if (has_next) { PG8_VOFF(nva, nxt); } else {
#pragma unroll
            for (int h = 0; h < 2; ++h)
#pragma unroll
                for (int i = 0; i < 2; ++i) nva[h][i] = va[h][i]; }
        for (int t = 0; t < nt; t += 2) {
            const bool last = (t == nt - 2);
            const char* a1 = cA + (size_t)(t + 1) * kstep;
            const char* a2 = last ? nA : cA + (size_t)(t + 2) * kstep; const char* b2 = last ? nB : cB + (size_t)(t + 2) * kstep;
            const char* a3 = a2 + kstep; const char* b3 = b2 + kstep;
            unsigned v2[2][2];
#pragma unroll
            for (int h = 0; h < 2; ++h)
#pragma unroll
                for (int i = 0; i < 2; ++i) v2[h][i] = last ? nva[h][i] : va[h][i];
            PG8_LDB(B0, 0, 0); PG8_LDB(B1, 0, 1); PG8_SCHED; PG8_LDA(At, 0, 0); PG8_STAGE(PG8_SA(1, 1), a1, va[1]);
            PG8_WAIT_V(8); PG8_WAIT_L(0); PG8_BAR; if (mma0) { PG8_MMA(0, 0, At, B0); PG8_MMA(0, 1, At, B1); } PG8_BAR; PG8_SCHED;
            PG8_LDA(At, 0, 1); PG8_STAGE(PG8_SB(0, 0), b2, voffB); PG8_STAGE(PG8_SB(0, 1), b2 + hstep, voffB); PG8_STAGE(PG8_SA(0, 0), a2, v2[0]);
            PG8_WAIT_V(8); PG8_WAIT_L(0); PG8_BAR; if (mma1) { PG8_MMA(1, 0, At, B0); PG8_MMA(1, 1, At, B1); } PG8_BAR; PG8_SCHED;
            PG8_LDB(B0, 1, 0); PG8_LDB(B1, 1, 1); PG8_SCHED; PG8_LDA(At, 1, 0); PG8_STAGE(PG8_SA(0, 1), a2, v2[1]);
            PG8_WAIT_V(8); PG8_WAIT_L(0); PG8_BAR; if (mma0) { PG8_MMA(0, 0, At, B0); PG8_MMA(0, 1, At, B1); } PG8_BAR; PG8_SCHED;
            PG8_LDA(At, 1, 1); PG8_STAGE(PG8_SB(1, 0), b3, voffB); PG8_STAGE(PG8_SB(1, 1), b3 + hstep, voffB); PG8_STAGE(PG8_SA(1, 0), a3, v2[0]);
            PG8_WAIT_V(8); PG8_WAIT_L(0); PG8_BAR; if (mma1) { PG8_MMA(1, 0, At, B0); PG8_MMA(1, 1, At, B1); } PG8_BAR; PG8_SCHED;
        }
        if (wr == 0) PG8_BAR;
        E(acc, cur, wr, wc, fr, fq);
        if (!has_next) break;
#pragma unroll
        for (int a = 0; a < 2; ++a)
#pragma unroll
            for (int b = 0; b < 2; ++b)
#pragma unroll
                for (int m = 0; m < 4; ++m)
#pragma unroll
                    for (int n = 0; n < 2; ++n) acc[a][b][m][n] = (f32x4){0.f, 0.f, 0.f, 0.f};
        cur = nxt; cA = nA; cB = nB; ++ui;
#pragma unroll
        for (int h = 0; h < 2; ++h)
#pragma unroll
            for (int i = 0; i < 2; ++i) va[h][i] = nva[h][i];
        if (wr == 1) PG8_BAR;
    }
    PG8_WAIT_V(0);
    PG8_BAR;
#undef PG8_SA
#undef PG8_SB
#undef PG8_STAGE
#undef PG8_LDA
#undef PG8_LDB
#undef PG8_MMA
#undef PG8_WAIT_V
#undef PG8_WAIT_L
#undef PG8_BAR
#undef PG8_SCHED
#undef PG8_VOFF
}

struct EpiRowScaleBf16 {
    bf16* O; int ldc; const float* rs;
    __device__ __forceinline__ void operator()(const f32x4 (&acc)[2][2][4][2], const Unit& u, int wr, int wc, int fr, int fq) const {
        const int row0 = u.pm * BM + wr * 64 + fr, col0 = u.pn * BM + wc * 32 + 8 * fq;
        float sc[2][4];
#pragma unroll
        for (int ai = 0; ai < 2; ++ai)
#pragma unroll
            for (int m = 0; m < 4; ++m) sc[ai][m] = rs[row0 + ai * HALF + m * 16];
#pragma unroll
        for (int ai = 0; ai < 2; ++ai)
#pragma unroll
            for (int m = 0; m < 4; ++m) { const int row = row0 + ai * HALF + m * 16; const float s = sc[ai][m]; bf16* rowp = O + (size_t)row * ldc + col0;
#pragma unroll
                for (int bj = 0; bj < 2; ++bj) { const f32x4 v0 = acc[ai][bj][m][0] * s, v1 = acc[ai][bj][m][1] * s;
                    v4u w; w.x = cvt_pk_bf16(v0[0], v0[1]); w.y = cvt_pk_bf16(v0[2], v0[3]); w.z = cvt_pk_bf16(v1[0], v1[1]); w.w = cvt_pk_bf16(v1[2], v1[3]);
                    *(v4u*)(rowp + bj * HALF) = w; } }
    }
};
struct EpiPlainBf16 {
    bf16* O; int ldc;
    __device__ __forceinline__ void operator()(const f32x4 (&acc)[2][2][4][2], const Unit& u, int wr, int wc, int fr, int fq) const {
        const int row0 = u.pm * BM + wr * 64 + fr, col0 = u.pn * BM + wc * 32 + 8 * fq;
#pragma unroll
        for (int ai = 0; ai < 2; ++ai)
#pragma unroll
            for (int m = 0; m < 4; ++m) { const int row = row0 + ai * HALF + m * 16; bf16* rowp = O + (size_t)row * ldc + col0;
#pragma unroll
                for (int bj = 0; bj < 2; ++bj) { const f32x4 v0 = acc[ai][bj][m][0], v1 = acc[ai][bj][m][1];
                    v4u w; w.x = cvt_pk_bf16(v0[0], v0[1]); w.y = cvt_pk_bf16(v0[2], v0[3]); w.z = cvt_pk_bf16(v1[0], v1[1]); w.w = cvt_pk_bf16(v1[2], v1[3]);
                    *(v4u*)(rowp + bj * HALF) = w; } }
    }
};
struct EpiGateBf16 {
    bf16* O; int ldc; const float* rs; const float* bias;
    __device__ __forceinline__ void operator()(const f32x4 (&acc)[2][2][4][2], const Unit& u, int wr, int wc, int fr, int fq) const {
        const int row0 = u.pm * BM + wr * 64 + fr, col0 = u.pn * BM + wc * 32 + 8 * fq;
        float sc[2][4]; f32x4 bv[2][2];
#pragma unroll
        for (int ai = 0; ai < 2; ++ai)
#pragma unroll
            for (int m = 0; m < 4; ++m) sc[ai][m] = rs[row0 + ai * HALF + m * 16];
#pragma unroll
        for (int bj = 0; bj < 2; ++bj)
#pragma unroll
            for (int n = 0; n < 2; ++n) bv[bj][n] = *(const f32x4*)(bias + col0 + bj * HALF + 4 * n);
#pragma unroll
        for (int ai = 0; ai < 2; ++ai)
#pragma unroll
            for (int m = 0; m < 4; ++m) { const int row = row0 + ai * HALF + m * 16; const float s = sc[ai][m]; bf16* rowp = O + (size_t)row * ldc + col0;
#pragma unroll
                for (int bj = 0; bj < 2; ++bj) { f32x4 v0 = acc[ai][bj][m][0] * s + bv[bj][0], v1 = acc[ai][bj][m][1] * s + bv[bj][1];
#pragma unroll
                    for (int q = 0; q < 4; ++q) { v0[q] = fast_sigmoid(v0[q]); v1[q] = fast_sigmoid(v1[q]); }
                    v4u w; w.x = cvt_pk_bf16(v0[0], v0[1]); w.y = cvt_pk_bf16(v0[2], v0[3]); w.z = cvt_pk_bf16(v1[0], v1[1]); w.w = cvt_pk_bf16(v1[2], v1[3]);
                    *(v4u*)(rowp + bj * HALF) = w; } }
    }
};
}

struct Args { const float* in[25]; float* out; unsigned char* ws; int ph_lo, ph_hi; };

struct Frame {
    LAS unsigned char* lds; volatile LAS unsigned* MISC; gu32* ctl; int tid, lane, wave, vcu, G;
};
__device__ __forceinline__ float wave_sum(float v) {
#pragma unroll
    for (int o = 1; o < 64; o <<= 1) v += __shfl_xor(v, o);
    return v;
}
template <int RM, bool HAS_CS>
__device__ __forceinline__ void p0_transpose_item(const float* __restrict__ W, int K, int N, bf16* __restrict__ WT, int row_off, const float* __restrict__ cs, LAS float* scr, int item, int lane) {
    const int nblk = N / 32, kb = item / nblk, nb = item % nblk, k0 = 64 * kb, n0 = 32 * nb;
    const int c = lane & 7;
    f32x4 s0 = {1.f, 1.f, 1.f, 1.f}, s1 = {1.f, 1.f, 1.f, 1.f};
    if (HAS_CS) { s0 = *(const f32x4*)(cs + k0 + 8 * c); s1 = *(const f32x4*)(cs + k0 + 8 * c + 4); }
#pragma unroll 8
    for (int i = 0; i < 32; ++i) { const int kk = 2 * i + (lane >> 5); scr[kk * 33 + (lane & 31)] = W[(size_t)(k0 + kk) * N + n0 + (lane & 31)]; }
    LDS_WAIT(); asm volatile("" ::: "memory");
#pragma unroll
    for (int j = 0; j < 4; ++j) { const int n = (lane >> 3) + 8 * j; const LAS float* s = scr + (8 * c) * 33 + n;
        v4u o; o.x = pk2(s[0 * 33] * s0.x, s[1 * 33] * s0.y); o.y = pk2(s[2 * 33] * s0.z, s[3 * 33] * s0.w); o.z = pk2(s[4 * 33] * s1.x, s[5 * 33] * s1.y); o.w = pk2(s[6 * 33] * s1.z, s[7 * 33] * s1.w);
        const int nn = n0 + n; const int orow = RM == 0 ? row_off + nn : (row_off + 8 * (nn >> 2) + (nn & 3) + (RM == 2 ? 4 : 0));
        *(GAS v4u*)(WT + (size_t)orow * K + k0 + 8 * c) = o; }
    LDS_WAIT(); asm volatile("" ::: "memory");
}

__device__ __forceinline__ unsigned pk4_fp8(float v0, float v1, float v2, float v3) {
    v0 = fminf(fmaxf(v0, -448.f), 448.f); v1 = fminf(fmaxf(v1, -448.f), 448.f); v2 = fminf(fmaxf(v2, -448.f), 448.f); v3 = fminf(fmaxf(v3, -448.f), 448.f);
    int w = 0; w = __builtin_amdgcn_cvt_pk_fp8_f32(v0, v1, w, false); w = __builtin_amdgcn_cvt_pk_fp8_f32(v2, v3, w, true); return (unsigned)w;
}
template <int RM, bool HAS_CS>
__device__ __forceinline__ void p0_transpose_item_f8(const float* __restrict__ W, int K, int N, unsigned char* __restrict__ WT, const float* __restrict__ cs, float scale, LAS float* scr, int item, int lane) {
    const int nblk = N / 32, kb = item / nblk, nb = item % nblk, k0 = 64 * kb, n0 = 32 * nb;
    const int n = lane & 31, kq = lane >> 5;
#pragma unroll 8
    for (int i = 0; i < 32; ++i) { const int kk = 2 * i + (lane >> 5); scr[kk * 33 + (lane & 31)] = W[(size_t)(k0 + kk) * N + n0 + (lane & 31)]; }
    LDS_WAIT(); asm volatile("" ::: "memory");
    const int nn = n0 + n; const int orow = RM == 0 ? nn : (8 * (nn >> 2) + (nn & 3) + (RM == 2 ? 4 : 0));
    unsigned char* dst = WT + (size_t)orow * K + k0 + 32 * kq;
    f32x4 csv[8];
#pragma unroll
    for (int i = 0; i < 8; ++i) csv[i] = HAS_CS ? *(const f32x4*)(cs + k0 + 32 * kq + 4 * i) * scale : (f32x4){scale, scale, scale, scale};
#pragma unroll
    for (int h = 0; h < 2; ++h) { v4u o;
#pragma unroll
        for (int q = 0; q < 4; ++q) { const int kk = 32 * kq + 16 * h + 4 * q; const f32x4 sc = csv[4 * h + q];
            o[q] = pk4_fp8(scr[kk * 33 + n] * sc[0], scr[(kk + 1) * 33 + n] * sc[1], scr[(kk + 2) * 33 + n] * sc[2], scr[(kk + 3) * 33 + n] * sc[3]); }
        *(GAS v4u*)(dst + 16 * h) = o; }
    LDS_WAIT(); asm volatile("" ::: "memory");
}
struct Ptrs {
    const float *x, *p, *g_mix, *w_in, *conv_w, *conv_b, *wa, *ba, *wx, *bx, *lam, *w_out, *g_ffn, *w_rg, *b_rg, *w_re, *b_re, *w1, *w3, *w2, *g_ple, *w_pg, *b_pg, *w_pp, *g_final;
    float* out; unsigned char* ws;
    float *rstd0, *rstd1, *rstd2; int* eid; float* ew; int* list; int* counts; int* goffs;
    bf16 *W_IN, *W_OUT, *W_PG, *W_PP, *WRT, *LRUW, *W13, *W2, *PB, *XB, *MIX, *ACT, *GATE, *PROJ, *D1, *X1B, *X2B, *Y, *PP;
};
__device__ __forceinline__ void make_ptrs(Ptrs& P, const Args& a) {
    P.x = a.in[0]; P.p = a.in[1]; P.g_mix = a.in[2]; P.w_in = a.in[3]; P.conv_w = a.in[4]; P.conv_b = a.in[5]; P.wa = a.in[6]; P.ba = a.in[7]; P.wx = a.in[8]; P.bx = a.in[9]; P.lam = a.in[10];
    P.w_out = a.in[11]; P.g_ffn = a.in[12]; P.w_rg = a.in[13]; P.b_rg = a.in[14]; P.w_re = a.in[15]; P.b_re = a.in[16]; P.w1 = a.in[17]; P.w3 = a.in[18]; P.w2 = a.in[19];
    P.g_ple = a.in[20]; P.w_pg = a.in[21]; P.b_pg = a.in[22]; P.w_pp = a.in[23]; P.g_final = a.in[24];
    P.out = a.out; P.ws = a.ws; unsigned char* ws = a.ws;
    P.rstd0 = (float*)(ws + WS_RSTD0); P.rstd1 = (float*)(ws + WS_RSTD1); P.rstd2 = (float*)(ws + WS_RSTD2);
    P.eid = (int*)(ws + WS_EID); P.ew = (float*)(ws + WS_EW); P.list = (int*)(ws + WS_LIST); P.counts = (int*)(ws + WS_CNT); P.goffs = P.counts + 256 * NE;
    P.W_IN = (bf16*)(ws + WS_WIN); P.W_OUT = (bf16*)(ws + WS_WOUT); P.W_PG = (bf16*)(ws + WS_WPG); P.W_PP = (bf16*)(ws + WS_WPP); P.WRT = (bf16*)(ws + WS_WRT); P.LRUW = (bf16*)(ws + WS_LRUW);
    P.W13 = (bf16*)(ws + WS_W13); P.W2 = (bf16*)(ws + WS_W2); P.PB = (bf16*)(ws + WS_PB);
    P.XB = (bf16*)(ws + WS_R64); P.MIX = (bf16*)(ws + WS_R64); P.ACT = (bf16*)(ws + WS_R64); P.GATE = (bf16*)(ws + WS_R64);
    P.PROJ = (bf16*)(ws + WS_PROJ); P.D1 = (bf16*)(ws + WS_D1); P.PP = (bf16*)(ws + WS_PP); P.X1B = (bf16*)(ws + WS_X1B); P.X2B = (bf16*)(ws + WS_X1B); P.Y = (bf16*)(ws + WS_Y);
}

__device__ __forceinline__ void p0_prologue(Frame& F, const Ptrs& P) {
    LAS float* scr = (LAS float*)(F.lds + RING_OFF + F.wave * 16384);
    const int gw = F.vcu * NWAVES + F.wave, NGW = F.G * NWAVES;
    constexpr int I_WIN = (D / 64) * (INC / 32), I_SQ = (D / 64) * (D / 32), I_WPP = (PLE / 64) * (D / 32), I_W1 = (D / 64) * (DE / 32), I_W2 = (DE / 64) * (D / 32);
    constexpr int NITEMS = I_WIN + 2 * I_SQ + I_WPP + NE * (2 * I_W1 + I_W2);
    for (int it = gw; it < NITEMS; it += NGW) {
        int r = it;
        if (r < I_WIN) { p0_transpose_item<0, true>(P.w_in, D, INC, P.W_IN, 0, P.g_mix, scr, r, F.lane); continue; } r -= I_WIN;
        if (r < I_SQ) { p0_transpose_item<0, false>(P.w_out, D, D, P.W_OUT, 0, nullptr, scr, r, F.lane); continue; } r -= I_SQ;
        if (r < I_SQ) { p0_transpose_item<0, true>(P.w_pg, D, D, P.W_PG, 0, P.g_ple, scr, r, F.lane); continue; } r -= I_SQ;
        if (r < I_WPP) { p0_transpose_item<0, false>(P.w_pp, PLE, D, P.W_PP, 0, nullptr, scr, r, F.lane); continue; } r -= I_WPP;
        const int per_e = 2 * I_W1 + I_W2, e = r / per_e; r -= e * per_e;
        if (r < I_W1) { p0_transpose_item_f8<1, true>(P.w1 + (size_t)e * D * DE, D, DE, (unsigned char*)P.W13 + (size_t)e * D * D, P.g_ffn, MOE_SW1, scr, r, F.lane); continue; } r -= I_W1;
        if (r < I_W1) { p0_transpose_item_f8<2, true>(P.w3 + (size_t)e * D * DE, D, DE, (unsigned char*)P.W13 + (size_t)e * D * D, P.g_ffn, MOE_SW1, scr, r, F.lane); continue; } r -= I_W1;
        p0_transpose_item_f8<0, false>(P.w2 + (size_t)e * DE * D, DE, D, (unsigned char*)P.W2 + (size_t)e * D * DE, nullptr, MOE_SW2, scr, r, F.lane);
    }
    for (int m = gw; m < T; m += NGW) {
        const GAS f32x4* xr = (const GAS f32x4*)(P.x + (size_t)m * D) + F.lane;
        f32x4 v[4]; float s = 0.f;
#pragma unroll
        for (int j = 0; j < 4; ++j) { v[j] = xr[64 * j]; s += (v[j].x * v[j].x + v[j].y * v[j].y) + (v[j].z * v[j].z + v[j].w * v[j].w); }
        s = wave_sum(s);
        GAS v2u* o8 = (GAS v2u*)(P.XB + (size_t)m * D) + F.lane;
#pragma unroll
        for (int j = 0; j < 4; ++j) { v2u w; w.x = pk2(v[j].x, v[j].y); w.y = pk2(v[j].z, v[j].w); o8[64 * j] = w; }
        if (F.lane == 0) P.rstd0[m] = 1.0f / sqrtf(s * (1.f / D) + EPS);
    }
    for (int m = gw; m < T; m += NGW) {
        const f32x4 v = *((const GAS f32x4*)(P.p + (size_t)m * PLE) + F.lane);
        v2u w; w.x = pk2(v.x, v.y); w.y = pk2(v.z, v.w); *((GAS v2u*)(P.PB + (size_t)m * PLE) + F.lane) = w;
    }
    for (int idx = (F.vcu * NTHR + F.tid); idx < 80 * D; idx += F.G * NTHR) {
        const int n = idx / D, k = idx % D; float v = 0.f;
        if (n < NG) v = P.w_rg[(size_t)k * NG + n] * P.g_ffn[k]; else if (n < NG + NE) v = P.w_re[(size_t)k * NE + (n - NG)] * P.g_ffn[k];
        const bf16 hi = f2bf(v); const bf16 lo = f2bf(v - bf2f(hi));
        P.WRT[idx] = hi; P.WRT[80 * D + idx] = lo;
    }
    for (int idx = (F.vcu * NTHR + F.tid); idx < 2 * 8 * 64 * 64; idx += F.G * NTHR) {
        const int g = idx >> 15, r = idx & 32767, hb = r >> 12, j = (r >> 6) & 63, i = r & 63;
        const float* w = g ? P.wx : P.wa;
        P.LRUW[idx] = f2bf(w[(hb * 64 + i) * 64 + j]);
    }
}


__device__ __forceinline__ f32x4 bf4(v2u w) { return (f32x4){bflo(w.x), bfhi(w.x), bflo(w.y), bfhi(w.y)}; }
__device__ __forceinline__ void p10_combine(Frame& F, const Ptrs& P) {
    const int gw = F.vcu * NWAVES + F.wave, NGW = F.G * NWAVES;
    for (int m = gw; m < T; m += NGW) {
        const size_t ro = (size_t)m * D;
        const GAS f32x4* xr = (const GAS f32x4*)(P.x + ro) + F.lane;
        const GAS v2u* d1 = (const GAS v2u*)(P.D1 + ro) + F.lane; const GAS v2u* y0 = (const GAS v2u*)(P.Y + ro) + F.lane; const GAS v2u* y1 = (const GAS v2u*)(P.Y + (size_t)T * D + ro) + F.lane;
        f32x4 v[4]; v2u a[4], b[4], c[4];
#pragma unroll
        for (int j = 0; j < 4; ++j) { v[j] = xr[64 * j]; a[j] = d1[64 * j]; b[j] = y0[64 * j]; c[j] = y1[64 * j]; }
        float s = 0.f;
#pragma unroll
        for (int j = 0; j < 4; ++j) { v[j] = (v[j] + bf4(a[j])) + (bf4(b[j]) + bf4(c[j])); s += (v[j].x * v[j].x + v[j].y * v[j].y) + (v[j].z * v[j].z + v[j].w * v[j].w); }
        s = wave_sum(s);
        GAS f32x4* o = (GAS f32x4*)(P.out + ro) + F.lane; GAS v2u* o8 = (GAS v2u*)(P.X2B + ro) + F.lane;
#pragma unroll
        for (int j = 0; j < 4; ++j) { o[64 * j] = v[j]; v2u w; w.x = pk2(v[j].x, v[j].y); w.y = pk2(v[j].z, v[j].w); o8[64 * j] = w; }
        if (F.lane == 0) P.rstd2[m] = 1.0f / sqrtf(s * (1.f / D) + EPS);
    }
}
__device__ __forceinline__ void p13_final(Frame& F, const Ptrs& P) {
    const int gw = F.vcu * NWAVES + F.wave, NGW = F.G * NWAVES;
    f32x4 gf[4];
#pragma unroll
    for (int j = 0; j < 4; ++j) gf[j] = *((const GAS f32x4*)P.g_final + F.lane + 64 * j);
    for (int m = gw; m < T; m += NGW) {
        const size_t ro = (size_t)m * D;
        GAS f32x4* xr = (GAS f32x4*)(P.out + ro) + F.lane;
        const GAS v2u* ga = (const GAS v2u*)(P.GATE + ro) + F.lane; const GAS v2u* pp = (const GAS v2u*)(P.PP + ro) + F.lane;
        f32x4 v[4]; v2u a[4], b[4];
#pragma unroll
        for (int j = 0; j < 4; ++j) { v[j] = xr[64 * j]; a[j] = ga[64 * j]; b[j] = pp[64 * j]; }
        float s = 0.f;
#pragma unroll
        for (int j = 0; j < 4; ++j) { v[j] = v[j] + bf4(a[j]) * bf4(b[j]); s += (v[j].x * v[j].x + v[j].y * v[j].y) + (v[j].z * v[j].z + v[j].w * v[j].w); }
        s = wave_sum(s);
        const float r = 1.0f / sqrtf(s * (1.f / D) + EPS);
#pragma unroll
        for (int j = 0; j < 4; ++j) xr[64 * j] = v[j] * r * gf[j];
    }
}
__device__ __forceinline__ LAS int* sched_offs(Frame& F) { return (LAS int*)(F.lds + SCHED_OFF); }
__device__ __forceinline__ LAS int* sched_tileb(Frame& F) { return (LAS int*)(F.lds + SCHED_OFF) + 72; }
__device__ __forceinline__ LAS int* sched_pre(Frame& F) { return (LAS int*)(F.lds + SCHED_OFF) + 144; }
__device__ __forceinline__ LAS int* sched_ta(Frame& F) { return (LAS int*)(F.lds + SCHED_OFF) + 256; }
__device__ __forceinline__ LAS int* sched_tc(Frame& F) { return (LAS int*)(F.lds + SCHED_OFF) + 328; }
__device__ __forceinline__ void sched_build(Frame& F, const Ptrs& P) {
    LAS int* offs = sched_offs(F); LAS int* tb = sched_tileb(F); LAS int* pre = sched_pre(F);
    LAS int* part = (LAS int*)(F.lds + UTAB_OFF);
    {
        const int e = F.tid & 63, pt = F.tid >> 6; int t = 0, p = 0; int cv[32];
#pragma unroll
        for (int j = 0; j < 32; ++j) cv[j] = P.counts[(pt * 32 + j) * NE + e];
#pragma unroll
        for (int j = 0; j < 32; ++j) { t += cv[j]; p += (pt * 32 + j < F.vcu) ? cv[j] : 0; }
        part[(pt * 64 + e) * 2] = t; part[(pt * 64 + e) * 2 + 1] = p;
    }
    __syncthreads();
    if (F.tid < NE) { int t = 0, p = 0;
#pragma unroll
        for (int pt = 0; pt < 8; ++pt) { t += part[(pt * 64 + F.tid) * 2]; p += part[(pt * 64 + F.tid) * 2 + 1]; }
        pre[F.tid] = p; part[1024 + F.tid] = t; }
    __syncthreads();
    if (F.tid == 0) { LAS int* ta = sched_ta(F); LAS int* tc = sched_tc(F); int o = 0, tbv = 0, tav = 0, tcv = 0;
        for (int e = 0; e < NE; ++e) { offs[e] = o; tb[e] = tbv; ta[e] = tav; tc[e] = tcv; const int t = part[1024 + e], tl = t & 255; o += t; tbv += t >> 8; tav += tl > 128 ? 1 : 0; tcv += (tl > 0 && tl <= 128) ? 1 : 0; }
        offs[NE] = o; tb[NE] = tbv; ta[NE] = tav; tc[NE] = tcv; }
    __syncthreads();
}

constexpr int P6_BROW = 272, P6_BHL = 80 * P6_BROW, P6_BBUF = 2 * P6_BHL, P6_LG_OFF = 90112;
static_assert(2 * P6_BBUF <= P6_LG_OFF && P6_LG_OFF + 8 * 16 * 80 * 4 <= RING_BYTES, "P6 LDS map");
__device__ __forceinline__ void p6_route(Frame& F, const Ptrs& P) {
    const int lane = F.lane, r = lane & 15, g = lane >> 4;
    const int tok = F.vcu * 128 + F.wave * 16 + r;
    LAS unsigned char* BS = F.lds + RING_OFF;
    LAS float* LG = (LAS float*)(F.lds + RING_OFF + P6_LG_OFF) + F.wave * (16 * 80);
    LAS float* SS = (LAS float*)(F.lds + UTAB_OFF) + F.wave * 16;
    LAS int* hist = (LAS int*)(F.lds + UTAB_OFF + 1024);
    if (F.tid < NE) hist[F.tid] = 0;
    f32x4 acc[5];
#pragma unroll
    for (int i = 0; i < 5; ++i) acc[i] = (f32x4){0.f, 0.f, 0.f, 0.f};
    float ssq = 0.f;
    const float* xrow = P.x + (size_t)tok * D + 8 * g; const bf16* drow = P.D1 + (size_t)tok * D + 8 * g; unsigned char* orow = (unsigned char*)P.X1B + (size_t)tok * D + 8 * g;
    unsigned bsrc[5], bdst[5];
#pragma unroll
    for (int i = 0; i < 5; ++i) { const int id = F.tid + 512 * i, hl = id / 1280, rem = id % 1280, row = rem >> 4, ch = rem & 15;
        bsrc[i] = (unsigned)((hl * 80 + row) * D + 8 * ch) * 2u; bdst[i] = (unsigned)(hl * P6_BHL + row * P6_BROW + ch * 16); }
    v4u breg[5]; f32x4 xa[4], xb[4]; v4u dd[4];
#pragma unroll
    for (int i = 0; i < 5; ++i) breg[i] = *(const v4u*)((const char*)P.WRT + bsrc[i]);
#pragma unroll
    for (int s = 0; s < 4; ++s) { xa[s] = *(const f32x4*)(xrow + 32 * s); xb[s] = *(const f32x4*)(xrow + 32 * s + 4); dd[s] = *(const v4u*)(drow + 32 * s); }
#pragma unroll 1
    for (int sl = 0; sl < 8; ++sl) {
        LAS unsigned char* bb = BS + (sl & 1) * P6_BBUF;
#pragma unroll
        for (int i = 0; i < 5; ++i) *(LAS v4u*)(bb + bdst[i]) = breg[i];
        __syncthreads();
        f32x4 cxa[4], cxb[4]; v4u cdd[4];
#pragma unroll
        for (int s = 0; s < 4; ++s) { cxa[s] = xa[s]; cxb[s] = xb[s]; cdd[s] = dd[s]; }
        if (sl < 7) {
#pragma unroll
            for (int i = 0; i < 5; ++i) breg[i] = *(const v4u*)((const char*)P.WRT + bsrc[i] + (sl + 1) * 256);
#pragma unroll
            for (int s = 0; s < 4; ++s) { xa[s] = *(const f32x4*)(xrow + 128 * (sl + 1) + 32 * s); xb[s] = *(const f32x4*)(xrow + 128 * (sl + 1) + 32 * s + 4); dd[s] = *(const v4u*)(drow + 128 * (sl + 1) + 32 * s); }
        }
#pragma unroll
        for (int s = 0; s < 4; ++s) {
            float v[8];
            v[0] = cxa[s][0] + bflo(cdd[s].x); v[1] = cxa[s][1] + bfhi(cdd[s].x); v[2] = cxa[s][2] + bflo(cdd[s].y); v[3] = cxa[s][3] + bfhi(cdd[s].y);
            v[4] = cxb[s][0] + bflo(cdd[s].z); v[5] = cxb[s][1] + bfhi(cdd[s].z); v[6] = cxb[s][2] + bflo(cdd[s].w); v[7] = cxb[s][3] + bfhi(cdd[s].w);
            v4u hw, lw;
#pragma unroll
            for (int q = 0; q < 4; ++q) {
                ssq += v[2 * q] * v[2 * q] + v[2 * q + 1] * v[2 * q + 1];
                const unsigned h = cvt_pk_bf16(v[2 * q], v[2 * q + 1]);
                const unsigned l = cvt_pk_bf16(v[2 * q] - bflo(h), v[2 * q + 1] - bfhi(h));
                hw[q] = h; lw[q] = l;
            }
            { v2u f8; f8.x = pk4_fp8(v[0] * MOE_SX, v[1] * MOE_SX, v[2] * MOE_SX, v[3] * MOE_SX); f8.y = pk4_fp8(v[4] * MOE_SX, v[5] * MOE_SX, v[6] * MOE_SX, v[7] * MOE_SX); *(v2u*)(orow + 128 * sl + 32 * s) = f8; }
            const bf16x8 ah = __builtin_bit_cast(bf16x8, hw), al = __builtin_bit_cast(bf16x8, lw);
#pragma unroll
            for (int nt = 0; nt < 5; ++nt) {
                const bf16x8 bh = *(const LAS bf16x8*)(bb + (16 * nt + r) * P6_BROW + (32 * s + 8 * g) * 2), bl = *(const LAS bf16x8*)(bb + P6_BHL + (16 * nt + r) * P6_BROW + (32 * s + 8 * g) * 2);
                acc[nt] = __builtin_amdgcn_mfma_f32_16x16x32_bf16(ah, bh, acc[nt], 0, 0, 0);
                acc[nt] = __builtin_amdgcn_mfma_f32_16x16x32_bf16(al, bh, acc[nt], 0, 0, 0);
                acc[nt] = __builtin_amdgcn_mfma_f32_16x16x32_bf16(ah, bl, acc[nt], 0, 0, 0);
            }
        }
    }
    ssq += __shfl_xor(ssq, 16); ssq += __shfl_xor(ssq, 32);
#pragma unroll
    for (int nt = 0; nt < 5; ++nt)
#pragma unroll
        for (int q = 0; q < 4; ++q) LG[(4 * g + q) * 80 + 16 * nt + r] = acc[nt][q];
    if (g == 0) SS[r] = ssq;
    __syncthreads();
    if (g == 0) {
        const float rs = 1.0f / sqrtf(SS[r] * (1.f / D) + EPS);
        const LAS float* L = LG + r * 80;
        float gl[8]; float mx = -3.0e38f; int gsel = 0;
#pragma unroll
        for (int i = 0; i < 8; ++i) { gl[i] = rs * L[i] + P.b_rg[i]; if (gl[i] > mx) { mx = gl[i]; gsel = i; } }
        float den = 0.f;
#pragma unroll
        for (int i = 0; i < 8; ++i) den += expf(gl[i] - mx);
        const float gw = 1.f / den;
        float v0 = -3.0e38f, v1 = -3.0e38f; int i0 = 0, i1 = 0;
        for (int i = 0; i < 8; ++i) {
            const float v = rs * L[8 + gsel * 8 + i] + P.b_re[gsel * 8 + i];
            if (v > v0) { v1 = v0; i1 = i0; v0 = v; i0 = i; } else if (v > v1) { v1 = v; i1 = i; }
        }
        const float e1 = expf(v1 - v0), w0 = 1.f / (1.f + e1), w1 = e1 / (1.f + e1);
        const int ea = gsel * 8 + i0, eb = gsel * 8 + i1;
        P.eid[tok * 2] = ea; P.eid[tok * 2 + 1] = eb; P.ew[tok * 2] = w0 * gw; P.ew[tok * 2 + 1] = w1 * gw; P.rstd1[tok] = rs;
        __hip_atomic_fetch_add(hist + ea, 1, __ATOMIC_RELAXED, __HIP_MEMORY_SCOPE_WORKGROUP); __hip_atomic_fetch_add(hist + eb, 1, __ATOMIC_RELAXED, __HIP_MEMORY_SCOPE_WORKGROUP);
    }
    __syncthreads();
    if (F.tid < NE) P.counts[F.vcu * NE + F.tid] = hist[F.tid];
}

__device__ __forceinline__ void p7_lists(Frame& F, const Ptrs& P) {
    sched_build(F, P);
    LAS int* offs = sched_offs(F); LAS int* pre = sched_pre(F);
    LAS int* eids = (LAS int*)(F.lds + RING_OFF);
    if (F.tid < 256) eids[F.tid] = P.eid[F.vcu * 256 + F.tid];
    __syncthreads();
    if (F.tid < NE) {
        const int e = F.tid; int pos = offs[e] + pre[e];
        for (int a = 0; a < 256; ++a) if (eids[a] == e) { P.list[pos] = F.vcu * 256 + a; ++pos; }
    }
    if (blockIdx.x == 0 && F.tid <= NE) P.goffs[F.tid] = offs[F.tid];
    __syncthreads();
}

namespace pg8 {
template <int MODE>
struct MoeSched {
    const char* Ab; const char* Bb; int K, G, c; LAS int* offs; LAS int* tb; LAS int* ta; LAS int* tc; LAS int* tab;
    __device__ __forceinline__ bool next(int i, Unit& u) const {
        const int L = i * G + c; const int nF = __builtin_amdgcn_readfirstlane(tb[NE]), nA = __builtin_amdgcn_readfirstlane(ta[NE]), nC = __builtin_amdgcn_readfirstlane(tc[NE]);
        if (L >= 4 * (nF + nA + nC)) return false;
        int rt = L >> 2; const LAS int* pf = tb; int cls = 0;
        if (rt >= nF) { rt -= nF; pf = ta; cls = 1; if (rt >= nA) { rt -= nA; pf = tc; cls = 2; } }
        int e = 0;
        for (int k = 1; k < NE; ++k) e += (pf[k] <= rt) ? 1 : 0;
        e = __builtin_amdgcn_readfirstlane(e);
        const int o0 = __builtin_amdgcn_readfirstlane(offs[e]), cnt = __builtin_amdgcn_readfirstlane(offs[e + 1]) - o0;
        u.e = e; u.pm = cls == 0 ? rt - __builtin_amdgcn_readfirstlane(tb[e]) : (cnt >> 8); u.pn = L & 3; u.slot0 = o0 + 256 * u.pm;
        u.rows = cls == 0 ? 256 : (cnt & 255); u.ui = i; return true;
    }
    __device__ __forceinline__ const char* a_base(const Unit& u) const { return MODE == 0 ? Ab : Ab + (size_t)u.slot0 * (size_t)(K * 2); }
    __device__ __forceinline__ const char* b_base(const Unit& u) const { return Bb + ((size_t)u.e * D + (size_t)u.pn * BM) * (size_t)K * 2; }
    __device__ __forceinline__ unsigned a_rowoff(const Unit& u, int r) const { return MODE == 0 ? (unsigned)tab[u.ui * 256 + r] : (unsigned)r * (unsigned)(K * 2); }
};
struct EpiAct {
    unsigned char* ACT; const LAS float* tabf;
    __device__ __forceinline__ void operator()(const f32x4 (&acc)[2][2][4][2], const Unit& u, int wr, int wc, int fr, int fq) const {
#pragma unroll
        for (int ai = 0; ai < 2; ++ai)
#pragma unroll
            for (int m = 0; m < 4; ++m) { const int r = ai * HALF + wr * 64 + m * 16 + fr;
                if (r < u.rows) { const float s = tabf[u.ui * 256 + r] * (1.f / (MOE_SX * MOE_SW1)); unsigned char* rowp = ACT + (size_t)(u.slot0 + r) * DE + u.pn * 128 + wc * 16 + 4 * fq;
#pragma unroll
                    for (int bj = 0; bj < 2; ++bj) { const f32x4 h1 = acc[ai][bj][m][0] * s, h3 = acc[ai][bj][m][1] * s; f32x4 a;
#pragma unroll
                        for (int q = 0; q < 4; ++q) a[q] = h1[q] * fast_sigmoid(h1[q]) * h3[q] * MOE_SA;
                        *(unsigned*)(rowp + bj * 64) = pk4_fp8(a[0], a[1], a[2], a[3]); } } }
    }
};
struct EpiY {
    bf16* Y; const LAS int* tab; const LAS float* tabf;
    __device__ __forceinline__ void operator()(const f32x4 (&acc)[2][2][4][2], const Unit& u, int wr, int wc, int fr, int fq) const {
#pragma unroll
        for (int ai = 0; ai < 2; ++ai)
#pragma unroll
            for (int m = 0; m < 4; ++m) { const int r = ai * HALF + wr * 64 + m * 16 + fr; const int aid = tab[u.ui * 256 + r];
                if (aid >= 0) { const float s = tabf[u.ui * 256 + r] * (1.f / (MOE_SA * MOE_SW2)); bf16* rowp = Y + ((size_t)(aid & 1) * T + (size_t)(aid >> 1)) * D + u.pn * BM + wc * 32 + 8 * fq;
#pragma unroll
                    for (int bj = 0; bj < 2; ++bj) { const f32x4 v0 = acc[ai][bj][m][0] * s, v1 = acc[ai][bj][m][1] * s;
                        v4u w; w.x = cvt_pk_bf16(v0[0], v0[1]); w.y = cvt_pk_bf16(v0[2], v0[3]); w.z = cvt_pk_bf16(v1[0], v1[1]); w.w = cvt_pk_bf16(v1[2], v1[3]);
                        *(v4u*)(rowp + bj * HALF) = w; } } }
    }
};
}
template <int MODE>
__device__ __forceinline__ void moe_phase(Frame& F, const Ptrs& P, bool rebuild) {
    if (rebuild) sched_build(F, P);
    LAS int* tab = (LAS int*)(F.lds + UTAB_OFF); LAS float* tabf = (LAS float*)(F.lds + UTABF_OFF);
    LAS int* uinfo = (LAS int*)(F.lds + SCHED_OFF) + 208;
    pg8::MoeSched<MODE> S; S.Ab = MODE == 0 ? (const char*)P.X1B : (const char*)P.ACT; S.Bb = MODE == 0 ? (const char*)P.W13 : (const char*)P.W2; S.K = MODE == 0 ? D / 2 : DE / 2;   S.G = F.G; S.c = F.vcu;
    S.offs = sched_offs(F); S.tb = sched_tileb(F); S.ta = sched_ta(F); S.tc = sched_tc(F); S.tab = tab;
    if (F.tid < 64) {
#pragma unroll
        for (int i = 0; i < MAXU; ++i) { pg8::Unit u; const bool ok = S.next(i, u); if (F.tid == 0) { uinfo[2 * i] = ok ? u.slot0 : 0; uinfo[2 * i + 1] = ok ? u.rows : 0; } }
    }
    __syncthreads();
    {
        const int r = F.tid & 255, i0 = F.tid >> 8; int aid[3]; bool val[3], act[3];
#pragma unroll
        for (int it = 0; it < 3; ++it) { const int i = i0 + 2 * it; const int s0 = uinfo[2 * i], rows = uinfo[2 * i + 1]; act[it] = rows > 0; val[it] = r < rows; aid[it] = act[it] ? P.list[s0 + (val[it] ? r : 0)] : 0; }
        float fv[3];
#pragma unroll
        for (int it = 0; it < 3; ++it) fv[it] = act[it] ? (MODE == 0 ? P.rstd1[aid[it] >> 1] : P.ew[aid[it]]) : 0.f;
#pragma unroll
        for (int it = 0; it < 3; ++it) if (act[it]) { const int i = i0 + 2 * it;
            if (MODE == 0) tab[i * 256 + r] = (aid[it] >> 1) * D; else tab[i * 256 + r] = val[it] ? aid[it] : -1;
            tabf[i * 256 + r] = fv[it]; }
    }
    __syncthreads();
    if constexpr (MODE == 0) { pg8::EpiAct E{(unsigned char*)P.ACT, tabf}; pg8::gemm_phase<pg8::EpiAct, pg8::MoeSched<0>, true>(F.lds + RING_OFF, S, E); }
    else { pg8::EpiY E{P.Y, tab, tabf}; pg8::gemm_phase<pg8::EpiY, pg8::MoeSched<1>, true>(F.lds + RING_OFF, S, E); }
}
typedef short v4i16 __attribute__((ext_vector_type(4)));
__device__ __forceinline__ unsigned off_b(unsigned row, unsigned ch) { return 256u * row + 16u * (ch ^ (((row & 3u) << 2) | ((row >> 2) & 3u))); }
__device__ __forceinline__ unsigned row_read_addr_16(unsigned lane, unsigned rb, unsigned s) { return off_b((lane & 15u) + 16u * rb, 4u * s + (lane >> 4)); }
__device__ __forceinline__ unsigned tr_read_addr_16(unsigned lane, unsigned c, unsigned ks, unsigned t) {
    const unsigned g = lane >> 4, q = (lane & 15u) >> 2, p = lane & 3u;
    return off_b(32u * ks + 8u * g + 4u * t + q, 2u * c + (p >> 1)) + 8u * (p & 1u);
}
__device__ __forceinline__ bf16x8 tr_frag2(LAS unsigned char* p0, LAS unsigned char* p1) {
    const v4i16 a = __builtin_amdgcn_ds_read_tr16_b64_v4i16((LAS v4i16*)p0);
    const v4i16 b = __builtin_amdgcn_ds_read_tr16_b64_v4i16((LAS v4i16*)p1);
    return (bf16x8){a[0], a[1], a[2], a[3], b[0], b[1], b[2], b[3]};
}
__device__ __forceinline__ void wave_lds_fence() { asm volatile("s_waitcnt lgkmcnt(0)" ::: "memory"); __builtin_amdgcn_wave_barrier(); asm volatile("" ::: "memory"); }
__device__ __forceinline__ float gelu_tanh_fast(float x) {
    const float u = 0.7978845608028654f * (x + 0.044715f * x * x * x);
    return x * fast_sigmoid(2.f * u);
}
constexpr float LOG2_ROPE_OVER_64 = 13.287712379549449f / 64.f;
constexpr int MIX_K_OFF = 0, MIX_V_OFF = 32768, MIX_S_OFF = 65536, MIX_S_STRIDE = 272, MIX_S_WAVE = 16 * MIX_S_STRIDE;
constexpr int MIX_CW_OFF = 0, MIX_XC_OFF = 12288, MIX_XC_WAVE = 16 * 68 * 4;
static_assert(MIX_S_OFF + 8 * MIX_S_WAVE <= RING_BYTES && MIX_XC_OFF + 8 * MIX_XC_WAVE <= RING_BYTES, "mixing LDS map");

__device__ __forceinline__ void sincos_rev(float ang, float& sn, float& cs) {
    float rev = ang * 0.15915494309189535f; rev -= floorf(rev);
    sn = __builtin_amdgcn_sinf(rev); cs = __builtin_amdgcn_cosf(rev);
}
struct KVRaw { v4u k[2][2]; v4u v[4]; };
__device__ __forceinline__ void kv_issue(KVRaw& R, int tid, const bf16* proj_t0, int h) {
    const int dg = tid & 7;
#pragma unroll
    for (int it = 0; it < 2; ++it) { const int c = (tid >> 3) + 64 * it; const bf16* row = proj_t0 + (size_t)c * INC + 1536 + h * HD + 8 * dg; R.k[it][0] = *(const v4u*)row; R.k[it][1] = *(const v4u*)(row + 64); }
#pragma unroll
    for (int it = 0; it < 4; ++it) { const int id = tid + 512 * it, c = id >> 4, ch = id & 15; R.v[it] = *(const v4u*)(proj_t0 + (size_t)c * INC + 2048 + h * HD + 8 * ch); }
}
template <bool DECAY>
__device__ __forceinline__ void kv_store(Frame& F, const KVRaw& R, int tid, int s0, float lg2) {
    LAS unsigned char* Kimg = F.lds + MIX_K_OFF; LAS unsigned char* Vimg = F.lds + MIX_V_OFF;
    const int dg = tid & 7;
    float inv[8];
#pragma unroll
    for (int j = 0; j < 8; ++j) inv[j] = __builtin_amdgcn_exp2f(-(float)(8 * dg + j) * LOG2_ROPE_OVER_64);
#pragma unroll
    for (int it = 0; it < 2; ++it) {
        const int c = (tid >> 3) + 64 * it;
        const v4u k1 = R.k[it][0], k2 = R.k[it][1];
        const float sc = 0.08838834764831845f * (DECAY ? __builtin_amdgcn_exp2f((float)(127 - c) * lg2) : 1.f);
        const float pos = (float)(s0 + c);
        v4u o1, o2;
#pragma unroll
        for (int q = 0; q < 4; ++q) {
            float sn0, cs0, sn1, cs1; sincos_rev(pos * inv[2 * q], sn0, cs0); sincos_rev(pos * inv[2 * q + 1], sn1, cs1);
            const float a0 = bflo(k1[q]), a1 = bfhi(k1[q]), b0 = bflo(k2[q]), b1 = bfhi(k2[q]);
            o1[q] = cvt_pk_bf16((a0 * cs0 - b0 * sn0) * sc, (a1 * cs1 - b1 * sn1) * sc);
            o2[q] = cvt_pk_bf16((a0 * sn0 + b0 * cs0) * sc, (a1 * sn1 + b1 * cs1) * sc);
        }
        *(LAS v4u*)(Kimg + off_b(c, dg)) = o1; *(LAS v4u*)(Kimg + off_b(c, dg + 8)) = o2;
    }
#pragma unroll
    for (int it = 0; it < 4; ++it) { const int id = tid + 512 * it, c = id >> 4, ch = id & 15; *(LAS v4u*)(Vimg + off_b(c, ch)) = R.v[it]; }
}

template <bool FINAL>
__device__ __forceinline__ void lru_chunk(Frame& F, const Ptrs& P, int b, int n, int lane) {
    const int r = lane & 15, g = lane >> 4, hb = F.wave;
    const int t0 = b * S + n * CH;
    LAS float* CW = (LAS float*)(F.lds + MIX_CW_OFF);
    LAS float* XC = (LAS float*)(F.lds + MIX_XC_OFF + F.wave * MIX_XC_WAVE);
    for (int i = F.tid; i < 5 * DL; i += NTHR) CW[i] = i < 4 * DL ? P.conv_w[i] : P.conv_b[i - 4 * DL];
    __syncthreads();
    bf16x8 Wa[4][2], Wx[4][2];
#pragma unroll
    for (int jt = 0; jt < 4; ++jt)
#pragma unroll
        for (int ks = 0; ks < 2; ++ks) {
            Wa[jt][ks] = *(const bf16x8*)(P.LRUW + ((size_t)(0 * 8 + hb) * 64 + 16 * jt + r) * 64 + 32 * ks + 8 * g);
            Wx[jt][ks] = *(const bf16x8*)(P.LRUW + ((size_t)(1 * 8 + hb) * 64 + 16 * jt + r) * 64 + 32 * ks + 8 * g);
        }
    float ba[4], bx[4], sp8[4], St[4], At[4];
#pragma unroll
    for (int jt = 0; jt < 4; ++jt) { const int ch = hb * 64 + 16 * jt + r; ba[jt] = P.ba[ch]; bx[jt] = P.bx[ch];
        const float nl = -P.lam[ch]; sp8[jt] = 8.f * (nl > 20.f ? nl : log1pf(expf(nl)));
        St[jt] = FINAL ? ((const float*)(P.ws + WS_LRU))[2 * B * NCH * DL + (b * NCH + n) * DL + ch] : 0.f; At[jt] = 1.f; }
#pragma unroll 1
    for (int tt = 0; tt < 8; ++tt) {
        const int c = 16 * tt + r;
        bf16 glv[4][4];
        if (FINAL) {
#pragma unroll
            for (int jt = 0; jt < 4; ++jt)
#pragma unroll
                for (int q = 0; q < 4; ++q) glv[jt][q] = P.PROJ[(size_t)(t0 + 16 * tt + 4 * g + q) * INC + DL + hb * 64 + 16 * jt + r];
        }
        bf16x8 fr[2];
#pragma unroll
        for (int ks = 0; ks < 2; ++ks) {
            const int chA = hb * 64 + 32 * ks + 8 * g;
            float xc[8];
            { const f32x4 b0 = *(const LAS f32x4*)(CW + 4 * DL + chA), b1 = *(const LAS f32x4*)(CW + 4 * DL + chA + 4);
              xc[0] = b0[0]; xc[1] = b0[1]; xc[2] = b0[2]; xc[3] = b0[3]; xc[4] = b1[0]; xc[5] = b1[1]; xc[6] = b1[2]; xc[7] = b1[3]; }
#pragma unroll
            for (int k = 0; k < 4; ++k) {
                const int sp = n * CH + c - 3 + k;
                v4u xv = {0u, 0u, 0u, 0u};
                if (sp >= 0) xv = *(const v4u*)(P.PROJ + (size_t)(t0 + c - 3 + k) * INC + chA);
                const f32x4 w0 = *(const LAS f32x4*)(CW + k * DL + chA), w1 = *(const LAS f32x4*)(CW + k * DL + chA + 4);
                xc[0] += w0[0] * bflo(xv.x); xc[1] += w0[1] * bfhi(xv.x); xc[2] += w0[2] * bflo(xv.y); xc[3] += w0[3] * bfhi(xv.y);
                xc[4] += w1[0] * bflo(xv.z); xc[5] += w1[1] * bfhi(xv.z); xc[6] += w1[2] * bflo(xv.w); xc[7] += w1[3] * bfhi(xv.w);
            }
            v4u pk; pk.x = cvt_pk_bf16(xc[0], xc[1]); pk.y = cvt_pk_bf16(xc[2], xc[3]); pk.z = cvt_pk_bf16(xc[4], xc[5]); pk.w = cvt_pk_bf16(xc[6], xc[7]);
            fr[ks] = __builtin_bit_cast(bf16x8, pk);
            *(LAS f32x4*)(XC + r * 68 + 32 * ks + 8 * g) = (f32x4){xc[0], xc[1], xc[2], xc[3]};
            *(LAS f32x4*)(XC + r * 68 + 32 * ks + 8 * g + 4) = (f32x4){xc[4], xc[5], xc[6], xc[7]};
        }
        wave_lds_fence();
#pragma unroll
        for (int jt = 0; jt < 4; ++jt) {
            f32x4 aa = {0.f, 0.f, 0.f, 0.f}, ax = {0.f, 0.f, 0.f, 0.f};
#pragma unroll
            for (int ks = 0; ks < 2; ++ks) { aa = __builtin_amdgcn_mfma_f32_16x16x32_bf16(fr[ks], Wa[jt][ks], aa, 0, 0, 0); ax = __builtin_amdgcn_mfma_f32_16x16x32_bf16(fr[ks], Wx[jt][ks], ax, 0, 0, 0); }
            float av[4], uv[4]; float Al = 1.f, Hl = 0.f;
#pragma unroll
            for (int q = 0; q < 4; ++q) {
                const float xcv = XC[(4 * g + q) * 68 + 16 * jt + r];
                const float rg = fast_sigmoid(aa[q] + ba[jt]), ig = fast_sigmoid(ax[q] + bx[jt]);
                const float la = -rg * sp8[jt];
                const float a = __builtin_amdgcn_exp2f(la * 1.4426950408889634f);
                const float x2 = 2.f * la;
                const float em = x2 > -0.25f ? -x2 * (1.f + x2 * (0.5f + x2 * (0.16666667f + x2 * (0.041666668f + x2 * (0.0083333333f + x2 * 0.0013888889f))))) : 1.f - a * a;
                const float u = sqrtf(em) * (ig * xcv);
                av[q] = a; uv[q] = u; Hl = a * Hl + u; Al *= a;
            }
            float Ap = 1.f, Hp = 0.f;
#pragma unroll
            for (int k = 3; k >= 1; --k) {
                const float Ao = __shfl(Al, lane - 16 * k), Ho = __shfl(Hl, lane - 16 * k);
                if (g >= k) { Hp = Ao * Hp + Ho; Ap *= Ao; }
            }
            float h = Ap * St[jt] + Hp;
            if (FINAL) {
#pragma unroll
                for (int q = 0; q < 4; ++q) {
                    h = av[q] * h + uv[q];
                    const size_t tok = (size_t)(t0 + 16 * tt + 4 * g + q);
                    const float gl = bf2f(glv[jt][q]);
                    P.MIX[tok * D + hb * 64 + 16 * jt + r] = f2bf(h * gelu_tanh_fast(gl));
                }
            } else {
                h = Al * h + Hl;
            }
            const float Atile = __shfl(Ap * Al, (lane & 15) + 48);
            St[jt] = __shfl(h, (lane & 15) + 48);
            At[jt] *= Atile;
        }
        wave_lds_fence();
    }
    if (!FINAL && g == 0) {
#pragma unroll
        for (int jt = 0; jt < 4; ++jt) { const int ch = hb * 64 + 16 * jt + r; float* AE = (float*)(P.ws + WS_LRU);
            AE[(b * NCH + n) * DL + ch] = At[jt]; AE[B * NCH * DL + (b * NCH + n) * DL + ch] = St[jt]; }
    }
}

__device__ __forceinline__ void p2_mix_summaries(Frame& F, const Ptrs& P) {
    const int w = F.wave;
#pragma unroll 1
    for (int u = F.vcu; u < B * NCH; u += F.G) {
        const int b = u / NCH, n = u % NCH; const int t0 = b * S + n * CH;
        __syncthreads();
        { int lane0 = F.lane; asm volatile("" : "+v"(lane0)); lru_chunk<false>(F, P, b, n, lane0); }
        KVRaw raw; { int tid0 = F.tid; asm volatile("" : "+v"(tid0)); kv_issue(raw, tid0, P.PROJ + (size_t)t0 * INC, 0); }
#pragma unroll 1
        for (int h = 0; h < NH; ++h) {
            int lane = F.lane; asm volatile("" : "+v"(lane));
            int tidv = F.tid; asm volatile("" : "+v"(tidv));
            const int r = lane & 15, g = lane >> 4;
            unsigned trb[8][2];
#pragma unroll
            for (int c = 0; c < 8; ++c) { trb[c][0] = tr_read_addr_16(lane, c, 0, 0); trb[c][1] = tr_read_addr_16(lane, c, 0, 1); }
            const float lg2 = __builtin_amdgcn_logf(1.f - __builtin_amdgcn_exp2f(-5.f - (float)h));
            __syncthreads();
            kv_store<true>(F, raw, tidv, n * CH, lg2);
            if (h + 1 < NH) kv_issue(raw, tidv, P.PROJ + (size_t)t0 * INC, h + 1);
            __syncthreads();
            LAS unsigned char* Kimg = F.lds + MIX_K_OFF; LAS unsigned char* Vimg = F.lds + MIX_V_OFF;
            f32x4 acc[8];
#pragma unroll
            for (int dt = 0; dt < 8; ++dt) acc[dt] = (f32x4){0.f, 0.f, 0.f, 0.f};
            const unsigned ta0 = tr_read_addr_16(lane, w, 0, 0), ta1 = tr_read_addr_16(lane, w, 0, 1);
#pragma unroll 1
            for (int ks = 0; ks < 4; ++ks) {
                const bf16x8 Af = tr_frag2(Vimg + ta0 + 8192 * ks, Vimg + ta1 + 8192 * ks);
#pragma unroll
                for (int dt = 0; dt < 8; ++dt) { const bf16x8 Bf = tr_frag2(Kimg + trb[dt][0] + 8192 * ks, Kimg + trb[dt][1] + 8192 * ks); acc[dt] = __builtin_amdgcn_mfma_f32_16x16x32_bf16(Af, Bf, acc[dt], 0, 0, 0); }
            }
            float* KV = P.out + ((size_t)((b * NH + h) * NCH + n)) * (HD * HD);
#pragma unroll
            for (int dt = 0; dt < 8; ++dt)
#pragma unroll
                for (int q = 0; q < 4; ++q) KV[(16 * w + 4 * g + q) * HD + 16 * dt + r] = acc[dt][q];
        }
    }
}
__device__ __forceinline__ void p3_scans(Frame& F, const Ptrs& P) {
    const int idx = F.vcu * NTHR + F.tid;
    for (int id = idx; id < B * NH * (HD * HD / 4); id += F.G * NTHR) {
        const int bh = id >> 12, el = (id & 4095) * 4, h = bh & 3;
        const float lg2 = __builtin_amdgcn_logf(1.f - __builtin_amdgcn_exp2f(-5.f - (float)h));
        const float dec = __builtin_amdgcn_exp2f(128.f * lg2);
        const float* KV = P.out + (size_t)bh * NCH * (HD * HD) + el;
        bf16* PV = (bf16*)(P.out + (size_t)B * NH * NCH * (HD * HD)) + (size_t)bh * NCH * (HD * HD) + el;
        f32x4 st = {0.f, 0.f, 0.f, 0.f};
#pragma unroll 8
        for (int n = 0; n < NCH; ++n) {
            const f32x4 kv = *(const f32x4*)(KV + (size_t)n * (HD * HD));
            v2u w; w.x = cvt_pk_bf16(st[0], st[1]); w.y = cvt_pk_bf16(st[2], st[3]);
            *(v2u*)(PV + (size_t)n * (HD * HD)) = w;
            st = st * dec + kv;
        }
    }
    if (idx < B * DL) {
        const int b = idx / DL, ch = idx % DL; float* AE = (float*)(P.ws + WS_LRU);
        float carry = 0.f;
        for (int n = 0; n < NCH; ++n) {
            const float a = AE[(b * NCH + n) * DL + ch], e = AE[B * NCH * DL + (b * NCH + n) * DL + ch];
            AE[2 * B * NCH * DL + (b * NCH + n) * DL + ch] = carry;
            carry = a * carry + e;
        }
    }
}
__device__ __forceinline__ void p4_mix_outputs(Frame& F, const Ptrs& P) {
    const int w = F.wave;
#pragma unroll 1
    for (int u = F.vcu; u < B * NCH; u += F.G) {
        const int b = u / NCH, n = u % NCH; const int t0 = b * S + n * CH;
        __syncthreads();
        { int lane0 = F.lane; asm volatile("" : "+v"(lane0)); lru_chunk<true>(F, P, b, n, lane0); }
        KVRaw raw; v4u qraw[2][2];
        { int tid0 = F.tid, lane0 = F.lane; asm volatile("" : "+v"(tid0), "+v"(lane0)); kv_issue(raw, tid0, P.PROJ + (size_t)t0 * INC, 0);
          const bf16* qrow = P.PROJ + (size_t)(t0 + 16 * w + (lane0 & 15)) * INC + 1024 + 8 * (lane0 >> 4);
#pragma unroll
          for (int ks = 0; ks < 2; ++ks) { qraw[ks][0] = *(const v4u*)(qrow + 32 * ks); qraw[ks][1] = *(const v4u*)(qrow + 32 * ks + 64); } }
#pragma unroll 1
        for (int h = 0; h < NH; ++h) {
            int lane = F.lane; asm volatile("" : "+v"(lane));
            int tidv = F.tid; asm volatile("" : "+v"(tidv));
            const int r = lane & 15, g = lane >> 4;
            unsigned trb[8][2], rrb[4];
#pragma unroll
            for (int c = 0; c < 8; ++c) { trb[c][0] = tr_read_addr_16(lane, c, 0, 0); trb[c][1] = tr_read_addr_16(lane, c, 0, 1); }
#pragma unroll
            for (int ks = 0; ks < 4; ++ks) rrb[ks] = row_read_addr_16(lane, 0, ks);
            const float lg2 = __builtin_amdgcn_logf(1.f - __builtin_amdgcn_exp2f(-5.f - (float)h));
            __syncthreads();
            kv_store<false>(F, raw, tidv, n * CH, lg2);
            bf16x8 Qf[4];
            {
                const float pos = (float)(n * CH + 16 * w + r);
#pragma unroll
                for (int ks = 0; ks < 2; ++ks) {
                    const v4u q1 = qraw[ks][0], q2 = qraw[ks][1];
                    v4u o1, o2;
#pragma unroll
                    for (int q = 0; q < 4; ++q) {
                        const float i0 = __builtin_amdgcn_exp2f(-(float)(32 * ks + 8 * g + 2 * q) * LOG2_ROPE_OVER_64), i1 = __builtin_amdgcn_exp2f(-(float)(32 * ks + 8 * g + 2 * q + 1) * LOG2_ROPE_OVER_64);
                        float sn0, cs0, sn1, cs1; sincos_rev(pos * i0, sn0, cs0); sincos_rev(pos * i1, sn1, cs1);
                        const float a0 = bflo(q1[q]), a1 = bfhi(q1[q]), b0 = bflo(q2[q]), b1 = bfhi(q2[q]);
                        o1[q] = cvt_pk_bf16(a0 * cs0 - b0 * sn0, a1 * cs1 - b1 * sn1);
                        o2[q] = cvt_pk_bf16(a0 * sn0 + b0 * cs0, a1 * sn1 + b1 * cs1);
                    }
                    Qf[ks] = __builtin_bit_cast(bf16x8, o1); Qf[ks + 2] = __builtin_bit_cast(bf16x8, o2);
                }
            }
            __syncthreads();
            LAS unsigned char* Kimg = F.lds + MIX_K_OFF; LAS unsigned char* Vimg = F.lds + MIX_V_OFF; LAS unsigned char* Sst = F.lds + MIX_S_OFF + w * MIX_S_WAVE;
            const bf16* PV = (const bf16*)(P.out + (size_t)B * NH * NCH * (HD * HD)) + ((size_t)((b * NH + h) * NCH + n)) * (HD * HD);
            bf16 grv[8][4];
#pragma unroll
            for (int et = 0; et < 8; ++et)
#pragma unroll
                for (int q = 0; q < 4; ++q) grv[et][q] = P.PROJ[(size_t)(t0 + 16 * w + 4 * g + q) * INC + 2560 + h * HD + 16 * et + r];
            bf16x8 Pf[4][4];
#pragma unroll
            for (int et = 0; et < 4; ++et)
#pragma unroll
                for (int ks = 0; ks < 4; ++ks) Pf[et][ks] = *(const bf16x8*)(PV + (size_t)(16 * et + r) * HD + 32 * ks + 8 * g);
            if (h + 1 < NH) {
                kv_issue(raw, tidv, P.PROJ + (size_t)t0 * INC, h + 1);
                const bf16* qrow = P.PROJ + (size_t)(t0 + 16 * w + r) * INC + 1024 + (h + 1) * HD + 8 * g;
#pragma unroll
                for (int ks = 0; ks < 2; ++ks) { qraw[ks][0] = *(const v4u*)(qrow + 32 * ks); qraw[ks][1] = *(const v4u*)(qrow + 32 * ks + 64); }
            }
#pragma unroll 1
            for (int mt = 0; mt <= w; ++mt) {
                f32x4 sa = {0.f, 0.f, 0.f, 0.f};
#pragma unroll
                for (int ks = 0; ks < 4; ++ks) { const bf16x8 Kf = *(const LAS bf16x8*)(Kimg + rrb[ks] + 4096 * mt); sa = __builtin_amdgcn_mfma_f32_16x16x32_bf16(Qf[ks], Kf, sa, 0, 0, 0); }
#pragma unroll
                for (int q = 0; q < 4; ++q) {
                    const int dlt = (16 * w + 4 * g + q) - (16 * mt + r);
                    const float v = dlt >= 0 ? sa[q] * __builtin_amdgcn_exp2f((float)dlt * lg2) : 0.f;
                    *(LAS bf16*)(Sst + (4 * g + q) * MIX_S_STRIDE + (16 * mt + r) * 2) = f2bf(v);
                }
            }
            if ((w & 1) == 0) {
#pragma unroll
                for (int q = 0; q < 4; ++q) *(LAS bf16*)(Sst + (4 * g + q) * MIX_S_STRIDE + (16 * (w + 1) + r) * 2) = 0;
            }
            wave_lds_fence();
            f32x4 acc[8];
            float rsc[4];
#pragma unroll
            for (int q = 0; q < 4; ++q) rsc[q] = __builtin_amdgcn_exp2f((float)(16 * w + 4 * g + q + 1) * lg2);
#pragma unroll
            for (int hf = 0; hf < 2; ++hf) {
                if (hf == 1) {
#pragma unroll
                    for (int et = 0; et < 4; ++et)
#pragma unroll
                        for (int ks = 0; ks < 4; ++ks) Pf[et][ks] = *(const bf16x8*)(PV + (size_t)(16 * (et + 4) + r) * HD + 32 * ks + 8 * g);
                }
#pragma unroll
                for (int et = 0; et < 4; ++et) {
                    f32x4 a = {0.f, 0.f, 0.f, 0.f};
#pragma unroll
                    for (int ks = 0; ks < 4; ++ks) a = __builtin_amdgcn_mfma_f32_16x16x32_bf16(Qf[ks], Pf[et][ks], a, 0, 0, 0);
#pragma unroll
                    for (int q = 0; q < 4; ++q) a[q] *= rsc[q];
                    acc[4 * hf + et] = a;
                }
            }
#pragma unroll 1
            for (int ks = 0; ks <= (w >> 1); ++ks) {
                const bf16x8 Sf = *(const LAS bf16x8*)(Sst + r * MIX_S_STRIDE + (32 * ks + 8 * g) * 2);
#pragma unroll
                for (int et = 0; et < 8; ++et) { const bf16x8 Vf = tr_frag2(Vimg + trb[et][0] + 8192 * ks, Vimg + trb[et][1] + 8192 * ks); acc[et] = __builtin_amdgcn_mfma_f32_16x16x32_bf16(Sf, Vf, acc[et], 0, 0, 0); }
            }
            float mu[4], rs[4];
#pragma unroll
            for (int q = 0; q < 4; ++q) {
                float s = 0.f;
#pragma unroll
                for (int et = 0; et < 8; ++et) s += acc[et][q];
                s += __shfl_xor(s, 1); s += __shfl_xor(s, 2); s += __shfl_xor(s, 4); s += __shfl_xor(s, 8);
                const float m = s * (1.f / 128.f); float v = 0.f;
#pragma unroll
                for (int et = 0; et < 8; ++et) { const float d = acc[et][q] - m; v += d * d; }
                v += __shfl_xor(v, 1); v += __shfl_xor(v, 2); v += __shfl_xor(v, 4); v += __shfl_xor(v, 8);
                mu[q] = m; rs[q] = 1.0f / sqrtf(v * (1.f / 128.f) + EPS);
            }
#pragma unroll
            for (int et = 0; et < 8; ++et)
#pragma unroll
                for (int q = 0; q < 4; ++q) {
                    const size_t tok = (size_t)(t0 + 16 * w + 4 * g + q);
                    const float gr = bf2f(grv[et][q]);
                    P.MIX[tok * D + DL + h * HD + 16 * et + r] = f2bf(gr * fast_sigmoid(gr) * (acc[et][q] - mu[q]) * rs[q]);
                }
        }
    }
}
__global__ void __launch_bounds__(NTHR, 2) mk_fwd(Args args) {
    extern __shared__ __attribute__((aligned(16))) unsigned char lds_raw[];
    Frame F;
    F.lds = (LAS unsigned char*)lds_raw;
    F.MISC = (volatile LAS unsigned*)(F.lds + LDSCTL_OFF);
    F.tid = threadIdx.x; F.lane = F.tid & 63; F.wave = __builtin_amdgcn_readfirstlane(F.tid >> 6);
    F.G = gridDim.x; { const int bx = blockIdx.x; F.vcu = (F.G % 8 == 0) ? (bx % 8) * (F.G / 8) + bx / 8 : bx; }
    F.ctl = (gu32*)(args.ws + WS_CTL);
    Ptrs P; make_ptrs(P, args);
    for (int u = F.tid; u < 256; u += NTHR) ((LAS unsigned*)(F.lds + LDSCTL_OFF))[u] = 0u;
    __syncthreads();
    XcdBarrier bar = xcd_barrier_post((unsigned*)(F.ctl + CW_BAR) + args.ph_hi * XCD_BAR_WORDS, F.MISC + 8);
    const int lo = args.ph_lo, hi = args.ph_hi;
#define IN(k) (lo <= (k) && (k) < hi)
#define SEAM(k) do { if (IN(k) && IN((k) + 1)) xcd_barrier(bar); } while (0)
    if (IN(0)) { p0_prologue(F, P); }
    SEAM(0);
    if (IN(1)) {
        pg8::PlainSched S; S.init(P.XB, P.W_IN, T, INC, D, F.G, (int)blockIdx.x);
        pg8::EpiRowScaleBf16 E{P.PROJ, INC, P.rstd0};
        pg8::gemm_phase(F.lds + RING_OFF, S, E);
    }
    SEAM(1);
    if (IN(2)) p2_mix_summaries(F, P);
    SEAM(2);
    if (IN(3)) p3_scans(F, P);
    SEAM(3);
    if (IN(4)) p4_mix_outputs(F, P);
    SEAM(4);
    if (IN(5)) {
        pg8::PlainSched S; S.init(P.MIX, P.W_OUT, T, D, D, F.G, (int)blockIdx.x);
        pg8::EpiPlainBf16 E{P.D1, D};
        pg8::gemm_phase(F.lds + RING_OFF, S, E);
    }
    SEAM(5);
    if (IN(6)) p6_route(F, P);
    SEAM(6);
    if (IN(7)) p7_lists(F, P);
    SEAM(7);
    if (IN(8)) moe_phase<0>(F, P, lo == 8);
    SEAM(8);
    if (IN(9)) moe_phase<1>(F, P, lo == 9);
    SEAM(9);
    if (IN(10)) p10_combine(F, P);
    SEAM(10);
    if (IN(11)) {
        pg8::PlainSched S; S.init(P.X2B, P.W_PG, T, D, D, F.G, (int)blockIdx.x);
        pg8::EpiGateBf16 E{P.GATE, D, P.rstd2, P.b_pg};
        pg8::gemm_phase(F.lds + RING_OFF, S, E);
    }
    if (IN(12)) {
        pg8::PlainSched S; S.init(P.PB, P.W_PP, T, D, PLE, F.G, (int)blockIdx.x);
        pg8::EpiPlainBf16 E{P.PP, D};
        pg8::gemm_phase(F.lds + RING_OFF, S, E);
    }
    SEAM(12);
    if (IN(13)) p13_final(F, P);
#undef IN
#undef SEAM
}

static int mk_grid = 0;
static void mk_launch(void* const* d_in, void* d_out, void* d_ws, int lo, int hi, hipStream_t stream) {
    if (mk_grid == 0) {
        int dev = 0, cus = 0;
        if (hipGetDevice(&dev) != hipSuccess || hipDeviceGetAttribute(&cus, hipDeviceAttributeMultiprocessorCount, dev) != hipSuccess) { mk_grid = -1; return; }
        if (hipFuncSetAttribute((const void*)mk_fwd, hipFuncAttributeMaxDynamicSharedMemorySize, LDS_BYTES) != hipSuccess) { fprintf(stderr, "mk: hipFuncSetAttribute failed\n"); mk_grid = -1; return; }
        int per_cu = 0;
        if (hipOccupancyMaxActiveBlocksPerMultiprocessor(&per_cu, (const void*)mk_fwd, NTHR, LDS_BYTES) != hipSuccess || per_cu < 1) { fprintf(stderr, "mk: occupancy query says %d\n", per_cu); (void)hipGetLastError(); }
        mk_grid = cus;
    }
    if (mk_grid < 0) return;
    Args a; memset(&a, 0, sizeof a);
    for (int i = 0; i < 25; ++i) a.in[i] = (const float*)d_in[i];
    a.out = (float*)d_out; a.ws = (unsigned char*)d_ws; a.ph_lo = lo; a.ph_hi = hi;
    hipLaunchKernelGGL(mk_fwd, dim3(mk_grid), dim3(NTHR), LDS_BYTES, stream, a);
}
extern "C" void kernel_launch(void* const* d_in, const int* in_sizes, int n_in, void* d_out, int out_size, void* d_ws, size_t ws_size, hipStream_t stream) {
    if (n_in != 25 || ws_size < WS_END || out_size != T * D) { fprintf(stderr, "kernel_launch: n_in %d, workspace %zu (need %zu), out_size %d: nothing launched\n", n_in, ws_size, (size_t)WS_END, out_size); return; }
    (void)hipMemsetAsync((unsigned char*)d_ws + WS_CTL, 0, 1 * MiB, stream);
    mk_launch(d_in, d_out, d_ws, 0, 14, stream);
}
```

```cpp
#include <hip/hip_runtime.h>
#include <stdint.h>
#include <stdio.h>
#include <string.h>

typedef unsigned short bf16;
namespace cfg {
constexpr int D = 1024, B = 8, S = 4096, T = B * S, PLE = 256, DL = 512, DR = 512, NH = 4, HD = 128, INC = 3072;
constexpr int NE = 64, DE = 512, NG = 8, EPG = 8, CH = 128, NCH = S / CH;
constexpr float EPS = 1e-6f;
constexpr float MOE_SX = 8.f, MOE_SW1 = 64.f, MOE_SA = 8.f, MOE_SW2 = 32.f;
constexpr float PLE_SX2 = 8.f, PLE_SWG = 64.f;
constexpr size_t MiB = 1u << 20;
constexpr size_t WS_CTL = 0;
constexpr size_t WS_RSTD0 = 1 * MiB, WS_RSTD1 = WS_RSTD0 + 128 * 1024, WS_RSTD2 = WS_RSTD1 + 128 * 1024;
constexpr size_t WS_EID = 2 * MiB, WS_EW = WS_EID + 256 * 1024, WS_LIST = WS_EW + 256 * 1024, WS_CNT = WS_LIST + 256 * 1024;
constexpr size_t WS_LOGITS = 3 * MiB;
constexpr size_t WS_LRU = 13 * MiB;
constexpr size_t WS_WIN = 16 * MiB, WS_WOUT = 22 * MiB, WS_WPG = 24 * MiB, WS_WPP = 26 * MiB, WS_WRT = 26 * MiB + 512 * 1024, WS_LRUW = 27 * MiB;
constexpr size_t WS_W13 = 28 * MiB, WS_W2 = 156 * MiB, WS_PB = 220 * MiB;
constexpr size_t WS_R64 = 236 * MiB;
constexpr size_t WS_PROJ = 300 * MiB;
constexpr size_t WS_D1 = 300 * MiB, WS_X1B = 364 * MiB, WS_Y = 428 * MiB, WS_PP = 428 * MiB;
constexpr size_t WS_END = 556 * MiB;
}
using namespace cfg;

__device__ __forceinline__ float bf2f(bf16 v) { return __uint_as_float((unsigned)v << 16); }
__device__ __forceinline__ bf16 f2bf(float f) { unsigned u = __float_as_uint(f); return (bf16)((u + 0x7fffu + ((u >> 16) & 1u)) >> 16); }
__device__ __forceinline__ float ldv(const float* p, size_t i) { return p[i]; }
__device__ __forceinline__ float ldv(const bf16* p, size_t i) { return bf2f(p[i]); }
__device__ __forceinline__ void stv(float* p, size_t i, float v) { p[i] = v; }
__device__ __forceinline__ void stv(bf16* p, size_t i, float v) { p[i] = f2bf(v); }

#define GAS __attribute__((address_space(1)))
#define LAS __attribute__((address_space(3)))
typedef unsigned v4u __attribute__((ext_vector_type(4)));
typedef unsigned v2u __attribute__((ext_vector_type(2)));
typedef float f32x4 __attribute__((ext_vector_type(4)));
typedef float f32x2 __attribute__((ext_vector_type(2)));
typedef short bf16x8 __attribute__((ext_vector_type(8)));
typedef short bf16x4 __attribute__((ext_vector_type(4)));
typedef GAS unsigned gu32;
#define RLX_AGENT __ATOMIC_RELAXED, __HIP_MEMORY_SCOPE_AGENT
#define LDS_WAIT() asm volatile("s_waitcnt lgkmcnt(0)" ::: "memory")
#define VM_WAIT() asm volatile("s_waitcnt vmcnt(0)" ::: "memory")
__device__ __forceinline__ unsigned pk2(float lo, float hi) { return (unsigned)f2bf(lo) | ((unsigned)f2bf(hi) << 16); }
typedef __bf16 hwbf16x2 __attribute__((ext_vector_type(2)));
__device__ __forceinline__ unsigned cvt_pk_bf16(float lo, float hi) { f32x2 v = {lo, hi}; hwbf16x2 b = __builtin_convertvector(v, hwbf16x2); return __builtin_bit_cast(unsigned, b); }
__device__ __forceinline__ float bflo(unsigned w) { return __uint_as_float(w << 16); }
__device__ __forceinline__ float bfhi(unsigned w) { return __uint_as_float(w & 0xffff0000u); }
__device__ __forceinline__ float fast_sigmoid(float x) { return __builtin_amdgcn_rcpf(1.f + __builtin_amdgcn_exp2f(-1.4426950408889634f * x)); }

#define XB_TMO      128
#define XB_XCNT(j)  (256  + 64 * (j))
#define XB_XSUB(j)  (1280 + 64 * (j))
#define XB_XGEN(j)  (2304 + 64 * (j))
#define XB_TOP      3328
#define XB_TOPGEN   3392
#define XCD_BAR_WORDS 3456
#define XB_SPIN_CAP (1u << 18)
__device__ __forceinline__ unsigned xb_ld(unsigned* p)              { return __hip_atomic_load(p, __ATOMIC_RELAXED, __HIP_MEMORY_SCOPE_AGENT); }
__device__ __forceinline__ unsigned xb_add(unsigned* p, unsigned v) { return __hip_atomic_fetch_add(p, v, __ATOMIC_RELAXED, __HIP_MEMORY_SCOPE_AGENT); }
__device__ __forceinline__ unsigned xb_xcc_id() { return (unsigned)__builtin_amdgcn_s_getreg((3 << 11) | 20) & 0xFu; }
#define XB_SPIN(cond, bar) do { unsigned _sp = 0; while (cond) { __builtin_amdgcn_s_sleep(1); \
    if ((++_sp & 255u) == 0u) { if (xb_ld(&(bar)[XB_TMO])) break; if (_sp > XB_SPIN_CAP) { atomicAdd(&(bar)[XB_TMO], 1u); break; } } } } while (0)
struct XcdBarrier { unsigned* bar; unsigned x; volatile LAS unsigned* st; };
__device__ __forceinline__ XcdBarrier xcd_barrier_post(unsigned* bar, volatile LAS unsigned* st) {
    XcdBarrier b; b.bar = bar; b.x = xb_xcc_id(); b.st = st;
    if (threadIdx.x == 0) (void)xb_add(&bar[XB_XCNT(b.x)], 1u);
    return b;
}
__device__ __forceinline__ void xcd_barrier_complete(unsigned* bar, unsigned x, unsigned& nloc, unsigned& nx) {
    const unsigned G = gridDim.x * gridDim.y * gridDim.z;
    unsigned sum, cnt, mine, sp = 0u;
    for (;;) {
        sum = 0u; cnt = 0u; mine = 0u;
#pragma unroll
        for (unsigned j = 0; j < 16; ++j) { const unsigned c = xb_ld(&bar[XB_XCNT(j)]); sum += c; cnt += (c > 0u) ? 1u : 0u; mine = (j == x) ? c : mine; }
        if (sum == G) break;
        __builtin_amdgcn_s_sleep(1);
        if ((++sp & 255u) == 0u) { if (xb_ld(&bar[XB_TMO])) break; if (sp > XB_SPIN_CAP) { atomicAdd(&bar[XB_TMO], 1u); break; } }
    }
    nloc = mine > 0u ? mine : 1u; nx = cnt > 0u ? cnt : 1u;
}
__device__ __forceinline__ void xcd_barrier(const XcdBarrier& b) {
    asm volatile("s_waitcnt vmcnt(0)" ::: "memory");
    __syncthreads();
    if (threadIdx.x == 0) {
        unsigned* bar = b.bar;
        __builtin_amdgcn_s_waitcnt(0);
        unsigned nloc = b.st[0], nx = b.st[1];
        if (nloc == 0u) { xcd_barrier_complete(bar, b.x, nloc, nx); b.st[0] = nloc; b.st[1] = nx; }
        const unsigned old = xb_add(&bar[XB_XSUB(b.x)], 1u);
        const unsigned gen = old / nloc;
        if (old + 1u == (gen + 1u) * nloc) {
            __builtin_amdgcn_fence(__ATOMIC_RELEASE, "agent");
            asm volatile("s_waitcnt vmcnt(0)" ::: "memory");
            const unsigned og = xb_add(&bar[XB_TOP], 1u);
            const unsigned tg = og / nx;
            if (og + 1u == (tg + 1u) * nx) xb_add(&bar[XB_TOPGEN], 1u);
            else XB_SPIN(xb_ld(&bar[XB_TOPGEN]) == tg, bar);
            __builtin_amdgcn_fence(__ATOMIC_ACQUIRE, "agent");
            xb_add(&bar[XB_XGEN(b.x)], 1u);
            asm volatile("s_waitcnt vmcnt(0)" ::: "memory");
        } else {
            XB_SPIN(xb_ld(&bar[XB_XGEN(b.x)]) == gen, bar);
            __builtin_amdgcn_fence(__ATOMIC_ACQUIRE, "agent");
            asm volatile("s_waitcnt vmcnt(0)" ::: "memory");
        }
    }
    __syncthreads();
}

constexpr int NWAVES = 8, NTHR = NWAVES * 64;
constexpr int RING_OFF = 0, RING_BYTES = 131072;
constexpr int LDSCTL_OFF = RING_BYTES;
constexpr int UTAB_OFF = LDSCTL_OFF + 1024;
constexpr int MAXU = 6;
constexpr int UTABF_OFF = UTAB_OFF + MAXU * 1024;
constexpr int SCHED_OFF = UTABF_OFF + MAXU * 1024;
constexpr int LDS_BYTES = SCHED_OFF + 2048;
static_assert(LDS_BYTES <= 160 * 1024 && LDS_BYTES > 80 * 1024, "LDS map");
constexpr int CW_TMO = 0, CW_BAR = 4096;

namespace pg8 {
constexpr int BM = 256, BK = 64, HALF = 128, HTB = HALF * BK * 2, STAGE_BYTES = 8 * HTB;
__host__ __device__ __forceinline__ int lds_byte(int r, int c) { const int st = (r >> 4) * 2 + (c >> 5), rr = r & 15, cc = c & 31, ob = rr * 64 + cc * 2; return st * 1024 + (ob ^ (((ob >> 9) & 1) << 5)); }
__host__ __device__ __forceinline__ void stage_rc(int b, int& R, int& C) { const int st = b / 1024, sb = b % 1024, swz = sb ^ (((sb >> 9) & 1) << 5); R = (st >> 1) * 16 + swz / 64; C = (st & 1) * 32 + (swz % 64) / 2; }
__host__ __device__ __forceinline__ int perm32(int rho) { const int n = rho >> 4, i = rho & 15; return 8 * (i >> 2) + 4 * n + (i & 3); }

struct Unit { int pm, pn, e, rows, slot0, ui; };

struct PlainSched {
    static constexpr bool GATHER = false;
    const bf16* A; const bf16* Bt; int K; int nM, nN, nwg, G, c;
    __device__ void init(const bf16* A_, const bf16* Bt_, int M, int N, int K_, int G_, int c_) { A = A_; Bt = Bt_; K = K_; nM = M / BM; nN = N / BM; nwg = nM * nN; G = G_; c = c_; }
    __device__ __forceinline__ bool next(int i, Unit& u) const {
        const long L = (long)i * G + c; if (L >= nwg) return false;
        int wgid = (int)L; { const int q = nwg / 8, r = nwg % 8, xcd = wgid % 8, off = wgid / 8; wgid = (xcd < r ? xcd * (q + 1) : r * (q + 1) + (xcd - r) * q) + off; }
        const int nig = 8 * nN, gid = wgid / nig, fm = gid * 8, gsz = (nM - fm) < 8 ? (nM - fm) : 8;
        u.pm = fm + ((wgid % nig) % gsz); u.pn = (wgid % nig) / gsz; u.e = 0; u.rows = 256; u.slot0 = 0; u.ui = i; return true;
    }
    __device__ __forceinline__ const char* a_base(const Unit& u) const { return (const char*)A + (size_t)u.pm * (size_t)(BM * 2) * K; }
    __device__ __forceinline__ const char* b_base(const Unit& u) const { return (const char*)Bt + (size_t)u.pn * (size_t)(BM * 2) * K; }
    __device__ __forceinline__ unsigned a_rowoff(const Unit&, int r) const { return (unsigned)r * (unsigned)K * 2u; }
};

typedef long i64x2 __attribute__((ext_vector_type(2)));
template <class Epi, class Sched, bool FP8 = false>
__device__ __forceinline__ void gemm_phase(LAS unsigned char* lds, const Sched& S, const Epi& E) {
    const int tid = threadIdx.x, wid = __builtin_amdgcn_readfirstlane(tid >> 6), lane = tid & 63, wr = wid >> 2, wc = wid & 3, fr = lane & 15, fq = lane >> 4;
    const int K = S.K, nt = K / BK;
    int Rr[2], Cc[2]; unsigned voffB[2];
#pragma unroll
    for (int i = 0; i < 2; ++i) { stage_rc(tid * 16 + i * 8192, Rr[i], Cc[i]); const int Rb = (Rr[i] & ~31) + perm32(Rr[i] & 31); voffB[i] = (unsigned)(Rb * K + Cc[i]) * 2u; }
    const size_t kstep = (size_t)(BK * 2);
    const size_t hstep = (size_t)HALF * K * 2;
    const unsigned ldsw = (unsigned)wid * 1024u;
    const int aoff = lds_byte(wr * 64 + fr, fq * 8), boff = lds_byte(wc * 32 + fr, fq * 8);
#define PG8_SA(b, h) (((b) * 2 + (h)) * HTB)
#define PG8_SB(b, h) ((4 + (b) * 2 + (h)) * HTB)
#define PG8_STAGE(bufoff, gbase, voff) do { _Pragma("unroll") for (int _i = 0; _i < 2; ++_i) \
        __builtin_amdgcn_global_load_lds((const unsigned*)((const char*)(gbase) + (voff)[_i]), (LAS unsigned*)(lds + (bufoff) + ldsw + _i * 8192), 16, 0, 0); } while (0)
#define PG8_LDA(dst, b, h) do { _Pragma("unroll") for (int m = 0; m < 4; ++m) _Pragma("unroll") for (int k = 0; k < 2; ++k) dst[m][k] = *(const LAS bf16x8*)(lds + PG8_SA(b, h) + aoff + m * 2048 + k * 1024); } while (0)
#define PG8_LDB(dst, b, h) do { _Pragma("unroll") for (int n = 0; n < 2; ++n) _Pragma("unroll") for (int k = 0; k < 2; ++k) dst[n][k] = *(const LAS bf16x8*)(lds + PG8_SB(b, h) + boff + n * 2048 + k * 1024); } while (0)
#define PG8_MMA(ai, bj, At, Bt) do { __builtin_amdgcn_s_setprio(1); _Pragma("unroll") for (int m = 0; m < 4; ++m) _Pragma("unroll") for (int n = 0; n < 2; ++n) _Pragma("unroll") for (int k = 0; k < 2; ++k) { \
        if constexpr (FP8) { const i64x2 a8_ = __builtin_bit_cast(i64x2, At[m][k]), b8_ = __builtin_bit_cast(i64x2, Bt[n][k]); \
            acc[ai][bj][m][n] = __builtin_amdgcn_mfma_f32_16x16x32_fp8_fp8(b8_[0], a8_[0], acc[ai][bj][m][n], 0, 0, 0); acc[ai][bj][m][n] = __builtin_amdgcn_mfma_f32_16x16x32_fp8_fp8(b8_[1], a8_[1], acc[ai][bj][m][n], 0, 0, 0); } \
        else acc[ai][bj][m][n] = __builtin_amdgcn_mfma_f32_16x16x32_bf16(Bt[n][k], At[m][k], acc[ai][bj][m][n], 0, 0, 0); } __builtin_amdgcn_s_setprio(0); } while (0)
#define PG8_WAIT_V(n) asm volatile("s_waitcnt vmcnt(" #n ")" ::: "memory")
#define PG8_WAIT_L(n) asm volatile("s_waitcnt lgkmcnt(" #n ")" ::: "memory")
#define PG8_BAR __builtin_amdgcn_s_barrier()
#define PG8_SCHED __builtin_amdgcn_sched_barrier(0)
#define PG8_VOFF(dst, u) do { _Pragma("unroll") for (int _h = 0; _h < 2; ++_h) _Pragma("unroll") for (int _i = 0; _i < 2; ++_i) dst[_h][_i] = S.a_rowoff(u, _h * HALF + Rr[_i]) + (unsigned)Cc[_i] * 2u; } while (0)
    Unit cur, nxt; int ui = 0;
    if (!S.next(0, cur)) return;
    f32x4 acc[2][2][4][2];
#pragma unroll
    for (int a = 0; a < 2; ++a)
#pragma unroll
        for (int b = 0; b < 2; ++b)
#pragma unroll
            for (int m = 0; m < 4; ++m)
#pragma unroll
                for (int n = 0; n < 2; ++n) acc[a][b][m][n] = (f32x4){0.f, 0.f, 0.f, 0.f};
    bf16x8 At[4][2], B0[2][2], B1[2][2];
    unsigned va[2][2], nva[2][2];
    PG8_VOFF(va, cur);
    const char* cA = S.a_base(cur); const char* cB = S.b_base(cur);
    PG8_STAGE(PG8_SB(0, 0), cB, voffB); PG8_STAGE(PG8_SB(0, 1), cB + hstep, voffB); PG8_STAGE(PG8_SA(0, 0), cA, va[0]); PG8_STAGE(PG8_SA(0, 1), cA, va[1]);
    if (wr == 1) PG8_BAR;
    PG8_WAIT_V(2); PG8_BAR;
    PG8_STAGE(PG8_SB(1, 0), cB + kstep, voffB); PG8_STAGE(PG8_SA(1, 0), cA + kstep, va[0]); PG8_STAGE(PG8_SB(1, 1), cB + hstep + kstep, voffB);
    PG8_WAIT_V(6); PG8_BAR;
    for (;;) {
        const bool has_next = S.next(ui + 1, nxt);
        const bool mma0 = cur.rows > 64 * wr, mma1 = cur.rows > HALF + 64 * wr;
        const char* nA = has_next ? S.a_base(nxt) : cA; const char* nB = has_next ? S.b_base(nxt) : cB;
        if (has_next) { PG8_VOFF(nva, nxt); } else {
#pragma unroll
            for (int h = 0; h < 2; ++h)
#pragma unroll
                for (int i = 0; i < 2; ++i) nva[h][i] = va[h][i]; }
        for (int t = 0; t < nt; t += 2) {
            const bool last = (t == nt - 2);
            const char* a1 = cA + (size_t)(t + 1) * kstep;
            const char* a2 = last ? nA : cA + (size_t)(t + 2) * kstep; const char* b2 = last ? nB : cB + (size_t)(t + 2) * kstep;
            const char* a3 = a2 + kstep; const char* b3 = b2 + kstep;
            unsigned v2[2][2];
#pragma unroll
            for (int h = 0; h < 2; ++h)
#pragma unroll
                for (int i = 0; i < 2; ++i) v2[h][i] = last ? nva[h][i] : va[h][i];
            PG8_LDB(B0, 0, 0); PG8_LDB(B1, 0, 1); PG8_SCHED; PG8_LDA(At, 0, 0); PG8_STAGE(PG8_SA(1, 1), a1, va[1]);
            PG8_WAIT_V(8); PG8_WAIT_L(0); PG8_BAR; if (mma0) { PG8_MMA(0, 0, At, B0); PG8_MMA(0, 1, At, B1); } PG8_BAR; PG8_SCHED;
            PG8_LDA(At, 0, 1); PG8_STAGE(PG8_SB(0, 0), b2, voffB); PG8_STAGE(PG8_SB(0, 1), b2 + hstep, voffB); PG8_STAGE(PG8_SA(0, 0), a2, v2[0]);
            PG8_WAIT_V(8); PG8_WAIT_L(0); PG8_BAR; if (mma1) { PG8_MMA(1, 0, At, B0); PG8_MMA(1, 1, At, B1); } PG8_BAR; PG8_SCHED;
            PG8_LDB(B0, 1, 0); PG8_LDB(B1, 1, 1); PG8_SCHED; PG8_LDA(At, 1, 0); PG8_STAGE(PG8_SA(0, 1), a2, v2[1]);
            PG8_WAIT_V(8); PG8_WAIT_L(0); PG8_BAR; if (mma0) { PG8_MMA(0, 0, At, B0); PG8_MMA(0, 1, At, B1); } PG8_BAR; PG8_SCHED;
            PG8_LDA(At, 1, 1); PG8_STAGE(PG8_SB(1, 0), b3, voffB); PG8_STAGE(PG8_SB(1, 1), b3 + hstep, voffB); PG8_STAGE(PG8_SA(1, 0), a3, v2[0]);
            PG8_WAIT_V(8); PG8_WAIT_L(0); PG8_BAR; if (mma1) { PG8_MMA(1, 0, At, B0); PG8_MMA(1, 1, At, B1); } PG8_BAR; PG8_SCHED;
        }
        if (wr == 0) PG8_BAR;
        E(acc, cur, wr, wc, fr, fq);
        if (!has_next) break;
#pragma unroll
        for (int a = 0; a < 2; ++a)
#pragma unroll
            for (int b = 0; b < 2; ++b)
#pragma unroll
                for (int m = 0; m < 4; ++m)
#pragma unroll
                    for (int n = 0; n < 2; ++n) acc[a][b][m][n] = (f32x4){0.f, 0.f, 0.f, 0.f};
        cur = nxt; cA = nA; cB = nB; ++ui;
#pragma unroll
        for (int h = 0; h < 2; ++h)
#pragma unroll
            for (int i = 0; i < 2; ++i) va[h][i] = nva[h][i];
        if (wr == 1) PG8_BAR;
    }
    PG8_WAIT_V(0);
    PG8_BAR;
#undef PG8_SA
#undef PG8_SB
#undef PG8_STAGE
#undef PG8_LDA
#undef PG8_LDB
#undef PG8_MMA
#undef PG8_WAIT_V
#undef PG8_WAIT_L
#undef PG8_BAR
#undef PG8_SCHED
#undef PG8_VOFF
}

struct EpiRowScaleBf16 {
    bf16* O; int ldc; const float* rs;
    __device__ __forceinline__ void operator()(const f32x4 (&acc)[2][2][4][2], const Unit& u, int wr, int wc, int fr, int fq) const {
        const int row0 = u.pm * BM + wr * 64 + fr, col0 = u.pn * BM + wc * 32 + 8 * fq;
        float sc[2][4];
#pragma unroll
        for (int ai = 0; ai < 2; ++ai)
#pragma unroll
            for (int m = 0; m < 4; ++m) sc[ai][m] = rs[row0 + ai * HALF + m * 16];
#pragma unroll
        for (int ai = 0; ai < 2; ++ai)
#pragma unroll
            for (int m = 0; m < 4; ++m) { const int row = row0 + ai * HALF + m * 16; const float s = sc[ai][m]; bf16* rowp = O + (size_t)row * ldc + col0;
#pragma unroll
                for (int bj = 0; bj < 2; ++bj) { const f32x4 v0 = acc[ai][bj][m][0] * s, v1 = acc[ai][bj][m][1] * s;
                    v4u w; w.x = cvt_pk_bf16(v0[0], v0[1]); w.y = cvt_pk_bf16(v0[2], v0[3]); w.z = cvt_pk_bf16(v1[0], v1[1]); w.w = cvt_pk_bf16(v1[2], v1[3]);
                    *(v4u*)(rowp + bj * HALF) = w; } }
    }
};
struct EpiPlainBf16 {
    bf16* O; int ldc;
    __device__ __forceinline__ void operator()(const f32x4 (&acc)[2][2][4][2], const Unit& u, int wr, int wc, int fr, int fq) const {
        const int row0 = u.pm * BM + wr * 64 + fr, col0 = u.pn * BM + wc * 32 + 8 * fq;
#pragma unroll
        for (int ai = 0; ai < 2; ++ai)
#pragma unroll
            for (int m = 0; m < 4; ++m) { const int row = row0 + ai * HALF + m * 16; bf16* rowp = O + (size_t)row * ldc + col0;
#pragma unroll
                for (int bj = 0; bj < 2; ++bj) { const f32x4 v0 = acc[ai][bj][m][0], v1 = acc[ai][bj][m][1];
                    v4u w; w.x = cvt_pk_bf16(v0[0], v0[1]); w.y = cvt_pk_bf16(v0[2], v0[3]); w.z = cvt_pk_bf16(v1[0], v1[1]); w.w = cvt_pk_bf16(v1[2], v1[3]);
                    *(v4u*)(rowp + bj * HALF) = w; } }
    }
};
struct EpiGateBf16 {
    bf16* O; int ldc; const float* rs; const float* bias; float osc;
    __device__ __forceinline__ void operator()(const f32x4 (&acc)[2][2][4][2], const Unit& u, int wr, int wc, int fr, int fq) const {
        const int row0 = u.pm * BM + wr * 64 + fr, col0 = u.pn * BM + wc * 32 + 8 * fq;
        float sc[2][4]; f32x4 bv[2][2];
#pragma unroll
        for (int ai = 0; ai < 2; ++ai)
#pragma unroll
            for (int m = 0; m < 4; ++m) sc[ai][m] = rs[row0 + ai * HALF + m * 16] * osc;
#pragma unroll
        for (int bj = 0; bj < 2; ++bj)
#pragma unroll
            for (int n = 0; n < 2; ++n) bv[bj][n] = *(const f32x4*)(bias + col0 + bj * HALF + 4 * n);
#pragma unroll
        for (int ai = 0; ai < 2; ++ai)
#pragma unroll
            for (int m = 0; m < 4; ++m) { const int row = row0 + ai * HALF + m * 16; const float s = sc[ai][m]; bf16* rowp = O + (size_t)row * ldc + col0;
#pragma unroll
                for (int bj = 0; bj < 2; ++bj) { f32x4 v0 = acc[ai][bj][m][0] * s + bv[bj][0], v1 = acc[ai][bj][m][1] * s + bv[bj][1];
#pragma unroll
                    for (int q = 0; q < 4; ++q) { v0[q] = fast_sigmoid(v0[q]); v1[q] = fast_sigmoid(v1[q]); }
                    v4u w; w.x = cvt_pk_bf16(v0[0], v0[1]); w.y = cvt_pk_bf16(v0[2], v0[3]); w.z = cvt_pk_bf16(v1[0], v1[1]); w.w = cvt_pk_bf16(v1[2], v1[3]);
                    *(v4u*)(rowp + bj * HALF) = w; } }
    }
};
}

struct Args { const float* in[25]; float* out; unsigned char* ws; int ph_lo, ph_hi; };

struct Frame {
    LAS unsigned char* lds; volatile LAS unsigned* MISC; gu32* ctl; int tid, lane, wave, vcu, G;
};
__device__ __forceinline__ float wave_sum(float v) {
#pragma unroll
    for (int o = 1; o < 64; o <<= 1) v += __shfl_xor(v, o);
    return v;
}
template <int RM, bool HAS_CS>
__device__ __forceinline__ void p0_transpose_item(const float* __restrict__ W, int K, int N, bf16* __restrict__ WT, int row_off, const float* __restrict__ cs, LAS float* scr, int item, int lane) {
    const int nblk = N / 32, kb = item / nblk, nb = item % nblk, k0 = 64 * kb, n0 = 32 * nb;
    const int c = lane & 7;
    f32x4 s0 = {1.f, 1.f, 1.f, 1.f}, s1 = {1.f, 1.f, 1.f, 1.f};
    if (HAS_CS) { s0 = *(const f32x4*)(cs + k0 + 8 * c); s1 = *(const f32x4*)(cs + k0 + 8 * c + 4); }
#pragma unroll 8
    for (int i = 0; i < 32; ++i) { const int kk = 2 * i + (lane >> 5); scr[kk * 33 + (lane & 31)] = W[(size_t)(k0 + kk) * N + n0 + (lane & 31)]; }
    LDS_WAIT(); asm volatile("" ::: "memory");
#pragma unroll
    for (int j = 0; j < 4; ++j) { const int n = (lane >> 3) + 8 * j; const LAS float* s = scr + (8 * c) * 33 + n;
        v4u o; o.x = pk2(s[0 * 33] * s0.x, s[1 * 33] * s0.y); o.y = pk2(s[2 * 33] * s0.z, s[3 * 33] * s0.w); o.z = pk2(s[4 * 33] * s1.x, s[5 * 33] * s1.y); o.w = pk2(s[6 * 33] * s1.z, s[7 * 33] * s1.w);
        const int nn = n0 + n; const int orow = RM == 0 ? row_off + nn : (row_off + 8 * (nn >> 2) + (nn & 3) + (RM == 2 ? 4 : 0));
        *(GAS v4u*)(WT + (size_t)orow * K + k0 + 8 * c) = o; }
    LDS_WAIT(); asm volatile("" ::: "memory");
}

__device__ __forceinline__ unsigned pk4_fp8(float v0, float v1, float v2, float v3) {
    v0 = __builtin_amdgcn_fmed3f(v0, -448.f, 448.f); v1 = __builtin_amdgcn_fmed3f(v1, -448.f, 448.f); v2 = __builtin_amdgcn_fmed3f(v2, -448.f, 448.f); v3 = __builtin_amdgcn_fmed3f(v3, -448.f, 448.f);
    int w = 0; w = __builtin_amdgcn_cvt_pk_fp8_f32(v0, v1, w, false); w = __builtin_amdgcn_cvt_pk_fp8_f32(v2, v3, w, true); return (unsigned)w;
}
template <int RM, bool HAS_CS>
__device__ __forceinline__ void p0_transpose_item_f8(const float* __restrict__ W, int K, int N, unsigned char* __restrict__ WT, const float* __restrict__ cs, float scale, LAS float* scr, int item, int lane) {
    const int nblk = N / 32, kb = item / nblk, nb = item % nblk, k0 = 64 * kb, n0 = 32 * nb;
    const int n = lane & 31, kq = lane >> 5;
#pragma unroll 8
    for (int i = 0; i < 32; ++i) { const int kk = 2 * i + (lane >> 5); scr[kk * 33 + (lane & 31)] = W[(size_t)(k0 + kk) * N + n0 + (lane & 31)]; }
    LDS_WAIT(); asm volatile("" ::: "memory");
    const int nn = n0 + n; const int orow = RM == 0 ? nn : (8 * (nn >> 2) + (nn & 3) + (RM == 2 ? 4 : 0));
    unsigned char* dst = WT + (size_t)orow * K + k0 + 32 * kq;
    f32x4 csv[8];
#pragma unroll
    for (int i = 0; i < 8; ++i) csv[i] = HAS_CS ? *(const f32x4*)(cs + k0 + 32 * kq + 4 * i) * scale : (f32x4){scale, scale, scale, scale};
#pragma unroll
    for (int h = 0; h < 2; ++h) { v4u o;
#pragma unroll
        for (int q = 0; q < 4; ++q) { const int kk = 32 * kq + 16 * h + 4 * q; const f32x4 sc = csv[4 * h + q];
            o[q] = pk4_fp8(scr[kk * 33 + n] * sc[0], scr[(kk + 1) * 33 + n] * sc[1], scr[(kk + 2) * 33 + n] * sc[2], scr[(kk + 3) * 33 + n] * sc[3]); }
        *(GAS v4u*)(dst + 16 * h) = o; }
    LDS_WAIT(); asm volatile("" ::: "memory");
}
struct Ptrs {
    const float *x, *p, *g_mix, *w_in, *conv_w, *conv_b, *wa, *ba, *wx, *bx, *lam, *w_out, *g_ffn, *w_rg, *b_rg, *w_re, *b_re, *w1, *w3, *w2, *g_ple, *w_pg, *b_pg, *w_pp, *g_final;
    float* out; unsigned char* ws;
    float *rstd0, *rstd1, *rstd2; int* eid; float* ew; int* list; int* counts; int* goffs;
    bf16 *W_IN, *W_OUT, *W_PG, *W_PP, *WRT, *LRUW, *W13, *W2, *PB, *XB, *MIX, *ACT, *GATE, *PROJ, *D1, *X1B, *X2B, *Y, *PP;
};
__device__ __forceinline__ void make_ptrs(Ptrs& P, const Args& a) {
    P.x = a.in[0]; P.p = a.in[1]; P.g_mix = a.in[2]; P.w_in = a.in[3]; P.conv_w = a.in[4]; P.conv_b = a.in[5]; P.wa = a.in[6]; P.ba = a.in[7]; P.wx = a.in[8]; P.bx = a.in[9]; P.lam = a.in[10];
    P.w_out = a.in[11]; P.g_ffn = a.in[12]; P.w_rg = a.in[13]; P.b_rg = a.in[14]; P.w_re = a.in[15]; P.b_re = a.in[16]; P.w1 = a.in[17]; P.w3 = a.in[18]; P.w2 = a.in[19];
    P.g_ple = a.in[20]; P.w_pg = a.in[21]; P.b_pg = a.in[22]; P.w_pp = a.in[23]; P.g_final = a.in[24];
    P.out = a.out; P.ws = a.ws; unsigned char* ws = a.ws;
    P.rstd0 = (float*)(ws + WS_RSTD0); P.rstd1 = (float*)(ws + WS_RSTD1); P.rstd2 = (float*)(ws + WS_RSTD2);
    P.eid = (int*)(ws + WS_EID); P.ew = (float*)(ws + WS_EW); P.list = (int*)(ws + WS_LIST); P.counts = (int*)(ws + WS_CNT); P.goffs = P.counts + 256 * NE;
    P.W_IN = (bf16*)(ws + WS_WIN); P.W_OUT = (bf16*)(ws + WS_WOUT); P.W_PG = (bf16*)(ws + WS_WPG); P.W_PP = (bf16*)(ws + WS_WPP); P.WRT = (bf16*)(ws + WS_WRT); P.LRUW = (bf16*)(ws + WS_LRUW);
    P.W13 = (bf16*)(ws + WS_W13); P.W2 = (bf16*)(ws + WS_W2); P.PB = (bf16*)(ws + WS_PB);
    P.XB = (bf16*)(ws + WS_R64); P.MIX = (bf16*)(ws + WS_R64); P.ACT = (bf16*)(ws + WS_R64); P.GATE = (bf16*)(ws + WS_R64);
    P.PROJ = (bf16*)(ws + WS_PROJ); P.D1 = (bf16*)(ws + WS_D1); P.PP = (bf16*)(ws + WS_PP); P.X1B = (bf16*)(ws + WS_X1B); P.X2B = (bf16*)(ws + WS_D1);     P.Y = (bf16*)(ws + WS_Y);
}

struct P0Item { const float* src; const float* cs; unsigned char* dst; int N, Kout, n0, rm, fmt; float scale; };
__device__ __forceinline__ bool p0_decode(const Ptrs& P, int it, P0Item& I) {
    constexpr int I_WIN = (D / 64) * (INC / 32), I_SQ = (D / 64) * (D / 32), I_WPP = (PLE / 64) * (D / 32), I_W1 = (D / 64) * (DE / 32), I_W2 = (DE / 64) * (D / 32);
    constexpr int NITEMS = I_WIN + 2 * I_SQ + I_WPP + NE * (2 * I_W1 + I_W2);
    if (it >= NITEMS) return false;
    int r = it; const float* W; const float* cs; unsigned char* dst; int K, N, rm = 0, fmt = 0; float scale = 1.f;
    if (r < I_WIN) { W = P.w_in; K = D; N = INC; dst = (unsigned char*)P.W_IN; cs = P.g_mix; }
    else if ((r -= I_WIN) < I_SQ) { W = P.w_out; K = D; N = D; dst = (unsigned char*)P.W_OUT; cs = nullptr; }
    else if ((r -= I_SQ) < I_SQ) { W = P.w_pg; K = D; N = D; dst = (unsigned char*)P.W_PG; cs = P.g_ple; fmt = 1; scale = PLE_SWG; }
    else if ((r -= I_SQ) < I_WPP) { W = P.w_pp; K = PLE; N = D; dst = (unsigned char*)P.W_PP; cs = nullptr; }
    else { r -= I_WPP; const int per_e = 2 * I_W1 + I_W2, e = r / per_e; r -= e * per_e; fmt = 1;
        if (r < I_W1) { W = P.w1 + (size_t)e * D * DE; K = D; N = DE; dst = (unsigned char*)P.W13 + (size_t)e * D * D; cs = P.g_ffn; rm = 1; scale = MOE_SW1; }
        else if ((r -= I_W1) < I_W1) { W = P.w3 + (size_t)e * D * DE; K = D; N = DE; dst = (unsigned char*)P.W13 + (size_t)e * D * D; cs = P.g_ffn; rm = 2; scale = MOE_SW1; }
        else { r -= I_W1; W = P.w2 + (size_t)e * DE * D; K = DE; N = D; dst = (unsigned char*)P.W2 + (size_t)e * D * DE; cs = nullptr; scale = MOE_SW2; } }
    const int nblk = N / 32, nkb = K / 64; const int kb = fmt ? r % nkb : r / nblk, nb = fmt ? r / nkb : r % nblk, k0 = 64 * kb, n0 = 32 * nb;
    I.src = W + (size_t)k0 * N + n0; I.cs = cs ? cs + k0 : nullptr; I.N = N; I.n0 = n0; I.rm = rm; I.fmt = fmt; I.scale = scale;
    I.Kout = fmt ? K : 2 * K; I.dst = dst + (fmt ? k0 : 2 * k0);
    return true;
}
__device__ __forceinline__ void p0_load(const P0Item& I, float (&v)[32], int lane) {
    const float* s = I.src + (size_t)(lane >> 5) * I.N + (lane & 31);
#pragma unroll
    for (int i = 0; i < 32; ++i) v[i] = s[(size_t)(2 * i) * I.N];
}
__device__ __forceinline__ int p0_orow(const P0Item& I, int n) { const int nn = I.n0 + n; return I.rm == 0 ? nn : (8 * (nn >> 2) + (nn & 3) + (I.rm == 2 ? 4 : 0)); }
__device__ __forceinline__ void p0_process(const P0Item& I, const float (&v)[32], LAS float* scr, int lane) {
#pragma unroll
    for (int i = 0; i < 32; ++i) scr[(2 * i + (lane >> 5)) * 33 + (lane & 31)] = v[i];
    LDS_WAIT(); asm volatile("" ::: "memory");
    if (I.fmt == 0) {
        const int c = lane & 7;
        f32x4 s0 = {1.f, 1.f, 1.f, 1.f}, s1 = {1.f, 1.f, 1.f, 1.f};
        if (I.cs) { s0 = *(const f32x4*)(I.cs + 8 * c); s1 = *(const f32x4*)(I.cs + 8 * c + 4); }
#pragma unroll
        for (int j = 0; j < 4; ++j) { const int n = (lane >> 3) + 8 * j; const LAS float* s = scr + (8 * c) * 33 + n;
            v4u o; o.x = cvt_pk_bf16(s[0 * 33] * s0.x, s[1 * 33] * s0.y); o.y = cvt_pk_bf16(s[2 * 33] * s0.z, s[3 * 33] * s0.w); o.z = cvt_pk_bf16(s[4 * 33] * s1.x, s[5 * 33] * s1.y); o.w = cvt_pk_bf16(s[6 * 33] * s1.z, s[7 * 33] * s1.w);
            *(GAS v4u*)(I.dst + (size_t)p0_orow(I, n) * I.Kout + 16 * c) = o; }
    } else {
        const int c = lane & 3;
        f32x4 sc[4];
#pragma unroll
        for (int q = 0; q < 4; ++q) sc[q] = I.cs ? *(const f32x4*)(I.cs + 16 * c + 4 * q) * I.scale : (f32x4){I.scale, I.scale, I.scale, I.scale};
#pragma unroll
        for (int j = 0; j < 2; ++j) { const int n = (lane >> 2) + 16 * j; const LAS float* s = scr + (16 * c) * 33 + n; v4u o;
#pragma unroll
            for (int q = 0; q < 4; ++q) o[q] = pk4_fp8(s[(4 * q) * 33] * sc[q][0], s[(4 * q + 1) * 33] * sc[q][1], s[(4 * q + 2) * 33] * sc[q][2], s[(4 * q + 3) * 33] * sc[q][3]);
            *(GAS v4u*)(I.dst + (size_t)p0_orow(I, n) * I.Kout + 16 * c) = o; }
    }
    LDS_WAIT(); asm volatile("" ::: "memory");
}
__device__ __forceinline__ void p0_prologue(Frame& F, const Ptrs& P) {
    LAS float* scr = (LAS float*)(F.lds + RING_OFF + F.wave * 16384);
    const int gw = F.vcu * NWAVES + F.wave, NGW = F.G * NWAVES;
    {
        P0Item A, Bn; float va[32], vb[32];
        int it = gw; bool hasA = p0_decode(P, it, A);
        if (hasA) p0_load(A, va, F.lane);
        while (hasA) {
            const bool hasB = p0_decode(P, it + NGW, Bn);
            if (hasB) p0_load(Bn, vb, F.lane);
            p0_process(A, va, scr, F.lane);
            if (!hasB) break;
            it += 2 * NGW; hasA = p0_decode(P, it, A);
            if (hasA) p0_load(A, va, F.lane);
            p0_process(Bn, vb, scr, F.lane);
        }
    }
    for (int m = gw; m < T; m += 2 * NGW) {
        const int m1 = m + NGW; const bool two = m1 < T;
        const GAS f32x4* xr0 = (const GAS f32x4*)(P.x + (size_t)m * D) + F.lane; const GAS f32x4* xr1 = (const GAS f32x4*)(P.x + (size_t)(two ? m1 : m) * D) + F.lane;
        f32x4 v[4], u[4]; float s = 0.f, s1 = 0.f;
#pragma unroll
        for (int j = 0; j < 4; ++j) { v[j] = xr0[64 * j]; u[j] = xr1[64 * j]; }
#pragma unroll
        for (int j = 0; j < 4; ++j) { s += (v[j].x * v[j].x + v[j].y * v[j].y) + (v[j].z * v[j].z + v[j].w * v[j].w); s1 += (u[j].x * u[j].x + u[j].y * u[j].y) + (u[j].z * u[j].z + u[j].w * u[j].w); }
        s = wave_sum(s); s1 = wave_sum(s1);
        GAS v2u* o8 = (GAS v2u*)(P.XB + (size_t)m * D) + F.lane;
#pragma unroll
        for (int j = 0; j < 4; ++j) { v2u w; w.x = pk2(v[j].x, v[j].y); w.y = pk2(v[j].z, v[j].w); o8[64 * j] = w; }
        if (F.lane == 0) P.rstd0[m] = 1.0f / sqrtf(s * (1.f / D) + EPS);
        if (two) {
            GAS v2u* o9 = (GAS v2u*)(P.XB + (size_t)m1 * D) + F.lane;
#pragma unroll
            for (int j = 0; j < 4; ++j) { v2u w; w.x = pk2(u[j].x, u[j].y); w.y = pk2(u[j].z, u[j].w); o9[64 * j] = w; }
            if (F.lane == 0) P.rstd0[m1] = 1.0f / sqrtf(s1 * (1.f / D) + EPS);
        }
    }
    for (int m = gw; m < T; m += 4 * NGW) {
        f32x4 v[4];
#pragma unroll
        for (int j = 0; j < 4; ++j) { const int mj = m + j * NGW; v[j] = *((const GAS f32x4*)(P.p + (size_t)(mj < T ? mj : m) * PLE) + F.lane); }
#pragma unroll
        for (int j = 0; j < 4; ++j) { const int mj = m + j * NGW; if (mj < T) { v2u w; w.x = pk2(v[j].x, v[j].y); w.y = pk2(v[j].z, v[j].w); *((GAS v2u*)(P.PB + (size_t)mj * PLE) + F.lane) = w; } }
    }
    for (int idx = (F.vcu * NTHR + F.tid); idx < 80 * D; idx += F.G * NTHR) {
        const int n = idx / D, k = idx % D; float v = 0.f;
        if (n < NG) v = P.w_rg[(size_t)k * NG + n] * P.g_ffn[k]; else if (n < NG + NE) v = P.w_re[(size_t)k * NE + (n - NG)] * P.g_ffn[k];
        const bf16 hi = f2bf(v); const bf16 lo = f2bf(v - bf2f(hi));
        P.WRT[idx] = hi; P.WRT[80 * D + idx] = lo;
    }
    for (int idx = (F.vcu * NTHR + F.tid); idx < 2 * 8 * 64 * 64; idx += F.G * NTHR) {
        const int g = idx >> 15, r = idx & 32767, hb = r >> 12, j = (r >> 6) & 63, i = r & 63;
        const float* w = g ? P.wx : P.wa;
        P.LRUW[idx] = f2bf(w[(hb * 64 + i) * 64 + j]);
    }
}


__device__ __forceinline__ f32x4 bf4(v2u w) { return (f32x4){bflo(w.x), bfhi(w.x), bflo(w.y), bfhi(w.y)}; }
__device__ __forceinline__ void p10_combine(Frame& F, const Ptrs& P) {
    const int gw = F.vcu * NWAVES + F.wave, NGW = F.G * NWAVES;
    for (int m = gw; m < T; m += NGW) {
        const size_t ro = (size_t)m * D;
        GAS v2u* x1 = (GAS v2u*)(P.X2B + ro) + F.lane; const GAS v2u* y0 = (const GAS v2u*)(P.Y + ro) + F.lane; const GAS v2u* y1 = (const GAS v2u*)(P.Y + (size_t)T * D + ro) + F.lane;
        f32x4 v[4]; v2u a[4], b[4], c[4];
#pragma unroll
        for (int j = 0; j < 4; ++j) { a[j] = x1[64 * j]; b[j] = y0[64 * j]; c[j] = y1[64 * j]; }
        float s = 0.f;
#pragma unroll
        for (int j = 0; j < 4; ++j) { v[j] = bf4(a[j]) + (bf4(b[j]) + bf4(c[j])); s += (v[j].x * v[j].x + v[j].y * v[j].y) + (v[j].z * v[j].z + v[j].w * v[j].w); }
        s = wave_sum(s);
        GAS unsigned* o4 = (GAS unsigned*)((unsigned char*)P.X1B + ro) + F.lane;
#pragma unroll
        for (int j = 0; j < 4; ++j) { v2u w; w.x = pk2(v[j].x, v[j].y); w.y = pk2(v[j].z, v[j].w); x1[64 * j] = w;
            o4[64 * j] = pk4_fp8(v[j].x * PLE_SX2, v[j].y * PLE_SX2, v[j].z * PLE_SX2, v[j].w * PLE_SX2); }
        if (F.lane == 0) P.rstd2[m] = 1.0f / sqrtf(s * (1.f / D) + EPS);
    }
}
__device__ __forceinline__ void p13_final(Frame& F, const Ptrs& P) {
    const int gw = F.vcu * NWAVES + F.wave, NGW = F.G * NWAVES;
    f32x4 gf[4];
#pragma unroll
    for (int j = 0; j < 4; ++j) gf[j] = *((const GAS f32x4*)P.g_final + F.lane + 64 * j);
    for (int m = gw; m < T; m += NGW) {
        const size_t ro = (size_t)m * D;
        GAS f32x4* xr = (GAS f32x4*)(P.out + ro) + F.lane;
        const GAS v2u* xb = (const GAS v2u*)(P.X2B + ro) + F.lane; const GAS v2u* ga = (const GAS v2u*)(P.GATE + ro) + F.lane; const GAS v2u* pp = (const GAS v2u*)(P.PP + ro) + F.lane;
        f32x4 v[4]; v2u a[4], b[4], c[4];
#pragma unroll
        for (int j = 0; j < 4; ++j) { c[j] = xb[64 * j]; a[j] = ga[64 * j]; b[j] = pp[64 * j]; }
        float s = 0.f;
#pragma unroll
        for (int j = 0; j < 4; ++j) { v[j] = bf4(c[j]) + bf4(a[j]) * bf4(b[j]); s += (v[j].x * v[j].x + v[j].y * v[j].y) + (v[j].z * v[j].z + v[j].w * v[j].w); }
        s = wave_sum(s);
        const float r = 1.0f / sqrtf(s * (1.f / D) + EPS);
#pragma unroll
        for (int j = 0; j < 4; ++j) xr[64 * j] = v[j] * r * gf[j];
    }
}
__device__ __forceinline__ LAS int* sched_offs(Frame& F) { return (LAS int*)(F.lds + SCHED_OFF); }
__device__ __forceinline__ LAS int* sched_tileb(Frame& F) { return (LAS int*)(F.lds + SCHED_OFF) + 72; }
__device__ __forceinline__ LAS int* sched_pre(Frame& F) { return (LAS int*)(F.lds + SCHED_OFF) + 144; }
__device__ __forceinline__ LAS int* sched_ta(Frame& F) { return (LAS int*)(F.lds + SCHED_OFF) + 256; }
__device__ __forceinline__ LAS int* sched_tc(Frame& F) { return (LAS int*)(F.lds + SCHED_OFF) + 328; }
__device__ __forceinline__ void sched_build(Frame& F, const Ptrs& P) {
    LAS int* offs = sched_offs(F); LAS int* tb = sched_tileb(F); LAS int* pre = sched_pre(F);
    LAS int* part = (LAS int*)(F.lds + UTAB_OFF);
    {
        const int e = F.tid & 63, pt = F.tid >> 6; int t = 0, p = 0; int cv[32];
#pragma unroll
        for (int j = 0; j < 32; ++j) cv[j] = P.counts[(pt * 32 + j) * NE + e];
#pragma unroll
        for (int j = 0; j < 32; ++j) { t += cv[j]; p += (pt * 32 + j < F.vcu) ? cv[j] : 0; }
        part[(pt * 64 + e) * 2] = t; part[(pt * 64 + e) * 2 + 1] = p;
    }
    __syncthreads();
    if (F.tid < NE) { int t = 0, p = 0;
#pragma unroll
        for (int pt = 0; pt < 8; ++pt) { t += part[(pt * 64 + F.tid) * 2]; p += part[(pt * 64 + F.tid) * 2 + 1]; }
        pre[F.tid] = p; part[1024 + F.tid] = t; }
    __syncthreads();
    if (F.tid == 0) { LAS int* ta = sched_ta(F); LAS int* tc = sched_tc(F); int o = 0, tbv = 0, tav = 0, tcv = 0;
        for (int e = 0; e < NE; ++e) { offs[e] = o; tb[e] = tbv; ta[e] = tav; tc[e] = tcv; const int t = part[1024 + e], tl = t & 255; o += t; tbv += t >> 8; tav += tl > 128 ? 1 : 0; tcv += (tl > 0 && tl <= 128) ? 1 : 0; }
        offs[NE] = o; tb[NE] = tbv; ta[NE] = tav; tc[NE] = tcv; }
    __syncthreads();
}

constexpr int P6_BROW = 272, P6_BHL = 80 * P6_BROW, P6_BBUF = 2 * P6_BHL, P6_LG_OFF = 90112;
static_assert(2 * P6_BBUF <= P6_LG_OFF && P6_LG_OFF + 8 * 16 * 80 * 4 <= RING_BYTES, "P6 LDS map");
__device__ __forceinline__ void p6_route(Frame& F, const Ptrs& P) {
    const int lane = F.lane, r = lane & 15, g = lane >> 4;
    const int tok = F.vcu * 128 + F.wave * 16 + r;
    LAS unsigned char* BS = F.lds + RING_OFF;
    LAS float* LG = (LAS float*)(F.lds + RING_OFF + P6_LG_OFF) + F.wave * (16 * 80);
    LAS float* SS = (LAS float*)(F.lds + UTAB_OFF) + F.wave * 16;
    LAS int* hist = (LAS int*)(F.lds + UTAB_OFF + 1024);
    if (F.tid < NE) hist[F.tid] = 0;
    f32x4 acc[5];
#pragma unroll
    for (int i = 0; i < 5; ++i) acc[i] = (f32x4){0.f, 0.f, 0.f, 0.f};
    float ssq = 0.f;
    const float* xrow = P.x + (size_t)tok * D + 8 * g; const bf16* drow = P.D1 + (size_t)tok * D + 8 * g; unsigned char* orow = (unsigned char*)P.X1B + (size_t)tok * D + 8 * g;
    unsigned bsrc[5], bdst[5];
#pragma unroll
    for (int i = 0; i < 5; ++i) { const int id = F.tid + 512 * i, hl = id / 1280, rem = id % 1280, row = rem >> 4, ch = rem & 15;
        bsrc[i] = (unsigned)((hl * 80 + row) * D + 8 * ch) * 2u; bdst[i] = (unsigned)(hl * P6_BHL + row * P6_BROW + ch * 16); }
    v4u breg[5]; f32x4 xa[4], xb[4]; v4u dd[4];
#pragma unroll
    for (int i = 0; i < 5; ++i) breg[i] = *(const v4u*)((const char*)P.WRT + bsrc[i]);
#pragma unroll
    for (int s = 0; s < 4; ++s) { xa[s] = *(const f32x4*)(xrow + 32 * s); xb[s] = *(const f32x4*)(xrow + 32 * s + 4); dd[s] = *(const v4u*)(drow + 32 * s); }
#pragma unroll 1
    for (int sl = 0; sl < 8; ++sl) {
        LAS unsigned char* bb = BS + (sl & 1) * P6_BBUF;
#pragma unroll
        for (int i = 0; i < 5; ++i) *(LAS v4u*)(bb + bdst[i]) = breg[i];
        __syncthreads();
        f32x4 cxa[4], cxb[4]; v4u cdd[4];
#pragma unroll
        for (int s = 0; s < 4; ++s) { cxa[s] = xa[s]; cxb[s] = xb[s]; cdd[s] = dd[s]; }
        if (sl < 7) {
#pragma unroll
            for (int i = 0; i < 5; ++i) breg[i] = *(const v4u*)((const char*)P.WRT + bsrc[i] + (sl + 1) * 256);
#pragma unroll
            for (int s = 0; s < 4; ++s) { xa[s] = *(const f32x4*)(xrow + 128 * (sl + 1) + 32 * s); xb[s] = *(const f32x4*)(xrow + 128 * (sl + 1) + 32 * s + 4); dd[s] = *(const v4u*)(drow + 128 * (sl + 1) + 32 * s); }
        }
#pragma unroll
        for (int s = 0; s < 4; ++s) {
            float v[8];
            v[0] = cxa[s][0] + bflo(cdd[s].x); v[1] = cxa[s][1] + bfhi(cdd[s].x); v[2] = cxa[s][2] + bflo(cdd[s].y); v[3] = cxa[s][3] + bfhi(cdd[s].y);
            v[4] = cxb[s][0] + bflo(cdd[s].z); v[5] = cxb[s][1] + bfhi(cdd[s].z); v[6] = cxb[s][2] + bflo(cdd[s].w); v[7] = cxb[s][3] + bfhi(cdd[s].w);
            v4u hw, lw;
#pragma unroll
            for (int q = 0; q < 4; ++q) {
                ssq += v[2 * q] * v[2 * q] + v[2 * q + 1] * v[2 * q + 1];
                const unsigned h = cvt_pk_bf16(v[2 * q], v[2 * q + 1]);
                const unsigned l = cvt_pk_bf16(v[2 * q] - bflo(h), v[2 * q + 1] - bfhi(h));
                hw[q] = h; lw[q] = l;
            }
            { v2u f8; f8.x = pk4_fp8(v[0] * MOE_SX, v[1] * MOE_SX, v[2] * MOE_SX, v[3] * MOE_SX); f8.y = pk4_fp8(v[4] * MOE_SX, v[5] * MOE_SX, v[6] * MOE_SX, v[7] * MOE_SX); *(v2u*)(orow + 128 * sl + 32 * s) = f8; }
            *(v4u*)(const_cast<bf16*>(drow) + 128 * sl + 32 * s) = hw;
            const bf16x8 ah = __builtin_bit_cast(bf16x8, hw), al = __builtin_bit_cast(bf16x8, lw);
#pragma unroll
            for (int nt = 0; nt < 5; ++nt) {
                const bf16x8 bh = *(const LAS bf16x8*)(bb + (16 * nt + r) * P6_BROW + (32 * s + 8 * g) * 2), bl = *(const LAS bf16x8*)(bb + P6_BHL + (16 * nt + r) * P6_BROW + (32 * s + 8 * g) * 2);
                acc[nt] = __builtin_amdgcn_mfma_f32_16x16x32_bf16(ah, bh, acc[nt], 0, 0, 0);
                acc[nt] = __builtin_amdgcn_mfma_f32_16x16x32_bf16(al, bh, acc[nt], 0, 0, 0);
                acc[nt] = __builtin_amdgcn_mfma_f32_16x16x32_bf16(ah, bl, acc[nt], 0, 0, 0);
            }
        }
    }
    ssq += __shfl_xor(ssq, 16); ssq += __shfl_xor(ssq, 32);
#pragma unroll
    for (int nt = 0; nt < 5; ++nt)
#pragma unroll
        for (int q = 0; q < 4; ++q) LG[(4 * g + q) * 80 + 16 * nt + r] = acc[nt][q];
    if (g == 0) SS[r] = ssq;
    __syncthreads();
    if (g == 0) {
        const float rs = 1.0f / sqrtf(SS[r] * (1.f / D) + EPS);
        const LAS float* L = LG + r * 80;
        float gl[8]; float mx = -3.0e38f; int gsel = 0;
#pragma unroll
        for (int i = 0; i < 8; ++i) { gl[i] = rs * L[i] + P.b_rg[i]; if (gl[i] > mx) { mx = gl[i]; gsel = i; } }
        float den = 0.f;
#pragma unroll
        for (int i = 0; i < 8; ++i) den += expf(gl[i] - mx);
        const float gw = 1.f / den;
        float v0 = -3.0e38f, v1 = -3.0e38f; int i0 = 0, i1 = 0;
        for (int i = 0; i < 8; ++i) {
            const float v = rs * L[8 + gsel * 8 + i] + P.b_re[gsel * 8 + i];
            if (v > v0) { v1 = v0; i1 = i0; v0 = v; i0 = i; } else if (v > v1) { v1 = v; i1 = i; }
        }
        const float e1 = expf(v1 - v0), w0 = 1.f / (1.f + e1), w1 = e1 / (1.f + e1);
        const int ea = gsel * 8 + i0, eb = gsel * 8 + i1;
        P.eid[tok * 2] = ea; P.eid[tok * 2 + 1] = eb; P.ew[tok * 2] = w0 * gw; P.ew[tok * 2 + 1] = w1 * gw; P.rstd1[tok] = rs;
        __hip_atomic_fetch_add(hist + ea, 1, __ATOMIC_RELAXED, __HIP_MEMORY_SCOPE_WORKGROUP); __hip_atomic_fetch_add(hist + eb, 1, __ATOMIC_RELAXED, __HIP_MEMORY_SCOPE_WORKGROUP);
    }
    __syncthreads();
    if (F.tid < NE) P.counts[F.vcu * NE + F.tid] = hist[F.tid];
}

__device__ __forceinline__ void p7_lists(Frame& F, const Ptrs& P) {
    sched_build(F, P);
    LAS int* offs = sched_offs(F); LAS int* pre = sched_pre(F);
    LAS int* eids = (LAS int*)(F.lds + RING_OFF);
    if (F.tid < 256) eids[F.tid] = P.eid[F.vcu * 256 + F.tid];
    __syncthreads();
    if (F.tid < NE) {
        const int e = F.tid; int pos = offs[e] + pre[e];
        for (int a = 0; a < 256; ++a) if (eids[a] == e) { P.list[pos] = F.vcu * 256 + a; ++pos; }
    }
    if (blockIdx.x == 0 && F.tid <= NE) P.goffs[F.tid] = offs[F.tid];
    __syncthreads();
}

namespace pg8 {
template <int MODE>
struct MoeSched {
    const char* Ab; const char* Bb; int K, G, c; LAS int* offs; LAS int* tb; LAS int* ta; LAS int* tc; LAS int* tab;
    __device__ __forceinline__ bool next(int i, Unit& u) const {
        const int L = i * G + c; const int nF = __builtin_amdgcn_readfirstlane(tb[NE]), nA = __builtin_amdgcn_readfirstlane(ta[NE]), nC = __builtin_amdgcn_readfirstlane(tc[NE]);
        if (L >= 4 * (nF + nA + nC)) return false;
        int rt = L >> 2; const LAS int* pf = tb; int cls = 0;
        if (rt >= nF) { rt -= nF; pf = ta; cls = 1; if (rt >= nA) { rt -= nA; pf = tc; cls = 2; } }
        int e = 0;
        for (int k = 1; k < NE; ++k) e += (pf[k] <= rt) ? 1 : 0;
        e = __builtin_amdgcn_readfirstlane(e);
        const int o0 = __builtin_amdgcn_readfirstlane(offs[e]), cnt = __builtin_amdgcn_readfirstlane(offs[e + 1]) - o0;
        u.e = e; u.pm = cls == 0 ? rt - __builtin_amdgcn_readfirstlane(tb[e]) : (cnt >> 8); u.pn = L & 3; u.slot0 = o0 + 256 * u.pm;
        u.rows = cls == 0 ? 256 : (cnt & 255); u.ui = i; return true;
    }
    __device__ __forceinline__ const char* a_base(const Unit& u) const { return MODE == 0 ? Ab : Ab + (size_t)u.slot0 * (size_t)(K * 2); }
    __device__ __forceinline__ const char* b_base(const Unit& u) const { return Bb + ((size_t)u.e * D + (size_t)u.pn * BM) * (size_t)K * 2; }
    __device__ __forceinline__ unsigned a_rowoff(const Unit& u, int r) const { return MODE == 0 ? (unsigned)tab[u.ui * 256 + r] : (unsigned)r * (unsigned)(K * 2); }
};
struct EpiAct {
    unsigned char* ACT; const LAS float* tabf;
    __device__ __forceinline__ void operator()(const f32x4 (&acc)[2][2][4][2], const Unit& u, int wr, int wc, int fr, int fq) const {
#pragma unroll
        for (int ai = 0; ai < 2; ++ai)
#pragma unroll
            for (int m = 0; m < 4; ++m) { const int r = ai * HALF + wr * 64 + m * 16 + fr;
                if (r < u.rows) { const float s = tabf[u.ui * 256 + r] * (1.f / (MOE_SX * MOE_SW1)); unsigned char* rowp = ACT + (size_t)(u.slot0 + r) * DE + u.pn * 128 + wc * 16 + 4 * fq;
#pragma unroll
                    for (int bj = 0; bj < 2; ++bj) { const f32x4 h1 = acc[ai][bj][m][0] * s, h3 = acc[ai][bj][m][1] * s; f32x4 a;
#pragma unroll
                        for (int q = 0; q < 4; ++q) a[q] = h1[q] * fast_sigmoid(h1[q]) * h3[q] * MOE_SA;
                        *(unsigned*)(rowp + bj * 64) = pk4_fp8(a[0], a[1], a[2], a[3]); } } }
    }
};
struct EpiY {
    bf16* Y; const LAS int* tab; const LAS float* tabf;
    __device__ __forceinline__ void operator()(const f32x4 (&acc)[2][2][4][2], const Unit& u, int wr, int wc, int fr, int fq) const {
#pragma unroll
        for (int ai = 0; ai < 2; ++ai)
#pragma unroll
            for (int m = 0; m < 4; ++m) { const int r = ai * HALF + wr * 64 + m * 16 + fr; const int aid = tab[u.ui * 256 + r];
                if (aid >= 0) { const float s = tabf[u.ui * 256 + r] * (1.f / (MOE_SA * MOE_SW2)); bf16* rowp = Y + ((size_t)(aid & 1) * T + (size_t)(aid >> 1)) * D + u.pn * BM + wc * 32 + 8 * fq;
#pragma unroll
                    for (int bj = 0; bj < 2; ++bj) { const f32x4 v0 = acc[ai][bj][m][0] * s, v1 = acc[ai][bj][m][1] * s;
                        v4u w; w.x = cvt_pk_bf16(v0[0], v0[1]); w.y = cvt_pk_bf16(v0[2], v0[3]); w.z = cvt_pk_bf16(v1[0], v1[1]); w.w = cvt_pk_bf16(v1[2], v1[3]);
                        *(v4u*)(rowp + bj * HALF) = w; } } }
    }
};
}
template <int MODE>
__device__ __forceinline__ void moe_phase(Frame& F, const Ptrs& P, bool rebuild) {
    if (rebuild) sched_build(F, P);
    LAS int* tab = (LAS int*)(F.lds + UTAB_OFF); LAS float* tabf = (LAS float*)(F.lds + UTABF_OFF);
    LAS int* uinfo = (LAS int*)(F.lds + SCHED_OFF) + 208;
    pg8::MoeSched<MODE> S; S.Ab = MODE == 0 ? (const char*)P.X1B : (const char*)P.ACT; S.Bb = MODE == 0 ? (const char*)P.W13 : (const char*)P.W2; S.K = MODE == 0 ? D / 2 : DE / 2;   S.G = F.G; S.c = F.vcu;
    S.offs = sched_offs(F); S.tb = sched_tileb(F); S.ta = sched_ta(F); S.tc = sched_tc(F); S.tab = tab;
    if (F.tid < 64) {
#pragma unroll
        for (int i = 0; i < MAXU; ++i) { pg8::Unit u; const bool ok = S.next(i, u); if (F.tid == 0) { uinfo[2 * i] = ok ? u.slot0 : 0; uinfo[2 * i + 1] = ok ? u.rows : 0; } }
    }
    __syncthreads();
    {
        const int r = F.tid & 255, i0 = F.tid >> 8; int aid[3]; bool val[3], act[3];
#pragma unroll
        for (int it = 0; it < 3; ++it) { const int i = i0 + 2 * it; const int s0 = uinfo[2 * i], rows = uinfo[2 * i + 1]; act[it] = rows > 0; val[it] = r < rows; aid[it] = act[it] ? P.list[s0 + (val[it] ? r : 0)] : 0; }
        float fv[3];
#pragma unroll
        for (int it = 0; it < 3; ++it) fv[it] = act[it] ? (MODE == 0 ? P.rstd1[aid[it] >> 1] : P.ew[aid[it]]) : 0.f;
#pragma unroll
        for (int it = 0; it < 3; ++it) if (act[it]) { const int i = i0 + 2 * it;
            if (MODE == 0) tab[i * 256 + r] = (aid[it] >> 1) * D; else tab[i * 256 + r] = val[it] ? aid[it] : -1;
            tabf[i * 256 + r] = fv[it]; }
    }
    __syncthreads();
    if constexpr (MODE == 0) { pg8::EpiAct E{(unsigned char*)P.ACT, tabf}; pg8::gemm_phase<pg8::EpiAct, pg8::MoeSched<0>, true>(F.lds + RING_OFF, S, E); }
    else { pg8::EpiY E{P.Y, tab, tabf}; pg8::gemm_phase<pg8::EpiY, pg8::MoeSched<1>, true>(F.lds + RING_OFF, S, E); }
}
typedef short v4i16 __attribute__((ext_vector_type(4)));
__device__ __forceinline__ unsigned off_b(unsigned row, unsigned ch) { return 256u * row + 16u * (ch ^ (((row & 3u) << 2) | ((row >> 2) & 3u))); }
__device__ __forceinline__ unsigned row_read_addr_16(unsigned lane, unsigned rb, unsigned s) { return off_b((lane & 15u) + 16u * rb, 4u * s + (lane >> 4)); }
__device__ __forceinline__ unsigned tr_read_addr_16(unsigned lane, unsigned c, unsigned ks, unsigned t) {
    const unsigned g = lane >> 4, q = (lane & 15u) >> 2, p = lane & 3u;
    return off_b(32u * ks + 8u * g + 4u * t + q, 2u * c + (p >> 1)) + 8u * (p & 1u);
}
__device__ __forceinline__ bf16x8 tr_frag2(LAS unsigned char* p0, LAS unsigned char* p1) {
    const v4i16 a = __builtin_amdgcn_ds_read_tr16_b64_v4i16((LAS v4i16*)p0);
    const v4i16 b = __builtin_amdgcn_ds_read_tr16_b64_v4i16((LAS v4i16*)p1);
    return (bf16x8){a[0], a[1], a[2], a[3], b[0], b[1], b[2], b[3]};
}
__device__ __forceinline__ void wave_lds_fence() { asm volatile("s_waitcnt lgkmcnt(0)" ::: "memory"); __builtin_amdgcn_wave_barrier(); asm volatile("" ::: "memory"); }
__device__ __forceinline__ float gelu_tanh_fast(float x) {
    const float u = 0.7978845608028654f * (x + 0.044715f * x * x * x);
    return x * fast_sigmoid(2.f * u);
}
constexpr float LOG2_ROPE_OVER_64 = 13.287712379549449f / 64.f;
constexpr int MIX_K_OFF = 0, MIX_V_OFF = 32768, MIX_S_OFF = 65536, MIX_S_STRIDE = 272, MIX_S_WAVE = 16 * MIX_S_STRIDE;
constexpr int MIX_CW_OFF = 0, MIX_XC_OFF = 12288, MIX_XC_WAVE = 16 * 68 * 4;
static_assert(MIX_S_OFF + 8 * MIX_S_WAVE <= RING_BYTES && MIX_XC_OFF + 8 * MIX_XC_WAVE <= RING_BYTES, "mixing LDS map");

__device__ __forceinline__ void sincos_rev(float ang, float& sn, float& cs) {
    float rev = ang * 0.15915494309189535f; rev -= floorf(rev);
    sn = __builtin_amdgcn_sinf(rev); cs = __builtin_amdgcn_cosf(rev);
}
struct KVRaw { v4u k[2][2]; v4u v[4]; };
__device__ __forceinline__ void kv_issue(KVRaw& R, int tid, const bf16* proj_t0, int h) {
    const int dg = tid & 7;
#pragma unroll
    for (int it = 0; it < 2; ++it) { const int c = (tid >> 3) + 64 * it; const bf16* row = proj_t0 + (size_t)c * INC + 1536 + h * HD + 8 * dg; R.k[it][0] = *(const v4u*)row; R.k[it][1] = *(const v4u*)(row + 64); }
#pragma unroll
    for (int it = 0; it < 4; ++it) { const int id = tid + 512 * it, c = id >> 4, ch = id & 15; R.v[it] = *(const v4u*)(proj_t0 + (size_t)c * INC + 2048 + h * HD + 8 * ch); }
}
template <bool DECAY>
__device__ __forceinline__ void kv_store(Frame& F, const KVRaw& R, int tid, int s0, float lg2) {
    LAS unsigned char* Kimg = F.lds + MIX_K_OFF; LAS unsigned char* Vimg = F.lds + MIX_V_OFF;
    const int dg = tid & 7;
    float inv[8];
#pragma unroll
    for (int j = 0; j < 8; ++j) inv[j] = __builtin_amdgcn_exp2f(-(float)(8 * dg + j) * LOG2_ROPE_OVER_64);
#pragma unroll
    for (int it = 0; it < 2; ++it) {
        const int c = (tid >> 3) + 64 * it;
        const v4u k1 = R.k[it][0], k2 = R.k[it][1];
        const float sc = 0.08838834764831845f * (DECAY ? __builtin_amdgcn_exp2f((float)(127 - c) * lg2) : 1.f);
        const float pos = (float)(s0 + c);
        v4u o1, o2;
#pragma unroll
        for (int q = 0; q < 4; ++q) {
            float sn0, cs0, sn1, cs1; sincos_rev(pos * inv[2 * q], sn0, cs0); sincos_rev(pos * inv[2 * q + 1], sn1, cs1);
            const float a0 = bflo(k1[q]), a1 = bfhi(k1[q]), b0 = bflo(k2[q]), b1 = bfhi(k2[q]);
            o1[q] = cvt_pk_bf16((a0 * cs0 - b0 * sn0) * sc, (a1 * cs1 - b1 * sn1) * sc);
            o2[q] = cvt_pk_bf16((a0 * sn0 + b0 * cs0) * sc, (a1 * sn1 + b1 * cs1) * sc);
        }
        *(LAS v4u*)(Kimg + off_b(c, dg)) = o1; *(LAS v4u*)(Kimg + off_b(c, dg + 8)) = o2;
    }
#pragma unroll
    for (int it = 0; it < 4; ++it) { const int id = tid + 512 * it, c = id >> 4, ch = id & 15; *(LAS v4u*)(Vimg + off_b(c, ch)) = R.v[it]; }
}

template <bool FINAL>
__device__ __forceinline__ void lru_chunk(Frame& F, const Ptrs& P, int b, int n, int lane) {
    const int r = lane & 15, g = lane >> 4, hb = F.wave;
    const int t0 = b * S + n * CH;
    LAS float* CW = (LAS float*)(F.lds + MIX_CW_OFF);
    LAS float* XC = (LAS float*)(F.lds + MIX_XC_OFF + F.wave * MIX_XC_WAVE);
    for (int i = F.tid; i < 5 * DL; i += NTHR) CW[i] = i < 4 * DL ? P.conv_w[i] : P.conv_b[i - 4 * DL];
    __syncthreads();
    bf16x8 Wa[4][2], Wx[4][2];
#pragma unroll
    for (int jt = 0; jt < 4; ++jt)
#pragma unroll
        for (int ks = 0; ks < 2; ++ks) {
            Wa[jt][ks] = *(const bf16x8*)(P.LRUW + ((size_t)(0 * 8 + hb) * 64 + 16 * jt + r) * 64 + 32 * ks + 8 * g);
            Wx[jt][ks] = *(const bf16x8*)(P.LRUW + ((size_t)(1 * 8 + hb) * 64 + 16 * jt + r) * 64 + 32 * ks + 8 * g);
        }
    float ba[4], bx[4], sp8[4], St[4], At[4];
#pragma unroll
    for (int jt = 0; jt < 4; ++jt) { const int ch = hb * 64 + 16 * jt + r; ba[jt] = P.ba[ch]; bx[jt] = P.bx[ch];
        const float nl = -P.lam[ch]; sp8[jt] = 8.f * (nl > 20.f ? nl : log1pf(expf(nl)));
        St[jt] = FINAL ? ((const float*)(P.ws + WS_LRU))[2 * B * NCH * DL + (b * NCH + n) * DL + ch] : 0.f; At[jt] = 1.f; }
#pragma unroll 1
    for (int tt = 0; tt < 8; ++tt) {
        const int c = 16 * tt + r;
        bf16 glv[4][4];
        if (FINAL) {
#pragma unroll
            for (int jt = 0; jt < 4; ++jt)
#pragma unroll
                for (int q = 0; q < 4; ++q) glv[jt][q] = P.PROJ[(size_t)(t0 + 16 * tt + 4 * g + q) * INC + DL + hb * 64 + 16 * jt + r];
        }
        bf16x8 fr[2];
#pragma unroll
        for (int ks = 0; ks < 2; ++ks) {
            const int chA = hb * 64 + 32 * ks + 8 * g;
            float xc[8];
            { const f32x4 b0 = *(const LAS f32x4*)(CW + 4 * DL + chA), b1 = *(const LAS f32x4*)(CW + 4 * DL + chA + 4);
              xc[0] = b0[0]; xc[1] = b0[1]; xc[2] = b0[2]; xc[3] = b0[3]; xc[4] = b1[0]; xc[5] = b1[1]; xc[6] = b1[2]; xc[7] = b1[3]; }
#pragma unroll
            for (int k = 0; k < 4; ++k) {
                const int sp = n * CH + c - 3 + k;
                v4u xv = {0u, 0u, 0u, 0u};
                if (sp >= 0) xv = *(const v4u*)(P.PROJ + (size_t)(t0 + c - 3 + k) * INC + chA);
                const f32x4 w0 = *(const LAS f32x4*)(CW + k * DL + chA), w1 = *(const LAS f32x4*)(CW + k * DL + chA + 4);
                xc[0] += w0[0] * bflo(xv.x); xc[1] += w0[1] * bfhi(xv.x); xc[2] += w0[2] * bflo(xv.y); xc[3] += w0[3] * bfhi(xv.y);
                xc[4] += w1[0] * bflo(xv.z); xc[5] += w1[1] * bfhi(xv.z); xc[6] += w1[2] * bflo(xv.w); xc[7] += w1[3] * bfhi(xv.w);
            }
            v4u pk; pk.x = cvt_pk_bf16(xc[0], xc[1]); pk.y = cvt_pk_bf16(xc[2], xc[3]); pk.z = cvt_pk_bf16(xc[4], xc[5]); pk.w = cvt_pk_bf16(xc[6], xc[7]);
            fr[ks] = __builtin_bit_cast(bf16x8, pk);
            *(LAS f32x4*)(XC + r * 68 + 32 * ks + 8 * g) = (f32x4){xc[0], xc[1], xc[2], xc[3]};
            *(LAS f32x4*)(XC + r * 68 + 32 * ks + 8 * g + 4) = (f32x4){xc[4], xc[5], xc[6], xc[7]};
        }
        wave_lds_fence();
#pragma unroll
        for (int jt = 0; jt < 4; ++jt) {
            f32x4 aa = {0.f, 0.f, 0.f, 0.f}, ax = {0.f, 0.f, 0.f, 0.f};
#pragma unroll
            for (int ks = 0; ks < 2; ++ks) { aa = __builtin_amdgcn_mfma_f32_16x16x32_bf16(fr[ks], Wa[jt][ks], aa, 0, 0, 0); ax = __builtin_amdgcn_mfma_f32_16x16x32_bf16(fr[ks], Wx[jt][ks], ax, 0, 0, 0); }
            float av[4], uv[4]; float Al = 1.f, Hl = 0.f;
#pragma unroll
            for (int q = 0; q < 4; ++q) {
                const float xcv = XC[(4 * g + q) * 68 + 16 * jt + r];
                const float rg = fast_sigmoid(aa[q] + ba[jt]), ig = fast_sigmoid(ax[q] + bx[jt]);
                const float la = -rg * sp8[jt];
                const float a = __builtin_amdgcn_exp2f(la * 1.4426950408889634f);
                const float x2 = 2.f * la;
                const float em = x2 > -0.25f ? -x2 * (1.f + x2 * (0.5f + x2 * (0.16666667f + x2 * (0.041666668f + x2 * (0.0083333333f + x2 * 0.0013888889f))))) : 1.f - a * a;
                const float u = sqrtf(em) * (ig * xcv);
                av[q] = a; uv[q] = u; Hl = a * Hl + u; Al *= a;
            }
            float Ap = 1.f, Hp = 0.f;
#pragma unroll
            for (int k = 3; k >= 1; --k) {
                const float Ao = __shfl(Al, lane - 16 * k), Ho = __shfl(Hl, lane - 16 * k);
                if (g >= k) { Hp = Ao * Hp + Ho; Ap *= Ao; }
            }
            float h = Ap * St[jt] + Hp;
            if (FINAL) {
#pragma unroll
                for (int q = 0; q < 4; ++q) {
                    h = av[q] * h + uv[q];
                    const size_t tok = (size_t)(t0 + 16 * tt + 4 * g + q);
                    const float gl = bf2f(glv[jt][q]);
                    P.MIX[tok * D + hb * 64 + 16 * jt + r] = f2bf(h * gelu_tanh_fast(gl));
                }
            } else {
                h = Al * h + Hl;
            }
            const float Atile = __shfl(Ap * Al, (lane & 15) + 48);
            St[jt] = __shfl(h, (lane & 15) + 48);
            At[jt] *= Atile;
        }
        wave_lds_fence();
    }
    if (!FINAL && g == 0) {
#pragma unroll
        for (int jt = 0; jt < 4; ++jt) { const int ch = hb * 64 + 16 * jt + r; float* AE = (float*)(P.ws + WS_LRU);
            AE[(b * NCH + n) * DL + ch] = At[jt]; AE[B * NCH * DL + (b * NCH + n) * DL + ch] = St[jt]; }
    }
}

__device__ __forceinline__ void p2_mix_summaries(Frame& F, const Ptrs& P) {
    const int w = F.wave;
#pragma unroll 1
    for (int u = F.vcu; u < B * NCH; u += F.G) {
        const int b = u / NCH, n = u % NCH; const int t0 = b * S + n * CH;
        __syncthreads();
        { int lane0 = F.lane; asm volatile("" : "+v"(lane0)); lru_chunk<false>(F, P, b, n, lane0); }
        KVRaw raw; { int tid0 = F.tid; asm volatile("" : "+v"(tid0)); kv_issue(raw, tid0, P.PROJ + (size_t)t0 * INC, 0); }
#pragma unroll 1
        for (int h = 0; h < NH; ++h) {
            int lane = F.lane; asm volatile("" : "+v"(lane));
            int tidv = F.tid; asm volatile("" : "+v"(tidv));
            const int r = lane & 15, g = lane >> 4;
            unsigned trb[8][2];
#pragma unroll
            for (int c = 0; c < 8; ++c) { trb[c][0] = tr_read_addr_16(lane, c, 0, 0); trb[c][1] = tr_read_addr_16(lane, c, 0, 1); }
            const float lg2 = __builtin_amdgcn_logf(1.f - __builtin_amdgcn_exp2f(-5.f - (float)h));
            __syncthreads();
            kv_store<true>(F, raw, tidv, n * CH, lg2);
            if (h + 1 < NH) kv_issue(raw, tidv, P.PROJ + (size_t)t0 * INC, h + 1);
            __syncthreads();
            LAS unsigned char* Kimg = F.lds + MIX_K_OFF; LAS unsigned char* Vimg = F.lds + MIX_V_OFF;
            f32x4 acc[8];
#pragma unroll
            for (int dt = 0; dt < 8; ++dt) acc[dt] = (f32x4){0.f, 0.f, 0.f, 0.f};
            const unsigned ta0 = tr_read_addr_16(lane, w, 0, 0), ta1 = tr_read_addr_16(lane, w, 0, 1);
#pragma unroll 1
            for (int ks = 0; ks < 4; ++ks) {
                const bf16x8 Af = tr_frag2(Vimg + ta0 + 8192 * ks, Vimg + ta1 + 8192 * ks);
#pragma unroll
                for (int dt = 0; dt < 8; ++dt) { const bf16x8 Bf = tr_frag2(Kimg + trb[dt][0] + 8192 * ks, Kimg + trb[dt][1] + 8192 * ks); acc[dt] = __builtin_amdgcn_mfma_f32_16x16x32_bf16(Af, Bf, acc[dt], 0, 0, 0); }
            }
            float* KV = P.out + ((size_t)((b * NH + h) * NCH + n)) * (HD * HD);
#pragma unroll
            for (int dt = 0; dt < 8; ++dt)
#pragma unroll
                for (int q = 0; q < 4; ++q) KV[(16 * w + 4 * g + q) * HD + 16 * dt + r] = acc[dt][q];
        }
    }
}
__device__ __forceinline__ void p3_scans(Frame& F, const Ptrs& P) {
    const int idx = F.vcu * NTHR + F.tid;
    for (int id = idx; id < B * NH * (HD * HD / 4); id += F.G * NTHR) {
        const int bh = id >> 12, el = (id & 4095) * 4, h = bh & 3;
        const float lg2 = __builtin_amdgcn_logf(1.f - __builtin_amdgcn_exp2f(-5.f - (float)h));
        const float dec = __builtin_amdgcn_exp2f(128.f * lg2);
        const float* KV = P.out + (size_t)bh * NCH * (HD * HD) + el;
        bf16* PV = (bf16*)(P.out + (size_t)B * NH * NCH * (HD * HD)) + (size_t)bh * NCH * (HD * HD) + el;
        f32x4 st = {0.f, 0.f, 0.f, 0.f};
#pragma unroll 8
        for (int n = 0; n < NCH; ++n) {
            const f32x4 kv = *(const f32x4*)(KV + (size_t)n * (HD * HD));
            v2u w; w.x = cvt_pk_bf16(st[0], st[1]); w.y = cvt_pk_bf16(st[2], st[3]);
            *(v2u*)(PV + (size_t)n * (HD * HD)) = w;
            st = st * dec + kv;
        }
    }
    if (idx < B * DL) {
        const int b = idx / DL, ch = idx % DL; float* AE = (float*)(P.ws + WS_LRU);
        float carry = 0.f;
        for (int n = 0; n < NCH; ++n) {
            const float a = AE[(b * NCH + n) * DL + ch], e = AE[B * NCH * DL + (b * NCH + n) * DL + ch];
            AE[2 * B * NCH * DL + (b * NCH + n) * DL + ch] = carry;
            carry = a * carry + e;
        }
    }
}
__device__ __forceinline__ void p4_mix_outputs(Frame& F, const Ptrs& P) {
    const int w = F.wave;
#pragma unroll 1
    for (int u = F.vcu; u < B * NCH; u += F.G) {
        const int b = u / NCH, n = u % NCH; const int t0 = b * S + n * CH;
        __syncthreads();
        { int lane0 = F.lane; asm volatile("" : "+v"(lane0)); lru_chunk<true>(F, P, b, n, lane0); }
        KVRaw raw; v4u qraw[2][2];
        { int tid0 = F.tid, lane0 = F.lane; asm volatile("" : "+v"(tid0), "+v"(lane0)); kv_issue(raw, tid0, P.PROJ + (size_t)t0 * INC, 0);
          const bf16* qrow = P.PROJ + (size_t)(t0 + 16 * w + (lane0 & 15)) * INC + 1024 + 8 * (lane0 >> 4);
#pragma unroll
          for (int ks = 0; ks < 2; ++ks) { qraw[ks][0] = *(const v4u*)(qrow + 32 * ks); qraw[ks][1] = *(const v4u*)(qrow + 32 * ks + 64); } }
#pragma unroll 1
        for (int h = 0; h < NH; ++h) {
            int lane = F.lane; asm volatile("" : "+v"(lane));
            int tidv = F.tid; asm volatile("" : "+v"(tidv));
            const int r = lane & 15, g = lane >> 4;
            unsigned trb[8][2], rrb[4];
#pragma unroll
            for (int c = 0; c < 8; ++c) { trb[c][0] = tr_read_addr_16(lane, c, 0, 0); trb[c][1] = tr_read_addr_16(lane, c, 0, 1); }
#pragma unroll
            for (int ks = 0; ks < 4; ++ks) rrb[ks] = row_read_addr_16(lane, 0, ks);
            const float lg2 = __builtin_amdgcn_logf(1.f - __builtin_amdgcn_exp2f(-5.f - (float)h));
            __syncthreads();
            kv_store<false>(F, raw, tidv, n * CH, lg2);
            bf16x8 Qf[4];
            {
                const float pos = (float)(n * CH + 16 * w + r);
#pragma unroll
                for (int ks = 0; ks < 2; ++ks) {
                    const v4u q1 = qraw[ks][0], q2 = qraw[ks][1];
                    v4u o1, o2;
#pragma unroll
                    for (int q = 0; q < 4; ++q) {
                        const float i0 = __builtin_amdgcn_exp2f(-(float)(32 * ks + 8 * g + 2 * q) * LOG2_ROPE_OVER_64), i1 = __builtin_amdgcn_exp2f(-(float)(32 * ks + 8 * g + 2 * q + 1) * LOG2_ROPE_OVER_64);
                        float sn0, cs0, sn1, cs1; sincos_rev(pos * i0, sn0, cs0); sincos_rev(pos * i1, sn1, cs1);
                        const float a0 = bflo(q1[q]), a1 = bfhi(q1[q]), b0 = bflo(q2[q]), b1 = bfhi(q2[q]);
                        o1[q] = cvt_pk_bf16(a0 * cs0 - b0 * sn0, a1 * cs1 - b1 * sn1);
                        o2[q] = cvt_pk_bf16(a0 * sn0 + b0 * cs0, a1 * sn1 + b1 * cs1);
                    }
                    Qf[ks] = __builtin_bit_cast(bf16x8, o1); Qf[ks + 2] = __builtin_bit_cast(bf16x8, o2);
                }
            }
            __syncthreads();
            LAS unsigned char* Kimg = F.lds + MIX_K_OFF; LAS unsigned char* Vimg = F.lds + MIX_V_OFF; LAS unsigned char* Sst = F.lds + MIX_S_OFF + w * MIX_S_WAVE;
            const bf16* PV = (const bf16*)(P.out + (size_t)B * NH * NCH * (HD * HD)) + ((size_t)((b * NH + h) * NCH + n)) * (HD * HD);
            bf16 grv[8][4];
#pragma unroll
            for (int et = 0; et < 8; ++et)
#pragma unroll
                for (int q = 0; q < 4; ++q) grv[et][q] = P.PROJ[(size_t)(t0 + 16 * w + 4 * g + q) * INC + 2560 + h * HD + 16 * et + r];
            bf16x8 Pf[4][4];
#pragma unroll
            for (int et = 0; et < 4; ++et)
#pragma unroll
                for (int ks = 0; ks < 4; ++ks) Pf[et][ks] = *(const bf16x8*)(PV + (size_t)(16 * et + r) * HD + 32 * ks + 8 * g);
            if (h + 1 < NH) {
                kv_issue(raw, tidv, P.PROJ + (size_t)t0 * INC, h + 1);
                const bf16* qrow = P.PROJ + (size_t)(t0 + 16 * w + r) * INC + 1024 + (h + 1) * HD + 8 * g;
#pragma unroll
                for (int ks = 0; ks < 2; ++ks) { qraw[ks][0] = *(const v4u*)(qrow + 32 * ks); qraw[ks][1] = *(const v4u*)(qrow + 32 * ks + 64); }
            }
#pragma unroll 1
            for (int mt = 0; mt <= w; ++mt) {
                f32x4 sa = {0.f, 0.f, 0.f, 0.f};
#pragma unroll
                for (int ks = 0; ks < 4; ++ks) { const bf16x8 Kf = *(const LAS bf16x8*)(Kimg + rrb[ks] + 4096 * mt); sa = __builtin_amdgcn_mfma_f32_16x16x32_bf16(Qf[ks], Kf, sa, 0, 0, 0); }
#pragma unroll
                for (int q = 0; q < 4; ++q) {
                    const int dlt = (16 * w + 4 * g + q) - (16 * mt + r);
                    const float v = dlt >= 0 ? sa[q] * __builtin_amdgcn_exp2f((float)dlt * lg2) : 0.f;
                    *(LAS bf16*)(Sst + (4 * g + q) * MIX_S_STRIDE + (16 * mt + r) * 2) = f2bf(v);
                }
            }
            if ((w & 1) == 0) {
#pragma unroll
                for (int q = 0; q < 4; ++q) *(LAS bf16*)(Sst + (4 * g + q) * MIX_S_STRIDE + (16 * (w + 1) + r) * 2) = 0;
            }
            wave_lds_fence();
            f32x4 acc[8];
            float rsc[4];
#pragma unroll
            for (int q = 0; q < 4; ++q) rsc[q] = __builtin_amdgcn_exp2f((float)(16 * w + 4 * g + q + 1) * lg2);
#pragma unroll
            for (int hf = 0; hf < 2; ++hf) {
                if (hf == 1) {
#pragma unroll
                    for (int et = 0; et < 4; ++et)
#pragma unroll
                        for (int ks = 0; ks < 4; ++ks) Pf[et][ks] = *(const bf16x8*)(PV + (size_t)(16 * (et + 4) + r) * HD + 32 * ks + 8 * g);
                }
#pragma unroll
                for (int et = 0; et < 4; ++et) {
                    f32x4 a = {0.f, 0.f, 0.f, 0.f};
#pragma unroll
                    for (int ks = 0; ks < 4; ++ks) a = __builtin_amdgcn_mfma_f32_16x16x32_bf16(Qf[ks], Pf[et][ks], a, 0, 0, 0);
#pragma unroll
                    for (int q = 0; q < 4; ++q) a[q] *= rsc[q];
                    acc[4 * hf + et] = a;
                }
            }
#pragma unroll 1
            for (int ks = 0; ks <= (w >> 1); ++ks) {
                const bf16x8 Sf = *(const LAS bf16x8*)(Sst + r * MIX_S_STRIDE + (32 * ks + 8 * g) * 2);
#pragma unroll
                for (int et = 0; et < 8; ++et) { const bf16x8 Vf = tr_frag2(Vimg + trb[et][0] + 8192 * ks, Vimg + trb[et][1] + 8192 * ks); acc[et] = __builtin_amdgcn_mfma_f32_16x16x32_bf16(Sf, Vf, acc[et], 0, 0, 0); }
            }
            float mu[4], rs[4];
#pragma unroll
            for (int q = 0; q < 4; ++q) {
                float s = 0.f;
#pragma unroll
                for (int et = 0; et < 8; ++et) s += acc[et][q];
                s += __shfl_xor(s, 1); s += __shfl_xor(s, 2); s += __shfl_xor(s, 4); s += __shfl_xor(s, 8);
                const float m = s * (1.f / 128.f); float v = 0.f;
#pragma unroll
                for (int et = 0; et < 8; ++et) { const float d = acc[et][q] - m; v += d * d; }
                v += __shfl_xor(v, 1); v += __shfl_xor(v, 2); v += __shfl_xor(v, 4); v += __shfl_xor(v, 8);
                mu[q] = m; rs[q] = 1.0f / sqrtf(v * (1.f / 128.f) + EPS);
            }
#pragma unroll
            for (int et = 0; et < 8; ++et)
#pragma unroll
                for (int q = 0; q < 4; ++q) {
                    const size_t tok = (size_t)(t0 + 16 * w + 4 * g + q);
                    const float gr = bf2f(grv[et][q]);
                    P.MIX[tok * D + DL + h * HD + 16 * et + r] = f2bf(gr * fast_sigmoid(gr) * (acc[et][q] - mu[q]) * rs[q]);
                }
        }
    }
}
__global__ void __launch_bounds__(NTHR, 2) mk_fwd(Args args) {
    extern __shared__ __attribute__((aligned(16))) unsigned char lds_raw[];
    Frame F;
    F.lds = (LAS unsigned char*)lds_raw;
    F.MISC = (volatile LAS unsigned*)(F.lds + LDSCTL_OFF);
    F.tid = threadIdx.x; F.lane = F.tid & 63; F.wave = __builtin_amdgcn_readfirstlane(F.tid >> 6);
    F.G = gridDim.x; { const int bx = blockIdx.x; F.vcu = (F.G % 8 == 0) ? (bx % 8) * (F.G / 8) + bx / 8 : bx; }
    F.ctl = (gu32*)(args.ws + WS_CTL);
    Ptrs P; make_ptrs(P, args);
    for (int u = F.tid; u < 256; u += NTHR) ((LAS unsigned*)(F.lds + LDSCTL_OFF))[u] = 0u;
    __syncthreads();
    XcdBarrier bar = xcd_barrier_post((unsigned*)(F.ctl + CW_BAR) + args.ph_hi * XCD_BAR_WORDS, F.MISC + 8);
    const int lo = args.ph_lo, hi = args.ph_hi;
#define IN(k) (lo <= (k) && (k) < hi)
#define SEAM(k) do { if (IN(k) && IN((k) + 1)) xcd_barrier(bar); } while (0)
    if (IN(0)) { p0_prologue(F, P); }
    SEAM(0);
    if (IN(1)) {
        pg8::PlainSched S; S.init(P.XB, P.W_IN, T, INC, D, F.G, (int)blockIdx.x);
        pg8::EpiRowScaleBf16 E{P.PROJ, INC, P.rstd0};
        pg8::gemm_phase(F.lds + RING_OFF, S, E);
    }
    SEAM(1);
    if (IN(2)) p2_mix_summaries(F, P);
    SEAM(2);
    if (IN(3)) p3_scans(F, P);
    SEAM(3);
    if (IN(4)) p4_mix_outputs(F, P);
    SEAM(4);
    if (IN(5)) {
        pg8::PlainSched S; S.init(P.MIX, P.W_OUT, T, D, D, F.G, (int)blockIdx.x);
        pg8::EpiPlainBf16 E{P.D1, D};
        pg8::gemm_phase(F.lds + RING_OFF, S, E);
    }
    SEAM(5);
    if (IN(6)) p6_route(F, P);
    SEAM(6);
    if (IN(7)) p7_lists(F, P);
    SEAM(7);
    if (IN(8)) moe_phase<0>(F, P, lo == 8);
    SEAM(8);
    if (IN(9)) moe_phase<1>(F, P, lo == 9);
    SEAM(9);
    if (IN(10)) p10_combine(F, P);
    SEAM(10);
    if (IN(11)) {
        pg8::PlainSched S; S.init((const bf16*)P.X1B, P.W_PG, T, D, D / 2, F.G, (int)blockIdx.x);
        pg8::EpiGateBf16 E{P.GATE, D, P.rstd2, P.b_pg, 1.f / (PLE_SX2 * PLE_SWG)};
        pg8::gemm_phase<pg8::EpiGateBf16, pg8::PlainSched, true>(F.lds + RING_OFF, S, E);
    }
    if (IN(12)) {
        pg8::PlainSched S; S.init(P.PB, P.W_PP, T, D, PLE, F.G, (int)blockIdx.x);
        pg8::EpiPlainBf16 E{P.PP, D};
        pg8::gemm_phase(F.lds + RING_OFF, S, E);
    }
    SEAM(12);
    if (IN(13)) p13_final(F, P);
#undef IN
#undef SEAM
}

static int mk_grid = 0;
static void mk_launch(void* const* d_in, void* d_out, void* d_ws, int lo, int hi, hipStream_t stream) {
    if (mk_grid == 0) {
        int dev = 0, cus = 0;
        if (hipGetDevice(&dev) != hipSuccess || hipDeviceGetAttribute(&cus, hipDeviceAttributeMultiprocessorCount, dev) != hipSuccess) { mk_grid = -1; return; }
        if (hipFuncSetAttribute((const void*)mk_fwd, hipFuncAttributeMaxDynamicSharedMemorySize, LDS_BYTES) != hipSuccess) { fprintf(stderr, "mk: hipFuncSetAttribute failed\n"); mk_grid = -1; return; }
        int per_cu = 0;
        if (hipOccupancyMaxActiveBlocksPerMultiprocessor(&per_cu, (const void*)mk_fwd, NTHR, LDS_BYTES) != hipSuccess || per_cu < 1) { fprintf(stderr, "mk: occupancy query says %d\n", per_cu); (void)hipGetLastError(); }
        mk_grid = cus;
    }
    if (mk_grid < 0) return;
    Args a; memset(&a, 0, sizeof a);
    for (int i = 0; i < 25; ++i) a.in[i] = (const float*)d_in[i];
    a.out = (float*)d_out; a.ws = (unsigned char*)d_ws; a.ph_lo = lo; a.ph_hi = hi;
    hipLaunchKernelGGL(mk_fwd, dim3(mk_grid), dim3(NTHR), LDS_BYTES, stream, a);
}
extern "C" void kernel_launch(void* const* d_in, const int* in_sizes, int n_in, void* d_out, int out_size, void* d_ws, size_t ws_size, hipStream_t stream) {
    if (n_in != 25 || ws_size < WS_END || out_size != T * D) { fprintf(stderr, "kernel_launch: n_in %d, workspace %zu (need %zu), out_size %d: nothing launched\n", n_in, ws_size, (size_t)WS_END, out_size); return; }
    (void)hipMemsetAsync((unsigned char*)d_ws + WS_CTL, 0, 1 * MiB, stream);
    mk_launch(d_in, d_out, d_ws, 0, 14, stream);
}
```

```cpp
#include <hip/hip_runtime.h>
#include <stdint.h>
#include <stdio.h>
#include <string.h>

typedef unsigned short bf16;
namespace cfg {
constexpr int D = 1024, B = 8, S = 4096, T = B * S, PLE = 256, DL = 512, DR = 512, NH = 4, HD = 128, INC = 3072;
constexpr int NE = 64, DE = 512, NG = 8, EPG = 8, CH = 128, NCH = S / CH;
constexpr float EPS = 1e-6f;
constexpr float MOE_SX = 8.f, MOE_SW1 = 64.f, MOE_SA = 8.f, MOE_SW2 = 32.f;
constexpr float PLE_SX2 = 8.f, PLE_SWG = 64.f;
constexpr size_t MiB = 1u << 20;
constexpr size_t WS_CTL = 0;
constexpr size_t WS_RSTD0 = 1 * MiB, WS_RSTD1 = WS_RSTD0 + 128 * 1024, WS_RSTD2 = WS_RSTD1 + 128 * 1024;
constexpr size_t WS_EID = 2 * MiB, WS_EW = WS_EID + 256 * 1024, WS_LIST = WS_EW + 256 * 1024, WS_CNT = WS_LIST + 256 * 1024;
constexpr size_t WS_LOGITS = 3 * MiB;
constexpr size_t WS_LRU = 13 * MiB;
constexpr size_t WS_WIN = 16 * MiB, WS_WOUT = 22 * MiB, WS_WPG = 24 * MiB, WS_WPP = 26 * MiB, WS_WRT = 26 * MiB + 512 * 1024, WS_LRUW = 27 * MiB;
constexpr size_t WS_W13 = 28 * MiB, WS_W2 = 156 * MiB, WS_PB = 220 * MiB;
constexpr size_t WS_R64 = 236 * MiB;
constexpr size_t WS_PROJ = 300 * MiB;
constexpr size_t WS_D1 = 300 * MiB, WS_X1B = 364 * MiB, WS_Y = 428 * MiB, WS_PP = 428 * MiB;
constexpr size_t WS_END = 556 * MiB;
}
using namespace cfg;

__device__ __forceinline__ float bf2f(bf16 v) { return __uint_as_float((unsigned)v << 16); }
__device__ __forceinline__ bf16 f2bf(float f) { unsigned u = __float_as_uint(f); return (bf16)((u + 0x7fffu + ((u >> 16) & 1u)) >> 16); }
__device__ __forceinline__ float ldv(const float* p, size_t i) { return p[i]; }
__device__ __forceinline__ float ldv(const bf16* p, size_t i) { return bf2f(p[i]); }
__device__ __forceinline__ void stv(float* p, size_t i, float v) { p[i] = v; }
__device__ __forceinline__ void stv(bf16* p, size_t i, float v) { p[i] = f2bf(v); }

#define GAS __attribute__((address_space(1)))
#define LAS __attribute__((address_space(3)))
typedef unsigned v4u __attribute__((ext_vector_type(4)));
typedef unsigned v2u __attribute__((ext_vector_type(2)));
typedef float f32x4 __attribute__((ext_vector_type(4)));
typedef float f32x2 __attribute__((ext_vector_type(2)));
typedef short bf16x8 __attribute__((ext_vector_type(8)));
typedef short bf16x4 __attribute__((ext_vector_type(4)));
typedef GAS unsigned gu32;
#define RLX_AGENT __ATOMIC_RELAXED, __HIP_MEMORY_SCOPE_AGENT
#define LDS_WAIT() asm volatile("s_waitcnt lgkmcnt(0)" ::: "memory")
#define VM_WAIT() asm volatile("s_waitcnt vmcnt(0)" ::: "memory")
__device__ __forceinline__ unsigned pk2(float lo, float hi) { return (unsigned)f2bf(lo) | ((unsigned)f2bf(hi) << 16); }
typedef __bf16 hwbf16x2 __attribute__((ext_vector_type(2)));
__device__ __forceinline__ unsigned cvt_pk_bf16(float lo, float hi) { f32x2 v = {lo, hi}; hwbf16x2 b = __builtin_convertvector(v, hwbf16x2); return __builtin_bit_cast(unsigned, b); }
__device__ __forceinline__ float bflo(unsigned w) { return __uint_as_float(w << 16); }
__device__ __forceinline__ float bfhi(unsigned w) { return __uint_as_float(w & 0xffff0000u); }
__device__ __forceinline__ float fast_sigmoid(float x) { return __builtin_amdgcn_rcpf(1.f + __builtin_amdgcn_exp2f(-1.4426950408889634f * x)); }

#define XB_TMO      128
#define XB_XCNT(j)  (256  + 64 * (j))
#define XB_XSUB(j)  (1280 + 64 * (j))
#define XB_XGEN(j)  (2304 + 64 * (j))
#define XB_TOP      3328
#define XB_TOPGEN   3392
#define XCD_BAR_WORDS 3456
#define XB_SPIN_CAP (1u << 18)
__device__ __forceinline__ unsigned xb_ld(unsigned* p)              { return __hip_atomic_load(p, __ATOMIC_RELAXED, __HIP_MEMORY_SCOPE_AGENT); }
__device__ __forceinline__ unsigned xb_add(unsigned* p, unsigned v) { return __hip_atomic_fetch_add(p, v, __ATOMIC_RELAXED, __HIP_MEMORY_SCOPE_AGENT); }
__device__ __forceinline__ unsigned xb_xcc_id() { return (unsigned)__builtin_amdgcn_s_getreg((3 << 11) | 20) & 0xFu; }
#define XB_SPIN(cond, bar) do { unsigned _sp = 0; while (cond) { __builtin_amdgcn_s_sleep(1); \
    if ((++_sp & 255u) == 0u) { if (xb_ld(&(bar)[XB_TMO])) break; if (_sp > XB_SPIN_CAP) { atomicAdd(&(bar)[XB_TMO], 1u); break; } } } } while (0)
struct XcdBarrier { unsigned* bar; unsigned x; volatile LAS unsigned* st; };
__device__ __forceinline__ XcdBarrier xcd_barrier_post(unsigned* bar, volatile LAS unsigned* st) {
    XcdBarrier b; b.bar = bar; b.x = xb_xcc_id(); b.st = st;
    if (threadIdx.x == 0) (void)xb_add(&bar[XB_XCNT(b.x)], 1u);
    return b;
}
__device__ __forceinline__ void xcd_barrier_complete(unsigned* bar, unsigned x, unsigned& nloc, unsigned& nx) {
    const unsigned G = gridDim.x * gridDim.y * gridDim.z;
    unsigned sum, cnt, mine, sp = 0u;
    for (;;) {
        sum = 0u; cnt = 0u; mine = 0u;
#pragma unroll
        for (unsigned j = 0; j < 16; ++j) { const unsigned c = xb_ld(&bar[XB_XCNT(j)]); sum += c; cnt += (c > 0u) ? 1u : 0u; mine = (j == x) ? c : mine; }
        if (sum == G) break;
        __builtin_amdgcn_s_sleep(1);
        if ((++sp & 255u) == 0u) { if (xb_ld(&bar[XB_TMO])) break; if (sp > XB_SPIN_CAP) { atomicAdd(&bar[XB_TMO], 1u); break; } }
    }
    nloc = mine > 0u ? mine : 1u; nx = cnt > 0u ? cnt : 1u;
}
__device__ __forceinline__ void xcd_barrier(const XcdBarrier& b) {
    asm volatile("s_waitcnt vmcnt(0)" ::: "memory");
    __syncthreads();
    if (threadIdx.x == 0) {
        unsigned* bar = b.bar;
        __builtin_amdgcn_s_waitcnt(0);
        unsigned nloc = b.st[0], nx = b.st[1];
        if (nloc == 0u) { xcd_barrier_complete(bar, b.x, nloc, nx); b.st[0] = nloc; b.st[1] = nx; }
        const unsigned old = xb_add(&bar[XB_XSUB(b.x)], 1u);
        const unsigned gen = old / nloc;
        if (old + 1u == (gen + 1u) * nloc) {
            __builtin_amdgcn_fence(__ATOMIC_RELEASE, "agent");
            asm volatile("s_waitcnt vmcnt(0)" ::: "memory");
            const unsigned og = xb_add(&bar[XB_TOP], 1u);
            const unsigned tg = og / nx;
            if (og + 1u == (tg + 1u) * nx) xb_add(&bar[XB_TOPGEN], 1u);
            else XB_SPIN(xb_ld(&bar[XB_TOPGEN]) == tg, bar);
            __builtin_amdgcn_fence(__ATOMIC_ACQUIRE, "agent");
            xb_add(&bar[XB_XGEN(b.x)], 1u);
            asm volatile("s_waitcnt vmcnt(0)" ::: "memory");
        } else {
            XB_SPIN(xb_ld(&bar[XB_XGEN(b.x)]) == gen, bar);
            __builtin_amdgcn_fence(__ATOMIC_ACQUIRE, "agent");
            asm volatile("s_waitcnt vmcnt(0)" ::: "memory");
        }
    }
    __syncthreads();
}

constexpr int NWAVES = 8, NTHR = NWAVES * 64;
constexpr int RING_OFF = 0, RING_BYTES = 131072;
constexpr int LDSCTL_OFF = RING_BYTES;
constexpr int UTAB_OFF = LDSCTL_OFF + 1024;
constexpr int MAXU = 6;
constexpr int UTABF_OFF = UTAB_OFF + MAXU * 1024;
constexpr int SCHED_OFF = UTABF_OFF + MAXU * 1024;
constexpr int LDS_BYTES = SCHED_OFF + 2048;
static_assert(LDS_BYTES <= 160 * 1024 && LDS_BYTES > 80 * 1024, "LDS map");
constexpr int CW_TMO = 0, CW_BAR = 4096;

namespace pg8 {
constexpr int BM = 256, BK = 64, HALF = 128, HTB = HALF * BK * 2, STAGE_BYTES = 8 * HTB;
__host__ __device__ __forceinline__ int lds_byte(int r, int c) { const int st = (r >> 4) * 2 + (c >> 5), rr = r & 15, cc = c & 31, ob = rr * 64 + cc * 2; return st * 1024 + (ob ^ (((ob >> 9) & 1) << 5)); }
__host__ __device__ __forceinline__ void stage_rc(int b, int& R, int& C) { const int st = b / 1024, sb = b % 1024, swz = sb ^ (((sb >> 9) & 1) << 5); R = (st >> 1) * 16 + swz / 64; C = (st & 1) * 32 + (swz % 64) / 2; }
__host__ __device__ __forceinline__ int perm32(int rho) { const int n = rho >> 4, i = rho & 15; return 8 * (i >> 2) + 4 * n + (i & 3); }

struct Unit { int pm, pn, e, rows, slot0, ui; };

struct PlainSched {
    static constexpr bool GATHER = false;
    const bf16* A; const bf16* Bt; int K; int nM, nN, nwg, G, c;
    __device__ void init(const bf16* A_, const bf16* Bt_, int M, int N, int K_, int G_, int c_) { A = A_; Bt = Bt_; K = K_; nM = M / BM; nN = N / BM; nwg = nM * nN; G = G_; c = c_; }
    __device__ __forceinline__ bool next(int i, Unit& u) const {
        const long L = (long)i * G + c; if (L >= nwg) return false;
        int wgid = (int)L; { const int q = nwg / 8, r = nwg % 8, xcd = wgid % 8, off = wgid / 8; wgid = (xcd < r ? xcd * (q + 1) : r * (q + 1) + (xcd - r) * q) + off; }
        const int nig = 8 * nN, gid = wgid / nig, fm = gid * 8, gsz = (nM - fm) < 8 ? (nM - fm) : 8;
        u.pm = fm + ((wgid % nig) % gsz); u.pn = (wgid % nig) / gsz; u.e = 0; u.rows = 256; u.slot0 = 0; u.ui = i; return true;
    }
    __device__ __forceinline__ const char* a_base(const Unit& u) const { return (const char*)A + (size_t)u.pm * (size_t)(BM * 2) * K; }
    __device__ __forceinline__ const char* b_base(const Unit& u) const { return (const char*)Bt + (size_t)u.pn * (size_t)(BM * 2) * K; }
    __device__ __forceinline__ unsigned a_rowoff(const Unit&, int r) const { return (unsigned)r * (unsigned)K * 2u; }
};

typedef long i64x2 __attribute__((ext_vector_type(2)));
template <class Epi, class Sched, bool FP8 = false>
__device__ __forceinline__ void gemm_phase(LAS unsigned char* lds, const Sched& S, const Epi& E) {
    const int tid = threadIdx.x, wid = __builtin_amdgcn_readfirstlane(tid >> 6), lane = tid & 63, wr = wid >> 2, wc = wid & 3, fr = lane & 15, fq = lane >> 4;
    const int K = S.K, nt = K / BK;
    int Rr[2], Cc[2]; unsigned voffB[2];
#pragma unroll
    for (int i = 0; i < 2; ++i) { stage_rc(tid * 16 + i * 8192, Rr[i], Cc[i]); const int Rb = (Rr[i] & ~31) + perm32(Rr[i] & 31); voffB[i] = (unsigned)(Rb * K + Cc[i]) * 2u; }
    const size_t kstep = (size_t)(BK * 2);
    const size_t hstep = (size_t)HALF * K * 2;
    const unsigned ldsw = (unsigned)wid * 1024u;
    const int aoff = lds_byte(wr * 64 + fr, fq * 8), boff = lds_byte(wc * 32 + fr, fq * 8);
#define PG8_SA(b, h) (((b) * 2 + (h)) * HTB)
#define PG8_SB(b, h) ((4 + (b) * 2 + (h)) * HTB)
#define PG8_STAGE(bufoff, gbase, voff) do { _Pragma("unroll") for (int _i = 0; _i < 2; ++_i) \
        __builtin_amdgcn_global_load_lds((const unsigned*)((const char*)(gbase) + (voff)[_i]), (LAS unsigned*)(lds + (bufoff) + ldsw + _i * 8192), 16, 0, 0); } while (0)
#define PG8_LDA(dst, b, h) do { _Pragma("unroll") for (int m = 0; m < 4; ++m) _Pragma("unroll") for (int k = 0; k < 2; ++k) dst[m][k] = *(const LAS bf16x8*)(lds + PG8_SA(b, h) + aoff + m * 2048 + k * 1024); } while (0)
#define PG8_LDB(dst, b, h) do { _Pragma("unroll") for (int n = 0; n < 2; ++n) _Pragma("unroll") for (int k = 0; k < 2; ++k) dst[n][k] = *(const LAS bf16x8*)(lds + PG8_SB(b, h) + boff + n * 2048 + k * 1024); } while (0)
#define PG8_MMA(ai, bj, At, Bt) do { __builtin_amdgcn_s_setprio(1); _Pragma("unroll") for (int m = 0; m < 4; ++m) _Pragma("unroll") for (int n = 0; n < 2; ++n) _Pragma("unroll") for (int k = 0; k < 2; ++k) { \
        if constexpr (FP8) { const i64x2 a8_ = __builtin_bit_cast(i64x2, At[m][k]), b8_ = __builtin_bit_cast(i64x2, Bt[n][k]); \
            acc[ai][bj][m][n] = __builtin_amdgcn_mfma_f32_16x16x32_fp8_fp8(b8_[0], a8_[0], acc[ai][bj][m][n], 0, 0, 0); acc[ai][bj][m][n] = __builtin_amdgcn_mfma_f32_16x16x32_fp8_fp8(b8_[1], a8_[1], acc[ai][bj][m][n], 0, 0, 0); } \
        else acc[ai][bj][m][n] = __builtin_amdgcn_mfma_f32_16x16x32_bf16(Bt[n][k], At[m][k], acc[ai][bj][m][n], 0, 0, 0); } __builtin_amdgcn_s_setprio(0); } while (0)
#define PG8_WAIT_V(n) asm volatile("s_waitcnt vmcnt(" #n ")" ::: "memory")
#define PG8_WAIT_L(n) asm volatile("s_waitcnt lgkmcnt(" #n ")" ::: "memory")
#define PG8_BAR __builtin_amdgcn_s_barrier()
#define PG8_SCHED __builtin_amdgcn_sched_barrier(0)
#define PG8_VOFF(dst, u) do { _Pragma("unroll") for (int _h = 0; _h < 2; ++_h) _Pragma("unroll") for (int _i = 0; _i < 2; ++_i) dst[_h][_i] = S.a_rowoff(u, _h * HALF + Rr[_i]) + (unsigned)Cc[_i] * 2u; } while (0)
    Unit cur, nxt; int ui = 0;
    if (!S.next(0, cur)) return;
    f32x4 acc[2][2][4][2];
#pragma unroll
    for (int a = 0; a < 2; ++a)
#pragma unroll
        for (int b = 0; b < 2; ++b)
#pragma unroll
            for (int m = 0; m < 4; ++m)
#pragma unroll
                for (int n = 0; n < 2; ++n) acc[a][b][m][n] = (f32x4){0.f, 0.f, 0.f, 0.f};
    bf16x8 At[4][2], B0[2][2], B1[2][2];
    unsigned va[2][2], nva[2][2];
    PG8_VOFF(va, cur);
    const char* cA = S.a_base(cur); const char* cB = S.b_base(cur);
    PG8_STAGE(PG8_SB(0, 0), cB, voffB); PG8_STAGE(PG8_SB(0, 1), cB + hstep, voffB); PG8_STAGE(PG8_SA(0, 0), cA, va[0]); PG8_STAGE(PG8_SA(0, 1), cA, va[1]);
    if (wr == 1) PG8_BAR;
    PG8_WAIT_V(2); PG8_BAR;
    PG8_STAGE(PG8_SB(1, 0), cB + kstep, voffB); PG8_STAGE(PG8_SA(1, 0), cA + kstep, va[0]); PG8_STAGE(PG8_SB(1, 1), cB + hstep + kstep, voffB);
    PG8_WAIT_V(6); PG8_BAR;
    for (;;) {
        const bool has_next = S.next(ui + 1, nxt);
        const bool mma0 = cur.rows > 64 * wr, mma1 = cur.rows > HALF + 64 * wr;
        const char* nA = has_next ? S.a_base(nxt) : cA; const char* nB = has_next ? S.b_base(nxt) : cB;
        if (has_next) { PG8_VOFF(nva, nxt); } else {
#pragma unroll
            for (int h = 0; h < 2; ++h)
#pragma unroll
                for (int i = 0; i < 2; ++i) nva[h][i] = va[h][i]; }
        for (int t = 0; t < nt; t += 2) {
            const bool last = (t == nt - 2);
            const char* a1 = cA + (size_t)(t + 1) * kstep;
            const char* a2 = last ? nA : cA + (size_t)(t + 2) * kstep; const char* b2 = last ? nB : cB + (size_t)(t + 2) * kstep;
            const char* a3 = a2 + kstep; const char* b3 = b2 + kstep;
            unsigned v2[2][2];
#pragma unroll
            for (int h = 0; h < 2; ++h)
#pragma unroll
                for (int i = 0; i < 2; ++i) v2[h][i] = last ? nva[h][i] : va[h][i];
            PG8_LDB(B0, 0, 0); PG8_LDB(B1, 0, 1); PG8_SCHED; PG8_LDA(At, 0, 0); PG8_STAGE(PG8_SA(1, 1), a1, va[1]);
            PG8_WAIT_V(8); PG8_WAIT_L(0); PG8_BAR; if (mma0) { PG8_MMA(0, 0, At, B0); PG8_MMA(0, 1, At, B1); } PG8_BAR; PG8_SCHED;
            PG8_LDA(At, 0, 1); PG8_STAGE(PG8_SB(0, 0), b2, voffB); PG8_STAGE(PG8_SB(0, 1), b2 + hstep, voffB); PG8_STAGE(PG8_SA(0, 0), a2, v2[0]);
            PG8_WAIT_V(8); PG8_WAIT_L(0); PG8_BAR; if (mma1) { PG8_MMA(1, 0, At, B0); PG8_MMA(1, 1, At, B1); } PG8_BAR; PG8_SCHED;
            PG8_LDB(B0, 1, 0); PG8_LDB(B1, 1, 1); PG8_SCHED; PG8_LDA(At, 1, 0); PG8_STAGE(PG8_SA(0, 1), a2, v2[1]);
            PG8_WAIT_V(8); PG8_WAIT_L(0); PG8_BAR; if (mma0) { PG8_MMA(0, 0, At, B0); PG8_MMA(0, 1, At, B1); } PG8_BAR; PG8_SCHED;
            PG8_LDA(At, 1, 1); PG8_STAGE(PG8_SB(1, 0), b3, voffB); PG8_STAGE(PG8_SB(1, 1), b3 + hstep, voffB); PG8_STAGE(PG8_SA(1, 0), a3, v2[0]);
            PG8_WAIT_V(8); PG8_WAIT_L(0); PG8_BAR; if (mma1) { PG8_MMA(1, 0, At, B0); PG8_MMA(1, 1, At, B1); } PG8_BAR; PG8_SCHED;
        }
        if (wr == 0) PG8_BAR;
        E(acc, cur, wr, wc, fr, fq);
        if (!has_next) break;
#pragma unroll
        for (int a = 0; a < 2; ++a)
#pragma unroll
            for (int b = 0; b < 2; ++b)
#pragma unroll
                for (int m = 0; m < 4; ++m)
#pragma unroll
                    for (int n = 0; n < 2; ++n) acc[a][b][m][n] = (f32x4){0.f, 0.f, 0.f, 0.f};
        cur = nxt; cA = nA; cB = nB; ++ui;
#pragma unroll
        for (int h = 0; h < 2; ++h)
#pragma unroll
            for (int i = 0; i < 2; ++i) va[h][i] = nva[h][i];
        if (wr == 1) PG8_BAR;
    }
    PG8_WAIT_V(0);
    PG8_BAR;
#undef PG8_SA
#undef PG8_SB
#undef PG8_STAGE
#undef PG8_LDA
#undef PG8_LDB
#undef PG8_MMA
#undef PG8_WAIT_V
#undef PG8_WAIT_L
#undef PG8_BAR
#undef PG8_SCHED
#undef PG8_VOFF
}

struct EpiRowScaleBf16 {
    bf16* O; int ldc; const float* rs;
    __device__ __forceinline__ void operator()(const f32x4 (&acc)[2][2][4][2], const Unit& u, int wr, int wc, int fr, int fq) const {
        const int row0 = u.pm * BM + wr * 64 + fr, col0 = u.pn * BM + wc * 32 + 8 * fq;
        float sc[2][4];
#pragma unroll
        for (int ai = 0; ai < 2; ++ai)
#pragma unroll
            for (int m = 0; m < 4; ++m) sc[ai][m] = rs[row0 + ai * HALF + m * 16];
#pragma unroll
        for (int ai = 0; ai < 2; ++ai)
#pragma unroll
            for (int m = 0; m < 4; ++m) { const int row = row0 + ai * HALF + m * 16; const float s = sc[ai][m]; bf16* rowp = O + (size_t)row * ldc + col0;
#pragma unroll
                for (int bj = 0; bj < 2; ++bj) { const f32x4 v0 = acc[ai][bj][m][0] * s, v1 = acc[ai][bj][m][1] * s;
                    v4u w; w.x = cvt_pk_bf16(v0[0], v0[1]); w.y = cvt_pk_bf16(v0[2], v0[3]); w.z = cvt_pk_bf16(v1[0], v1[1]); w.w = cvt_pk_bf16(v1[2], v1[3]);
                    *(v4u*)(rowp + bj * HALF) = w; } }
    }
};
struct EpiPlainBf16 {
    bf16* O; int ldc;
    __device__ __forceinline__ void operator()(const f32x4 (&acc)[2][2][4][2], const Unit& u, int wr, int wc, int fr, int fq) const {
        const int row0 = u.pm * BM + wr * 64 + fr, col0 = u.pn * BM + wc * 32 + 8 * fq;
#pragma unroll
        for (int ai = 0; ai < 2; ++ai)
#pragma unroll
            for (int m = 0; m < 4; ++m) { const int row = row0 + ai * HALF + m * 16; bf16* rowp = O + (size_t)row * ldc + col0;
#pragma unroll
                for (int bj = 0; bj < 2; ++bj) { const f32x4 v0 = acc[ai][bj][m][0], v1 = acc[ai][bj][m][1];
                    v4u w; w.x = cvt_pk_bf16(v0[0], v0[1]); w.y = cvt_pk_bf16(v0[2], v0[3]); w.z = cvt_pk_bf16(v1[0], v1[1]); w.w = cvt_pk_bf16(v1[2], v1[3]);
                    *(v4u*)(rowp + bj * HALF) = w; } }
    }
};
struct EpiGateBf16 {
    bf16* O; int ldc; const float* rs; const float* bias; float osc;
    __device__ __forceinline__ void operator()(const f32x4 (&acc)[2][2][4][2], const Unit& u, int wr, int wc, int fr, int fq) const {
        const int row0 = u.pm * BM + wr * 64 + fr, col0 = u.pn * BM + wc * 32 + 8 * fq;
        float sc[2][4]; f32x4 bv[2][2];
#pragma unroll
        for (int ai = 0; ai < 2; ++ai)
#pragma unroll
            for (int m = 0; m < 4; ++m) sc[ai][m] = rs[row0 + ai * HALF + m * 16] * osc;
#pragma unroll
        for (int bj = 0; bj < 2; ++bj)
#pragma unroll
            for (int n = 0; n < 2; ++n) bv[bj][n] = *(const f32x4*)(bias + col0 + bj * HALF + 4 * n);
#pragma unroll
        for (int ai = 0; ai < 2; ++ai)
#pragma unroll
            for (int m = 0; m < 4; ++m) { const int row = row0 + ai * HALF + m * 16; const float s = sc[ai][m]; bf16* rowp = O + (size_t)row * ldc + col0;
#pragma unroll
                for (int bj = 0; bj < 2; ++bj) { f32x4 v0 = acc[ai][bj][m][0] * s + bv[bj][0], v1 = acc[ai][bj][m][1] * s + bv[bj][1];
#pragma unroll
                    for (int q = 0; q < 4; ++q) { v0[q] = fast_sigmoid(v0[q]); v1[q] = fast_sigmoid(v1[q]); }
                    v4u w; w.x = cvt_pk_bf16(v0[0], v0[1]); w.y = cvt_pk_bf16(v0[2], v0[3]); w.z = cvt_pk_bf16(v1[0], v1[1]); w.w = cvt_pk_bf16(v1[2], v1[3]);
                    *(v4u*)(rowp + bj * HALF) = w; } }
    }
};
}

struct Args { const float* in[25]; float* out; unsigned char* ws; int ph_lo, ph_hi; };

struct Frame {
    LAS unsigned char* lds; volatile LAS unsigned* MISC; gu32* ctl; int tid, lane, wave, vcu, G;
};
__device__ __forceinline__ float wave_sum(float v) {
#pragma unroll
    for (int o = 1; o < 64; o <<= 1) v += __shfl_xor(v, o);
    return v;
}
template <int RM, bool HAS_CS>
__device__ __forceinline__ void p0_transpose_item(const float* __restrict__ W, int K, int N, bf16* __restrict__ WT, int row_off, const float* __restrict__ cs, LAS float* scr, int item, int lane) {
    const int nblk = N / 32, kb = item / nblk, nb = item % nblk, k0 = 64 * kb, n0 = 32 * nb;
    const int c = lane & 7;
    f32x4 s0 = {1.f, 1.f, 1.f, 1.f}, s1 = {1.f, 1.f, 1.f, 1.f};
    if (HAS_CS) { s0 = *(const f32x4*)(cs + k0 + 8 * c); s1 = *(const f32x4*)(cs + k0 + 8 * c + 4); }
#pragma unroll 8
    for (int i = 0; i < 32; ++i) { const int kk = 2 * i + (lane >> 5); scr[kk * 33 + (lane & 31)] = W[(size_t)(k0 + kk) * N + n0 + (lane & 31)]; }
    LDS_WAIT(); asm volatile("" ::: "memory");
#pragma unroll
    for (int j = 0; j < 4; ++j) { const int n = (lane >> 3) + 8 * j; const LAS float* s = scr + (8 * c) * 33 + n;
        v4u o; o.x = pk2(s[0 * 33] * s0.x, s[1 * 33] * s0.y); o.y = pk2(s[2 * 33] * s0.z, s[3 * 33] * s0.w); o.z = pk2(s[4 * 33] * s1.x, s[5 * 33] * s1.y); o.w = pk2(s[6 * 33] * s1.z, s[7 * 33] * s1.w);
        const int nn = n0 + n; const int orow = RM == 0 ? row_off + nn : (row_off + 8 * (nn >> 2) + (nn & 3) + (RM == 2 ? 4 : 0));
        *(GAS v4u*)(WT + (size_t)orow * K + k0 + 8 * c) = o; }
    LDS_WAIT(); asm volatile("" ::: "memory");
}

__device__ __forceinline__ unsigned pk4_fp8(float v0, float v1, float v2, float v3) {
    v0 = __builtin_amdgcn_fmed3f(v0, -448.f, 448.f); v1 = __builtin_amdgcn_fmed3f(v1, -448.f, 448.f); v2 = __builtin_amdgcn_fmed3f(v2, -448.f, 448.f); v3 = __builtin_amdgcn_fmed3f(v3, -448.f, 448.f);
    int w = 0; w = __builtin_amdgcn_cvt_pk_fp8_f32(v0, v1, w, false); w = __builtin_amdgcn_cvt_pk_fp8_f32(v2, v3, w, true); return (unsigned)w;
}
template <int RM, bool HAS_CS>
__device__ __forceinline__ void p0_transpose_item_f8(const float* __restrict__ W, int K, int N, unsigned char* __restrict__ WT, const float* __restrict__ cs, float scale, LAS float* scr, int item, int lane) {
    const int nblk = N / 32, kb = item / nblk, nb = item % nblk, k0 = 64 * kb, n0 = 32 * nb;
    const int n = lane & 31, kq = lane >> 5;
#pragma unroll 8
    for (int i = 0; i < 32; ++i) { const int kk = 2 * i + (lane >> 5); scr[kk * 33 + (lane & 31)] = W[(size_t)(k0 + kk) * N + n0 + (lane & 31)]; }
    LDS_WAIT(); asm volatile("" ::: "memory");
    const int nn = n0 + n; const int orow = RM == 0 ? nn : (8 * (nn >> 2) + (nn & 3) + (RM == 2 ? 4 : 0));
    unsigned char* dst = WT + (size_t)orow * K + k0 + 32 * kq;
    f32x4 csv[8];
#pragma unroll
    for (int i = 0; i < 8; ++i) csv[i] = HAS_CS ? *(const f32x4*)(cs + k0 + 32 * kq + 4 * i) * scale : (f32x4){scale, scale, scale, scale};
#pragma unroll
    for (int h = 0; h < 2; ++h) { v4u o;
#pragma unroll
        for (int q = 0; q < 4; ++q) { const int kk = 32 * kq + 16 * h + 4 * q; const f32x4 sc = csv[4 * h + q];
            o[q] = pk4_fp8(scr[kk * 33 + n] * sc[0], scr[(kk + 1) * 33 + n] * sc[1], scr[(kk + 2) * 33 + n] * sc[2], scr[(kk + 3) * 33 + n] * sc[3]); }
        *(GAS v4u*)(dst + 16 * h) = o; }
    LDS_WAIT(); asm volatile("" ::: "memory");
}
struct Ptrs {
    const float *x, *p, *g_mix, *w_in, *conv_w, *conv_b, *wa, *ba, *wx, *bx, *lam, *w_out, *g_ffn, *w_rg, *b_rg, *w_re, *b_re, *w1, *w3, *w2, *g_ple, *w_pg, *b_pg, *w_pp, *g_final;
    float* out; unsigned char* ws;
    float *rstd0, *rstd1, *rstd2; int* eid; float* ew; int* list; int* counts; int* goffs;
    bf16 *W_IN, *W_OUT, *W_PG, *W_PP, *WRT, *LRUW, *W13, *W2, *PB, *XB, *MIX, *ACT, *GATE, *PROJ, *D1, *X1B, *X2B, *Y, *PP;
};
__device__ __forceinline__ void make_ptrs(Ptrs& P, const Args& a) {
    P.x = a.in[0]; P.p = a.in[1]; P.g_mix = a.in[2]; P.w_in = a.in[3]; P.conv_w = a.in[4]; P.conv_b = a.in[5]; P.wa = a.in[6]; P.ba = a.in[7]; P.wx = a.in[8]; P.bx = a.in[9]; P.lam = a.in[10];
    P.w_out = a.in[11]; P.g_ffn = a.in[12]; P.w_rg = a.in[13]; P.b_rg = a.in[14]; P.w_re = a.in[15]; P.b_re = a.in[16]; P.w1 = a.in[17]; P.w3 = a.in[18]; P.w2 = a.in[19];
    P.g_ple = a.in[20]; P.w_pg = a.in[21]; P.b_pg = a.in[22]; P.w_pp = a.in[23]; P.g_final = a.in[24];
    P.out = a.out; P.ws = a.ws; unsigned char* ws = a.ws;
    P.rstd0 = (float*)(ws + WS_RSTD0); P.rstd1 = (float*)(ws + WS_RSTD1); P.rstd2 = (float*)(ws + WS_RSTD2);
    P.eid = (int*)(ws + WS_EID); P.ew = (float*)(ws + WS_EW); P.list = (int*)(ws + WS_LIST); P.counts = (int*)(ws + WS_CNT); P.goffs = P.counts + 256 * NE;
    P.W_IN = (bf16*)(ws + WS_WIN); P.W_OUT = (bf16*)(ws + WS_WOUT); P.W_PG = (bf16*)(ws + WS_WPG); P.W_PP = (bf16*)(ws + WS_WPP); P.WRT = (bf16*)(ws + WS_WRT); P.LRUW = (bf16*)(ws + WS_LRUW);
    P.W13 = (bf16*)(ws + WS_W13); P.W2 = (bf16*)(ws + WS_W2); P.PB = (bf16*)(ws + WS_PB);
    P.XB = (bf16*)(ws + WS_R64); P.MIX = (bf16*)(ws + WS_R64); P.ACT = (bf16*)(ws + WS_R64); P.GATE = (bf16*)(ws + WS_R64);
    P.PROJ = (bf16*)(ws + WS_PROJ); P.D1 = (bf16*)(ws + WS_D1); P.PP = (bf16*)(ws + WS_PP); P.X1B = (bf16*)(ws + WS_X1B); P.X2B = (bf16*)(ws + WS_D1);     P.Y = (bf16*)(ws + WS_Y);
}

struct P0Item { const float* src; const float* cs; unsigned char* dst; int N, Kout, n0, rm, fmt; float scale; };
__device__ __forceinline__ bool p0_decode(const Ptrs& P, int it, P0Item& I) {
    constexpr int I_WIN = (D / 64) * (INC / 32), I_SQ = (D / 64) * (D / 32), I_PG = (D / 128) * (D / 32), I_WPP = (PLE / 64) * (D / 32), I_W1 = (D / 128) * (DE / 32), I_W2 = (DE / 128) * (D / 32);
    constexpr int NITEMS = I_WIN + I_SQ + I_PG + I_WPP + NE * (2 * I_W1 + I_W2);
    if (it >= NITEMS) return false;
    int r = it; const float* W; const float* cs; unsigned char* dst; int K, N, rm = 0, fmt = 0; float scale = 1.f;
    if (r < I_WIN) { W = P.w_in; K = D; N = INC; dst = (unsigned char*)P.W_IN; cs = P.g_mix; }
    else if ((r -= I_WIN) < I_SQ) { W = P.w_out; K = D; N = D; dst = (unsigned char*)P.W_OUT; cs = nullptr; }
    else if ((r -= I_SQ) < I_PG) { W = P.w_pg; K = D; N = D; dst = (unsigned char*)P.W_PG; cs = P.g_ple; fmt = 1; scale = PLE_SWG; }
    else if ((r -= I_PG) < I_WPP) { W = P.w_pp; K = PLE; N = D; dst = (unsigned char*)P.W_PP; cs = nullptr; }
    else { r -= I_WPP; const int per_e = 2 * I_W1 + I_W2, e = r / per_e; r -= e * per_e; fmt = 1;
        if (r < I_W1) { W = P.w1 + (size_t)e * D * DE; K = D; N = DE; dst = (unsigned char*)P.W13 + (size_t)e * D * D; cs = P.g_ffn; rm = 1; scale = MOE_SW1; }
        else if ((r -= I_W1) < I_W1) { W = P.w3 + (size_t)e * D * DE; K = D; N = DE; dst = (unsigned char*)P.W13 + (size_t)e * D * D; cs = P.g_ffn; rm = 2; scale = MOE_SW1; }
        else { r -= I_W1; W = P.w2 + (size_t)e * DE * D; K = DE; N = D; dst = (unsigned char*)P.W2 + (size_t)e * D * DE; cs = nullptr; scale = MOE_SW2; } }
    const int KI = fmt ? 128 : 64;
    const int nblk = N / 32, kb = r / nblk, nb = r % nblk, k0 = KI * kb, n0 = 32 * nb;
    I.src = W + (size_t)k0 * N + n0; I.cs = cs ? cs + k0 : nullptr; I.N = N; I.n0 = n0; I.rm = rm; I.fmt = fmt; I.scale = scale;
    I.Kout = fmt ? K : 2 * K; I.dst = dst + (fmt ? k0 : 2 * k0);
    return true;
}
__device__ __forceinline__ void p0_load(const P0Item& I, float (&v)[64], int lane) {
    const float* s = I.src + (size_t)(lane >> 5) * I.N + (lane & 31);
#pragma unroll
    for (int i = 0; i < 32; ++i) v[i] = s[(size_t)(2 * i) * I.N];
    if (I.fmt) {
#pragma unroll
        for (int i = 32; i < 64; ++i) v[i] = s[(size_t)(2 * i) * I.N];
    }
}
__device__ __forceinline__ int p0_orow(const P0Item& I, int n) { const int nn = I.n0 + n; return I.rm == 0 ? nn : (8 * (nn >> 2) + (nn & 3) + (I.rm == 2 ? 4 : 0)); }
__device__ __forceinline__ void p0_process(const P0Item& I, const float (&v)[64], LAS float* scr, int lane) {
    if (I.fmt == 0) {
#pragma unroll
        for (int i = 0; i < 32; ++i) scr[(2 * i + (lane >> 5)) * 33 + (lane & 31)] = v[i];
        LDS_WAIT(); asm volatile("" ::: "memory");
        const int c = lane & 7;
        f32x4 s0 = {1.f, 1.f, 1.f, 1.f}, s1 = {1.f, 1.f, 1.f, 1.f};
        if (I.cs) { s0 = *(const f32x4*)(I.cs + 8 * c); s1 = *(const f32x4*)(I.cs + 8 * c + 4); }
#pragma unroll
        for (int j = 0; j < 4; ++j) { const int n = (lane >> 3) + 8 * j; const LAS float* s = scr + (8 * c) * 33 + n;
            v4u o; o.x = cvt_pk_bf16(s[0 * 33] * s0.x, s[1 * 33] * s0.y); o.y = cvt_pk_bf16(s[2 * 33] * s0.z, s[3 * 33] * s0.w); o.z = cvt_pk_bf16(s[4 * 33] * s1.x, s[5 * 33] * s1.y); o.w = cvt_pk_bf16(s[6 * 33] * s1.z, s[7 * 33] * s1.w);
            *(GAS v4u*)(I.dst + (size_t)p0_orow(I, n) * I.Kout + 16 * c) = o; }
    } else {
#pragma unroll
        for (int i = 0; i < 64; ++i) { const int k = 2 * i + (lane >> 5); scr[k * 32 + (((lane & 31) + k) & 31)] = v[i]; }
        LDS_WAIT(); asm volatile("" ::: "memory");
        const int c = lane & 7;
        f32x4 sc[4];
#pragma unroll
        for (int q = 0; q < 4; ++q) sc[q] = I.cs ? *(const f32x4*)(I.cs + 16 * c + 4 * q) * I.scale : (f32x4){I.scale, I.scale, I.scale, I.scale};
#pragma unroll
        for (int j = 0; j < 4; ++j) { const int n = (lane >> 3) + 8 * j; v4u o;
#pragma unroll
            for (int q = 0; q < 4; ++q) { float t[4];
#pragma unroll
                for (int e = 0; e < 4; ++e) { const int k = 16 * c + 4 * q + e; t[e] = scr[k * 32 + ((n + k) & 31)] * sc[q][e]; }
                o[q] = pk4_fp8(t[0], t[1], t[2], t[3]); }
            *(GAS v4u*)(I.dst + (size_t)p0_orow(I, n) * I.Kout + 16 * c) = o; }
    }
    LDS_WAIT(); asm volatile("" ::: "memory");
}
__device__ __forceinline__ void p0_prologue(Frame& F, const Ptrs& P) {
    LAS float* scr = (LAS float*)(F.lds + RING_OFF + F.wave * 16384);
    const int gw = F.vcu * NWAVES + F.wave, NGW = F.G * NWAVES;
    {
#pragma unroll 1
        for (int it = gw; ; it += NGW) { P0Item A; float va[64];
            if (!p0_decode(P, it, A)) break;
            p0_load(A, va, F.lane); p0_process(A, va, scr, F.lane); }
    }
    for (int m = gw; m < T; m += 2 * NGW) {
        const int m1 = m + NGW; const bool two = m1 < T;
        const GAS f32x4* xr0 = (const GAS f32x4*)(P.x + (size_t)m * D) + F.lane; const GAS f32x4* xr1 = (const GAS f32x4*)(P.x + (size_t)(two ? m1 : m) * D) + F.lane;
        f32x4 v[4], u[4]; float s = 0.f, s1 = 0.f;
#pragma unroll
        for (int j = 0; j < 4; ++j) { v[j] = xr0[64 * j]; u[j] = xr1[64 * j]; }
#pragma unroll
        for (int j = 0; j < 4; ++j) { s += (v[j].x * v[j].x + v[j].y * v[j].y) + (v[j].z * v[j].z + v[j].w * v[j].w); s1 += (u[j].x * u[j].x + u[j].y * u[j].y) + (u[j].z * u[j].z + u[j].w * u[j].w); }
        s = wave_sum(s); s1 = wave_sum(s1);
        GAS v2u* o8 = (GAS v2u*)(P.XB + (size_t)m * D) + F.lane;
#pragma unroll
        for (int j = 0; j < 4; ++j) { v2u w; w.x = pk2(v[j].x, v[j].y); w.y = pk2(v[j].z, v[j].w); o8[64 * j] = w; }
        if (F.lane == 0) P.rstd0[m] = 1.0f / sqrtf(s * (1.f / D) + EPS);
        if (two) {
            GAS v2u* o9 = (GAS v2u*)(P.XB + (size_t)m1 * D) + F.lane;
#pragma unroll
            for (int j = 0; j < 4; ++j) { v2u w; w.x = pk2(u[j].x, u[j].y); w.y = pk2(u[j].z, u[j].w); o9[64 * j] = w; }
            if (F.lane == 0) P.rstd0[m1] = 1.0f / sqrtf(s1 * (1.f / D) + EPS);
        }
    }
    for (int m = gw; m < T; m += 4 * NGW) {
        f32x4 v[4];
#pragma unroll
        for (int j = 0; j < 4; ++j) { const int mj = m + j * NGW; v[j] = *((const GAS f32x4*)(P.p + (size_t)(mj < T ? mj : m) * PLE) + F.lane); }
#pragma unroll
        for (int j = 0; j < 4; ++j) { const int mj = m + j * NGW; if (mj < T) { v2u w; w.x = pk2(v[j].x, v[j].y); w.y = pk2(v[j].z, v[j].w); *((GAS v2u*)(P.PB + (size_t)mj * PLE) + F.lane) = w; } }
    }
    for (int idx = (F.vcu * NTHR + F.tid); idx < 80 * D; idx += F.G * NTHR) {
        const int n = idx / D, k = idx % D; float v = 0.f;
        if (n < NG) v = P.w_rg[(size_t)k * NG + n] * P.g_ffn[k]; else if (n < NG + NE) v = P.w_re[(size_t)k * NE + (n - NG)] * P.g_ffn[k];
        const bf16 hi = f2bf(v); const bf16 lo = f2bf(v - bf2f(hi));
        P.WRT[idx] = hi; P.WRT[80 * D + idx] = lo;
    }
    for (int idx = (F.vcu * NTHR + F.tid); idx < 2 * 8 * 64 * 64; idx += F.G * NTHR) {
        const int g = idx >> 15, r = idx & 32767, hb = r >> 12, j = (r >> 6) & 63, i = r & 63;
        const float* w = g ? P.wx : P.wa;
        P.LRUW[idx] = f2bf(w[(hb * 64 + i) * 64 + j]);
    }
}


__device__ __forceinline__ f32x4 bf4(v2u w) { return (f32x4){bflo(w.x), bfhi(w.x), bflo(w.y), bfhi(w.y)}; }
__device__ __forceinline__ void p10_combine(Frame& F, const Ptrs& P) {
    const int gw = F.vcu * NWAVES + F.wave, NGW = F.G * NWAVES;
    for (int m = gw; m < T; m += NGW) {
        const size_t ro = (size_t)m * D;
        GAS v2u* x1 = (GAS v2u*)(P.X2B + ro) + F.lane; const GAS v2u* y0 = (const GAS v2u*)(P.Y + ro) + F.lane; const GAS v2u* y1 = (const GAS v2u*)(P.Y + (size_t)T * D + ro) + F.lane;
        f32x4 v[4]; v2u a[4], b[4], c[4];
#pragma unroll
        for (int j = 0; j < 4; ++j) { a[j] = x1[64 * j]; b[j] = y0[64 * j]; c[j] = y1[64 * j]; }
        float s = 0.f;
#pragma unroll
        for (int j = 0; j < 4; ++j) { v[j] = bf4(a[j]) + (bf4(b[j]) + bf4(c[j])); s += (v[j].x * v[j].x + v[j].y * v[j].y) + (v[j].z * v[j].z + v[j].w * v[j].w); }
        s = wave_sum(s);
        GAS unsigned* o4 = (GAS unsigned*)((unsigned char*)P.X1B + ro) + F.lane;
#pragma unroll
        for (int j = 0; j < 4; ++j) { v2u w; w.x = pk2(v[j].x, v[j].y); w.y = pk2(v[j].z, v[j].w); x1[64 * j] = w;
            o4[64 * j] = pk4_fp8(v[j].x * PLE_SX2, v[j].y * PLE_SX2, v[j].z * PLE_SX2, v[j].w * PLE_SX2); }
        if (F.lane == 0) P.rstd2[m] = 1.0f / sqrtf(s * (1.f / D) + EPS);
    }
}
__device__ __forceinline__ void p13_final(Frame& F, const Ptrs& P) {
    const int gw = F.vcu * NWAVES + F.wave, NGW = F.G * NWAVES;
    f32x4 gf[4];
#pragma unroll
    for (int j = 0; j < 4; ++j) gf[j] = *((const GAS f32x4*)P.g_final + F.lane + 64 * j);
    for (int m = gw; m < T; m += NGW) {
        const size_t ro = (size_t)m * D;
        GAS f32x4* xr = (GAS f32x4*)(P.out + ro) + F.lane;
        const GAS v2u* xb = (const GAS v2u*)(P.X2B + ro) + F.lane; const GAS v2u* ga = (const GAS v2u*)(P.GATE + ro) + F.lane; const GAS v2u* pp = (const GAS v2u*)(P.PP + ro) + F.lane;
        f32x4 v[4]; v2u a[4], b[4], c[4];
#pragma unroll
        for (int j = 0; j < 4; ++j) { c[j] = xb[64 * j]; a[j] = ga[64 * j]; b[j] = pp[64 * j]; }
        float s = 0.f;
#pragma unroll
        for (int j = 0; j < 4; ++j) { v[j] = bf4(c[j]) + bf4(a[j]) * bf4(b[j]); s += (v[j].x * v[j].x + v[j].y * v[j].y) + (v[j].z * v[j].z + v[j].w * v[j].w); }
        s = wave_sum(s);
        const float r = 1.0f / sqrtf(s * (1.f / D) + EPS);
#pragma unroll
        for (int j = 0; j < 4; ++j) xr[64 * j] = v[j] * r * gf[j];
    }
}
__device__ __forceinline__ LAS int* sched_offs(Frame& F) { return (LAS int*)(F.lds + SCHED_OFF); }
__device__ __forceinline__ LAS int* sched_tileb(Frame& F) { return (LAS int*)(F.lds + SCHED_OFF) + 72; }
__device__ __forceinline__ LAS int* sched_pre(Frame& F) { return (LAS int*)(F.lds + SCHED_OFF) + 144; }
__device__ __forceinline__ LAS int* sched_ta(Frame& F) { return (LAS int*)(F.lds + SCHED_OFF) + 256; }
__device__ __forceinline__ LAS int* sched_tc(Frame& F) { return (LAS int*)(F.lds + SCHED_OFF) + 328; }
__device__ __forceinline__ void sched_build(Frame& F, const Ptrs& P) {
    LAS int* offs = sched_offs(F); LAS int* tb = sched_tileb(F); LAS int* pre = sched_pre(F);
    LAS int* part = (LAS int*)(F.lds + UTAB_OFF);
    {
        const int e = F.tid & 63, pt = F.tid >> 6; int t = 0, p = 0; int cv[32];
#pragma unroll
        for (int j = 0; j < 32; ++j) cv[j] = P.counts[(pt * 32 + j) * NE + e];
#pragma unroll
        for (int j = 0; j < 32; ++j) { t += cv[j]; p += (pt * 32 + j < F.vcu) ? cv[j] : 0; }
        part[(pt * 64 + e) * 2] = t; part[(pt * 64 + e) * 2 + 1] = p;
    }
    __syncthreads();
    if (F.tid < NE) { int t = 0, p = 0;
#pragma unroll
        for (int pt = 0; pt < 8; ++pt) { t += part[(pt * 64 + F.tid) * 2]; p += part[(pt * 64 + F.tid) * 2 + 1]; }
        pre[F.tid] = p; part[1024 + F.tid] = t; }
    __syncthreads();
    if (F.tid == 0) { LAS int* ta = sched_ta(F); LAS int* tc = sched_tc(F); int o = 0, tbv = 0, tav = 0, tcv = 0;
        for (int e = 0; e < NE; ++e) { offs[e] = o; tb[e] = tbv; ta[e] = tav; tc[e] = tcv; const int t = part[1024 + e], tl = t & 255; o += t; tbv += t >> 8; tav += tl > 128 ? 1 : 0; tcv += (tl > 0 && tl <= 128) ? 1 : 0; }
        offs[NE] = o; tb[NE] = tbv; ta[NE] = tav; tc[NE] = tcv; }
    __syncthreads();
}

constexpr int P6_BROW = 272, P6_BHL = 80 * P6_BROW, P6_BBUF = 2 * P6_BHL, P6_LG_OFF = 90112;
static_assert(2 * P6_BBUF <= P6_LG_OFF && P6_LG_OFF + 8 * 16 * 80 * 4 <= RING_BYTES, "P6 LDS map");
__device__ __forceinline__ void p6_route(Frame& F, const Ptrs& P) {
    const int lane = F.lane, r = lane & 15, g = lane >> 4;
    const int tok = F.vcu * 128 + F.wave * 16 + r;
    LAS unsigned char* BS = F.lds + RING_OFF;
    LAS float* LG = (LAS float*)(F.lds + RING_OFF + P6_LG_OFF) + F.wave * (16 * 80);
    LAS float* SS = (LAS float*)(F.lds + UTAB_OFF) + F.wave * 16;
    LAS int* hist = (LAS int*)(F.lds + UTAB_OFF + 1024);
    if (F.tid < NE) hist[F.tid] = 0;
    f32x4 acc[5];
#pragma unroll
    for (int i = 0; i < 5; ++i) acc[i] = (f32x4){0.f, 0.f, 0.f, 0.f};
    float ssq = 0.f;
    const float* xrow = P.x + (size_t)tok * D + 8 * g; const bf16* drow = P.D1 + (size_t)tok * D + 8 * g; unsigned char* orow = (unsigned char*)P.X1B + (size_t)tok * D + 8 * g;
    unsigned bsrc[5], bdst[5];
#pragma unroll
    for (int i = 0; i < 5; ++i) { const int id = F.tid + 512 * i, hl = id / 1280, rem = id % 1280, row = rem >> 4, ch = rem & 15;
        bsrc[i] = (unsigned)((hl * 80 + row) * D + 8 * ch) * 2u; bdst[i] = (unsigned)(hl * P6_BHL + row * P6_BROW + ch * 16); }
    v4u breg[5]; f32x4 xa[4], xb[4]; v4u dd[4];
#pragma unroll
    for (int i = 0; i < 5; ++i) breg[i] = *(const v4u*)((const char*)P.WRT + bsrc[i]);
#pragma unroll
    for (int s = 0; s < 4; ++s) { xa[s] = *(const f32x4*)(xrow + 32 * s); xb[s] = *(const f32x4*)(xrow + 32 * s + 4); dd[s] = *(const v4u*)(drow + 32 * s); }
#pragma unroll 1
    for (int sl = 0; sl < 8; ++sl) {
        LAS unsigned char* bb = BS + (sl & 1) * P6_BBUF;
#pragma unroll
        for (int i = 0; i < 5; ++i) *(LAS v4u*)(bb + bdst[i]) = breg[i];
        __syncthreads();
        f32x4 cxa[4], cxb[4]; v4u cdd[4];
#pragma unroll
        for (int s = 0; s < 4; ++s) { cxa[s] = xa[s]; cxb[s] = xb[s]; cdd[s] = dd[s]; }
        if (sl < 7) {
#pragma unroll
            for (int i = 0; i < 5; ++i) breg[i] = *(const v4u*)((const char*)P.WRT + bsrc[i] + (sl + 1) * 256);
#pragma unroll
            for (int s = 0; s < 4; ++s) { xa[s] = *(const f32x4*)(xrow + 128 * (sl + 1) + 32 * s); xb[s] = *(const f32x4*)(xrow + 128 * (sl + 1) + 32 * s + 4); dd[s] = *(const v4u*)(drow + 128 * (sl + 1) + 32 * s); }
        }
#pragma unroll
        for (int s = 0; s < 4; ++s) {
            float v[8];
            v[0] = cxa[s][0] + bflo(cdd[s].x); v[1] = cxa[s][1] + bfhi(cdd[s].x); v[2] = cxa[s][2] + bflo(cdd[s].y); v[3] = cxa[s][3] + bfhi(cdd[s].y);
            v[4] = cxb[s][0] + bflo(cdd[s].z); v[5] = cxb[s][1] + bfhi(cdd[s].z); v[6] = cxb[s][2] + bflo(cdd[s].w); v[7] = cxb[s][3] + bfhi(cdd[s].w);
            v4u hw, lw;
#pragma unroll
            for (int q = 0; q < 4; ++q) {
                ssq += v[2 * q] * v[2 * q] + v[2 * q + 1] * v[2 * q + 1];
                const unsigned h = cvt_pk_bf16(v[2 * q], v[2 * q + 1]);
                const unsigned l = cvt_pk_bf16(v[2 * q] - bflo(h), v[2 * q + 1] - bfhi(h));
                hw[q] = h; lw[q] = l;
            }
            { v2u f8; f8.x = pk4_fp8(v[0] * MOE_SX, v[1] * MOE_SX, v[2] * MOE_SX, v[3] * MOE_SX); f8.y = pk4_fp8(v[4] * MOE_SX, v[5] * MOE_SX, v[6] * MOE_SX, v[7] * MOE_SX); *(v2u*)(orow + 128 * sl + 32 * s) = f8; }
            *(v4u*)(const_cast<bf16*>(drow) + 128 * sl + 32 * s) = hw;
            const bf16x8 ah = __builtin_bit_cast(bf16x8, hw), al = __builtin_bit_cast(bf16x8, lw);
#pragma unroll
            for (int nt = 0; nt < 5; ++nt) {
                const bf16x8 bh = *(const LAS bf16x8*)(bb + (16 * nt + r) * P6_BROW + (32 * s + 8 * g) * 2), bl = *(const LAS bf16x8*)(bb + P6_BHL + (16 * nt + r) * P6_BROW + (32 * s + 8 * g) * 2);
                acc[nt] = __builtin_amdgcn_mfma_f32_16x16x32_bf16(ah, bh, acc[nt], 0, 0, 0);
                acc[nt] = __builtin_amdgcn_mfma_f32_16x16x32_bf16(al, bh, acc[nt], 0, 0, 0);
                acc[nt] = __builtin_amdgcn_mfma_f32_16x16x32_bf16(ah, bl, acc[nt], 0, 0, 0);
            }
        }
    }
    ssq += __shfl_xor(ssq, 16); ssq += __shfl_xor(ssq, 32);
#pragma unroll
    for (int nt = 0; nt < 5; ++nt)
#pragma unroll
        for (int q = 0; q < 4; ++q) LG[(4 * g + q) * 80 + 16 * nt + r] = acc[nt][q];
    if (g == 0) SS[r] = ssq;
    __syncthreads();
    if (g == 0) {
        const float rs = 1.0f / sqrtf(SS[r] * (1.f / D) + EPS);
        const LAS float* L = LG + r * 80;
        float gl[8]; float mx = -3.0e38f; int gsel = 0;
#pragma unroll
        for (int i = 0; i < 8; ++i) { gl[i] = rs * L[i] + P.b_rg[i]; if (gl[i] > mx) { mx = gl[i]; gsel = i; } }
        float den = 0.f;
#pragma unroll
        for (int i = 0; i < 8; ++i) den += expf(gl[i] - mx);
        const float gw = 1.f / den;
        float v0 = -3.0e38f, v1 = -3.0e38f; int i0 = 0, i1 = 0;
        for (int i = 0; i < 8; ++i) {
            const float v = rs * L[8 + gsel * 8 + i] + P.b_re[gsel * 8 + i];
            if (v > v0) { v1 = v0; i1 = i0; v0 = v; i0 = i; } else if (v > v1) { v1 = v; i1 = i; }
        }
        const float e1 = expf(v1 - v0), w0 = 1.f / (1.f + e1), w1 = e1 / (1.f + e1);
        const int ea = gsel * 8 + i0, eb = gsel * 8 + i1;
        P.eid[tok * 2] = ea; P.eid[tok * 2 + 1] = eb; P.ew[tok * 2] = w0 * gw; P.ew[tok * 2 + 1] = w1 * gw; P.rstd1[tok] = rs;
        __hip_atomic_fetch_add(hist + ea, 1, __ATOMIC_RELAXED, __HIP_MEMORY_SCOPE_WORKGROUP); __hip_atomic_fetch_add(hist + eb, 1, __ATOMIC_RELAXED, __HIP_MEMORY_SCOPE_WORKGROUP);
    }
    __syncthreads();
    if (F.tid < NE) P.counts[F.vcu * NE + F.tid] = hist[F.tid];
}

__device__ __forceinline__ void p7_lists(Frame& F, const Ptrs& P) {
    sched_build(F, P);
    LAS int* offs = sched_offs(F); LAS int* pre = sched_pre(F);
    LAS int* eids = (LAS int*)(F.lds + RING_OFF);
    if (F.tid < 256) eids[F.tid] = P.eid[F.vcu * 256 + F.tid];
    __syncthreads();
    if (F.tid < NE) {
        const int e = F.tid; int pos = offs[e] + pre[e];
        for (int a = 0; a < 256; ++a) if (eids[a] == e) { P.list[pos] = F.vcu * 256 + a; ++pos; }
    }
    if (blockIdx.x == 0 && F.tid <= NE) P.goffs[F.tid] = offs[F.tid];
    __syncthreads();
}

namespace pg8 {
template <int MODE>
struct MoeSched {
    const char* Ab; const char* Bb; int K, G, c; LAS int* offs; LAS int* tb; LAS int* ta; LAS int* tc; LAS int* tab;
    __device__ __forceinline__ bool next(int i, Unit& u) const {
        const int L = i * G + c; const int nF = __builtin_amdgcn_readfirstlane(tb[NE]), nA = __builtin_amdgcn_readfirstlane(ta[NE]), nC = __builtin_amdgcn_readfirstlane(tc[NE]);
        if (L >= 4 * (nF + nA + nC)) return false;
        int rt = L >> 2; const LAS int* pf = tb; int cls = 0;
        if (rt >= nF) { rt -= nF; pf = ta; cls = 1; if (rt >= nA) { rt -= nA; pf = tc; cls = 2; } }
        int e = 0;
        for (int k = 1; k < NE; ++k) e += (pf[k] <= rt) ? 1 : 0;
        e = __builtin_amdgcn_readfirstlane(e);
        const int o0 = __builtin_amdgcn_readfirstlane(offs[e]), cnt = __builtin_amdgcn_readfirstlane(offs[e + 1]) - o0;
        u.e = e; u.pm = cls == 0 ? rt - __builtin_amdgcn_readfirstlane(tb[e]) : (cnt >> 8); u.pn = L & 3; u.slot0 = o0 + 256 * u.pm;
        u.rows = cls == 0 ? 256 : (cnt & 255); u.ui = i; return true;
    }
    __device__ __forceinline__ const char* a_base(const Unit& u) const { return MODE == 0 ? Ab : Ab + (size_t)u.slot0 * (size_t)(K * 2); }
    __device__ __forceinline__ const char* b_base(const Unit& u) const { return Bb + ((size_t)u.e * D + (size_t)u.pn * BM) * (size_t)K * 2; }
    __device__ __forceinline__ unsigned a_rowoff(const Unit& u, int r) const { return MODE == 0 ? (unsigned)tab[u.ui * 256 + r] : (unsigned)r * (unsigned)(K * 2); }
};
struct EpiAct {
    unsigned char* ACT; const LAS float* tabf;
    __device__ __forceinline__ void operator()(const f32x4 (&acc)[2][2][4][2], const Unit& u, int wr, int wc, int fr, int fq) const {
#pragma unroll
        for (int ai = 0; ai < 2; ++ai)
#pragma unroll
            for (int m = 0; m < 4; ++m) { const int r = ai * HALF + wr * 64 + m * 16 + fr;
                if (r < u.rows) { const float s = tabf[u.ui * 256 + r] * (1.f / (MOE_SX * MOE_SW1)); unsigned char* rowp = ACT + (size_t)(u.slot0 + r) * DE + u.pn * 128 + wc * 16 + 4 * fq;
#pragma unroll
                    for (int bj = 0; bj < 2; ++bj) { const f32x4 h1 = acc[ai][bj][m][0] * s, h3 = acc[ai][bj][m][1] * s; f32x4 a;
#pragma unroll
                        for (int q = 0; q < 4; ++q) a[q] = h1[q] * fast_sigmoid(h1[q]) * h3[q] * MOE_SA;
                        *(unsigned*)(rowp + bj * 64) = pk4_fp8(a[0], a[1], a[2], a[3]); } } }
    }
};
struct EpiY {
    bf16* Y; const LAS int* tab; const LAS float* tabf;
    __device__ __forceinline__ void operator()(const f32x4 (&acc)[2][2][4][2], const Unit& u, int wr, int wc, int fr, int fq) const {
#pragma unroll
        for (int ai = 0; ai < 2; ++ai)
#pragma unroll
            for (int m = 0; m < 4; ++m) { const int r = ai * HALF + wr * 64 + m * 16 + fr; const int aid = tab[u.ui * 256 + r];
                if (aid >= 0) { const float s = tabf[u.ui * 256 + r] * (1.f / (MOE_SA * MOE_SW2)); bf16* rowp = Y + ((size_t)(aid & 1) * T + (size_t)(aid >> 1)) * D + u.pn * BM + wc * 32 + 8 * fq;
#pragma unroll
                    for (int bj = 0; bj < 2; ++bj) { const f32x4 v0 = acc[ai][bj][m][0] * s, v1 = acc[ai][bj][m][1] * s;
                        v4u w; w.x = cvt_pk_bf16(v0[0], v0[1]); w.y = cvt_pk_bf16(v0[2], v0[3]); w.z = cvt_pk_bf16(v1[0], v1[1]); w.w = cvt_pk_bf16(v1[2], v1[3]);
                        *(v4u*)(rowp + bj * HALF) = w; } } }
    }
};
}
template <int MODE>
__device__ __forceinline__ void moe_phase(Frame& F, const Ptrs& P, bool rebuild) {
    if (rebuild) sched_build(F, P);
    LAS int* tab = (LAS int*)(F.lds + UTAB_OFF); LAS float* tabf = (LAS float*)(F.lds + UTABF_OFF);
    LAS int* uinfo = (LAS int*)(F.lds + SCHED_OFF) + 208;
    pg8::MoeSched<MODE> S; S.Ab = MODE == 0 ? (const char*)P.X1B : (const char*)P.ACT; S.Bb = MODE == 0 ? (const char*)P.W13 : (const char*)P.W2; S.K = MODE == 0 ? D / 2 : DE / 2;   S.G = F.G; S.c = F.vcu;
    S.offs = sched_offs(F); S.tb = sched_tileb(F); S.ta = sched_ta(F); S.tc = sched_tc(F); S.tab = tab;
    if (F.tid < 64) {
#pragma unroll
        for (int i = 0; i < MAXU; ++i) { pg8::Unit u; const bool ok = S.next(i, u); if (F.tid == 0) { uinfo[2 * i] = ok ? u.slot0 : 0; uinfo[2 * i + 1] = ok ? u.rows : 0; } }
    }
    __syncthreads();
    {
        const int r = F.tid & 255, i0 = F.tid >> 8; int aid[3]; bool val[3], act[3];
#pragma unroll
        for (int it = 0; it < 3; ++it) { const int i = i0 + 2 * it; const int s0 = uinfo[2 * i], rows = uinfo[2 * i + 1]; act[it] = rows > 0; val[it] = r < rows; aid[it] = act[it] ? P.list[s0 + (val[it] ? r : 0)] : 0; }
        float fv[3];
#pragma unroll
        for (int it = 0; it < 3; ++it) fv[it] = act[it] ? (MODE == 0 ? P.rstd1[aid[it] >> 1] : P.ew[aid[it]]) : 0.f;
#pragma unroll
        for (int it = 0; it < 3; ++it) if (act[it]) { const int i = i0 + 2 * it;
            if (MODE == 0) tab[i * 256 + r] = (aid[it] >> 1) * D; else tab[i * 256 + r] = val[it] ? aid[it] : -1;
            tabf[i * 256 + r] = fv[it]; }
    }
    __syncthreads();
    if constexpr (MODE == 0) { pg8::EpiAct E{(unsigned char*)P.ACT, tabf}; pg8::gemm_phase<pg8::EpiAct, pg8::MoeSched<0>, true>(F.lds + RING_OFF, S, E); }
    else { pg8::EpiY E{P.Y, tab, tabf}; pg8::gemm_phase<pg8::EpiY, pg8::MoeSched<1>, true>(F.lds + RING_OFF, S, E); }
}
typedef short v4i16 __attribute__((ext_vector_type(4)));
__device__ __forceinline__ unsigned off_b(unsigned row, unsigned ch) { return 256u * row + 16u * (ch ^ (((row & 3u) << 2) | ((row >> 2) & 3u))); }
__device__ __forceinline__ unsigned row_read_addr_16(unsigned lane, unsigned rb, unsigned s) { return off_b((lane & 15u) + 16u * rb, 4u * s + (lane >> 4)); }
__device__ __forceinline__ unsigned tr_read_addr_16(unsigned lane, unsigned c, unsigned ks, unsigned t) {
    const unsigned g = lane >> 4, q = (lane & 15u) >> 2, p = lane & 3u;
    return off_b(32u * ks + 8u * g + 4u * t + q, 2u * c + (p >> 1)) + 8u * (p & 1u);
}
__device__ __forceinline__ bf16x8 tr_frag2(LAS unsigned char* p0, LAS unsigned char* p1) {
    const v4i16 a = __builtin_amdgcn_ds_read_tr16_b64_v4i16((LAS v4i16*)p0);
    const v4i16 b = __builtin_amdgcn_ds_read_tr16_b64_v4i16((LAS v4i16*)p1);
    return (bf16x8){a[0], a[1], a[2], a[3], b[0], b[1], b[2], b[3]};
}
__device__ __forceinline__ void wave_lds_fence() { asm volatile("s_waitcnt lgkmcnt(0)" ::: "memory"); __builtin_amdgcn_wave_barrier(); asm volatile("" ::: "memory"); }
__device__ __forceinline__ float gelu_tanh_fast(float x) {
    const float u = 0.7978845608028654f * (x + 0.044715f * x * x * x);
    return x * fast_sigmoid(2.f * u);
}
constexpr float LOG2_ROPE_OVER_64 = 13.287712379549449f / 64.f;
constexpr int MIX_K_OFF = 0, MIX_V_OFF = 32768, MIX_S_OFF = 65536, MIX_S_STRIDE = 272, MIX_S_WAVE = 16 * MIX_S_STRIDE;
constexpr int MIX_CW_OFF = 0, MIX_XC_OFF = 12288, MIX_XC_WAVE = 16 * 68 * 4;
static_assert(MIX_S_OFF + 8 * MIX_S_WAVE <= RING_BYTES && MIX_XC_OFF + 8 * MIX_XC_WAVE <= RING_BYTES, "mixing LDS map");

__device__ __forceinline__ void sincos_rev(float ang, float& sn, float& cs) {
    float rev = ang * 0.15915494309189535f; rev -= floorf(rev);
    sn = __builtin_amdgcn_sinf(rev); cs = __builtin_amdgcn_cosf(rev);
}
struct KVRaw { v4u k[2][2]; v4u v[4]; };
__device__ __forceinline__ void kv_issue(KVRaw& R, int tid, const bf16* proj_t0, int h) {
    const int dg = tid & 7;
#pragma unroll
    for (int it = 0; it < 2; ++it) { const int c = (tid >> 3) + 64 * it; const bf16* row = proj_t0 + (size_t)c * INC + 1536 + h * HD + 8 * dg; R.k[it][0] = *(const v4u*)row; R.k[it][1] = *(const v4u*)(row + 64); }
#pragma unroll
    for (int it = 0; it < 4; ++it) { const int id = tid + 512 * it, c = id >> 4, ch = id & 15; R.v[it] = *(const v4u*)(proj_t0 + (size_t)c * INC + 2048 + h * HD + 8 * ch); }
}
template <bool DECAY>
__device__ __forceinline__ void kv_store(Frame& F, const KVRaw& R, int tid, int s0, float lg2) {
    LAS unsigned char* Kimg = F.lds + MIX_K_OFF; LAS unsigned char* Vimg = F.lds + MIX_V_OFF;
    const int dg = tid & 7;
    float inv[8];
#pragma unroll
    for (int j = 0; j < 8; ++j) inv[j] = __builtin_amdgcn_exp2f(-(float)(8 * dg + j) * LOG2_ROPE_OVER_64);
#pragma unroll
    for (int it = 0; it < 2; ++it) {
        const int c = (tid >> 3) + 64 * it;
        const v4u k1 = R.k[it][0], k2 = R.k[it][1];
        const float sc = 0.08838834764831845f * (DECAY ? __builtin_amdgcn_exp2f((float)(127 - c) * lg2) : 1.f);
        const float pos = (float)(s0 + c);
        v4u o1, o2;
#pragma unroll
        for (int q = 0; q < 4; ++q) {
            float sn0, cs0, sn1, cs1; sincos_rev(pos * inv[2 * q], sn0, cs0); sincos_rev(pos * inv[2 * q + 1], sn1, cs1);
            const float a0 = bflo(k1[q]), a1 = bfhi(k1[q]), b0 = bflo(k2[q]), b1 = bfhi(k2[q]);
            o1[q] = cvt_pk_bf16((a0 * cs0 - b0 * sn0) * sc, (a1 * cs1 - b1 * sn1) * sc);
            o2[q] = cvt_pk_bf16((a0 * sn0 + b0 * cs0) * sc, (a1 * sn1 + b1 * cs1) * sc);
        }
        *(LAS v4u*)(Kimg + off_b(c, dg)) = o1; *(LAS v4u*)(Kimg + off_b(c, dg + 8)) = o2;
    }
#pragma unroll
    for (int it = 0; it < 4; ++it) { const int id = tid + 512 * it, c = id >> 4, ch = id & 15; *(LAS v4u*)(Vimg + off_b(c, ch)) = R.v[it]; }
}

template <bool FINAL>
__device__ __forceinline__ void lru_chunk(Frame& F, const Ptrs& P, int b, int n, int lane) {
    const int r = lane & 15, g = lane >> 4, hb = F.wave;
    const int t0 = b * S + n * CH;
    LAS float* CW = (LAS float*)(F.lds + MIX_CW_OFF);
    LAS float* XC = (LAS float*)(F.lds + MIX_XC_OFF + F.wave * MIX_XC_WAVE);
    for (int i = F.tid; i < 5 * DL; i += NTHR) CW[i] = i < 4 * DL ? P.conv_w[i] : P.conv_b[i - 4 * DL];
    __syncthreads();
    bf16x8 Wa[4][2], Wx[4][2];
#pragma unroll
    for (int jt = 0; jt < 4; ++jt)
#pragma unroll
        for (int ks = 0; ks < 2; ++ks) {
            Wa[jt][ks] = *(const bf16x8*)(P.LRUW + ((size_t)(0 * 8 + hb) * 64 + 16 * jt + r) * 64 + 32 * ks + 8 * g);
            Wx[jt][ks] = *(const bf16x8*)(P.LRUW + ((size_t)(1 * 8 + hb) * 64 + 16 * jt + r) * 64 + 32 * ks + 8 * g);
        }
    float ba[4], bx[4], sp8[4], St[4], At[4];
#pragma unroll
    for (int jt = 0; jt < 4; ++jt) { const int ch = hb * 64 + 16 * jt + r; ba[jt] = P.ba[ch]; bx[jt] = P.bx[ch];
        const float nl = -P.lam[ch]; sp8[jt] = 8.f * (nl > 20.f ? nl : log1pf(expf(nl)));
        St[jt] = FINAL ? ((const float*)(P.ws + WS_LRU))[2 * B * NCH * DL + (b * NCH + n) * DL + ch] : 0.f; At[jt] = 1.f; }
#pragma unroll 1
    for (int tt = 0; tt < 8; ++tt) {
        const int c = 16 * tt + r;
        bf16 glv[4][4];
        if (FINAL) {
#pragma unroll
            for (int jt = 0; jt < 4; ++jt)
#pragma unroll
                for (int q = 0; q < 4; ++q) glv[jt][q] = P.PROJ[(size_t)(t0 + 16 * tt + 4 * g + q) * INC + DL + hb * 64 + 16 * jt + r];
        }
        bf16x8 fr[2];
#pragma unroll
        for (int ks = 0; ks < 2; ++ks) {
            const int chA = hb * 64 + 32 * ks + 8 * g;
            float xc[8];
            { const f32x4 b0 = *(const LAS f32x4*)(CW + 4 * DL + chA), b1 = *(const LAS f32x4*)(CW + 4 * DL + chA + 4);
              xc[0] = b0[0]; xc[1] = b0[1]; xc[2] = b0[2]; xc[3] = b0[3]; xc[4] = b1[0]; xc[5] = b1[1]; xc[6] = b1[2]; xc[7] = b1[3]; }
#pragma unroll
            for (int k = 0; k < 4; ++k) {
                const int sp = n * CH + c - 3 + k;
                v4u xv = {0u, 0u, 0u, 0u};
                if (sp >= 0) xv = *(const v4u*)(P.PROJ + (size_t)(t0 + c - 3 + k) * INC + chA);
                const f32x4 w0 = *(const LAS f32x4*)(CW + k * DL + chA), w1 = *(const LAS f32x4*)(CW + k * DL + chA + 4);
                xc[0] += w0[0] * bflo(xv.x); xc[1] += w0[1] * bfhi(xv.x); xc[2] += w0[2] * bflo(xv.y); xc[3] += w0[3] * bfhi(xv.y);
                xc[4] += w1[0] * bflo(xv.z); xc[5] += w1[1] * bfhi(xv.z); xc[6] += w1[2] * bflo(xv.w); xc[7] += w1[3] * bfhi(xv.w);
            }
            v4u pk; pk.x = cvt_pk_bf16(xc[0], xc[1]); pk.y = cvt_pk_bf16(xc[2], xc[3]); pk.z = cvt_pk_bf16(xc[4], xc[5]); pk.w = cvt_pk_bf16(xc[6], xc[7]);
            fr[ks] = __builtin_bit_cast(bf16x8, pk);
            *(LAS f32x4*)(XC + r * 68 + 32 * ks + 8 * g) = (f32x4){xc[0], xc[1], xc[2], xc[3]};
            *(LAS f32x4*)(XC + r * 68 + 32 * ks + 8 * g + 4) = (f32x4){xc[4], xc[5], xc[6], xc[7]};
        }
        wave_lds_fence();
#pragma unroll
        for (int jt = 0; jt < 4; ++jt) {
            f32x4 aa = {0.f, 0.f, 0.f, 0.f}, ax = {0.f, 0.f, 0.f, 0.f};
#pragma unroll
            for (int ks = 0; ks < 2; ++ks) { aa = __builtin_amdgcn_mfma_f32_16x16x32_bf16(fr[ks], Wa[jt][ks], aa, 0, 0, 0); ax = __builtin_amdgcn_mfma_f32_16x16x32_bf16(fr[ks], Wx[jt][ks], ax, 0, 0, 0); }
            float av[4], uv[4]; float Al = 1.f, Hl = 0.f;
#pragma unroll
            for (int q = 0; q < 4; ++q) {
                const float xcv = XC[(4 * g + q) * 68 + 16 * jt + r];
                const float rg = fast_sigmoid(aa[q] + ba[jt]), ig = fast_sigmoid(ax[q] + bx[jt]);
                const float la = -rg * sp8[jt];
                const float a = __builtin_amdgcn_exp2f(la * 1.4426950408889634f);
                const float x2 = 2.f * la;
                const float em = x2 > -0.25f ? -x2 * (1.f + x2 * (0.5f + x2 * (0.16666667f + x2 * (0.041666668f + x2 * (0.0083333333f + x2 * 0.0013888889f))))) : 1.f - a * a;
                const float u = sqrtf(em) * (ig * xcv);
                av[q] = a; uv[q] = u; Hl = a * Hl + u; Al *= a;
            }
            float Ap = 1.f, Hp = 0.f;
#pragma unroll
            for (int k = 3; k >= 1; --k) {
                const float Ao = __shfl(Al, lane - 16 * k), Ho = __shfl(Hl, lane - 16 * k);
                if (g >= k) { Hp = Ao * Hp + Ho; Ap *= Ao; }
            }
            float h = Ap * St[jt] + Hp;
            if (FINAL) {
#pragma unroll
                for (int q = 0; q < 4; ++q) {
                    h = av[q] * h + uv[q];
                    const size_t tok = (size_t)(t0 + 16 * tt + 4 * g + q);
                    const float gl = bf2f(glv[jt][q]);
                    P.MIX[tok * D + hb * 64 + 16 * jt + r] = (bf16)cvt_pk_bf16(h * gelu_tanh_fast(gl), 0.f);
                }
            } else {
                h = Al * h + Hl;
            }
            const float Atile = __shfl(Ap * Al, (lane & 15) + 48);
            St[jt] = __shfl(h, (lane & 15) + 48);
            At[jt] *= Atile;
        }
        wave_lds_fence();
    }
    if (!FINAL && g == 0) {
#pragma unroll
        for (int jt = 0; jt < 4; ++jt) { const int ch = hb * 64 + 16 * jt + r; float* AE = (float*)(P.ws + WS_LRU);
            AE[(b * NCH + n) * DL + ch] = At[jt]; AE[B * NCH * DL + (b * NCH + n) * DL + ch] = St[jt]; }
    }
}

__device__ __forceinline__ void p2_mix_summaries(Frame& F, const Ptrs& P) {
    const int w = F.wave;
#pragma unroll 1
    for (int u = F.vcu; u < B * NCH; u += F.G) {
        const int b = u / NCH, n = u % NCH; const int t0 = b * S + n * CH;
        __syncthreads();
        { int lane0 = F.lane; asm volatile("" : "+v"(lane0)); lru_chunk<false>(F, P, b, n, lane0); }
        KVRaw raw; { int tid0 = F.tid; asm volatile("" : "+v"(tid0)); kv_issue(raw, tid0, P.PROJ + (size_t)t0 * INC, 0); }
#pragma unroll 1
        for (int h = 0; h < NH; ++h) {
            int lane = F.lane; asm volatile("" : "+v"(lane));
            int tidv = F.tid; asm volatile("" : "+v"(tidv));
            const int r = lane & 15, g = lane >> 4;
            unsigned trb[8][2];
#pragma unroll
            for (int c = 0; c < 8; ++c) { trb[c][0] = tr_read_addr_16(lane, c, 0, 0); trb[c][1] = tr_read_addr_16(lane, c, 0, 1); }
            const float lg2 = __builtin_amdgcn_logf(1.f - __builtin_amdgcn_exp2f(-5.f - (float)h));
            __syncthreads();
            kv_store<true>(F, raw, tidv, n * CH, lg2);
            if (h + 1 < NH) kv_issue(raw, tidv, P.PROJ + (size_t)t0 * INC, h + 1);
            __syncthreads();
            LAS unsigned char* Kimg = F.lds + MIX_K_OFF; LAS unsigned char* Vimg = F.lds + MIX_V_OFF;
            f32x4 acc[8];
#pragma unroll
            for (int dt = 0; dt < 8; ++dt) acc[dt] = (f32x4){0.f, 0.f, 0.f, 0.f};
            const unsigned ta0 = tr_read_addr_16(lane, w, 0, 0), ta1 = tr_read_addr_16(lane, w, 0, 1);
#pragma unroll 1
            for (int ks = 0; ks < 4; ++ks) {
                const bf16x8 Af = tr_frag2(Vimg + ta0 + 8192 * ks, Vimg + ta1 + 8192 * ks);
#pragma unroll
                for (int dt = 0; dt < 8; ++dt) { const bf16x8 Bf = tr_frag2(Kimg + trb[dt][0] + 8192 * ks, Kimg + trb[dt][1] + 8192 * ks); acc[dt] = __builtin_amdgcn_mfma_f32_16x16x32_bf16(Af, Bf, acc[dt], 0, 0, 0); }
            }
            float* KV = P.out + ((size_t)((b * NH + h) * NCH + n)) * (HD * HD);
#pragma unroll
            for (int dt = 0; dt < 8; ++dt)
#pragma unroll
                for (int q = 0; q < 4; ++q) KV[(16 * w + 4 * g + q) * HD + 16 * dt + r] = acc[dt][q];
        }
    }
}
__device__ __forceinline__ void p3_scans(Frame& F, const Ptrs& P) {
    const int idx = F.vcu * NTHR + F.tid;
    for (int id = idx; id < B * NH * (HD * HD / 4); id += F.G * NTHR) {
        const int bh = id >> 12, el = (id & 4095) * 4, h = bh & 3;
        const float lg2 = __builtin_amdgcn_logf(1.f - __builtin_amdgcn_exp2f(-5.f - (float)h));
        const float dec = __builtin_amdgcn_exp2f(128.f * lg2);
        const float* KV = P.out + (size_t)bh * NCH * (HD * HD) + el;
        bf16* PV = (bf16*)(P.out + (size_t)B * NH * NCH * (HD * HD)) + (size_t)bh * NCH * (HD * HD) + el;
        f32x4 st = {0.f, 0.f, 0.f, 0.f};
#pragma unroll 8
        for (int n = 0; n < NCH; ++n) {
            const f32x4 kv = *(const f32x4*)(KV + (size_t)n * (HD * HD));
            v2u w; w.x = cvt_pk_bf16(st[0], st[1]); w.y = cvt_pk_bf16(st[2], st[3]);
            *(v2u*)(PV + (size_t)n * (HD * HD)) = w;
            st = st * dec + kv;
        }
    }
    if (idx < B * DL) {
        const int b = idx / DL, ch = idx % DL; float* AE = (float*)(P.ws + WS_LRU);
        float carry = 0.f;
        for (int n = 0; n < NCH; ++n) {
            const float a = AE[(b * NCH + n) * DL + ch], e = AE[B * NCH * DL + (b * NCH + n) * DL + ch];
            AE[2 * B * NCH * DL + (b * NCH + n) * DL + ch] = carry;
            carry = a * carry + e;
        }
    }
}
__device__ __forceinline__ void p4_mix_outputs(Frame& F, const Ptrs& P) {
    const int w = F.wave;
#pragma unroll 1
    for (int u = F.vcu; u < B * NCH; u += F.G) {
        const int b = u / NCH, n = u % NCH; const int t0 = b * S + n * CH;
        __syncthreads();
        { int lane0 = F.lane; asm volatile("" : "+v"(lane0)); lru_chunk<true>(F, P, b, n, lane0); }
        KVRaw raw; v4u qraw[2][2];
        { int tid0 = F.tid, lane0 = F.lane; asm volatile("" : "+v"(tid0), "+v"(lane0)); kv_issue(raw, tid0, P.PROJ + (size_t)t0 * INC, 0);
          const bf16* qrow = P.PROJ + (size_t)(t0 + 16 * w + (lane0 & 15)) * INC + 1024 + 8 * (lane0 >> 4);
#pragma unroll
          for (int ks = 0; ks < 2; ++ks) { qraw[ks][0] = *(const v4u*)(qrow + 32 * ks); qraw[ks][1] = *(const v4u*)(qrow + 32 * ks + 64); } }
#pragma unroll 1
        for (int h = 0; h < NH; ++h) {
            int lane = F.lane; asm volatile("" : "+v"(lane));
            int tidv = F.tid; asm volatile("" : "+v"(tidv));
            const int r = lane & 15, g = lane >> 4;
            unsigned trb[8][2], rrb[4];
#pragma unroll
            for (int c = 0; c < 8; ++c) { trb[c][0] = tr_read_addr_16(lane, c, 0, 0); trb[c][1] = tr_read_addr_16(lane, c, 0, 1); }
#pragma unroll
            for (int ks = 0; ks < 4; ++ks) rrb[ks] = row_read_addr_16(lane, 0, ks);
            const float lg2 = __builtin_amdgcn_logf(1.f - __builtin_amdgcn_exp2f(-5.f - (float)h));
            __syncthreads();
            kv_store<false>(F, raw, tidv, n * CH, lg2);
            bf16x8 Qf[4];
            {
                const float pos = (float)(n * CH + 16 * w + r);
#pragma unroll
                for (int ks = 0; ks < 2; ++ks) {
                    const v4u q1 = qraw[ks][0], q2 = qraw[ks][1];
                    v4u o1, o2;
#pragma unroll
                    for (int q = 0; q < 4; ++q) {
                        const float i0 = __builtin_amdgcn_exp2f(-(float)(32 * ks + 8 * g + 2 * q) * LOG2_ROPE_OVER_64), i1 = __builtin_amdgcn_exp2f(-(float)(32 * ks + 8 * g + 2 * q + 1) * LOG2_ROPE_OVER_64);
                        float sn0, cs0, sn1, cs1; sincos_rev(pos * i0, sn0, cs0); sincos_rev(pos * i1, sn1, cs1);
                        const float a0 = bflo(q1[q]), a1 = bfhi(q1[q]), b0 = bflo(q2[q]), b1 = bfhi(q2[q]);
                        o1[q] = cvt_pk_bf16(a0 * cs0 - b0 * sn0, a1 * cs1 - b1 * sn1);
                        o2[q] = cvt_pk_bf16(a0 * sn0 + b0 * cs0, a1 * sn1 + b1 * cs1);
                    }
                    Qf[ks] = __builtin_bit_cast(bf16x8, o1); Qf[ks + 2] = __builtin_bit_cast(bf16x8, o2);
                }
            }
            __syncthreads();
            LAS unsigned char* Kimg = F.lds + MIX_K_OFF; LAS unsigned char* Vimg = F.lds + MIX_V_OFF; LAS unsigned char* Sst = F.lds + MIX_S_OFF + w * MIX_S_WAVE;
            const bf16* PV = (const bf16*)(P.out + (size_t)B * NH * NCH * (HD * HD)) + ((size_t)((b * NH + h) * NCH + n)) * (HD * HD);
            bf16 grv[8][4];
#pragma unroll
            for (int et = 0; et < 8; ++et)
#pragma unroll
                for (int q = 0; q < 4; ++q) grv[et][q] = P.PROJ[(size_t)(t0 + 16 * w + 4 * g + q) * INC + 2560 + h * HD + 16 * et + r];
            bf16x8 Pf[4][4];
#pragma unroll
            for (int et = 0; et < 4; ++et)
#pragma unroll
                for (int ks = 0; ks < 4; ++ks) Pf[et][ks] = *(const bf16x8*)(PV + (size_t)(16 * et + r) * HD + 32 * ks + 8 * g);
            if (h + 1 < NH) {
                kv_issue(raw, tidv, P.PROJ + (size_t)t0 * INC, h + 1);
                const bf16* qrow = P.PROJ + (size_t)(t0 + 16 * w + r) * INC + 1024 + (h + 1) * HD + 8 * g;
#pragma unroll
                for (int ks = 0; ks < 2; ++ks) { qraw[ks][0] = *(const v4u*)(qrow + 32 * ks); qraw[ks][1] = *(const v4u*)(qrow + 32 * ks + 64); }
            }
#pragma unroll 1
            for (int mt = 0; mt <= w; ++mt) {
                f32x4 sa = {0.f, 0.f, 0.f, 0.f};
#pragma unroll
                for (int ks = 0; ks < 4; ++ks) { const bf16x8 Kf = *(const LAS bf16x8*)(Kimg + rrb[ks] + 4096 * mt); sa = __builtin_amdgcn_mfma_f32_16x16x32_bf16(Qf[ks], Kf, sa, 0, 0, 0); }
#pragma unroll
                for (int q = 0; q < 4; ++q) {
                    const int dlt = (16 * w + 4 * g + q) - (16 * mt + r);
                    const float v = dlt >= 0 ? sa[q] * __builtin_amdgcn_exp2f((float)dlt * lg2) : 0.f;
                    *(LAS bf16*)(Sst + (4 * g + q) * MIX_S_STRIDE + (16 * mt + r) * 2) = (bf16)cvt_pk_bf16(v, 0.f);
                }
            }
            if ((w & 1) == 0) {
#pragma unroll
                for (int q = 0; q < 4; ++q) *(LAS bf16*)(Sst + (4 * g + q) * MIX_S_STRIDE + (16 * (w + 1) + r) * 2) = 0;
            }
            wave_lds_fence();
            f32x4 acc[8];
            float rsc[4];
#pragma unroll
            for (int q = 0; q < 4; ++q) rsc[q] = __builtin_amdgcn_exp2f((float)(16 * w + 4 * g + q + 1) * lg2);
#pragma unroll
            for (int et = 0; et < 4; ++et) {
                f32x4 a = {0.f, 0.f, 0.f, 0.f};
#pragma unroll
                for (int ks = 0; ks < 4; ++ks) a = __builtin_amdgcn_mfma_f32_16x16x32_bf16(Qf[ks], Pf[et][ks], a, 0, 0, 0);
#pragma unroll
                for (int q = 0; q < 4; ++q) a[q] *= rsc[q];
                acc[et] = a; acc[et + 4] = (f32x4){0.f, 0.f, 0.f, 0.f};
            }
#pragma unroll
            for (int et = 0; et < 4; ++et)
#pragma unroll
                for (int ks = 0; ks < 4; ++ks) Pf[et][ks] = *(const bf16x8*)(PV + (size_t)(16 * (et + 4) + r) * HD + 32 * ks + 8 * g);
#pragma unroll 1
            for (int ks = 0; ks <= (w >> 1); ++ks) {
                const bf16x8 Sf = *(const LAS bf16x8*)(Sst + r * MIX_S_STRIDE + (32 * ks + 8 * g) * 2);
#pragma unroll
                for (int et = 0; et < 8; ++et) { const bf16x8 Vf = tr_frag2(Vimg + trb[et][0] + 8192 * ks, Vimg + trb[et][1] + 8192 * ks); acc[et] = __builtin_amdgcn_mfma_f32_16x16x32_bf16(Sf, Vf, acc[et], 0, 0, 0); }
            }
#pragma unroll
            for (int et = 0; et < 4; ++et) {
                f32x4 a = {0.f, 0.f, 0.f, 0.f};
#pragma unroll
                for (int ks = 0; ks < 4; ++ks) a = __builtin_amdgcn_mfma_f32_16x16x32_bf16(Qf[ks], Pf[et][ks], a, 0, 0, 0);
#pragma unroll
                for (int q = 0; q < 4; ++q) acc[et + 4][q] += a[q] * rsc[q];
            }
            float mu[4], rs[4];
#pragma unroll
            for (int q = 0; q < 4; ++q) {
                float s = 0.f;
#pragma unroll
                for (int et = 0; et < 8; ++et) s += acc[et][q];
                s += __shfl_xor(s, 1); s += __shfl_xor(s, 2); s += __shfl_xor(s, 4); s += __shfl_xor(s, 8);
                const float m = s * (1.f / 128.f); float v = 0.f;
#pragma unroll
                for (int et = 0; et < 8; ++et) { const float d = acc[et][q] - m; v += d * d; }
                v += __shfl_xor(v, 1); v += __shfl_xor(v, 2); v += __shfl_xor(v, 4); v += __shfl_xor(v, 8);
                mu[q] = m; rs[q] = 1.0f / sqrtf(v * (1.f / 128.f) + EPS);
            }
#pragma unroll
            for (int et = 0; et < 8; ++et)
#pragma unroll
                for (int q = 0; q < 4; ++q) {
                    const size_t tok = (size_t)(t0 + 16 * w + 4 * g + q);
                    const float gr = bf2f(grv[et][q]);
                    P.MIX[tok * D + DL + h * HD + 16 * et + r] = (bf16)cvt_pk_bf16(gr * fast_sigmoid(gr) * (acc[et][q] - mu[q]) * rs[q], 0.f);
                }
        }
    }
}
__global__ void __launch_bounds__(NTHR, 2) mk_fwd(Args args) {
    extern __shared__ __attribute__((aligned(16))) unsigned char lds_raw[];
    Frame F;
    F.lds = (LAS unsigned char*)lds_raw;
    F.MISC = (volatile LAS unsigned*)(F.lds + LDSCTL_OFF);
    F.tid = threadIdx.x; F.lane = F.tid & 63; F.wave = __builtin_amdgcn_readfirstlane(F.tid >> 6);
    F.G = gridDim.x; { const int bx = blockIdx.x; F.vcu = (F.G % 8 == 0) ? (bx % 8) * (F.G / 8) + bx / 8 : bx; }
    F.ctl = (gu32*)(args.ws + WS_CTL);
    Ptrs P; make_ptrs(P, args);
    for (int u = F.tid; u < 256; u += NTHR) ((LAS unsigned*)(F.lds + LDSCTL_OFF))[u] = 0u;
    __syncthreads();
    XcdBarrier bar = xcd_barrier_post((unsigned*)(F.ctl + CW_BAR) + args.ph_hi * XCD_BAR_WORDS, F.MISC + 8);
    const int lo = args.ph_lo, hi = args.ph_hi;
#define IN(k) (lo <= (k) && (k) < hi)
#define SEAM(k) do { if (IN(k) && IN((k) + 1)) xcd_barrier(bar); } while (0)
    if (IN(0)) { p0_prologue(F, P); }
    SEAM(0);
    if (IN(1)) {
        pg8::PlainSched S; S.init(P.XB, P.W_IN, T, INC, D, F.G, (int)blockIdx.x);
        pg8::EpiRowScaleBf16 E{P.PROJ, INC, P.rstd0};
        pg8::gemm_phase(F.lds + RING_OFF, S, E);
    }
    SEAM(1);
    if (IN(2)) p2_mix_summaries(F, P);
    SEAM(2);
    if (IN(3)) p3_scans(F, P);
    SEAM(3);
    if (IN(4)) p4_mix_outputs(F, P);
    SEAM(4);
    if (IN(5)) {
        pg8::PlainSched S; S.init(P.MIX, P.W_OUT, T, D, D, F.G, (int)blockIdx.x);
        pg8::EpiPlainBf16 E{P.D1, D};
        pg8::gemm_phase(F.lds + RING_OFF, S, E);
    }
    SEAM(5);
    if (IN(6)) p6_route(F, P);
    SEAM(6);
    if (IN(7)) p7_lists(F, P);
    SEAM(7);
    if (IN(8)) moe_phase<0>(F, P, lo == 8);
    SEAM(8);
    if (IN(9)) moe_phase<1>(F, P, lo == 9);
    SEAM(9);
    if (IN(10)) p10_combine(F, P);
    SEAM(10);
    if (IN(11)) {
        pg8::PlainSched S; S.init((const bf16*)P.X1B, P.W_PG, T, D, D / 2, F.G, (int)blockIdx.x);
        pg8::EpiGateBf16 E{P.GATE, D, P.rstd2, P.b_pg, 1.f / (PLE_SX2 * PLE_SWG)};
        pg8::gemm_phase<pg8::EpiGateBf16, pg8::PlainSched, true>(F.lds + RING_OFF, S, E);
    }
    if (IN(12)) {
        pg8::PlainSched S; S.init(P.PB, P.W_PP, T, D, PLE, F.G, (int)blockIdx.x);
        pg8::EpiPlainBf16 E{P.PP, D};
        pg8::gemm_phase(F.lds + RING_OFF, S, E);
    }
    SEAM(12);
    if (IN(13)) p13_final(F, P);
#undef IN
#undef SEAM
}

static int mk_grid = 0;
static void mk_launch(void* const* d_in, void* d_out, void* d_ws, int lo, int hi, hipStream_t stream) {
    if (mk_grid == 0) {
        int dev = 0, cus = 0;
        if (hipGetDevice(&dev) != hipSuccess || hipDeviceGetAttribute(&cus, hipDeviceAttributeMultiprocessorCount, dev) != hipSuccess) { mk_grid = -1; return; }
        if (hipFuncSetAttribute((const void*)mk_fwd, hipFuncAttributeMaxDynamicSharedMemorySize, LDS_BYTES) != hipSuccess) { fprintf(stderr, "mk: hipFuncSetAttribute failed\n"); mk_grid = -1; return; }
        int per_cu = 0;
        if (hipOccupancyMaxActiveBlocksPerMultiprocessor(&per_cu, (const void*)mk_fwd, NTHR, LDS_BYTES) != hipSuccess || per_cu < 1) { fprintf(stderr, "mk: occupancy query says %d\n", per_cu); (void)hipGetLastError(); }
        mk_grid = cus;
    }
    if (mk_grid < 0) return;
    Args a; memset(&a, 0, sizeof a);
    for (int i = 0; i < 25; ++i) a.in[i] = (const float*)d_in[i];
    a.out = (float*)d_out; a.ws = (unsigned char*)d_ws; a.ph_lo = lo; a.ph_hi = hi;
    hipLaunchKernelGGL(mk_fwd, dim3(mk_grid), dim3(NTHR), LDS_BYTES, stream, a);
}
extern "C" void kernel_launch(void* const* d_in, const int* in_sizes, int n_in, void* d_out, int out_size, void* d_ws, size_t ws_size, hipStream_t stream) {
    if (n_in != 25 || ws_size < WS_END || out_size != T * D) { fprintf(stderr, "kernel_launch: n_in %d, workspace %zu (need %zu), out_size %d: nothing launched\n", n_in, ws_size, (size_t)WS_END, out_size); return; }
    (void)hipMemsetAsync((unsigned char*)d_ws + WS_CTL, 0, 1 * MiB, stream);
    mk_launch(d_in, d_out, d_ws, 0, 14, stream);
}
```

```cpp
#include <hip/hip_runtime.h>
#include <stdint.h>
#include <stdio.h>
#include <string.h>

typedef unsigned short bf16;
namespace cfg {
constexpr int D = 1024, B = 8, S = 4096, T = B * S, PLE = 256, DL = 512, DR = 512, NH = 4, HD = 128, INC = 3072;
constexpr int NE = 64, DE = 512, NG = 8, EPG = 8, CH = 128, NCH = S / CH;
constexpr float EPS = 1e-6f;
constexpr float MOE_SX = 8.f, MOE_SW1 = 64.f, MOE_SA = 8.f, MOE_SW2 = 32.f;
constexpr float PLE_SX2 = 8.f, PLE_SWG = 64.f;
constexpr size_t MiB = 1u << 20;
constexpr size_t WS_CTL = 0;
constexpr size_t WS_RSTD0 = 1 * MiB, WS_RSTD1 = WS_RSTD0 + 128 * 1024, WS_RSTD2 = WS_RSTD1 + 128 * 1024;
constexpr size_t WS_EID = 2 * MiB, WS_EW = WS_EID + 256 * 1024, WS_LIST = WS_EW + 256 * 1024, WS_CNT = WS_LIST + 256 * 1024;
constexpr size_t WS_LOGITS = 3 * MiB;
constexpr size_t WS_LRU = 13 * MiB;
constexpr size_t WS_WIN = 16 * MiB, WS_WOUT = 22 * MiB, WS_WPG = 24 * MiB, WS_WPP = 26 * MiB, WS_WRT = 26 * MiB + 512 * 1024, WS_LRUW = 27 * MiB;
constexpr size_t WS_W13 = 28 * MiB, WS_W2 = 156 * MiB, WS_PB = 220 * MiB;
constexpr size_t WS_R64 = 236 * MiB;
constexpr size_t WS_PROJ = 300 * MiB;
constexpr size_t WS_D1 = 300 * MiB, WS_X1B = 364 * MiB, WS_Y = 428 * MiB, WS_PP = 428 * MiB;
constexpr size_t WS_END = 556 * MiB;
}
using namespace cfg;

__device__ __forceinline__ float bf2f(bf16 v) { return __uint_as_float((unsigned)v << 16); }
__device__ __forceinline__ bf16 f2bf(float f) { unsigned u = __float_as_uint(f); return (bf16)((u + 0x7fffu + ((u >> 16) & 1u)) >> 16); }
__device__ __forceinline__ float ldv(const float* p, size_t i) { return p[i]; }
__device__ __forceinline__ float ldv(const bf16* p, size_t i) { return bf2f(p[i]); }
__device__ __forceinline__ void stv(float* p, size_t i, float v) { p[i] = v; }
__device__ __forceinline__ void stv(bf16* p, size_t i, float v) { p[i] = f2bf(v); }

#define GAS __attribute__((address_space(1)))
#define LAS __attribute__((address_space(3)))
typedef unsigned v4u __attribute__((ext_vector_type(4)));
typedef unsigned v2u __attribute__((ext_vector_type(2)));
typedef float f32x4 __attribute__((ext_vector_type(4)));
typedef float f32x2 __attribute__((ext_vector_type(2)));
typedef short bf16x8 __attribute__((ext_vector_type(8)));
typedef short bf16x4 __attribute__((ext_vector_type(4)));
typedef GAS unsigned gu32;
#define RLX_AGENT __ATOMIC_RELAXED, __HIP_MEMORY_SCOPE_AGENT
#define LDS_WAIT() asm volatile("s_waitcnt lgkmcnt(0)" ::: "memory")
#define VM_WAIT() asm volatile("s_waitcnt vmcnt(0)" ::: "memory")
__device__ __forceinline__ unsigned pk2(float lo, float hi) { return (unsigned)f2bf(lo) | ((unsigned)f2bf(hi) << 16); }
typedef __bf16 hwbf16x2 __attribute__((ext_vector_type(2)));
__device__ __forceinline__ unsigned cvt_pk_bf16(float lo, float hi) { f32x2 v = {lo, hi}; hwbf16x2 b = __builtin_convertvector(v, hwbf16x2); return __builtin_bit_cast(unsigned, b); }
__device__ __forceinline__ float bflo(unsigned w) { return __uint_as_float(w << 16); }
__device__ __forceinline__ float bfhi(unsigned w) { return __uint_as_float(w & 0xffff0000u); }
__device__ __forceinline__ float fast_sigmoid(float x) { return __builtin_amdgcn_rcpf(1.f + __builtin_amdgcn_exp2f(-1.4426950408889634f * x)); }

#define XB_TMO      128
#define XB_XCNT(j)  (256  + 64 * (j))
#define XB_XSUB(j)  (1280 + 64 * (j))
#define XB_XGEN(j)  (2304 + 64 * (j))
#define XB_TOP      3328
#define XB_TOPGEN   3392
#define XCD_BAR_WORDS 3456
#define XB_SPIN_CAP (1u << 18)
__device__ __forceinline__ unsigned xb_ld(unsigned* p)              { return __hip_atomic_load(p, __ATOMIC_RELAXED, __HIP_MEMORY_SCOPE_AGENT); }
__device__ __forceinline__ unsigned xb_add(unsigned* p, unsigned v) { return __hip_atomic_fetch_add(p, v, __ATOMIC_RELAXED, __HIP_MEMORY_SCOPE_AGENT); }
__device__ __forceinline__ unsigned xb_xcc_id() { return (unsigned)__builtin_amdgcn_s_getreg((3 << 11) | 20) & 0xFu; }
#define XB_SPIN(cond, bar) do { unsigned _sp = 0; while (cond) { __builtin_amdgcn_s_sleep(1); \
    if ((++_sp & 255u) == 0u) { if (xb_ld(&(bar)[XB_TMO])) break; if (_sp > XB_SPIN_CAP) { atomicAdd(&(bar)[XB_TMO], 1u); break; } } } } while (0)
struct XcdBarrier { unsigned* bar; unsigned x; volatile LAS unsigned* st; };
__device__ __forceinline__ XcdBarrier xcd_barrier_post(unsigned* bar, volatile LAS unsigned* st) {
    XcdBarrier b; b.bar = bar; b.x = xb_xcc_id(); b.st = st;
    if (threadIdx.x == 0) (void)xb_add(&bar[XB_XCNT(b.x)], 1u);
    return b;
}
__device__ __forceinline__ void xcd_barrier_complete(unsigned* bar, unsigned x, unsigned& nloc, unsigned& nx) {
    const unsigned G = gridDim.x * gridDim.y * gridDim.z;
    unsigned sum, cnt, mine, sp = 0u;
    for (;;) {
        sum = 0u; cnt = 0u; mine = 0u;
#pragma unroll
        for (unsigned j = 0; j < 16; ++j) { const unsigned c = xb_ld(&bar[XB_XCNT(j)]); sum += c; cnt += (c > 0u) ? 1u : 0u; mine = (j == x) ? c : mine; }
        if (sum == G) break;
        __builtin_amdgcn_s_sleep(1);
        if ((++sp & 255u) == 0u) { if (xb_ld(&bar[XB_TMO])) break; if (sp > XB_SPIN_CAP) { atomicAdd(&bar[XB_TMO], 1u); break; } }
    }
    nloc = mine > 0u ? mine : 1u; nx = cnt > 0u ? cnt : 1u;
}
__device__ __forceinline__ void xcd_barrier(const XcdBarrier& b) {
    asm volatile("s_waitcnt vmcnt(0)" ::: "memory");
    __syncthreads();
    if (threadIdx.x == 0) {
        unsigned* bar = b.bar;
        __builtin_amdgcn_s_waitcnt(0);
        unsigned nloc = b.st[0], nx = b.st[1];
        if (nloc == 0u) { xcd_barrier_complete(bar, b.x, nloc, nx); b.st[0] = nloc; b.st[1] = nx; }
        const unsigned old = xb_add(&bar[XB_XSUB(b.x)], 1u);
        const unsigned gen = old / nloc;
        if (old + 1u == (gen + 1u) * nloc) {
            __builtin_amdgcn_fence(__ATOMIC_RELEASE, "agent");
            asm volatile("s_waitcnt vmcnt(0)" ::: "memory");
            const unsigned og = xb_add(&bar[XB_TOP], 1u);
            const unsigned tg = og / nx;
            if (og + 1u == (tg + 1u) * nx) xb_add(&bar[XB_TOPGEN], 1u);
            else XB_SPIN(xb_ld(&bar[XB_TOPGEN]) == tg, bar);
            __builtin_amdgcn_fence(__ATOMIC_ACQUIRE, "agent");
            xb_add(&bar[XB_XGEN(b.x)], 1u);
            asm volatile("s_waitcnt vmcnt(0)" ::: "memory");
        } else {
            XB_SPIN(xb_ld(&bar[XB_XGEN(b.x)]) == gen, bar);
            __builtin_amdgcn_fence(__ATOMIC_ACQUIRE, "agent");
            asm volatile("s_waitcnt vmcnt(0)" ::: "memory");
        }
    }
    __syncthreads();
}

constexpr int NWAVES = 8, NTHR = NWAVES * 64;
constexpr int RING_OFF = 0, RING_BYTES = 131072;
constexpr int LDSCTL_OFF = RING_BYTES;
constexpr int UTAB_OFF = LDSCTL_OFF + 1024;
constexpr int MAXU = 6;
constexpr int UTABF_OFF = UTAB_OFF + MAXU * 1024;
constexpr int SCHED_OFF = UTABF_OFF + MAXU * 1024;
constexpr int LDS_BYTES = SCHED_OFF + 2048;
static_assert(LDS_BYTES <= 160 * 1024 && LDS_BYTES > 80 * 1024, "LDS map");
constexpr int CW_TMO = 0, CW_BAR = 4096;

namespace pg8 {
constexpr int BM = 256, BK = 64, HALF = 128, HTB = HALF * BK * 2, STAGE_BYTES = 8 * HTB;
__host__ __device__ __forceinline__ int lds_byte(int r, int c) { const int st = (r >> 4) * 2 + (c >> 5), rr = r & 15, cc = c & 31, ob = rr * 64 + cc * 2; return st * 1024 + (ob ^ (((ob >> 9) & 1) << 5)); }
__host__ __device__ __forceinline__ void stage_rc(int b, int& R, int& C) { const int st = b / 1024, sb = b % 1024, swz = sb ^ (((sb >> 9) & 1) << 5); R = (st >> 1) * 16 + swz / 64; C = (st & 1) * 32 + (swz % 64) / 2; }
__host__ __device__ __forceinline__ int perm32(int rho) { const int n = rho >> 4, i = rho & 15; return 8 * (i >> 2) + 4 * n + (i & 3); }

struct Unit { int pm, pn, e, rows, slot0, ui; };

struct PlainSched {
    static constexpr bool GATHER = false;
    const bf16* A; const bf16* Bt; int K; int nM, nN, nwg, G, c;
    __device__ void init(const bf16* A_, const bf16* Bt_, int M, int N, int K_, int G_, int c_) { A = A_; Bt = Bt_; K = K_; nM = M / BM; nN = N / BM; nwg = nM * nN; G = G_; c = c_; }
    __device__ __forceinline__ bool next(int i, Unit& u) const {
        const long L = (long)i * G + c; if (L >= nwg) return false;
        int wgid = (int)L; { const int q = nwg / 8, r = nwg % 8, xcd = wgid % 8, off = wgid / 8; wgid = (xcd < r ? xcd * (q + 1) : r * (q + 1) + (xcd - r) * q) + off; }
        const int nig = 8 * nN, gid = wgid / nig, fm = gid * 8, gsz = (nM - fm) < 8 ? (nM - fm) : 8;
        u.pm = fm + ((wgid % nig) % gsz); u.pn = (wgid % nig) / gsz; u.e = 0; u.rows = 256; u.slot0 = 0; u.ui = i; return true;
    }
    __device__ __forceinline__ const char* a_base(const Unit& u) const { return (const char*)A + (size_t)u.pm * (size_t)(BM * 2) * K; }
    __device__ __forceinline__ const char* b_base(const Unit& u) const { return (const char*)Bt + (size_t)u.pn * (size_t)(BM * 2) * K; }
    __device__ __forceinline__ unsigned a_rowoff(const Unit&, int r) const { return (unsigned)r * (unsigned)K * 2u; }
};

typedef long i64x2 __attribute__((ext_vector_type(2)));
template <class Epi, class Sched, bool FP8 = false>
__device__ __forceinline__ void gemm_phase(LAS unsigned char* lds, const Sched& S, const Epi& E) {
    const int tid = threadIdx.x, wid = __builtin_amdgcn_readfirstlane(tid >> 6), lane = tid & 63, wr = wid >> 2, wc = wid & 3, fr = lane & 15, fq = lane >> 4;
    const int K = S.K, nt = K / BK;
    int Rr[2], Cc[2]; unsigned voffB[2];
#pragma unroll
    for (int i = 0; i < 2; ++i) { stage_rc(tid * 16 + i * 8192, Rr[i], Cc[i]); const int Rb = (Rr[i] & ~31) + perm32(Rr[i] & 31); voffB[i] = (unsigned)(Rb * K + Cc[i]) * 2u; }
    const size_t kstep = (size_t)(BK * 2);
    const size_t hstep = (size_t)HALF * K * 2;
    const unsigned ldsw = (unsigned)wid * 1024u;
    const int aoff = lds_byte(wr * 64 + fr, fq * 8), boff = lds_byte(wc * 32 + fr, fq * 8);
#define PG8_SA(b, h) (((b) * 2 + (h)) * HTB)
#define PG8_SB(b, h) ((4 + (b) * 2 + (h)) * HTB)
#define PG8_STAGE(bufoff, gbase, voff) do { _Pragma("unroll") for (int _i = 0; _i < 2; ++_i) \
        __builtin_amdgcn_global_load_lds((const unsigned*)((const char*)(gbase) + (voff)[_i]), (LAS unsigned*)(lds + (bufoff) + ldsw + _i * 8192), 16, 0, 0); } while (0)
#define PG8_LDA(dst, b, h) do { _Pragma("unroll") for (int m = 0; m < 4; ++m) _Pragma("unroll") for (int k = 0; k < 2; ++k) dst[m][k] = *(const LAS bf16x8*)(lds + PG8_SA(b, h) + aoff + m * 2048 + k * 1024); } while (0)
#define PG8_LDB(dst, b, h) do { _Pragma("unroll") for (int n = 0; n < 2; ++n) _Pragma("unroll") for (int k = 0; k < 2; ++k) dst[n][k] = *(const LAS bf16x8*)(lds + PG8_SB(b, h) + boff + n * 2048 + k * 1024); } while (0)
#define PG8_MMA(ai, bj, At, Bt) do { __builtin_amdgcn_s_setprio(1); _Pragma("unroll") for (int m = 0; m < 4; ++m) _Pragma("unroll") for (int n = 0; n < 2; ++n) _Pragma("unroll") for (int k = 0; k < 2; ++k) { \
        if constexpr (FP8) { const i64x2 a8_ = __builtin_bit_cast(i64x2, At[m][k]), b8_ = __builtin_bit_cast(i64x2, Bt[n][k]); \
            acc[ai][bj][m][n] = __builtin_amdgcn_mfma_f32_16x16x32_fp8_fp8(b8_[0], a8_[0], acc[ai][bj][m][n], 0, 0, 0); acc[ai][bj][m][n] = __builtin_amdgcn_mfma_f32_16x16x32_fp8_fp8(b8_[1], a8_[1], acc[ai][bj][m][n], 0, 0, 0); } \
        else acc[ai][bj][m][n] = __builtin_amdgcn_mfma_f32_16x16x32_bf16(Bt[n][k], At[m][k], acc[ai][bj][m][n], 0, 0, 0); } __builtin_amdgcn_s_setprio(0); } while (0)
#define PG8_WAIT_V(n) asm volatile("s_waitcnt vmcnt(" #n ")" ::: "memory")
#define PG8_WAIT_L(n) asm volatile("s_waitcnt lgkmcnt(" #n ")" ::: "memory")
#define PG8_BAR __builtin_amdgcn_s_barrier()
#define PG8_SCHED __builtin_amdgcn_sched_barrier(0)
#define PG8_VOFF(dst, u) do { _Pragma("unroll") for (int _h = 0; _h < 2; ++_h) _Pragma("unroll") for (int _i = 0; _i < 2; ++_i) dst[_h][_i] = S.a_rowoff(u, _h * HALF + Rr[_i]) + (unsigned)Cc[_i] * 2u; } while (0)
    Unit cur, nxt; int ui = 0;
    if (!S.next(0, cur)) return;
    f32x4 acc[2][2][4][2];
#pragma unroll
    for (int a = 0; a < 2; ++a)
#pragma unroll
        for (int b = 0; b < 2; ++b)
#pragma unroll
            for (int m = 0; m < 4; ++m)
#pragma unroll
                for (int n = 0; n < 2; ++n) acc[a][b][m][n] = (f32x4){0.f, 0.f, 0.f, 0.f};
    bf16x8 At[4][2], B0[2][2], B1[2][2];
    unsigned va[2][2], nva[2][2];
    PG8_VOFF(va, cur);
    const char* cA = S.a_base(cur); const char* cB = S.b_base(cur);
    PG8_STAGE(PG8_SB(0, 0), cB, voffB); PG8_STAGE(PG8_SB(0, 1), cB + hstep, voffB); PG8_STAGE(PG8_SA(0, 0), cA, va[0]); PG8_STAGE(PG8_SA(0, 1), cA, va[1]);
    if (wr == 1) PG8_BAR;
    PG8_WAIT_V(2); PG8_BAR;
    PG8_STAGE(PG8_SB(1, 0), cB + kstep, voffB); PG8_STAGE(PG8_SA(1, 0), cA + kstep, va[0]); PG8_STAGE(PG8_SB(1, 1), cB + hstep + kstep, voffB);
    PG8_WAIT_V(6); PG8_BAR;
    for (;;) {
        const bool has_next = S.next(ui + 1, nxt);
        const bool mma0 = cur.rows > 64 * wr, mma1 = cur.rows > HALF + 64 * wr;
        const char* nA = has_next ? S.a_base(nxt) : cA; const char* nB = has_next ? S.b_base(nxt) : cB;
        if (has_next) { PG8_VOFF(nva, nxt); } else {
#pragma unroll
            for (int h = 0; h < 2; ++h)
#pragma unroll
                for (int i = 0; i < 2; ++i) nva[h][i] = va[h][i]; }
        for (int t = 0; t < nt; t += 2) {
            const bool last = (t == nt - 2);
            const char* a1 = cA + (size_t)(t + 1) * kstep;
            const char* a2 = last ? nA : cA + (size_t)(t + 2) * kstep; const char* b2 = last ? nB : cB + (size_t)(t + 2) * kstep;
            const char* a3 = a2 + kstep; const char* b3 = b2 + kstep;
            unsigned v2[2][2];
#pragma unroll
            for (int h = 0; h < 2; ++h)
#pragma unroll
                for (int i = 0; i < 2; ++i) v2[h][i] = last ? nva[h][i] : va[h][i];
            PG8_LDB(B0, 0, 0); PG8_LDB(B1, 0, 1); PG8_SCHED; PG8_LDA(At, 0, 0); PG8_STAGE(PG8_SA(1, 1), a1, va[1]);
            PG8_WAIT_V(8); PG8_WAIT_L(0); PG8_BAR; if (mma0) { PG8_MMA(0, 0, At, B0); PG8_MMA(0, 1, At, B1); } PG8_BAR; PG8_SCHED;
            PG8_LDA(At, 0, 1); PG8_STAGE(PG8_SB(0, 0), b2, voffB); PG8_STAGE(PG8_SB(0, 1), b2 + hstep, voffB); PG8_STAGE(PG8_SA(0, 0), a2, v2[0]);
            PG8_WAIT_V(8); PG8_WAIT_L(0); PG8_BAR; if (mma1) { PG8_MMA(1, 0, At, B0); PG8_MMA(1, 1, At, B1); } PG8_BAR; PG8_SCHED;
            PG8_LDB(B0, 1, 0); PG8_LDB(B1, 1, 1); PG8_SCHED; PG8_LDA(At, 1, 0); PG8_STAGE(PG8_SA(0, 1), a2, v2[1]);
            PG8_WAIT_V(8); PG8_WAIT_L(0); PG8_BAR; if (mma0) { PG8_MMA(0, 0, At, B0); PG8_MMA(0, 1, At, B1); } PG8_BAR; PG8_SCHED;
            PG8_LDA(At, 1, 1); PG8_STAGE(PG8_SB(1, 0), b3, voffB); PG8_STAGE(PG8_SB(1, 1), b3 + hstep, voffB); PG8_STAGE(PG8_SA(1, 0), a3, v2[0]);
            PG8_WAIT_V(8); PG8_WAIT_L(0); PG8_BAR; if (mma1) { PG8_MMA(1, 0, At, B0); PG8_MMA(1, 1, At, B1); } PG8_BAR; PG8_SCHED;
        }
        if (wr == 0) PG8_BAR;
        E(acc, cur, wr, wc, fr, fq);
        if (!has_next) break;
#pragma unroll
        for (int a = 0; a < 2; ++a)
#pragma unroll
            for (int b = 0; b < 2; ++b)
#pragma unroll
                for (int m = 0; m < 4; ++m)
#pragma unroll
                    for (int n = 0; n < 2; ++n) acc[a][b][m][n] = (f32x4){0.f, 0.f, 0.f, 0.f};
        cur = nxt; cA = nA; cB = nB; ++ui;
#pragma unroll
        for (int h = 0; h < 2; ++h)
#pragma unroll
            for (int i = 0; i < 2; ++i) va[h][i] = nva[h][i];
        if (wr == 1) PG8_BAR;
    }
    PG8_WAIT_V(0);
    PG8_BAR;
#undef PG8_SA
#undef PG8_SB
#undef PG8_STAGE
#undef PG8_LDA
#undef PG8_LDB
#undef PG8_MMA
#undef PG8_WAIT_V
#undef PG8_WAIT_L
#undef PG8_BAR
#undef PG8_SCHED
#undef PG8_VOFF
}

struct EpiRowScaleBf16 {
    bf16* O; int ldc; const float* rs;
    __device__ __forceinline__ void operator()(const f32x4 (&acc)[2][2][4][2], const Unit& u, int wr, int wc, int fr, int fq) const {
        const int row0 = u.pm * BM + wr * 64 + fr, col0 = u.pn * BM + wc * 32 + 8 * fq;
        float sc[2][4];
#pragma unroll
        for (int ai = 0; ai < 2; ++ai)
#pragma unroll
            for (int m = 0; m < 4; ++m) sc[ai][m] = rs[row0 + ai * HALF + m * 16];
#pragma unroll
        for (int ai = 0; ai < 2; ++ai)
#pragma unroll
            for (int m = 0; m < 4; ++m) { const int row = row0 + ai * HALF + m * 16; const float s = sc[ai][m]; bf16* rowp = O + (size_t)row * ldc + col0;
#pragma unroll
                for (int bj = 0; bj < 2; ++bj) { const f32x4 v0 = acc[ai][bj][m][0] * s, v1 = acc[ai][bj][m][1] * s;
                    v4u w; w.x = cvt_pk_bf16(v0[0], v0[1]); w.y = cvt_pk_bf16(v0[2], v0[3]); w.z = cvt_pk_bf16(v1[0], v1[1]); w.w = cvt_pk_bf16(v1[2], v1[3]);
                    *(v4u*)(rowp + bj * HALF) = w; } }
    }
};
struct EpiPlainBf16 {
    bf16* O; int ldc;
    __device__ __forceinline__ void operator()(const f32x4 (&acc)[2][2][4][2], const Unit& u, int wr, int wc, int fr, int fq) const {
        const int row0 = u.pm * BM + wr * 64 + fr, col0 = u.pn * BM + wc * 32 + 8 * fq;
#pragma unroll
        for (int ai = 0; ai < 2; ++ai)
#pragma unroll
            for (int m = 0; m < 4; ++m) { const int row = row0 + ai * HALF + m * 16; bf16* rowp = O + (size_t)row * ldc + col0;
#pragma unroll
                for (int bj = 0; bj < 2; ++bj) { const f32x4 v0 = acc[ai][bj][m][0], v1 = acc[ai][bj][m][1];
                    v4u w; w.x = cvt_pk_bf16(v0[0], v0[1]); w.y = cvt_pk_bf16(v0[2], v0[3]); w.z = cvt_pk_bf16(v1[0], v1[1]); w.w = cvt_pk_bf16(v1[2], v1[3]);
                    *(v4u*)(rowp + bj * HALF) = w; } }
    }
};
struct EpiGateBf16 {
    bf16* O; int ldc; const float* rs; const float* bias; float osc;
    __device__ __forceinline__ void operator()(const f32x4 (&acc)[2][2][4][2], const Unit& u, int wr, int wc, int fr, int fq) const {
        const int row0 = u.pm * BM + wr * 64 + fr, col0 = u.pn * BM + wc * 32 + 8 * fq;
        float sc[2][4]; f32x4 bv[2][2];
#pragma unroll
        for (int ai = 0; ai < 2; ++ai)
#pragma unroll
            for (int m = 0; m < 4; ++m) sc[ai][m] = rs[row0 + ai * HALF + m * 16] * osc;
#pragma unroll
        for (int bj = 0; bj < 2; ++bj)
#pragma unroll
            for (int n = 0; n < 2; ++n) bv[bj][n] = *(const f32x4*)(bias + col0 + bj * HALF + 4 * n);
#pragma unroll
        for (int ai = 0; ai < 2; ++ai)
#pragma unroll
            for (int m = 0; m < 4; ++m) { const int row = row0 + ai * HALF + m * 16; const float s = sc[ai][m]; bf16* rowp = O + (size_t)row * ldc + col0;
#pragma unroll
                for (int bj = 0; bj < 2; ++bj) { f32x4 v0 = acc[ai][bj][m][0] * s + bv[bj][0], v1 = acc[ai][bj][m][1] * s + bv[bj][1];
#pragma unroll
                    for (int q = 0; q < 4; ++q) { v0[q] = fast_sigmoid(v0[q]); v1[q] = fast_sigmoid(v1[q]); }
                    v4u w; w.x = cvt_pk_bf16(v0[0], v0[1]); w.y = cvt_pk_bf16(v0[2], v0[3]); w.z = cvt_pk_bf16(v1[0], v1[1]); w.w = cvt_pk_bf16(v1[2], v1[3]);
                    *(v4u*)(rowp + bj * HALF) = w; } }
    }
};
}

struct Args { const float* in[25]; float* out; unsigned char* ws; int ph_lo, ph_hi; };

struct Frame {
    LAS unsigned char* lds; volatile LAS unsigned* MISC; gu32* ctl; int tid, lane, wave, vcu, G;
};
__device__ __forceinline__ float wave_sum(float v) {
#pragma unroll
    for (int o = 1; o < 64; o <<= 1) v += __shfl_xor(v, o);
    return v;
}
template <int RM, bool HAS_CS>
__device__ __forceinline__ void p0_transpose_item(const float* __restrict__ W, int K, int N, bf16* __restrict__ WT, int row_off, const float* __restrict__ cs, LAS float* scr, int item, int lane) {
    const int nblk = N / 32, kb = item / nblk, nb = item % nblk, k0 = 64 * kb, n0 = 32 * nb;
    const int c = lane & 7;
    f32x4 s0 = {1.f, 1.f, 1.f, 1.f}, s1 = {1.f, 1.f, 1.f, 1.f};
    if (HAS_CS) { s0 = *(const f32x4*)(cs + k0 + 8 * c); s1 = *(const f32x4*)(cs + k0 + 8 * c + 4); }
#pragma unroll 8
    for (int i = 0; i < 32; ++i) { const int kk = 2 * i + (lane >> 5); scr[kk * 33 + (lane & 31)] = W[(size_t)(k0 + kk) * N + n0 + (lane & 31)]; }
    LDS_WAIT(); asm volatile("" ::: "memory");
#pragma unroll
    for (int j = 0; j < 4; ++j) { const int n = (lane >> 3) + 8 * j; const LAS float* s = scr + (8 * c) * 33 + n;
        v4u o; o.x = pk2(s[0 * 33] * s0.x, s[1 * 33] * s0.y); o.y = pk2(s[2 * 33] * s0.z, s[3 * 33] * s0.w); o.z = pk2(s[4 * 33] * s1.x, s[5 * 33] * s1.y); o.w = pk2(s[6 * 33] * s1.z, s[7 * 33] * s1.w);
        const int nn = n0 + n; const int orow = RM == 0 ? row_off + nn : (row_off + 8 * (nn >> 2) + (nn & 3) + (RM == 2 ? 4 : 0));
        *(GAS v4u*)(WT + (size_t)orow * K + k0 + 8 * c) = o; }
    LDS_WAIT(); asm volatile("" ::: "memory");
}

__device__ __forceinline__ unsigned pk4_fp8(float v0, float v1, float v2, float v3) {
    v0 = __builtin_amdgcn_fmed3f(v0, -448.f, 448.f); v1 = __builtin_amdgcn_fmed3f(v1, -448.f, 448.f); v2 = __builtin_amdgcn_fmed3f(v2, -448.f, 448.f); v3 = __builtin_amdgcn_fmed3f(v3, -448.f, 448.f);
    int w = 0; w = __builtin_amdgcn_cvt_pk_fp8_f32(v0, v1, w, false); w = __builtin_amdgcn_cvt_pk_fp8_f32(v2, v3, w, true); return (unsigned)w;
}
template <int RM, bool HAS_CS>
__device__ __forceinline__ void p0_transpose_item_f8(const float* __restrict__ W, int K, int N, unsigned char* __restrict__ WT, const float* __restrict__ cs, float scale, LAS float* scr, int item, int lane) {
    const int nblk = N / 32, kb = item / nblk, nb = item % nblk, k0 = 64 * kb, n0 = 32 * nb;
    const int n = lane & 31, kq = lane >> 5;
#pragma unroll 8
    for (int i = 0; i < 32; ++i) { const int kk = 2 * i + (lane >> 5); scr[kk * 33 + (lane & 31)] = W[(size_t)(k0 + kk) * N + n0 + (lane & 31)]; }
    LDS_WAIT(); asm volatile("" ::: "memory");
    const int nn = n0 + n; const int orow = RM == 0 ? nn : (8 * (nn >> 2) + (nn & 3) + (RM == 2 ? 4 : 0));
    unsigned char* dst = WT + (size_t)orow * K + k0 + 32 * kq;
    f32x4 csv[8];
#pragma unroll
    for (int i = 0; i < 8; ++i) csv[i] = HAS_CS ? *(const f32x4*)(cs + k0 + 32 * kq + 4 * i) * scale : (f32x4){scale, scale, scale, scale};
#pragma unroll
    for (int h = 0; h < 2; ++h) { v4u o;
#pragma unroll
        for (int q = 0; q < 4; ++q) { const int kk = 32 * kq + 16 * h + 4 * q; const f32x4 sc = csv[4 * h + q];
            o[q] = pk4_fp8(scr[kk * 33 + n] * sc[0], scr[(kk + 1) * 33 + n] * sc[1], scr[(kk + 2) * 33 + n] * sc[2], scr[(kk + 3) * 33 + n] * sc[3]); }
        *(GAS v4u*)(dst + 16 * h) = o; }
    LDS_WAIT(); asm volatile("" ::: "memory");
}
struct Ptrs {
    const float *x, *p, *g_mix, *w_in, *conv_w, *conv_b, *wa, *ba, *wx, *bx, *lam, *w_out, *g_ffn, *w_rg, *b_rg, *w_re, *b_re, *w1, *w3, *w2, *g_ple, *w_pg, *b_pg, *w_pp, *g_final;
    float* out; unsigned char* ws;
    float *rstd0, *rstd1, *rstd2; int* eid; float* ew; int* list; int* counts; int* goffs;
    bf16 *W_IN, *W_OUT, *W_PG, *W_PP, *WRT, *LRUW, *W13, *W2, *PB, *XB, *MIX, *ACT, *GATE, *PROJ, *D1, *X1B, *X2B, *Y, *PP;
};
__device__ __forceinline__ void make_ptrs(Ptrs& P, const Args& a) {
    P.x = a.in[0]; P.p = a.in[1]; P.g_mix = a.in[2]; P.w_in = a.in[3]; P.conv_w = a.in[4]; P.conv_b = a.in[5]; P.wa = a.in[6]; P.ba = a.in[7]; P.wx = a.in[8]; P.bx = a.in[9]; P.lam = a.in[10];
    P.w_out = a.in[11]; P.g_ffn = a.in[12]; P.w_rg = a.in[13]; P.b_rg = a.in[14]; P.w_re = a.in[15]; P.b_re = a.in[16]; P.w1 = a.in[17]; P.w3 = a.in[18]; P.w2 = a.in[19];
    P.g_ple = a.in[20]; P.w_pg = a.in[21]; P.b_pg = a.in[22]; P.w_pp = a.in[23]; P.g_final = a.in[24];
    P.out = a.out; P.ws = a.ws; unsigned char* ws = a.ws;
    P.rstd0 = (float*)(ws + WS_RSTD0); P.rstd1 = (float*)(ws + WS_RSTD1); P.rstd2 = (float*)(ws + WS_RSTD2);
    P.eid = (int*)(ws + WS_EID); P.ew = (float*)(ws + WS_EW); P.list = (int*)(ws + WS_LIST); P.counts = (int*)(ws + WS_CNT); P.goffs = P.counts + 256 * NE;
    P.W_IN = (bf16*)(ws + WS_WIN); P.W_OUT = (bf16*)(ws + WS_WOUT); P.W_PG = (bf16*)(ws + WS_WPG); P.W_PP = (bf16*)(ws + WS_WPP); P.WRT = (bf16*)(ws + WS_WRT); P.LRUW = (bf16*)(ws + WS_LRUW);
    P.W13 = (bf16*)(ws + WS_W13); P.W2 = (bf16*)(ws + WS_W2); P.PB = (bf16*)(ws + WS_PB);
    P.XB = (bf16*)(ws + WS_R64); P.MIX = (bf16*)(ws + WS_R64); P.ACT = (bf16*)(ws + WS_R64); P.GATE = (bf16*)(ws + WS_R64);
    P.PROJ = (bf16*)(ws + WS_PROJ); P.D1 = (bf16*)(ws + WS_D1); P.PP = (bf16*)(ws + WS_PP); P.X1B = (bf16*)(ws + WS_X1B); P.X2B = (bf16*)(ws + WS_D1);     P.Y = (bf16*)(ws + WS_Y);
}

struct P0Item { const float* src; const float* cs; unsigned char* dst; int N, Kout, n0, rm, fmt; float scale; };
__device__ __forceinline__ bool p0_decode(const Ptrs& P, int it, P0Item& I) {
    constexpr int I_WIN = (D / 64) * (INC / 32), I_SQ = (D / 64) * (D / 32), I_PG = (D / 128) * (D / 32), I_WPP = (PLE / 64) * (D / 32), I_W1 = (D / 128) * (DE / 32), I_W2 = (DE / 128) * (D / 32);
    constexpr int NITEMS = I_WIN + I_SQ + I_PG + I_WPP + NE * (2 * I_W1 + I_W2);
    if (it >= NITEMS) return false;
    int r = it; const float* W; const float* cs; unsigned char* dst; int K, N, rm = 0, fmt = 0; float scale = 1.f;
    if (r < I_WIN) { W = P.w_in; K = D; N = INC; dst = (unsigned char*)P.W_IN; cs = P.g_mix; }
    else if ((r -= I_WIN) < I_SQ) { W = P.w_out; K = D; N = D; dst = (unsigned char*)P.W_OUT; cs = nullptr; }
    else if ((r -= I_SQ) < I_PG) { W = P.w_pg; K = D; N = D; dst = (unsigned char*)P.W_PG; cs = P.g_ple; fmt = 1; scale = PLE_SWG; }
    else if ((r -= I_PG) < I_WPP) { W = P.w_pp; K = PLE; N = D; dst = (unsigned char*)P.W_PP; cs = nullptr; }
    else { r -= I_WPP; const int per_e = 2 * I_W1 + I_W2, e = r / per_e; r -= e * per_e; fmt = 1;
        if (r < I_W1) { W = P.w1 + (size_t)e * D * DE; K = D; N = DE; dst = (unsigned char*)P.W13 + (size_t)e * D * D; cs = P.g_ffn; rm = 1; scale = MOE_SW1; }
        else if ((r -= I_W1) < I_W1) { W = P.w3 + (size_t)e * D * DE; K = D; N = DE; dst = (unsigned char*)P.W13 + (size_t)e * D * D; cs = P.g_ffn; rm = 2; scale = MOE_SW1; }
        else { r -= I_W1; W = P.w2 + (size_t)e * DE * D; K = DE; N = D; dst = (unsigned char*)P.W2 + (size_t)e * D * DE; cs = nullptr; scale = MOE_SW2; } }
    const int KI = fmt ? 128 : 64;
    const int nblk = N / 32, kb = r / nblk, nb = r % nblk, k0 = KI * kb, n0 = 32 * nb;
    I.src = W + (size_t)k0 * N + n0; I.cs = cs ? cs + k0 : nullptr; I.N = N; I.n0 = n0; I.rm = rm; I.fmt = fmt; I.scale = scale;
    I.Kout = fmt ? K : 2 * K; I.dst = dst + (fmt ? k0 : 2 * k0);
    return true;
}
__device__ __forceinline__ void p0_load(const P0Item& I, float (&v)[64], int lane) {
    const float* s = I.src + (size_t)(lane >> 5) * I.N + (lane & 31);
#pragma unroll
    for (int i = 0; i < 32; ++i) v[i] = s[(size_t)(2 * i) * I.N];
    if (I.fmt) {
#pragma unroll
        for (int i = 32; i < 64; ++i) v[i] = s[(size_t)(2 * i) * I.N];
    }
}
__device__ __forceinline__ int p0_orow(const P0Item& I, int n) { const int nn = I.n0 + n; return I.rm == 0 ? nn : (8 * (nn >> 2) + (nn & 3) + (I.rm == 2 ? 4 : 0)); }
__device__ __forceinline__ void p0_process(const P0Item& I, const float (&v)[64], LAS float* scr, int lane) {
    if (I.fmt == 0) {
#pragma unroll
        for (int i = 0; i < 32; ++i) scr[(2 * i + (lane >> 5)) * 33 + (lane & 31)] = v[i];
        LDS_WAIT(); asm volatile("" ::: "memory");
        const int c = lane & 7;
        f32x4 s0 = {1.f, 1.f, 1.f, 1.f}, s1 = {1.f, 1.f, 1.f, 1.f};
        if (I.cs) { s0 = *(const f32x4*)(I.cs + 8 * c); s1 = *(const f32x4*)(I.cs + 8 * c + 4); }
#pragma unroll
        for (int j = 0; j < 4; ++j) { const int n = (lane >> 3) + 8 * j; const LAS float* s = scr + (8 * c) * 33 + n;
            v4u o; o.x = cvt_pk_bf16(s[0 * 33] * s0.x, s[1 * 33] * s0.y); o.y = cvt_pk_bf16(s[2 * 33] * s0.z, s[3 * 33] * s0.w); o.z = cvt_pk_bf16(s[4 * 33] * s1.x, s[5 * 33] * s1.y); o.w = cvt_pk_bf16(s[6 * 33] * s1.z, s[7 * 33] * s1.w);
            *(GAS v4u*)(I.dst + (size_t)p0_orow(I, n) * I.Kout + 16 * c) = o; }
    } else {
#pragma unroll
        for (int i = 0; i < 64; ++i) { const int k = 2 * i + (lane >> 5); scr[k * 32 + (((lane & 31) + k) & 31)] = v[i]; }
        LDS_WAIT(); asm volatile("" ::: "memory");
        const int c = lane & 7;
        f32x4 sc[4];
#pragma unroll
        for (int q = 0; q < 4; ++q) sc[q] = I.cs ? *(const f32x4*)(I.cs + 16 * c + 4 * q) * I.scale : (f32x4){I.scale, I.scale, I.scale, I.scale};
#pragma unroll
        for (int j = 0; j < 4; ++j) { const int n = (lane >> 3) + 8 * j; v4u o;
#pragma unroll
            for (int q = 0; q < 4; ++q) { float t[4];
#pragma unroll
                for (int e = 0; e < 4; ++e) { const int k = 16 * c + 4 * q + e; t[e] = scr[k * 32 + ((n + k) & 31)] * sc[q][e]; }
                o[q] = pk4_fp8(t[0], t[1], t[2], t[3]); }
            *(GAS v4u*)(I.dst + (size_t)p0_orow(I, n) * I.Kout + 16 * c) = o; }
    }
    LDS_WAIT(); asm volatile("" ::: "memory");
}
__device__ __forceinline__ void p0_prologue(Frame& F, const Ptrs& P) {
    LAS float* scr = (LAS float*)(F.lds + RING_OFF + F.wave * 16384);
    const int gw = F.vcu * NWAVES + F.wave, NGW = F.G * NWAVES;
    {
#pragma unroll 1
        for (int it = gw; ; it += NGW) { P0Item A; float va[64];
            if (!p0_decode(P, it, A)) break;
            p0_load(A, va, F.lane); p0_process(A, va, scr, F.lane); }
    }
    for (int m = gw; m < T; m += 2 * NGW) {
        const int m1 = m + NGW; const bool two = m1 < T;
        const GAS f32x4* xr0 = (const GAS f32x4*)(P.x + (size_t)m * D) + F.lane; const GAS f32x4* xr1 = (const GAS f32x4*)(P.x + (size_t)(two ? m1 : m) * D) + F.lane;
        f32x4 v[4], u[4]; float s = 0.f, s1 = 0.f;
#pragma unroll
        for (int j = 0; j < 4; ++j) { v[j] = xr0[64 * j]; u[j] = xr1[64 * j]; }
#pragma unroll
        for (int j = 0; j < 4; ++j) { s += (v[j].x * v[j].x + v[j].y * v[j].y) + (v[j].z * v[j].z + v[j].w * v[j].w); s1 += (u[j].x * u[j].x + u[j].y * u[j].y) + (u[j].z * u[j].z + u[j].w * u[j].w); }
        s = wave_sum(s); s1 = wave_sum(s1);
        GAS v2u* o8 = (GAS v2u*)(P.XB + (size_t)m * D) + F.lane;
#pragma unroll
        for (int j = 0; j < 4; ++j) { v2u w; w.x = pk2(v[j].x, v[j].y); w.y = pk2(v[j].z, v[j].w); o8[64 * j] = w; }
        if (F.lane == 0) P.rstd0[m] = 1.0f / sqrtf(s * (1.f / D) + EPS);
        if (two) {
            GAS v2u* o9 = (GAS v2u*)(P.XB + (size_t)m1 * D) + F.lane;
#pragma unroll
            for (int j = 0; j < 4; ++j) { v2u w; w.x = pk2(u[j].x, u[j].y); w.y = pk2(u[j].z, u[j].w); o9[64 * j] = w; }
            if (F.lane == 0) P.rstd0[m1] = 1.0f / sqrtf(s1 * (1.f / D) + EPS);
        }
    }
    for (int m = gw; m < T; m += 4 * NGW) {
        f32x4 v[4];
#pragma unroll
        for (int j = 0; j < 4; ++j) { const int mj = m + j * NGW; v[j] = *((const GAS f32x4*)(P.p + (size_t)(mj < T ? mj : m) * PLE) + F.lane); }
#pragma unroll
        for (int j = 0; j < 4; ++j) { const int mj = m + j * NGW; if (mj < T) { v2u w; w.x = pk2(v[j].x, v[j].y); w.y = pk2(v[j].z, v[j].w); *((GAS v2u*)(P.PB + (size_t)mj * PLE) + F.lane) = w; } }
    }
    for (int idx = (F.vcu * NTHR + F.tid); idx < 80 * D; idx += F.G * NTHR) {
        const int n = idx / D, k = idx % D; float v = 0.f;
        if (n < NG) v = P.w_rg[(size_t)k * NG + n] * P.g_ffn[k]; else if (n < NG + NE) v = P.w_re[(size_t)k * NE + (n - NG)] * P.g_ffn[k];
        const bf16 hi = f2bf(v); const bf16 lo = f2bf(v - bf2f(hi));
        P.WRT[idx] = hi; P.WRT[80 * D + idx] = lo;
    }
    for (int idx = (F.vcu * NTHR + F.tid); idx < 2 * 8 * 64 * 64; idx += F.G * NTHR) {
        const int g = idx >> 15, r = idx & 32767, hb = r >> 12, j = (r >> 6) & 63, i = r & 63;
        const float* w = g ? P.wx : P.wa;
        P.LRUW[idx] = f2bf(w[(hb * 64 + i) * 64 + j]);
    }
}


__device__ __forceinline__ f32x4 bf4(v2u w) { return (f32x4){bflo(w.x), bfhi(w.x), bflo(w.y), bfhi(w.y)}; }
__device__ __forceinline__ void p10_combine(Frame& F, const Ptrs& P) {
    const int gw = F.vcu * NWAVES + F.wave, NGW = F.G * NWAVES;
    for (int m = gw; m < T; m += NGW) {
        const size_t ro = (size_t)m * D;
        GAS v2u* x1 = (GAS v2u*)(P.X2B + ro) + F.lane; const GAS v2u* y0 = (const GAS v2u*)(P.Y + ro) + F.lane; const GAS v2u* y1 = (const GAS v2u*)(P.Y + (size_t)T * D + ro) + F.lane;
        f32x4 v[4]; v2u a[4], b[4], c[4];
#pragma unroll
        for (int j = 0; j < 4; ++j) { a[j] = x1[64 * j]; b[j] = y0[64 * j]; c[j] = y1[64 * j]; }
        float s = 0.f;
#pragma unroll
        for (int j = 0; j < 4; ++j) { v[j] = bf4(a[j]) + (bf4(b[j]) + bf4(c[j])); s += (v[j].x * v[j].x + v[j].y * v[j].y) + (v[j].z * v[j].z + v[j].w * v[j].w); }
        s = wave_sum(s);
        GAS unsigned* o4 = (GAS unsigned*)((unsigned char*)P.X1B + ro) + F.lane;
#pragma unroll
        for (int j = 0; j < 4; ++j) { v2u w; w.x = pk2(v[j].x, v[j].y); w.y = pk2(v[j].z, v[j].w); x1[64 * j] = w;
            o4[64 * j] = pk4_fp8(v[j].x * PLE_SX2, v[j].y * PLE_SX2, v[j].z * PLE_SX2, v[j].w * PLE_SX2); }
        if (F.lane == 0) P.rstd2[m] = 1.0f / sqrtf(s * (1.f / D) + EPS);
    }
}
__device__ __forceinline__ void p13_final(Frame& F, const Ptrs& P) {
    const int gw = F.vcu * NWAVES + F.wave, NGW = F.G * NWAVES;
    f32x4 gf[4];
#pragma unroll
    for (int j = 0; j < 4; ++j) gf[j] = *((const GAS f32x4*)P.g_final + F.lane + 64 * j);
    for (int m = gw; m < T; m += NGW) {
        const size_t ro = (size_t)m * D;
        GAS f32x4* xr = (GAS f32x4*)(P.out + ro) + F.lane;
        const GAS v2u* xb = (const GAS v2u*)(P.X2B + ro) + F.lane; const GAS v2u* ga = (const GAS v2u*)(P.GATE + ro) + F.lane; const GAS v2u* pp = (const GAS v2u*)(P.PP + ro) + F.lane;
        f32x4 v[4]; v2u a[4], b[4], c[4];
#pragma unroll
        for (int j = 0; j < 4; ++j) { c[j] = xb[64 * j]; a[j] = ga[64 * j]; b[j] = pp[64 * j]; }
        float s = 0.f;
#pragma unroll
        for (int j = 0; j < 4; ++j) { v[j] = bf4(c[j]) + bf4(a[j]) * bf4(b[j]); s += (v[j].x * v[j].x + v[j].y * v[j].y) + (v[j].z * v[j].z + v[j].w * v[j].w); }
        s = wave_sum(s);
        const float r = 1.0f / sqrtf(s * (1.f / D) + EPS);
#pragma unroll
        for (int j = 0; j < 4; ++j) xr[64 * j] = v[j] * r * gf[j];
    }
}
__device__ __forceinline__ LAS int* sched_offs(Frame& F) { return (LAS int*)(F.lds + SCHED_OFF); }
__device__ __forceinline__ LAS int* sched_tileb(Frame& F) { return (LAS int*)(F.lds + SCHED_OFF) + 72; }
__device__ __forceinline__ LAS int* sched_pre(Frame& F) { return (LAS int*)(F.lds + SCHED_OFF) + 144; }
__device__ __forceinline__ LAS int* sched_ta(Frame& F) { return (LAS int*)(F.lds + SCHED_OFF) + 256; }
__device__ __forceinline__ LAS int* sched_tc(Frame& F) { return (LAS int*)(F.lds + SCHED_OFF) + 328; }
__device__ __forceinline__ void sched_build(Frame& F, const Ptrs& P) {
    LAS int* offs = sched_offs(F); LAS int* tb = sched_tileb(F); LAS int* pre = sched_pre(F);
    LAS int* part = (LAS int*)(F.lds + UTAB_OFF);
    {
        const int e = F.tid & 63, pt = F.tid >> 6; int t = 0, p = 0; int cv[32];
#pragma unroll
        for (int j = 0; j < 32; ++j) cv[j] = P.counts[(pt * 32 + j) * NE + e];
#pragma unroll
        for (int j = 0; j < 32; ++j) { t += cv[j]; p += (pt * 32 + j < F.vcu) ? cv[j] : 0; }
        part[(pt * 64 + e) * 2] = t; part[(pt * 64 + e) * 2 + 1] = p;
    }
    __syncthreads();
    if (F.tid < NE) { int t = 0, p = 0;
#pragma unroll
        for (int pt = 0; pt < 8; ++pt) { t += part[(pt * 64 + F.tid) * 2]; p += part[(pt * 64 + F.tid) * 2 + 1]; }
        pre[F.tid] = p; part[1024 + F.tid] = t; }
    __syncthreads();
    if (F.tid < NE) {
        LAS int* ta = sched_ta(F); LAS int* tc = sched_tc(F);
        const int t = part[1024 + F.tid], tl = t & 255;
        int v0 = t, v1 = t >> 8, v2 = tl > 128 ? 1 : 0, v3 = (tl > 0 && tl <= 128) ? 1 : 0;
        const int i0 = v0, i1 = v1, i2 = v2, i3 = v3;
#pragma unroll
        for (int o = 1; o < 64; o <<= 1) { const int a0 = __shfl_up(v0, o), a1 = __shfl_up(v1, o), a2 = __shfl_up(v2, o), a3 = __shfl_up(v3, o); if (F.lane >= o) { v0 += a0; v1 += a1; v2 += a2; v3 += a3; } }
        offs[F.tid] = v0 - i0; tb[F.tid] = v1 - i1; ta[F.tid] = v2 - i2; tc[F.tid] = v3 - i3;
        if (F.tid == NE - 1) { offs[NE] = v0; tb[NE] = v1; ta[NE] = v2; tc[NE] = v3; }
    }
    __syncthreads();
}

constexpr int P6_BROW = 272, P6_BHL = 80 * P6_BROW, P6_BBUF = 2 * P6_BHL, P6_LG_OFF = 90112;
static_assert(2 * P6_BBUF <= P6_LG_OFF && P6_LG_OFF + 8 * 16 * 80 * 4 <= RING_BYTES, "P6 LDS map");
__device__ __forceinline__ void p6_route(Frame& F, const Ptrs& P) {
    const int lane = F.lane, r = lane & 15, g = lane >> 4;
    const int tok = F.vcu * 128 + F.wave * 16 + r;
    LAS unsigned char* BS = F.lds + RING_OFF;
    LAS float* LG = (LAS float*)(F.lds + RING_OFF + P6_LG_OFF) + F.wave * (16 * 80);
    LAS float* SS = (LAS float*)(F.lds + UTAB_OFF) + F.wave * 16;
    LAS int* hist = (LAS int*)(F.lds + UTAB_OFF + 1024);
    if (F.tid < NE) hist[F.tid] = 0;
    f32x4 acc[5];
#pragma unroll
    for (int i = 0; i < 5; ++i) acc[i] = (f32x4){0.f, 0.f, 0.f, 0.f};
    float ssq = 0.f;
    const float* xrow = P.x + (size_t)tok * D + 8 * g; const bf16* drow = P.D1 + (size_t)tok * D + 8 * g; unsigned char* orow = (unsigned char*)P.X1B + (size_t)tok * D + 8 * g;
    unsigned bsrc[5], bdst[5];
#pragma unroll
    for (int i = 0; i < 5; ++i) { const int id = F.tid + 512 * i, hl = id / 1280, rem = id % 1280, row = rem >> 4, ch = rem & 15;
        bsrc[i] = (unsigned)((hl * 80 + row) * D + 8 * ch) * 2u; bdst[i] = (unsigned)(hl * P6_BHL + row * P6_BROW + ch * 16); }
    v4u breg[5]; f32x4 xa[4], xb[4]; v4u dd[4];
#pragma unroll
    for (int i = 0; i < 5; ++i) breg[i] = *(const v4u*)((const char*)P.WRT + bsrc[i]);
#pragma unroll
    for (int s = 0; s < 4; ++s) { xa[s] = *(const f32x4*)(xrow + 32 * s); xb[s] = *(const f32x4*)(xrow + 32 * s + 4); dd[s] = *(const v4u*)(drow + 32 * s); }
#pragma unroll 1
    for (int sl = 0; sl < 8; ++sl) {
        LAS unsigned char* bb = BS + (sl & 1) * P6_BBUF;
#pragma unroll
        for (int i = 0; i < 5; ++i) *(LAS v4u*)(bb + bdst[i]) = breg[i];
        __syncthreads();
        f32x4 cxa[4], cxb[4]; v4u cdd[4];
#pragma unroll
        for (int s = 0; s < 4; ++s) { cxa[s] = xa[s]; cxb[s] = xb[s]; cdd[s] = dd[s]; }
        if (sl < 7) {
#pragma unroll
            for (int i = 0; i < 5; ++i) breg[i] = *(const v4u*)((const char*)P.WRT + bsrc[i] + (sl + 1) * 256);
#pragma unroll
            for (int s = 0; s < 4; ++s) { xa[s] = *(const f32x4*)(xrow + 128 * (sl + 1) + 32 * s); xb[s] = *(const f32x4*)(xrow + 128 * (sl + 1) + 32 * s + 4); dd[s] = *(const v4u*)(drow + 128 * (sl + 1) + 32 * s); }
        }
#pragma unroll
        for (int s = 0; s < 4; ++s) {
            float v[8];
            v[0] = cxa[s][0] + bflo(cdd[s].x); v[1] = cxa[s][1] + bfhi(cdd[s].x); v[2] = cxa[s][2] + bflo(cdd[s].y); v[3] = cxa[s][3] + bfhi(cdd[s].y);
            v[4] = cxb[s][0] + bflo(cdd[s].z); v[5] = cxb[s][1] + bfhi(cdd[s].z); v[6] = cxb[s][2] + bflo(cdd[s].w); v[7] = cxb[s][3] + bfhi(cdd[s].w);
            v4u hw, lw;
#pragma unroll
            for (int q = 0; q < 4; ++q) {
                ssq += v[2 * q] * v[2 * q] + v[2 * q + 1] * v[2 * q + 1];
                const unsigned h = cvt_pk_bf16(v[2 * q], v[2 * q + 1]);
                const unsigned l = cvt_pk_bf16(v[2 * q] - bflo(h), v[2 * q + 1] - bfhi(h));
                hw[q] = h; lw[q] = l;
            }
            { v2u f8; f8.x = pk4_fp8(v[0] * MOE_SX, v[1] * MOE_SX, v[2] * MOE_SX, v[3] * MOE_SX); f8.y = pk4_fp8(v[4] * MOE_SX, v[5] * MOE_SX, v[6] * MOE_SX, v[7] * MOE_SX); *(v2u*)(orow + 128 * sl + 32 * s) = f8; }
            *(v4u*)(const_cast<bf16*>(drow) + 128 * sl + 32 * s) = hw;
            const bf16x8 ah = __builtin_bit_cast(bf16x8, hw), al = __builtin_bit_cast(bf16x8, lw);
#pragma unroll
            for (int nt = 0; nt < 5; ++nt) {
                const bf16x8 bh = *(const LAS bf16x8*)(bb + (16 * nt + r) * P6_BROW + (32 * s + 8 * g) * 2), bl = *(const LAS bf16x8*)(bb + P6_BHL + (16 * nt + r) * P6_BROW + (32 * s + 8 * g) * 2);
                acc[nt] = __builtin_amdgcn_mfma_f32_16x16x32_bf16(ah, bh, acc[nt], 0, 0, 0);
                acc[nt] = __builtin_amdgcn_mfma_f32_16x16x32_bf16(al, bh, acc[nt], 0, 0, 0);
                acc[nt] = __builtin_amdgcn_mfma_f32_16x16x32_bf16(ah, bl, acc[nt], 0, 0, 0);
            }
        }
    }
    ssq += __shfl_xor(ssq, 16); ssq += __shfl_xor(ssq, 32);
#pragma unroll
    for (int nt = 0; nt < 5; ++nt)
#pragma unroll
        for (int q = 0; q < 4; ++q) LG[(4 * g + q) * 80 + 16 * nt + r] = acc[nt][q];
    if (g == 0) SS[r] = ssq;
    __syncthreads();
    if (g == 0) {
        const float rs = 1.0f / sqrtf(SS[r] * (1.f / D) + EPS);
        const LAS float* L = LG + r * 80;
        float gl[8]; float mx = -3.0e38f; int gsel = 0;
#pragma unroll
        for (int i = 0; i < 8; ++i) { gl[i] = rs * L[i] + P.b_rg[i]; if (gl[i] > mx) { mx = gl[i]; gsel = i; } }
        float den = 0.f;
#pragma unroll
        for (int i = 0; i < 8; ++i) den += expf(gl[i] - mx);
        const float gw = 1.f / den;
        float v0 = -3.0e38f, v1 = -3.0e38f; int i0 = 0, i1 = 0;
        for (int i = 0; i < 8; ++i) {
            const float v = rs * L[8 + gsel * 8 + i] + P.b_re[gsel * 8 + i];
            if (v > v0) { v1 = v0; i1 = i0; v0 = v; i0 = i; } else if (v > v1) { v1 = v; i1 = i; }
        }
        const float e1 = expf(v1 - v0), w0 = 1.f / (1.f + e1), w1 = e1 / (1.f + e1);
        const int ea = gsel * 8 + i0, eb = gsel * 8 + i1;
        P.eid[tok * 2] = ea; P.eid[tok * 2 + 1] = eb; P.ew[tok * 2] = w0 * gw; P.ew[tok * 2 + 1] = w1 * gw; P.rstd1[tok] = rs;
        __hip_atomic_fetch_add(hist + ea, 1, __ATOMIC_RELAXED, __HIP_MEMORY_SCOPE_WORKGROUP); __hip_atomic_fetch_add(hist + eb, 1, __ATOMIC_RELAXED, __HIP_MEMORY_SCOPE_WORKGROUP);
    }
    __syncthreads();
    if (F.tid < NE) P.counts[F.vcu * NE + F.tid] = hist[F.tid];
}

__device__ __forceinline__ void p7_lists(Frame& F, const Ptrs& P) {
    sched_build(F, P);
    LAS int* offs = sched_offs(F); LAS int* pre = sched_pre(F);
    LAS int* lcnt = (LAS int*)(F.lds + RING_OFF);
    if (F.tid < NE) lcnt[F.tid] = 0;
    __syncthreads();
    if (F.tid < 256) { const int a = F.vcu * 256 + F.tid; const int e = P.eid[a];
        const int rank = __hip_atomic_fetch_add(lcnt + e, 1, __ATOMIC_RELAXED, __HIP_MEMORY_SCOPE_WORKGROUP);
        P.list[offs[e] + pre[e] + rank] = a; }
    if (blockIdx.x == 0 && F.tid <= NE) P.goffs[F.tid] = offs[F.tid];
    __syncthreads();
}

namespace pg8 {
template <int MODE>
struct MoeSched {
    const char* Ab; const char* Bb; int K, G, c; LAS int* offs; LAS int* tb; LAS int* ta; LAS int* tc; LAS int* tab;
    __device__ __forceinline__ bool next(int i, Unit& u) const {
        const int L = i * G + c; const int nF = __builtin_amdgcn_readfirstlane(tb[NE]), nA = __builtin_amdgcn_readfirstlane(ta[NE]), nC = __builtin_amdgcn_readfirstlane(tc[NE]);
        if (L >= 4 * (nF + nA + nC)) return false;
        int rt = L >> 2; const LAS int* pf = tb; int cls = 0;
        if (rt >= nF) { rt -= nF; pf = ta; cls = 1; if (rt >= nA) { rt -= nA; pf = tc; cls = 2; } }
        int e = 0;
        for (int k = 1; k < NE; ++k) e += (pf[k] <= rt) ? 1 : 0;
        e = __builtin_amdgcn_readfirstlane(e);
        const int o0 = __builtin_amdgcn_readfirstlane(offs[e]), cnt = __builtin_amdgcn_readfirstlane(offs[e + 1]) - o0;
        u.e = e; u.pm = cls == 0 ? rt - __builtin_amdgcn_readfirstlane(tb[e]) : (cnt >> 8); u.pn = L & 3; u.slot0 = o0 + 256 * u.pm;
        u.rows = cls == 0 ? 256 : (cnt & 255); u.ui = i; return true;
    }
    __device__ __forceinline__ const char* a_base(const Unit& u) const { return MODE == 0 ? Ab : Ab + (size_t)u.slot0 * (size_t)(K * 2); }
    __device__ __forceinline__ const char* b_base(const Unit& u) const { return Bb + ((size_t)u.e * D + (size_t)u.pn * BM) * (size_t)K * 2; }
    __device__ __forceinline__ unsigned a_rowoff(const Unit& u, int r) const { return MODE == 0 ? (unsigned)tab[u.ui * 256 + r] : (unsigned)r * (unsigned)(K * 2); }
};
struct EpiAct {
    unsigned char* ACT; const LAS float* tabf;
    __device__ __forceinline__ void operator()(const f32x4 (&acc)[2][2][4][2], const Unit& u, int wr, int wc, int fr, int fq) const {
#pragma unroll
        for (int ai = 0; ai < 2; ++ai)
#pragma unroll
            for (int m = 0; m < 4; ++m) { const int r = ai * HALF + wr * 64 + m * 16 + fr;
                if (r < u.rows) { const float s = tabf[u.ui * 256 + r] * (1.f / (MOE_SX * MOE_SW1)); unsigned char* rowp = ACT + (size_t)(u.slot0 + r) * DE + u.pn * 128 + wc * 16 + 4 * fq;
#pragma unroll
                    for (int bj = 0; bj < 2; ++bj) { const f32x4 h1 = acc[ai][bj][m][0] * s, h3 = acc[ai][bj][m][1] * s; f32x4 a;
#pragma unroll
                        for (int q = 0; q < 4; ++q) a[q] = h1[q] * fast_sigmoid(h1[q]) * h3[q] * MOE_SA;
                        *(unsigned*)(rowp + bj * 64) = pk4_fp8(a[0], a[1], a[2], a[3]); } } }
    }
};
struct EpiY {
    bf16* Y; const LAS int* tab; const LAS float* tabf;
    __device__ __forceinline__ void operator()(const f32x4 (&acc)[2][2][4][2], const Unit& u, int wr, int wc, int fr, int fq) const {
#pragma unroll
        for (int ai = 0; ai < 2; ++ai)
#pragma unroll
            for (int m = 0; m < 4; ++m) { const int r = ai * HALF + wr * 64 + m * 16 + fr; const int aid = tab[u.ui * 256 + r];
                if (aid >= 0) { const float s = tabf[u.ui * 256 + r] * (1.f / (MOE_SA * MOE_SW2)); bf16* rowp = Y + ((size_t)(aid & 1) * T + (size_t)(aid >> 1)) * D + u.pn * BM + wc * 32 + 8 * fq;
#pragma unroll
                    for (int bj = 0; bj < 2; ++bj) { const f32x4 v0 = acc[ai][bj][m][0] * s, v1 = acc[ai][bj][m][1] * s;
                        v4u w; w.x = cvt_pk_bf16(v0[0], v0[1]); w.y = cvt_pk_bf16(v0[2], v0[3]); w.z = cvt_pk_bf16(v1[0], v1[1]); w.w = cvt_pk_bf16(v1[2], v1[3]);
                        *(v4u*)(rowp + bj * HALF) = w; } } }
    }
};
}
template <int MODE>
__device__ __forceinline__ void moe_phase(Frame& F, const Ptrs& P, bool rebuild) {
    if (rebuild) sched_build(F, P);
    LAS int* tab = (LAS int*)(F.lds + UTAB_OFF); LAS float* tabf = (LAS float*)(F.lds + UTABF_OFF);
    LAS int* uinfo = (LAS int*)(F.lds + SCHED_OFF) + 208;
    pg8::MoeSched<MODE> S; S.Ab = MODE == 0 ? (const char*)P.X1B : (const char*)P.ACT; S.Bb = MODE == 0 ? (const char*)P.W13 : (const char*)P.W2; S.K = MODE == 0 ? D / 2 : DE / 2;   S.G = F.G; S.c = F.vcu;
    S.offs = sched_offs(F); S.tb = sched_tileb(F); S.ta = sched_ta(F); S.tc = sched_tc(F); S.tab = tab;
    if (F.tid < 64) {
#pragma unroll
        for (int i = 0; i < MAXU; ++i) { pg8::Unit u; const bool ok = S.next(i, u); if (F.tid == 0) { uinfo[2 * i] = ok ? u.slot0 : 0; uinfo[2 * i + 1] = ok ? u.rows : 0; } }
    }
    __syncthreads();
    {
        const int r = F.tid & 255, i0 = F.tid >> 8; int aid[3]; bool val[3], act[3];
#pragma unroll
        for (int it = 0; it < 3; ++it) { const int i = i0 + 2 * it; const int s0 = uinfo[2 * i], rows = uinfo[2 * i + 1]; act[it] = rows > 0; val[it] = r < rows; aid[it] = act[it] ? P.list[s0 + (val[it] ? r : 0)] : 0; }
        float fv[3];
#pragma unroll
        for (int it = 0; it < 3; ++it) fv[it] = act[it] ? (MODE == 0 ? P.rstd1[aid[it] >> 1] : P.ew[aid[it]]) : 0.f;
#pragma unroll
        for (int it = 0; it < 3; ++it) if (act[it]) { const int i = i0 + 2 * it;
            if (MODE == 0) tab[i * 256 + r] = (aid[it] >> 1) * D; else tab[i * 256 + r] = val[it] ? aid[it] : -1;
            tabf[i * 256 + r] = fv[it]; }
    }
    __syncthreads();
    if constexpr (MODE == 0) { pg8::EpiAct E{(unsigned char*)P.ACT, tabf}; pg8::gemm_phase<pg8::EpiAct, pg8::MoeSched<0>, true>(F.lds + RING_OFF, S, E); }
    else { pg8::EpiY E{P.Y, tab, tabf}; pg8::gemm_phase<pg8::EpiY, pg8::MoeSched<1>, true>(F.lds + RING_OFF, S, E); }
}
typedef short v4i16 __attribute__((ext_vector_type(4)));
__device__ __forceinline__ unsigned off_b(unsigned row, unsigned ch) { return 256u * row + 16u * (ch ^ (((row & 3u) << 2) | ((row >> 2) & 3u))); }
__device__ __forceinline__ unsigned row_read_addr_16(unsigned lane, unsigned rb, unsigned s) { return off_b((lane & 15u) + 16u * rb, 4u * s + (lane >> 4)); }
__device__ __forceinline__ unsigned tr_read_addr_16(unsigned lane, unsigned c, unsigned ks, unsigned t) {
    const unsigned g = lane >> 4, q = (lane & 15u) >> 2, p = lane & 3u;
    return off_b(32u * ks + 8u * g + 4u * t + q, 2u * c + (p >> 1)) + 8u * (p & 1u);
}
__device__ __forceinline__ bf16x8 tr_frag2(LAS unsigned char* p0, LAS unsigned char* p1) {
    const v4i16 a = __builtin_amdgcn_ds_read_tr16_b64_v4i16((LAS v4i16*)p0);
    const v4i16 b = __builtin_amdgcn_ds_read_tr16_b64_v4i16((LAS v4i16*)p1);
    return (bf16x8){a[0], a[1], a[2], a[3], b[0], b[1], b[2], b[3]};
}
__device__ __forceinline__ void wave_lds_fence() { asm volatile("s_waitcnt lgkmcnt(0)" ::: "memory"); __builtin_amdgcn_wave_barrier(); asm volatile("" ::: "memory"); }
__device__ __forceinline__ float gelu_tanh_fast(float x) {
    const float u = 0.7978845608028654f * (x + 0.044715f * x * x * x);
    return x * fast_sigmoid(2.f * u);
}
constexpr float LOG2_ROPE_OVER_64 = 13.287712379549449f / 64.f;
constexpr int MIX_K_OFF = 0, MIX_V_OFF = 32768, MIX_S_OFF = 65536, MIX_S_STRIDE = 272, MIX_S_WAVE = 16 * MIX_S_STRIDE;
constexpr int MIX_CW_OFF = 0, MIX_XC_OFF = 12288, MIX_XC_WAVE = 16 * 68 * 4;
constexpr int MIX_HS_OFF = 49152, MIX_HS_STRIDE = 144, MIX_HS_WAVE = 16 * MIX_HS_STRIDE;
static_assert(MIX_S_OFF + 8 * MIX_S_WAVE <= RING_BYTES && MIX_XC_OFF + 8 * MIX_XC_WAVE <= MIX_HS_OFF && MIX_HS_OFF + 8 * MIX_HS_WAVE <= RING_BYTES, "mixing LDS map");

__device__ __forceinline__ void sincos_rev(float ang, float& sn, float& cs) {
    float rev = ang * 0.15915494309189535f; rev -= floorf(rev);
    sn = __builtin_amdgcn_sinf(rev); cs = __builtin_amdgcn_cosf(rev);
}
struct KVRaw { v4u k[2][2]; v4u v[4]; };
__device__ __forceinline__ void kv_issue(KVRaw& R, int tid, const bf16* proj_t0, int h) {
    const int dg = tid & 7;
#pragma unroll
    for (int it = 0; it < 2; ++it) { const int c = (tid >> 3) + 64 * it; const bf16* row = proj_t0 + (size_t)c * INC + 1536 + h * HD + 8 * dg; R.k[it][0] = *(const v4u*)row; R.k[it][1] = *(const v4u*)(row + 64); }
#pragma unroll
    for (int it = 0; it < 4; ++it) { const int id = tid + 512 * it, c = id >> 4, ch = id & 15; R.v[it] = *(const v4u*)(proj_t0 + (size_t)c * INC + 2048 + h * HD + 8 * ch); }
}
template <bool DECAY>
__device__ __forceinline__ void kv_store(Frame& F, const KVRaw& R, int tid, int s0, float lg2) {
    LAS unsigned char* Kimg = F.lds + MIX_K_OFF; LAS unsigned char* Vimg = F.lds + MIX_V_OFF;
    const int dg = tid & 7;
    float inv[8];
#pragma unroll
    for (int j = 0; j < 8; ++j) inv[j] = __builtin_amdgcn_exp2f(-(float)(8 * dg + j) * LOG2_ROPE_OVER_64);
#pragma unroll
    for (int it = 0; it < 2; ++it) {
        const int c = (tid >> 3) + 64 * it;
        const v4u k1 = R.k[it][0], k2 = R.k[it][1];
        const float sc = 0.08838834764831845f * (DECAY ? __builtin_amdgcn_exp2f((float)(127 - c) * lg2) : 1.f);
        const float pos = (float)(s0 + c);
        v4u o1, o2;
#pragma unroll
        for (int q = 0; q < 4; ++q) {
            float sn0, cs0, sn1, cs1; sincos_rev(pos * inv[2 * q], sn0, cs0); sincos_rev(pos * inv[2 * q + 1], sn1, cs1);
            const float a0 = bflo(k1[q]), a1 = bfhi(k1[q]), b0 = bflo(k2[q]), b1 = bfhi(k2[q]);
            o1[q] = cvt_pk_bf16((a0 * cs0 - b0 * sn0) * sc, (a1 * cs1 - b1 * sn1) * sc);
            o2[q] = cvt_pk_bf16((a0 * sn0 + b0 * cs0) * sc, (a1 * sn1 + b1 * cs1) * sc);
        }
        *(LAS v4u*)(Kimg + off_b(c, dg)) = o1; *(LAS v4u*)(Kimg + off_b(c, dg + 8)) = o2;
    }
#pragma unroll
    for (int it = 0; it < 4; ++it) { const int id = tid + 512 * it, c = id >> 4, ch = id & 15; *(LAS v4u*)(Vimg + off_b(c, ch)) = R.v[it]; }
}

template <bool FINAL>
__device__ __forceinline__ void lru_chunk(Frame& F, const Ptrs& P, int b, int n, int lane) {
    const int r = lane & 15, g = lane >> 4, hb = F.wave;
    const int t0 = b * S + n * CH;
    LAS float* CW = (LAS float*)(F.lds + MIX_CW_OFF);
    LAS float* XC = (LAS float*)(F.lds + MIX_XC_OFF + F.wave * MIX_XC_WAVE);
    LAS unsigned char* HS = F.lds + MIX_HS_OFF + F.wave * MIX_HS_WAVE;
    for (int i = F.tid; i < 5 * DL; i += NTHR) CW[i] = i < 4 * DL ? P.conv_w[i] : P.conv_b[i - 4 * DL];
    __syncthreads();
    bf16x8 Wa[4][2], Wx[4][2];
#pragma unroll
    for (int jt = 0; jt < 4; ++jt)
#pragma unroll
        for (int ks = 0; ks < 2; ++ks) {
            Wa[jt][ks] = *(const bf16x8*)(P.LRUW + ((size_t)(0 * 8 + hb) * 64 + 16 * jt + r) * 64 + 32 * ks + 8 * g);
            Wx[jt][ks] = *(const bf16x8*)(P.LRUW + ((size_t)(1 * 8 + hb) * 64 + 16 * jt + r) * 64 + 32 * ks + 8 * g);
        }
    float ba[4], bx[4], sp8[4], St[4], At[4];
#pragma unroll
    for (int jt = 0; jt < 4; ++jt) { const int ch = hb * 64 + 16 * jt + r; ba[jt] = P.ba[ch]; bx[jt] = P.bx[ch];
        const float nl = -P.lam[ch]; sp8[jt] = 8.f * (nl > 20.f ? nl : log1pf(expf(nl)));
        St[jt] = FINAL ? ((const float*)(P.ws + WS_LRU))[2 * B * NCH * DL + (b * NCH + n) * DL + ch] : 0.f; At[jt] = 1.f; }
#pragma unroll 1
    for (int tt = 0; tt < 8; ++tt) {
        const int c = 16 * tt + r;
        v4u glv[2];
        if (FINAL) {
#pragma unroll
            for (int i = 0; i < 2; ++i) glv[i] = *(const v4u*)(P.PROJ + (size_t)(t0 + 16 * tt + (lane >> 3) + 8 * i) * INC + DL + hb * 64 + 8 * (lane & 7));
        }
        bf16x8 fr[2];
#pragma unroll
        for (int ks = 0; ks < 2; ++ks) {
            const int chA = hb * 64 + 32 * ks + 8 * g;
            float xc[8];
            { const f32x4 b0 = *(const LAS f32x4*)(CW + 4 * DL + chA), b1 = *(const LAS f32x4*)(CW + 4 * DL + chA + 4);
              xc[0] = b0[0]; xc[1] = b0[1]; xc[2] = b0[2]; xc[3] = b0[3]; xc[4] = b1[0]; xc[5] = b1[1]; xc[6] = b1[2]; xc[7] = b1[3]; }
#pragma unroll
            for (int k = 0; k < 4; ++k) {
                const int sp = n * CH + c - 3 + k;
                v4u xv = {0u, 0u, 0u, 0u};
                if (sp >= 0) xv = *(const v4u*)(P.PROJ + (size_t)(t0 + c - 3 + k) * INC + chA);
                const f32x4 w0 = *(const LAS f32x4*)(CW + k * DL + chA), w1 = *(const LAS f32x4*)(CW + k * DL + chA + 4);
                xc[0] += w0[0] * bflo(xv.x); xc[1] += w0[1] * bfhi(xv.x); xc[2] += w0[2] * bflo(xv.y); xc[3] += w0[3] * bfhi(xv.y);
                xc[4] += w1[0] * bflo(xv.z); xc[5] += w1[1] * bfhi(xv.z); xc[6] += w1[2] * bflo(xv.w); xc[7] += w1[3] * bfhi(xv.w);
            }
            v4u pk; pk.x = cvt_pk_bf16(xc[0], xc[1]); pk.y = cvt_pk_bf16(xc[2], xc[3]); pk.z = cvt_pk_bf16(xc[4], xc[5]); pk.w = cvt_pk_bf16(xc[6], xc[7]);
            fr[ks] = __builtin_bit_cast(bf16x8, pk);
            *(LAS f32x4*)(XC + r * 68 + 32 * ks + 8 * g) = (f32x4){xc[0], xc[1], xc[2], xc[3]};
            *(LAS f32x4*)(XC + r * 68 + 32 * ks + 8 * g + 4) = (f32x4){xc[4], xc[5], xc[6], xc[7]};
        }
        wave_lds_fence();
#pragma unroll
        for (int jt = 0; jt < 4; ++jt) {
            f32x4 aa = {0.f, 0.f, 0.f, 0.f}, ax = {0.f, 0.f, 0.f, 0.f};
#pragma unroll
            for (int ks = 0; ks < 2; ++ks) { aa = __builtin_amdgcn_mfma_f32_16x16x32_bf16(fr[ks], Wa[jt][ks], aa, 0, 0, 0); ax = __builtin_amdgcn_mfma_f32_16x16x32_bf16(fr[ks], Wx[jt][ks], ax, 0, 0, 0); }
            float av[4], uv[4]; float Al = 1.f, Hl = 0.f;
#pragma unroll
            for (int q = 0; q < 4; ++q) {
                const float xcv = XC[(4 * g + q) * 68 + 16 * jt + r];
                const float rg = fast_sigmoid(aa[q] + ba[jt]), ig = fast_sigmoid(ax[q] + bx[jt]);
                const float la = -rg * sp8[jt];
                const float a = __builtin_amdgcn_exp2f(la * 1.4426950408889634f);
                const float x2 = 2.f * la;
                const float em = x2 > -0.25f ? -x2 * (1.f + x2 * (0.5f + x2 * (0.16666667f + x2 * (0.041666668f + x2 * (0.0083333333f + x2 * 0.0013888889f))))) : 1.f - a * a;
                const float u = sqrtf(em) * (ig * xcv);
                av[q] = a; uv[q] = u; Hl = a * Hl + u; Al *= a;
            }
            float Ap = 1.f, Hp = 0.f;
#pragma unroll
            for (int k = 3; k >= 1; --k) {
                const float Ao = __shfl(Al, lane - 16 * k), Ho = __shfl(Hl, lane - 16 * k);
                if (g >= k) { Hp = Ao * Hp + Ho; Ap *= Ao; }
            }
            float h = Ap * St[jt] + Hp;
            if (FINAL) {
#pragma unroll
                for (int q = 0; q < 4; ++q) {
                    h = av[q] * h + uv[q];
                    *(LAS bf16*)(HS + (4 * g + q) * MIX_HS_STRIDE + (16 * jt + r) * 2) = (bf16)cvt_pk_bf16(h, 0.f);
                }
            } else {
                h = Al * h + Hl;
            }
            const float Atile = __shfl(Ap * Al, (lane & 15) + 48);
            St[jt] = __shfl(h, (lane & 15) + 48);
            At[jt] *= Atile;
        }
        wave_lds_fence();
        if (FINAL) {
#pragma unroll
            for (int i = 0; i < 2; ++i) { const int tk = (lane >> 3) + 8 * i, ch8 = lane & 7;
                const v4u hv = *(const LAS v4u*)(HS + tk * MIX_HS_STRIDE + ch8 * 16); v4u o;
#pragma unroll
                for (int q = 0; q < 4; ++q) o[q] = cvt_pk_bf16(bflo(hv[q]) * gelu_tanh_fast(bflo(glv[i][q])), bfhi(hv[q]) * gelu_tanh_fast(bfhi(glv[i][q])));
                *(v4u*)(P.MIX + (size_t)(t0 + 16 * tt + tk) * D + hb * 64 + 8 * ch8) = o; }
            wave_lds_fence();
        }
    }
    if (!FINAL && g == 0) {
#pragma unroll
        for (int jt = 0; jt < 4; ++jt) { const int ch = hb * 64 + 16 * jt + r; float* AE = (float*)(P.ws + WS_LRU);
            AE[(b * NCH + n) * DL + ch] = At[jt]; AE[B * NCH * DL + (b * NCH + n) * DL + ch] = St[jt]; }
    }
}

__device__ __forceinline__ void p2_mix_summaries(Frame& F, const Ptrs& P) {
    const int w = F.wave;
#pragma unroll 1
    for (int u = F.vcu; u < B * NCH; u += F.G) {
        const int b = u / NCH, n = u % NCH; const int t0 = b * S + n * CH;
        __syncthreads();
        { int lane0 = F.lane; asm volatile("" : "+v"(lane0)); lru_chunk<false>(F, P, b, n, lane0); }
        KVRaw raw; { int tid0 = F.tid; asm volatile("" : "+v"(tid0)); kv_issue(raw, tid0, P.PROJ + (size_t)t0 * INC, 0); }
#pragma unroll 1
        for (int h = 0; h < NH; ++h) {
            int lane = F.lane; asm volatile("" : "+v"(lane));
            int tidv = F.tid; asm volatile("" : "+v"(tidv));
            const int r = lane & 15, g = lane >> 4;
            unsigned trb[8][2];
#pragma unroll
            for (int c = 0; c < 8; ++c) { trb[c][0] = tr_read_addr_16(lane, c, 0, 0); trb[c][1] = tr_read_addr_16(lane, c, 0, 1); }
            const float lg2 = __builtin_amdgcn_logf(1.f - __builtin_amdgcn_exp2f(-5.f - (float)h));
            __syncthreads();
            kv_store<true>(F, raw, tidv, n * CH, lg2);
            if (h + 1 < NH) kv_issue(raw, tidv, P.PROJ + (size_t)t0 * INC, h + 1);
            __syncthreads();
            LAS unsigned char* Kimg = F.lds + MIX_K_OFF; LAS unsigned char* Vimg = F.lds + MIX_V_OFF;
            f32x4 acc[8];
#pragma unroll
            for (int dt = 0; dt < 8; ++dt) acc[dt] = (f32x4){0.f, 0.f, 0.f, 0.f};
            const unsigned ta0 = tr_read_addr_16(lane, w, 0, 0), ta1 = tr_read_addr_16(lane, w, 0, 1);
#pragma unroll 1
            for (int ks = 0; ks < 4; ++ks) {
                const bf16x8 Af = tr_frag2(Vimg + ta0 + 8192 * ks, Vimg + ta1 + 8192 * ks);
#pragma unroll
                for (int dt = 0; dt < 8; ++dt) { const bf16x8 Bf = tr_frag2(Kimg + trb[dt][0] + 8192 * ks, Kimg + trb[dt][1] + 8192 * ks); acc[dt] = __builtin_amdgcn_mfma_f32_16x16x32_bf16(Af, Bf, acc[dt], 0, 0, 0); }
            }
            bf16* KV = (bf16*)P.out + ((size_t)((b * NH + h) * NCH + n)) * (HD * HD);
            LAS unsigned char* Sst = F.lds + MIX_S_OFF + w * MIX_S_WAVE;
#pragma unroll
            for (int dt = 0; dt < 8; ++dt)
#pragma unroll
                for (int q = 0; q < 4; ++q) *(LAS bf16*)(Sst + (4 * g + q) * MIX_S_STRIDE + (16 * dt + r) * 2) = (bf16)cvt_pk_bf16(acc[dt][q], 0.f);
            wave_lds_fence();
#pragma unroll
            for (int i = 0; i < 4; ++i) { const int id = lane + 64 * i, row = id >> 4, ch = id & 15;
                *(v4u*)(KV + (size_t)(16 * w + row) * HD + 8 * ch) = *(const LAS v4u*)(Sst + row * MIX_S_STRIDE + ch * 16); }
            wave_lds_fence();
        }
    }
}
__device__ __forceinline__ void p3_scans(Frame& F, const Ptrs& P) {
    const int idx = F.vcu * NTHR + F.tid;
    for (int id = idx; id < B * NH * (HD * HD / 4); id += F.G * NTHR) {
        const int bh = id >> 12, el = (id & 4095) * 4, h = bh & 3;
        const float lg2 = __builtin_amdgcn_logf(1.f - __builtin_amdgcn_exp2f(-5.f - (float)h));
        const float dec = __builtin_amdgcn_exp2f(128.f * lg2);
        const bf16* KV = (const bf16*)P.out + (size_t)bh * NCH * (HD * HD) + el;
        bf16* PV = (bf16*)(P.out + (size_t)B * NH * NCH * (HD * HD)) + (size_t)bh * NCH * (HD * HD) + el;
        f32x4 st = {0.f, 0.f, 0.f, 0.f};
#pragma unroll 8
        for (int n = 0; n < NCH; ++n) {
            const f32x4 kv = bf4(*(const v2u*)(KV + (size_t)n * (HD * HD)));
            v2u w; w.x = cvt_pk_bf16(st[0], st[1]); w.y = cvt_pk_bf16(st[2], st[3]);
            *(v2u*)(PV + (size_t)n * (HD * HD)) = w;
            st = st * dec + kv;
        }
    }
    if (idx < B * DL) {
        const int b = idx / DL, ch = idx % DL; float* AE = (float*)(P.ws + WS_LRU);
        float carry = 0.f;
        for (int n = 0; n < NCH; ++n) {
            const float a = AE[(b * NCH + n) * DL + ch], e = AE[B * NCH * DL + (b * NCH + n) * DL + ch];
            AE[2 * B * NCH * DL + (b * NCH + n) * DL + ch] = carry;
            carry = a * carry + e;
        }
    }
}
__device__ __forceinline__ void p4_mix_outputs(Frame& F, const Ptrs& P) {
    const int w = F.wave;
#pragma unroll 1
    for (int u = F.vcu; u < B * NCH; u += F.G) {
        const int b = u / NCH, n = u % NCH; const int t0 = b * S + n * CH;
        __syncthreads();
        { int lane0 = F.lane; asm volatile("" : "+v"(lane0)); lru_chunk<true>(F, P, b, n, lane0); }
        KVRaw raw; v4u qraw[2][2];
        { int tid0 = F.tid, lane0 = F.lane; asm volatile("" : "+v"(tid0), "+v"(lane0)); kv_issue(raw, tid0, P.PROJ + (size_t)t0 * INC, 0);
          const bf16* qrow = P.PROJ + (size_t)(t0 + 16 * w + (lane0 & 15)) * INC + 1024 + 8 * (lane0 >> 4);
#pragma unroll
          for (int ks = 0; ks < 2; ++ks) { qraw[ks][0] = *(const v4u*)(qrow + 32 * ks); qraw[ks][1] = *(const v4u*)(qrow + 32 * ks + 64); } }
#pragma unroll 1
        for (int h = 0; h < NH; ++h) {
            int lane = F.lane; asm volatile("" : "+v"(lane));
            int tidv = F.tid; asm volatile("" : "+v"(tidv));
            const int r = lane & 15, g = lane >> 4;
            unsigned trb[8][2], rrb[4];
#pragma unroll
            for (int c = 0; c < 8; ++c) { trb[c][0] = tr_read_addr_16(lane, c, 0, 0); trb[c][1] = tr_read_addr_16(lane, c, 0, 1); }
#pragma unroll
            for (int ks = 0; ks < 4; ++ks) rrb[ks] = row_read_addr_16(lane, 0, ks);
            const float lg2 = __builtin_amdgcn_logf(1.f - __builtin_amdgcn_exp2f(-5.f - (float)h));
            __syncthreads();
            kv_store<false>(F, raw, tidv, n * CH, lg2);
            bf16x8 Qf[4];
            {
                const float pos = (float)(n * CH + 16 * w + r);
#pragma unroll
                for (int ks = 0; ks < 2; ++ks) {
                    const v4u q1 = qraw[ks][0], q2 = qraw[ks][1];
                    v4u o1, o2;
#pragma unroll
                    for (int q = 0; q < 4; ++q) {
                        const float i0 = __builtin_amdgcn_exp2f(-(float)(32 * ks + 8 * g + 2 * q) * LOG2_ROPE_OVER_64), i1 = __builtin_amdgcn_exp2f(-(float)(32 * ks + 8 * g + 2 * q + 1) * LOG2_ROPE_OVER_64);
                        float sn0, cs0, sn1, cs1; sincos_rev(pos * i0, sn0, cs0); sincos_rev(pos * i1, sn1, cs1);
                        const float a0 = bflo(q1[q]), a1 = bfhi(q1[q]), b0 = bflo(q2[q]), b1 = bfhi(q2[q]);
                        o1[q] = cvt_pk_bf16(a0 * cs0 - b0 * sn0, a1 * cs1 - b1 * sn1);
                        o2[q] = cvt_pk_bf16(a0 * sn0 + b0 * cs0, a1 * sn1 + b1 * cs1);
                    }
                    Qf[ks] = __builtin_bit_cast(bf16x8, o1); Qf[ks + 2] = __builtin_bit_cast(bf16x8, o2);
                }
            }
            __syncthreads();
            LAS unsigned char* Kimg = F.lds + MIX_K_OFF; LAS unsigned char* Vimg = F.lds + MIX_V_OFF; LAS unsigned char* Sst = F.lds + MIX_S_OFF + w * MIX_S_WAVE;
            const bf16* PV = (const bf16*)(P.out + (size_t)B * NH * NCH * (HD * HD)) + ((size_t)((b * NH + h) * NCH + n)) * (HD * HD);
            v4u grv[4];
#pragma unroll
            for (int i = 0; i < 4; ++i) grv[i] = *(const v4u*)(P.PROJ + (size_t)(t0 + 16 * w + (lane >> 4) + 4 * i) * INC + 2560 + h * HD + 8 * (lane & 15));
            bf16x8 Pf[4][4];
#pragma unroll
            for (int et = 0; et < 4; ++et)
#pragma unroll
                for (int ks = 0; ks < 4; ++ks) Pf[et][ks] = *(const bf16x8*)(PV + (size_t)(16 * et + r) * HD + 32 * ks + 8 * g);
            if (h + 1 < NH) {
                kv_issue(raw, tidv, P.PROJ + (size_t)t0 * INC, h + 1);
                const bf16* qrow = P.PROJ + (size_t)(t0 + 16 * w + r) * INC + 1024 + (h + 1) * HD + 8 * g;
#pragma unroll
                for (int ks = 0; ks < 2; ++ks) { qraw[ks][0] = *(const v4u*)(qrow + 32 * ks); qraw[ks][1] = *(const v4u*)(qrow + 32 * ks + 64); }
            }
#pragma unroll 1
            for (int mt = 0; mt <= w; ++mt) {
                f32x4 sa = {0.f, 0.f, 0.f, 0.f};
#pragma unroll
                for (int ks = 0; ks < 4; ++ks) { const bf16x8 Kf = *(const LAS bf16x8*)(Kimg + rrb[ks] + 4096 * mt); sa = __builtin_amdgcn_mfma_f32_16x16x32_bf16(Qf[ks], Kf, sa, 0, 0, 0); }
#pragma unroll
                for (int q = 0; q < 4; ++q) {
                    const int dlt = (16 * w + 4 * g + q) - (16 * mt + r);
                    const float v = dlt >= 0 ? sa[q] * __builtin_amdgcn_exp2f((float)dlt * lg2) : 0.f;
                    *(LAS bf16*)(Sst + (4 * g + q) * MIX_S_STRIDE + (16 * mt + r) * 2) = (bf16)cvt_pk_bf16(v, 0.f);
                }
            }
            if ((w & 1) == 0) {
#pragma unroll
                for (int q = 0; q < 4; ++q) *(LAS bf16*)(Sst + (4 * g + q) * MIX_S_STRIDE + (16 * (w + 1) + r) * 2) = 0;
            }
            wave_lds_fence();
            f32x4 acc[8];
            float rsc[4];
#pragma unroll
            for (int q = 0; q < 4; ++q) rsc[q] = __builtin_amdgcn_exp2f((float)(16 * w + 4 * g + q + 1) * lg2);
#pragma unroll
            for (int et = 0; et < 4; ++et) {
                f32x4 a = {0.f, 0.f, 0.f, 0.f};
#pragma unroll
                for (int ks = 0; ks < 4; ++ks) a = __builtin_amdgcn_mfma_f32_16x16x32_bf16(Qf[ks], Pf[et][ks], a, 0, 0, 0);
#pragma unroll
                for (int q = 0; q < 4; ++q) a[q] *= rsc[q];
                acc[et] = a; acc[et + 4] = (f32x4){0.f, 0.f, 0.f, 0.f};
            }
#pragma unroll
            for (int et = 0; et < 4; ++et)
#pragma unroll
                for (int ks = 0; ks < 4; ++ks) Pf[et][ks] = *(const bf16x8*)(PV + (size_t)(16 * (et + 4) + r) * HD + 32 * ks + 8 * g);
#pragma unroll 1
            for (int ks = 0; ks <= (w >> 1); ++ks) {
                const bf16x8 Sf = *(const LAS bf16x8*)(Sst + r * MIX_S_STRIDE + (32 * ks + 8 * g) * 2);
#pragma unroll
                for (int et = 0; et < 8; ++et) { const bf16x8 Vf = tr_frag2(Vimg + trb[et][0] + 8192 * ks, Vimg + trb[et][1] + 8192 * ks); acc[et] = __builtin_amdgcn_mfma_f32_16x16x32_bf16(Sf, Vf, acc[et], 0, 0, 0); }
            }
#pragma unroll
            for (int et = 0; et < 4; ++et) {
                f32x4 a = {0.f, 0.f, 0.f, 0.f};
#pragma unroll
                for (int ks = 0; ks < 4; ++ks) a = __builtin_amdgcn_mfma_f32_16x16x32_bf16(Qf[ks], Pf[et][ks], a, 0, 0, 0);
#pragma unroll
                for (int q = 0; q < 4; ++q) acc[et + 4][q] += a[q] * rsc[q];
            }
            float mu[4], rs[4];
#pragma unroll
            for (int q = 0; q < 4; ++q) {
                float s = 0.f;
#pragma unroll
                for (int et = 0; et < 8; ++et) s += acc[et][q];
                s += __shfl_xor(s, 1); s += __shfl_xor(s, 2); s += __shfl_xor(s, 4); s += __shfl_xor(s, 8);
                const float m = s * (1.f / 128.f); float v = 0.f;
#pragma unroll
                for (int et = 0; et < 8; ++et) { const float d = acc[et][q] - m; v += d * d; }
                v += __shfl_xor(v, 1); v += __shfl_xor(v, 2); v += __shfl_xor(v, 4); v += __shfl_xor(v, 8);
                mu[q] = m; rs[q] = 1.0f / sqrtf(v * (1.f / 128.f) + EPS);
            }
#pragma unroll
            for (int et = 0; et < 8; ++et)
#pragma unroll
                for (int q = 0; q < 4; ++q) *(LAS bf16*)(Sst + (4 * g + q) * MIX_S_STRIDE + (16 * et + r) * 2) = (bf16)cvt_pk_bf16((acc[et][q] - mu[q]) * rs[q], 0.f);
            wave_lds_fence();
#pragma unroll
            for (int i = 0; i < 4; ++i) { const int row = (lane >> 4) + 4 * i, ch = lane & 15;
                const v4u ov = *(const LAS v4u*)(Sst + row * MIX_S_STRIDE + ch * 16); v4u o;
#pragma unroll
                for (int q = 0; q < 4; ++q) { const float g0 = bflo(grv[i][q]), g1 = bfhi(grv[i][q]); o[q] = cvt_pk_bf16(g0 * fast_sigmoid(g0) * bflo(ov[q]), g1 * fast_sigmoid(g1) * bfhi(ov[q])); }
                *(v4u*)(P.MIX + (size_t)(t0 + 16 * w + row) * D + DL + h * HD + 8 * ch) = o; }
            wave_lds_fence();
        }
    }
}
__global__ void __launch_bounds__(NTHR, 2) mk_fwd(Args args) {
    extern __shared__ __attribute__((aligned(16))) unsigned char lds_raw[];
    Frame F;
    F.lds = (LAS unsigned char*)lds_raw;
    F.MISC = (volatile LAS unsigned*)(F.lds + LDSCTL_OFF);
    F.tid = threadIdx.x; F.lane = F.tid & 63; F.wave = __builtin_amdgcn_readfirstlane(F.tid >> 6);
    F.G = gridDim.x; { const int bx = blockIdx.x; F.vcu = (F.G % 8 == 0) ? (bx % 8) * (F.G / 8) + bx / 8 : bx; }
    F.ctl = (gu32*)(args.ws + WS_CTL);
    Ptrs P; make_ptrs(P, args);
    for (int u = F.tid; u < 256; u += NTHR) ((LAS unsigned*)(F.lds + LDSCTL_OFF))[u] = 0u;
    __syncthreads();
    XcdBarrier bar = xcd_barrier_post((unsigned*)(F.ctl + CW_BAR) + args.ph_hi * XCD_BAR_WORDS, F.MISC + 8);
    const int lo = args.ph_lo, hi = args.ph_hi;
#define IN(k) (lo <= (k) && (k) < hi)
#define SEAM(k) do { if (IN(k) && IN((k) + 1)) xcd_barrier(bar); } while (0)
    if (IN(0)) { p0_prologue(F, P); }
    SEAM(0);
    if (IN(1)) {
        pg8::PlainSched S; S.init(P.XB, P.W_IN, T, INC, D, F.G, (int)blockIdx.x);
        pg8::EpiRowScaleBf16 E{P.PROJ, INC, P.rstd0};
        pg8::gemm_phase(F.lds + RING_OFF, S, E);
    }
    SEAM(1);
    if (IN(2)) p2_mix_summaries(F, P);
    SEAM(2);
    if (IN(3)) p3_scans(F, P);
    SEAM(3);
    if (IN(4)) p4_mix_outputs(F, P);
    SEAM(4);
    if (IN(5)) {
        pg8::PlainSched S; S.init(P.MIX, P.W_OUT, T, D, D, F.G, (int)blockIdx.x);
        pg8::EpiPlainBf16 E{P.D1, D};
        pg8::gemm_phase(F.lds + RING_OFF, S, E);
    }
    SEAM(5);
    if (IN(6)) p6_route(F, P);
    SEAM(6);
    if (IN(7)) p7_lists(F, P);
    SEAM(7);
    if (IN(8)) moe_phase<0>(F, P, lo == 8);
    SEAM(8);
    if (IN(9)) moe_phase<1>(F, P, lo == 9);
    SEAM(9);
    if (IN(10)) p10_combine(F, P);
    SEAM(10);
    if (IN(11)) {
        pg8::PlainSched S; S.init((const bf16*)P.X1B, P.W_PG, T, D, D / 2, F.G, (int)blockIdx.x);
        pg8::EpiGateBf16 E{P.GATE, D, P.rstd2, P.b_pg, 1.f / (PLE_SX2 * PLE_SWG)};
        pg8::gemm_phase<pg8::EpiGateBf16, pg8::PlainSched, true>(F.lds + RING_OFF, S, E);
    }
    if (IN(12)) {
        pg8::PlainSched S; S.init(P.PB, P.W_PP, T, D, PLE, F.G, (int)blockIdx.x);
        pg8::EpiPlainBf16 E{P.PP, D};
        pg8::gemm_phase(F.lds + RING_OFF, S, E);
    }
    SEAM(12);
    if (IN(13)) p13_final(F, P);
#undef IN
#undef SEAM
}

static int mk_grid = 0;
static void mk_launch(void* const* d_in, void* d_out, void* d_ws, int lo, int hi, hipStream_t stream) {
    if (mk_grid == 0) {
        int dev = 0, cus = 0;
        if (hipGetDevice(&dev) != hipSuccess || hipDeviceGetAttribute(&cus, hipDeviceAttributeMultiprocessorCount, dev) != hipSuccess) { mk_grid = -1; return; }
        if (hipFuncSetAttribute((const void*)mk_fwd, hipFuncAttributeMaxDynamicSharedMemorySize, LDS_BYTES) != hipSuccess) { fprintf(stderr, "mk: hipFuncSetAttribute failed\n"); mk_grid = -1; return; }
        int per_cu = 0;
        if (hipOccupancyMaxActiveBlocksPerMultiprocessor(&per_cu, (const void*)mk_fwd, NTHR, LDS_BYTES) != hipSuccess || per_cu < 1) { fprintf(stderr, "mk: occupancy query says %d\n", per_cu); (void)hipGetLastError(); }
        mk_grid = cus;
    }
    if (mk_grid < 0) return;
    Args a; memset(&a, 0, sizeof a);
    for (int i = 0; i < 25; ++i) a.in[i] = (const float*)d_in[i];
    a.out = (float*)d_out; a.ws = (unsigned char*)d_ws; a.ph_lo = lo; a.ph_hi = hi;
    hipLaunchKernelGGL(mk_fwd, dim3(mk_grid), dim3(NTHR), LDS_BYTES, stream, a);
}
extern "C" void kernel_launch(void* const* d_in, const int* in_sizes, int n_in, void* d_out, int out_size, void* d_ws, size_t ws_size, hipStream_t stream) {
    if (n_in != 25 || ws_size < WS_END || out_size != T * D) { fprintf(stderr, "kernel_launch: n_in %d, workspace %zu (need %zu), out_size %d: nothing launched\n", n_in, ws_size, (size_t)WS_END, out_size); return; }
    (void)hipMemsetAsync((unsigned char*)d_ws + WS_CTL, 0, 1 * MiB, stream);
    mk_launch(d_in, d_out, d_ws, 0, 14, stream);
}
```

```cpp
#include <hip/hip_runtime.h>
#include <stdint.h>
#include <stdio.h>
#include <string.h>

typedef unsigned short bf16;
namespace cfg {
constexpr int D = 1024, B = 8, S = 4096, T = B * S, PLE = 256, DL = 512, DR = 512, NH = 4, HD = 128, INC = 3072;
constexpr int NE = 64, DE = 512, NG = 8, EPG = 8, CH = 128, NCH = S / CH;
constexpr float EPS = 1e-6f;
constexpr float MOE_SX = 8.f, MOE_SW1 = 64.f, MOE_SA = 8.f, MOE_SW2 = 32.f;
constexpr float PLE_SX2 = 8.f, PLE_SWG = 64.f;
constexpr size_t MiB = 1u << 20;
constexpr size_t WS_CTL = 0;
constexpr size_t WS_RSTD0 = 1 * MiB, WS_RSTD1 = WS_RSTD0 + 128 * 1024, WS_RSTD2 = WS_RSTD1 + 128 * 1024;
constexpr size_t WS_EID = 2 * MiB, WS_EW = WS_EID + 256 * 1024, WS_LIST = WS_EW + 256 * 1024, WS_CNT = WS_LIST + 256 * 1024;
constexpr size_t WS_ROPE = 4 * MiB;
constexpr size_t WS_LOGITS = 3 * MiB;
constexpr size_t WS_LRU = 13 * MiB;
constexpr size_t WS_WIN = 16 * MiB, WS_WOUT = 22 * MiB, WS_WPG = 24 * MiB, WS_WPP = 26 * MiB, WS_WRT = 26 * MiB + 512 * 1024, WS_LRUW = 27 * MiB;
constexpr size_t WS_W13 = 28 * MiB, WS_W2 = 156 * MiB, WS_PB = 220 * MiB;
constexpr size_t WS_R64 = 236 * MiB;
constexpr size_t WS_PROJ = 300 * MiB;
constexpr size_t WS_D1 = 300 * MiB, WS_X1B = 364 * MiB, WS_Y = 428 * MiB, WS_PP = 428 * MiB;
constexpr size_t WS_END = 556 * MiB;
}
using namespace cfg;

__device__ __forceinline__ float bf2f(bf16 v) { return __uint_as_float((unsigned)v << 16); }
__device__ __forceinline__ bf16 f2bf(float f) { unsigned u = __float_as_uint(f); return (bf16)((u + 0x7fffu + ((u >> 16) & 1u)) >> 16); }
__device__ __forceinline__ float ldv(const float* p, size_t i) { return p[i]; }
__device__ __forceinline__ float ldv(const bf16* p, size_t i) { return bf2f(p[i]); }
__device__ __forceinline__ void stv(float* p, size_t i, float v) { p[i] = v; }
__device__ __forceinline__ void stv(bf16* p, size_t i, float v) { p[i] = f2bf(v); }

#define GAS __attribute__((address_space(1)))
#define LAS __attribute__((address_space(3)))
typedef unsigned v4u __attribute__((ext_vector_type(4)));
typedef unsigned v2u __attribute__((ext_vector_type(2)));
typedef float f32x4 __attribute__((ext_vector_type(4)));
typedef float f32x2 __attribute__((ext_vector_type(2)));
typedef short bf16x8 __attribute__((ext_vector_type(8)));
typedef short bf16x4 __attribute__((ext_vector_type(4)));
typedef GAS unsigned gu32;
#define RLX_AGENT __ATOMIC_RELAXED, __HIP_MEMORY_SCOPE_AGENT
#define LDS_WAIT() asm volatile("s_waitcnt lgkmcnt(0)" ::: "memory")
#define VM_WAIT() asm volatile("s_waitcnt vmcnt(0)" ::: "memory")
__device__ __forceinline__ unsigned pk2(float lo, float hi) { return (unsigned)f2bf(lo) | ((unsigned)f2bf(hi) << 16); }
typedef __bf16 hwbf16x2 __attribute__((ext_vector_type(2)));
__device__ __forceinline__ unsigned cvt_pk_bf16(float lo, float hi) { f32x2 v = {lo, hi}; hwbf16x2 b = __builtin_convertvector(v, hwbf16x2); return __builtin_bit_cast(unsigned, b); }
__device__ __forceinline__ float bflo(unsigned w) { return __uint_as_float(w << 16); }
__device__ __forceinline__ float bfhi(unsigned w) { return __uint_as_float(w & 0xffff0000u); }
__device__ __forceinline__ float fast_sigmoid(float x) { return __builtin_amdgcn_rcpf(1.f + __builtin_amdgcn_exp2f(-1.4426950408889634f * x)); }

#define XB_TMO      128
#define XB_XCNT(j)  (256  + 64 * (j))
#define XB_XSUB(j)  (1280 + 64 * (j))
#define XB_XGEN(j)  (2304 + 64 * (j))
#define XB_TOP      3328
#define XB_TOPGEN   3392
#define XCD_BAR_WORDS 3456
#define XB_SPIN_CAP (1u << 18)
__device__ __forceinline__ unsigned xb_ld(unsigned* p)              { return __hip_atomic_load(p, __ATOMIC_RELAXED, __HIP_MEMORY_SCOPE_AGENT); }
__device__ __forceinline__ unsigned xb_add(unsigned* p, unsigned v) { return __hip_atomic_fetch_add(p, v, __ATOMIC_RELAXED, __HIP_MEMORY_SCOPE_AGENT); }
__device__ __forceinline__ unsigned xb_xcc_id() { return (unsigned)__builtin_amdgcn_s_getreg((3 << 11) | 20) & 0xFu; }
#define XB_SPIN(cond, bar) do { unsigned _sp = 0; while (cond) { __builtin_amdgcn_s_sleep(1); \
    if ((++_sp & 255u) == 0u) { if (xb_ld(&(bar)[XB_TMO])) break; if (_sp > XB_SPIN_CAP) { atomicAdd(&(bar)[XB_TMO], 1u); break; } } } } while (0)
struct XcdBarrier { unsigned* bar; unsigned x; volatile LAS unsigned* st; };
__device__ __forceinline__ XcdBarrier xcd_barrier_post(unsigned* bar, volatile LAS unsigned* st) {
    XcdBarrier b; b.bar = bar; b.x = xb_xcc_id(); b.st = st;
    if (threadIdx.x == 0) (void)xb_add(&bar[XB_XCNT(b.x)], 1u);
    return b;
}
__device__ __forceinline__ void xcd_barrier_complete(unsigned* bar, unsigned x, unsigned& nloc, unsigned& nx) {
    const unsigned G = gridDim.x * gridDim.y * gridDim.z;
    unsigned sum, cnt, mine, sp = 0u;
    for (;;) {
        sum = 0u; cnt = 0u; mine = 0u;
#pragma unroll
        for (unsigned j = 0; j < 16; ++j) { const unsigned c = xb_ld(&bar[XB_XCNT(j)]); sum += c; cnt += (c > 0u) ? 1u : 0u; mine = (j == x) ? c : mine; }
        if (sum == G) break;
        __builtin_amdgcn_s_sleep(1);
        if ((++sp & 255u) == 0u) { if (xb_ld(&bar[XB_TMO])) break; if (sp > XB_SPIN_CAP) { atomicAdd(&bar[XB_TMO], 1u); break; } }
    }
    nloc = mine > 0u ? mine : 1u; nx = cnt > 0u ? cnt : 1u;
}
__device__ __forceinline__ void xcd_barrier(const XcdBarrier& b) {
    asm volatile("s_waitcnt vmcnt(0)" ::: "memory");
    __syncthreads();
    if (threadIdx.x == 0) {
        unsigned* bar = b.bar;
        __builtin_amdgcn_s_waitcnt(0);
        unsigned nloc = b.st[0], nx = b.st[1];
        if (nloc == 0u) { xcd_barrier_complete(bar, b.x, nloc, nx); b.st[0] = nloc; b.st[1] = nx; }
        const unsigned old = xb_add(&bar[XB_XSUB(b.x)], 1u);
        const unsigned gen = old / nloc;
        if (old + 1u == (gen + 1u) * nloc) {
            __builtin_amdgcn_fence(__ATOMIC_RELEASE, "agent");
            asm volatile("s_waitcnt vmcnt(0)" ::: "memory");
            const unsigned og = xb_add(&bar[XB_TOP], 1u);
            const unsigned tg = og / nx;
            if (og + 1u == (tg + 1u) * nx) xb_add(&bar[XB_TOPGEN], 1u);
            else XB_SPIN(xb_ld(&bar[XB_TOPGEN]) == tg, bar);
            __builtin_amdgcn_fence(__ATOMIC_ACQUIRE, "agent");
            xb_add(&bar[XB_XGEN(b.x)], 1u);
            asm volatile("s_waitcnt vmcnt(0)" ::: "memory");
        } else {
            XB_SPIN(xb_ld(&bar[XB_XGEN(b.x)]) == gen, bar);
            __builtin_amdgcn_fence(__ATOMIC_ACQUIRE, "agent");
            asm volatile("s_waitcnt vmcnt(0)" ::: "memory");
        }
    }
    __syncthreads();
}

constexpr int NWAVES = 8, NTHR = NWAVES * 64;
constexpr int RING_OFF = 0, RING_BYTES = 131072;
constexpr int LDSCTL_OFF = RING_BYTES;
constexpr int UTAB_OFF = LDSCTL_OFF + 1024;
constexpr int MAXU = 6;
constexpr int UTABF_OFF = UTAB_OFF + MAXU * 1024;
constexpr int SCHED_OFF = UTABF_OFF + MAXU * 1024;
constexpr int LDS_BYTES = SCHED_OFF + 2048;
static_assert(LDS_BYTES <= 160 * 1024 && LDS_BYTES > 80 * 1024, "LDS map");
constexpr int CW_TMO = 0, CW_BAR = 4096;

namespace pg8 {
constexpr int BM = 256, BK = 64, HALF = 128, HTB = HALF * BK * 2, STAGE_BYTES = 8 * HTB;
__host__ __device__ __forceinline__ int lds_byte(int r, int c) { const int st = (r >> 4) * 2 + (c >> 5), rr = r & 15, cc = c & 31, ob = rr * 64 + cc * 2; return st * 1024 + (ob ^ (((ob >> 9) & 1) << 5)); }
__host__ __device__ __forceinline__ void stage_rc(int b, int& R, int& C) { const int st = b / 1024, sb = b % 1024, swz = sb ^ (((sb >> 9) & 1) << 5); R = (st >> 1) * 16 + swz / 64; C = (st & 1) * 32 + (swz % 64) / 2; }
__host__ __device__ __forceinline__ int perm32(int rho) { const int n = rho >> 4, i = rho & 15; return 8 * (i >> 2) + 4 * n + (i & 3); }

struct Unit { int pm, pn, e, rows, slot0, ui; };

struct PlainSched {
    static constexpr bool GATHER = false;
    const bf16* A; const bf16* Bt; int K; int nM, nN, nwg, G, c;
    __device__ void init(const bf16* A_, const bf16* Bt_, int M, int N, int K_, int G_, int c_) { A = A_; Bt = Bt_; K = K_; nM = M / BM; nN = N / BM; nwg = nM * nN; G = G_; c = c_; }
    __device__ __forceinline__ bool next(int i, Unit& u) const {
        const long L = (long)i * G + c; if (L >= nwg) return false;
        int wgid = (int)L; { const int q = nwg / 8, r = nwg % 8, xcd = wgid % 8, off = wgid / 8; wgid = (xcd < r ? xcd * (q + 1) : r * (q + 1) + (xcd - r) * q) + off; }
        const int nig = 8 * nN, gid = wgid / nig, fm = gid * 8, gsz = (nM - fm) < 8 ? (nM - fm) : 8;
        u.pm = fm + ((wgid % nig) % gsz); u.pn = (wgid % nig) / gsz; u.e = 0; u.rows = 256; u.slot0 = 0; u.ui = i; return true;
    }
    __device__ __forceinline__ const char* a_base(const Unit& u) const { return (const char*)A + (size_t)u.pm * (size_t)(BM * 2) * K; }
    __device__ __forceinline__ const char* b_base(const Unit& u) const { return (const char*)Bt + (size_t)u.pn * (size_t)(BM * 2) * K; }
    __device__ __forceinline__ unsigned a_rowoff(const Unit&, int r) const { return (unsigned)r * (unsigned)K * 2u; }
};

typedef long i64x2 __attribute__((ext_vector_type(2)));
template <class Epi, class Sched, bool FP8 = false>
__device__ __forceinline__ void gemm_phase(LAS unsigned char* lds, const Sched& S, const Epi& E) {
    const int tid = threadIdx.x, wid = __builtin_amdgcn_readfirstlane(tid >> 6), lane = tid & 63, wr = wid >> 2, wc = wid & 3, fr = lane & 15, fq = lane >> 4;
    const int K = S.K, nt = K / BK;
    int Rr[2], Cc[2]; unsigned voffB[2];
#pragma unroll
    for (int i = 0; i < 2; ++i) { stage_rc(tid * 16 + i * 8192, Rr[i], Cc[i]); const int Rb = (Rr[i] & ~31) + perm32(Rr[i] & 31); voffB[i] = (unsigned)(Rb * K + Cc[i]) * 2u; }
    const size_t kstep = (size_t)(BK * 2);
    const size_t hstep = (size_t)HALF * K * 2;
    const unsigned ldsw = (unsigned)wid * 1024u;
    const int aoff = lds_byte(wr * 64 + fr, fq * 8), boff = lds_byte(wc * 32 + fr, fq * 8);
#define PG8_SA(b, h) (((b) * 2 + (h)) * HTB)
#define PG8_SB(b, h) ((4 + (b) * 2 + (h)) * HTB)
#define PG8_STAGE(bufoff, gbase, voff) do { _Pragma("unroll") for (int _i = 0; _i < 2; ++_i) \
        __builtin_amdgcn_global_load_lds((const unsigned*)((const char*)(gbase) + (voff)[_i]), (LAS unsigned*)(lds + (bufoff) + ldsw + _i * 8192), 16, 0, 0); } while (0)
#define PG8_LDA(dst, b, h) do { _Pragma("unroll") for (int m = 0; m < 4; ++m) _Pragma("unroll") for (int k = 0; k < 2; ++k) dst[m][k] = *(const LAS bf16x8*)(lds + PG8_SA(b, h) + aoff + m * 2048 + k * 1024); } while (0)
#define PG8_LDB(dst, b, h) do { _Pragma("unroll") for (int n = 0; n < 2; ++n) _Pragma("unroll") for (int k = 0; k < 2; ++k) dst[n][k] = *(const LAS bf16x8*)(lds + PG8_SB(b, h) + boff + n * 2048 + k * 1024); } while (0)
#define PG8_MMA(ai, bj, At, Bt) do { __builtin_amdgcn_s_setprio(1); _Pragma("unroll") for (int m = 0; m < 4; ++m) _Pragma("unroll") for (int n = 0; n < 2; ++n) _Pragma("unroll") for (int k = 0; k < 2; ++k) { \
        if constexpr (FP8) { const i64x2 a8_ = __builtin_bit_cast(i64x2, At[m][k]), b8_ = __builtin_bit_cast(i64x2, Bt[n][k]); \
            acc[ai][bj][m][n] = __builtin_amdgcn_mfma_f32_16x16x32_fp8_fp8(b8_[0], a8_[0], acc[ai][bj][m][n], 0, 0, 0); acc[ai][bj][m][n] = __builtin_amdgcn_mfma_f32_16x16x32_fp8_fp8(b8_[1], a8_[1], acc[ai][bj][m][n], 0, 0, 0); } \
        else acc[ai][bj][m][n] = __builtin_amdgcn_mfma_f32_16x16x32_bf16(Bt[n][k], At[m][k], acc[ai][bj][m][n], 0, 0, 0); } __builtin_amdgcn_s_setprio(0); } while (0)
#define PG8_WAIT_V(n) asm volatile("s_waitcnt vmcnt(" #n ")" ::: "memory")
#define PG8_WAIT_L(n) asm volatile("s_waitcnt lgkmcnt(" #n ")" ::: "memory")
#define PG8_BAR __builtin_amdgcn_s_barrier()
#define PG8_SCHED __builtin_amdgcn_sched_barrier(0)
#define PG8_VOFF(dst, u) do { _Pragma("unroll") for (int _h = 0; _h < 2; ++_h) _Pragma("unroll") for (int _i = 0; _i < 2; ++_i) dst[_h][_i] = S.a_rowoff(u, _h * HALF + Rr[_i]) + (unsigned)Cc[_i] * 2u; } while (0)
    Unit cur, nxt; int ui = 0;
    if (!S.next(0, cur)) return;
    f32x4 acc[2][2][4][2];
#pragma unroll
    for (int a = 0; a < 2; ++a)
#pragma unroll
        for (int b = 0; b < 2; ++b)
#pragma unroll
            for (int m = 0; m < 4; ++m)
#pragma unroll
                for (int n = 0; n < 2; ++n) acc[a][b][m][n] = (f32x4){0.f, 0.f, 0.f, 0.f};
    bf16x8 At[4][2], B0[2][2], B1[2][2];
    unsigned va[2][2], nva[2][2];
    PG8_VOFF(va, cur);
    const char* cA = S.a_base(cur); const char* cB = S.b_base(cur);
    PG8_STAGE(PG8_SB(0, 0), cB, voffB); PG8_STAGE(PG8_SB(0, 1), cB + hstep, voffB); PG8_STAGE(PG8_SA(0, 0), cA, va[0]); PG8_STAGE(PG8_SA(0, 1), cA, va[1]);
    if (wr == 1) PG8_BAR;
    PG8_WAIT_V(2); PG8_BAR;
    PG8_STAGE(PG8_SB(1, 0), cB + kstep, voffB); PG8_STAGE(PG8_SA(1, 0), cA + kstep, va[0]); PG8_STAGE(PG8_SB(1, 1), cB + hstep + kstep, voffB);
    PG8_WAIT_V(6); PG8_BAR;
    for (;;) {
        const bool has_next = S.next(ui + 1, nxt);
        const bool mma0 = cur.rows > 64 * wr, mma1 = cur.rows > HALF + 64 * wr;
        const char* nA = has_next ? S.a_base(nxt) : cA; const char* nB = has_next ? S.b_base(nxt) : cB;
        if (has_next) { PG8_VOFF(nva, nxt); } else {
#pragma unroll
            for (int h = 0; h < 2; ++h)
#pragma unroll
                for (int i = 0; i < 2; ++i) nva[h][i] = va[h][i]; }
        for (int t = 0; t < nt; t += 2) {
            const bool last = (t == nt - 2);
            const char* a1 = cA + (size_t)(t + 1) * kstep;
            const char* a2 = last ? nA : cA + (size_t)(t + 2) * kstep; const char* b2 = last ? nB : cB + (size_t)(t + 2) * kstep;
            const char* a3 = a2 + kstep; const char* b3 = b2 + kstep;
            unsigned v2[2][2];
#pragma unroll
            for (int h = 0; h < 2; ++h)
#pragma unroll
                for (int i = 0; i < 2; ++i) v2[h][i] = last ? nva[h][i] : va[h][i];
            PG8_LDB(B0, 0, 0); PG8_LDB(B1, 0, 1); PG8_SCHED; PG8_LDA(At, 0, 0); PG8_STAGE(PG8_SA(1, 1), a1, va[1]);
            PG8_WAIT_V(8); PG8_WAIT_L(0); PG8_BAR; if (mma0) { PG8_MMA(0, 0, At, B0); PG8_MMA(0, 1, At, B1); } PG8_BAR; PG8_SCHED;
            PG8_LDA(At, 0, 1); PG8_STAGE(PG8_SB(0, 0), b2, voffB); PG8_STAGE(PG8_SB(0, 1), b2 + hstep, voffB); PG8_STAGE(PG8_SA(0, 0), a2, v2[0]);
            PG8_WAIT_V(8); PG8_WAIT_L(0); PG8_BAR; if (mma1) { PG8_MMA(1, 0, At, B0); PG8_MMA(1, 1, At, B1); } PG8_BAR; PG8_SCHED;
            PG8_LDB(B0, 1, 0); PG8_LDB(B1, 1, 1); PG8_SCHED; PG8_LDA(At, 1, 0); PG8_STAGE(PG8_SA(0, 1), a2, v2[1]);
            PG8_WAIT_V(8); PG8_WAIT_L(0); PG8_BAR; if (mma0) { PG8_MMA(0, 0, At, B0); PG8_MMA(0, 1, At, B1); } PG8_BAR; PG8_SCHED;
            PG8_LDA(At, 1, 1); PG8_STAGE(PG8_SB(1, 0), b3, voffB); PG8_STAGE(PG8_SB(1, 1), b3 + hstep, voffB); PG8_STAGE(PG8_SA(1, 0), a3, v2[0]);
            PG8_WAIT_V(8); PG8_WAIT_L(0); PG8_BAR; if (mma1) { PG8_MMA(1, 0, At, B0); PG8_MMA(1, 1, At, B1); } PG8_BAR; PG8_SCHED;
        }
        if (wr == 0) PG8_BAR;
        E(acc, cur, wr, wc, fr, fq);
        if (!has_next) break;
#pragma unroll
        for (int a = 0; a < 2; ++a)
#pragma unroll
            for (int b = 0; b < 2; ++b)
#pragma unroll
                for (int m = 0; m < 4; ++m)
#pragma unroll
                    for (int n = 0; n < 2; ++n) acc[a][b][m][n] = (f32x4){0.f, 0.f, 0.f, 0.f};
        cur = nxt; cA = nA; cB = nB; ++ui;
#pragma unroll
        for (int h = 0; h < 2; ++h)
#pragma unroll
            for (int i = 0; i < 2; ++i) va[h][i] = nva[h][i];
        if (wr == 1) PG8_BAR;
    }
    PG8_WAIT_V(0);
    PG8_BAR;
#undef PG8_SA
#undef PG8_SB
#undef PG8_STAGE
#undef PG8_LDA
#undef PG8_LDB
#undef PG8_MMA
#undef PG8_WAIT_V
#undef PG8_WAIT_L
#undef PG8_BAR
#undef PG8_SCHED
#undef PG8_VOFF
}

struct EpiRowScaleBf16 {
    bf16* O; int ldc; const float* rs;
    __device__ __forceinline__ void operator()(const f32x4 (&acc)[2][2][4][2], const Unit& u, int wr, int wc, int fr, int fq) const {
        const int row0 = u.pm * BM + wr * 64 + fr, col0 = u.pn * BM + wc * 32 + 8 * fq;
        float sc[2][4];
#pragma unroll
        for (int ai = 0; ai < 2; ++ai)
#pragma unroll
            for (int m = 0; m < 4; ++m) sc[ai][m] = rs[row0 + ai * HALF + m * 16];
#pragma unroll
        for (int ai = 0; ai < 2; ++ai)
#pragma unroll
            for (int m = 0; m < 4; ++m) { const int row = row0 + ai * HALF + m * 16; const float s = sc[ai][m]; bf16* rowp = O + (size_t)row * ldc + col0;
#pragma unroll
                for (int bj = 0; bj < 2; ++bj) { const f32x4 v0 = acc[ai][bj][m][0] * s, v1 = acc[ai][bj][m][1] * s;
                    v4u w; w.x = cvt_pk_bf16(v0[0], v0[1]); w.y = cvt_pk_bf16(v0[2], v0[3]); w.z = cvt_pk_bf16(v1[0], v1[1]); w.w = cvt_pk_bf16(v1[2], v1[3]);
                    *(v4u*)(rowp + bj * HALF) = w; } }
    }
};
struct EpiPlainBf16 {
    bf16* O; int ldc;
    __device__ __forceinline__ void operator()(const f32x4 (&acc)[2][2][4][2], const Unit& u, int wr, int wc, int fr, int fq) const {
        const int row0 = u.pm * BM + wr * 64 + fr, col0 = u.pn * BM + wc * 32 + 8 * fq;
#pragma unroll
        for (int ai = 0; ai < 2; ++ai)
#pragma unroll
            for (int m = 0; m < 4; ++m) { const int row = row0 + ai * HALF + m * 16; bf16* rowp = O + (size_t)row * ldc + col0;
#pragma unroll
                for (int bj = 0; bj < 2; ++bj) { const f32x4 v0 = acc[ai][bj][m][0], v1 = acc[ai][bj][m][1];
                    v4u w; w.x = cvt_pk_bf16(v0[0], v0[1]); w.y = cvt_pk_bf16(v0[2], v0[3]); w.z = cvt_pk_bf16(v1[0], v1[1]); w.w = cvt_pk_bf16(v1[2], v1[3]);
                    *(v4u*)(rowp + bj * HALF) = w; } }
    }
};
struct EpiGateBf16 {
    bf16* O; int ldc; const float* rs; const float* bias; float osc;
    __device__ __forceinline__ void operator()(const f32x4 (&acc)[2][2][4][2], const Unit& u, int wr, int wc, int fr, int fq) const {
        const int row0 = u.pm * BM + wr * 64 + fr, col0 = u.pn * BM + wc * 32 + 8 * fq;
        float sc[2][4]; f32x4 bv[2][2];
#pragma unroll
        for (int ai = 0; ai < 2; ++ai)
#pragma unroll
            for (int m = 0; m < 4; ++m) sc[ai][m] = rs[row0 + ai * HALF + m * 16] * osc;
#pragma unroll
        for (int bj = 0; bj < 2; ++bj)
#pragma unroll
            for (int n = 0; n < 2; ++n) bv[bj][n] = *(const f32x4*)(bias + col0 + bj * HALF + 4 * n);
#pragma unroll
        for (int ai = 0; ai < 2; ++ai)
#pragma unroll
            for (int m = 0; m < 4; ++m) { const int row = row0 + ai * HALF + m * 16; const float s = sc[ai][m]; bf16* rowp = O + (size_t)row * ldc + col0;
#pragma unroll
                for (int bj = 0; bj < 2; ++bj) { f32x4 v0 = acc[ai][bj][m][0] * s + bv[bj][0], v1 = acc[ai][bj][m][1] * s + bv[bj][1];
#pragma unroll
                    for (int q = 0; q < 4; ++q) { v0[q] = fast_sigmoid(v0[q]); v1[q] = fast_sigmoid(v1[q]); }
                    v4u w; w.x = cvt_pk_bf16(v0[0], v0[1]); w.y = cvt_pk_bf16(v0[2], v0[3]); w.z = cvt_pk_bf16(v1[0], v1[1]); w.w = cvt_pk_bf16(v1[2], v1[3]);
                    *(v4u*)(rowp + bj * HALF) = w; } }
    }
};
}

struct Args { const float* in[25]; float* out; unsigned char* ws; int ph_lo, ph_hi; };

struct Frame {
    LAS unsigned char* lds; volatile LAS unsigned* MISC; gu32* ctl; int tid, lane, wave, vcu, G;
};
__device__ __forceinline__ float wave_sum(float v) {
#pragma unroll
    for (int o = 1; o < 64; o <<= 1) v += __shfl_xor(v, o);
    return v;
}
template <int RM, bool HAS_CS>
__device__ __forceinline__ void p0_transpose_item(const float* __restrict__ W, int K, int N, bf16* __restrict__ WT, int row_off, const float* __restrict__ cs, LAS float* scr, int item, int lane) {
    const int nblk = N / 32, kb = item / nblk, nb = item % nblk, k0 = 64 * kb, n0 = 32 * nb;
    const int c = lane & 7;
    f32x4 s0 = {1.f, 1.f, 1.f, 1.f}, s1 = {1.f, 1.f, 1.f, 1.f};
    if (HAS_CS) { s0 = *(const f32x4*)(cs + k0 + 8 * c); s1 = *(const f32x4*)(cs + k0 + 8 * c + 4); }
#pragma unroll 8
    for (int i = 0; i < 32; ++i) { const int kk = 2 * i + (lane >> 5); scr[kk * 33 + (lane & 31)] = W[(size_t)(k0 + kk) * N + n0 + (lane & 31)]; }
    LDS_WAIT(); asm volatile("" ::: "memory");
#pragma unroll
    for (int j = 0; j < 4; ++j) { const int n = (lane >> 3) + 8 * j; const LAS float* s = scr + (8 * c) * 33 + n;
        v4u o; o.x = pk2(s[0 * 33] * s0.x, s[1 * 33] * s0.y); o.y = pk2(s[2 * 33] * s0.z, s[3 * 33] * s0.w); o.z = pk2(s[4 * 33] * s1.x, s[5 * 33] * s1.y); o.w = pk2(s[6 * 33] * s1.z, s[7 * 33] * s1.w);
        const int nn = n0 + n; const int orow = RM == 0 ? row_off + nn : (row_off + 8 * (nn >> 2) + (nn & 3) + (RM == 2 ? 4 : 0));
        *(GAS v4u*)(WT + (size_t)orow * K + k0 + 8 * c) = o; }
    LDS_WAIT(); asm volatile("" ::: "memory");
}

__device__ __forceinline__ unsigned pk4_fp8(float v0, float v1, float v2, float v3) {
    v0 = __builtin_amdgcn_fmed3f(v0, -448.f, 448.f); v1 = __builtin_amdgcn_fmed3f(v1, -448.f, 448.f); v2 = __builtin_amdgcn_fmed3f(v2, -448.f, 448.f); v3 = __builtin_amdgcn_fmed3f(v3, -448.f, 448.f);
    int w = 0; w = __builtin_amdgcn_cvt_pk_fp8_f32(v0, v1, w, false); w = __builtin_amdgcn_cvt_pk_fp8_f32(v2, v3, w, true); return (unsigned)w;
}
template <int RM, bool HAS_CS>
__device__ __forceinline__ void p0_transpose_item_f8(const float* __restrict__ W, int K, int N, unsigned char* __restrict__ WT, const float* __restrict__ cs, float scale, LAS float* scr, int item, int lane) {
    const int nblk = N / 32, kb = item / nblk, nb = item % nblk, k0 = 64 * kb, n0 = 32 * nb;
    const int n = lane & 31, kq = lane >> 5;
#pragma unroll 8
    for (int i = 0; i < 32; ++i) { const int kk = 2 * i + (lane >> 5); scr[kk * 33 + (lane & 31)] = W[(size_t)(k0 + kk) * N + n0 + (lane & 31)]; }
    LDS_WAIT(); asm volatile("" ::: "memory");
    const int nn = n0 + n; const int orow = RM == 0 ? nn : (8 * (nn >> 2) + (nn & 3) + (RM == 2 ? 4 : 0));
    unsigned char* dst = WT + (size_t)orow * K + k0 + 32 * kq;
    f32x4 csv[8];
#pragma unroll
    for (int i = 0; i < 8; ++i) csv[i] = HAS_CS ? *(const f32x4*)(cs + k0 + 32 * kq + 4 * i) * scale : (f32x4){scale, scale, scale, scale};
#pragma unroll
    for (int h = 0; h < 2; ++h) { v4u o;
#pragma unroll
        for (int q = 0; q < 4; ++q) { const int kk = 32 * kq + 16 * h + 4 * q; const f32x4 sc = csv[4 * h + q];
            o[q] = pk4_fp8(scr[kk * 33 + n] * sc[0], scr[(kk + 1) * 33 + n] * sc[1], scr[(kk + 2) * 33 + n] * sc[2], scr[(kk + 3) * 33 + n] * sc[3]); }
        *(GAS v4u*)(dst + 16 * h) = o; }
    LDS_WAIT(); asm volatile("" ::: "memory");
}
struct Ptrs {
    const float *x, *p, *g_mix, *w_in, *conv_w, *conv_b, *wa, *ba, *wx, *bx, *lam, *w_out, *g_ffn, *w_rg, *b_rg, *w_re, *b_re, *w1, *w3, *w2, *g_ple, *w_pg, *b_pg, *w_pp, *g_final;
    float* out; unsigned char* ws;
    float *rstd0, *rstd1, *rstd2; int* eid; float* ew; int* list; int* counts; int* goffs;
    bf16 *W_IN, *W_OUT, *W_PG, *W_PP, *WRT, *LRUW, *W13, *W2, *PB, *XB, *MIX, *ACT, *GATE, *PROJ, *D1, *X1B, *X2B, *Y, *PP;
};
__device__ __forceinline__ void make_ptrs(Ptrs& P, const Args& a) {
    P.x = a.in[0]; P.p = a.in[1]; P.g_mix = a.in[2]; P.w_in = a.in[3]; P.conv_w = a.in[4]; P.conv_b = a.in[5]; P.wa = a.in[6]; P.ba = a.in[7]; P.wx = a.in[8]; P.bx = a.in[9]; P.lam = a.in[10];
    P.w_out = a.in[11]; P.g_ffn = a.in[12]; P.w_rg = a.in[13]; P.b_rg = a.in[14]; P.w_re = a.in[15]; P.b_re = a.in[16]; P.w1 = a.in[17]; P.w3 = a.in[18]; P.w2 = a.in[19];
    P.g_ple = a.in[20]; P.w_pg = a.in[21]; P.b_pg = a.in[22]; P.w_pp = a.in[23]; P.g_final = a.in[24];
    P.out = a.out; P.ws = a.ws; unsigned char* ws = a.ws;
    P.rstd0 = (float*)(ws + WS_RSTD0); P.rstd1 = (float*)(ws + WS_RSTD1); P.rstd2 = (float*)(ws + WS_RSTD2);
    P.eid = (int*)(ws + WS_EID); P.ew = (float*)(ws + WS_EW); P.list = (int*)(ws + WS_LIST); P.counts = (int*)(ws + WS_CNT); P.goffs = P.counts + 256 * NE;
    P.W_IN = (bf16*)(ws + WS_WIN); P.W_OUT = (bf16*)(ws + WS_WOUT); P.W_PG = (bf16*)(ws + WS_WPG); P.W_PP = (bf16*)(ws + WS_WPP); P.WRT = (bf16*)(ws + WS_WRT); P.LRUW = (bf16*)(ws + WS_LRUW);
    P.W13 = (bf16*)(ws + WS_W13); P.W2 = (bf16*)(ws + WS_W2); P.PB = (bf16*)(ws + WS_PB);
    P.XB = (bf16*)(ws + WS_R64); P.MIX = (bf16*)(ws + WS_R64); P.ACT = (bf16*)(ws + WS_R64); P.GATE = (bf16*)(ws + WS_R64);
    P.PROJ = (bf16*)(ws + WS_PROJ); P.D1 = (bf16*)(ws + WS_D1); P.PP = (bf16*)(ws + WS_PP); P.X1B = (bf16*)(ws + WS_X1B); P.X2B = (bf16*)(ws + WS_D1);     P.Y = (bf16*)(ws + WS_Y);
}

struct P0Item { const float* src; const float* cs; unsigned char* dst; int N, Kout, n0, rm, fmt; float scale; };
__device__ __forceinline__ bool p0_decode(const Ptrs& P, int it, P0Item& I) {
    constexpr int I_WIN = (D / 64) * (INC / 32), I_SQ = (D / 64) * (D / 32), I_PG = (D / 128) * (D / 32), I_WPP = (PLE / 64) * (D / 32), I_W1 = (D / 128) * (DE / 32), I_W2 = (DE / 128) * (D / 32);
    constexpr int NITEMS = I_WIN + I_SQ + I_PG + I_WPP + NE * (2 * I_W1 + I_W2);
    if (it >= NITEMS) return false;
    int r = it; const float* W; const float* cs; unsigned char* dst; int K, N, rm = 0, fmt = 0; float scale = 1.f;
    if (r < I_WIN) { W = P.w_in; K = D; N = INC; dst = (unsigned char*)P.W_IN; cs = P.g_mix; }
    else if ((r -= I_WIN) < I_SQ) { W = P.w_out; K = D; N = D; dst = (unsigned char*)P.W_OUT; cs = nullptr; }
    else if ((r -= I_SQ) < I_PG) { W = P.w_pg; K = D; N = D; dst = (unsigned char*)P.W_PG; cs = P.g_ple; fmt = 1; scale = PLE_SWG; }
    else if ((r -= I_PG) < I_WPP) { W = P.w_pp; K = PLE; N = D; dst = (unsigned char*)P.W_PP; cs = nullptr; }
    else { r -= I_WPP; const int per_e = 2 * I_W1 + I_W2, e = r / per_e; r -= e * per_e; fmt = 1;
        if (r < I_W1) { W = P.w1 + (size_t)e * D * DE; K = D; N = DE; dst = (unsigned char*)P.W13 + (size_t)e * D * D; cs = P.g_ffn; rm = 1; scale = MOE_SW1; }
        else if ((r -= I_W1) < I_W1) { W = P.w3 + (size_t)e * D * DE; K = D; N = DE; dst = (unsigned char*)P.W13 + (size_t)e * D * D; cs = P.g_ffn; rm = 2; scale = MOE_SW1; }
        else { r -= I_W1; W = P.w2 + (size_t)e * DE * D; K = DE; N = D; dst = (unsigned char*)P.W2 + (size_t)e * D * DE; cs = nullptr; scale = MOE_SW2; } }
    const int KI = fmt ? 128 : 64;
    const int nblk = N / 32, kb = r / nblk, nb = r % nblk, k0 = KI * kb, n0 = 32 * nb;
    I.src = W + (size_t)k0 * N + n0; I.cs = cs ? cs + k0 : nullptr; I.N = N; I.n0 = n0; I.rm = rm; I.fmt = fmt; I.scale = scale;
    I.Kout = fmt ? K : 2 * K; I.dst = dst + (fmt ? k0 : 2 * k0);
    return true;
}
__device__ __forceinline__ void p0_load(const P0Item& I, float (&v)[64], int lane) {
    const float* s = I.src + (size_t)(lane >> 5) * I.N + (lane & 31);
#pragma unroll
    for (int i = 0; i < 32; ++i) v[i] = s[(size_t)(2 * i) * I.N];
    if (I.fmt) {
#pragma unroll
        for (int i = 32; i < 64; ++i) v[i] = s[(size_t)(2 * i) * I.N];
    }
}
__device__ __forceinline__ int p0_orow(const P0Item& I, int n) { const int nn = I.n0 + n; return I.rm == 0 ? nn : (8 * (nn >> 2) + (nn & 3) + (I.rm == 2 ? 4 : 0)); }
__device__ __forceinline__ void p0_process(const P0Item& I, const float (&v)[64], LAS float* scr, int lane) {
    if (I.fmt == 0) {
#pragma unroll
        for (int i = 0; i < 32; ++i) scr[(2 * i + (lane >> 5)) * 33 + (lane & 31)] = v[i];
        LDS_WAIT(); asm volatile("" ::: "memory");
        const int c = lane & 7;
        f32x4 s0 = {1.f, 1.f, 1.f, 1.f}, s1 = {1.f, 1.f, 1.f, 1.f};
        if (I.cs) { s0 = *(const f32x4*)(I.cs + 8 * c); s1 = *(const f32x4*)(I.cs + 8 * c + 4); }
#pragma unroll
        for (int j = 0; j < 4; ++j) { const int n = (lane >> 3) + 8 * j; const LAS float* s = scr + (8 * c) * 33 + n;
            v4u o; o.x = cvt_pk_bf16(s[0 * 33] * s0.x, s[1 * 33] * s0.y); o.y = cvt_pk_bf16(s[2 * 33] * s0.z, s[3 * 33] * s0.w); o.z = cvt_pk_bf16(s[4 * 33] * s1.x, s[5 * 33] * s1.y); o.w = cvt_pk_bf16(s[6 * 33] * s1.z, s[7 * 33] * s1.w);
            *(GAS v4u*)(I.dst + (size_t)p0_orow(I, n) * I.Kout + 16 * c) = o; }
    } else {
#pragma unroll
        for (int i = 0; i < 64; ++i) { const int k = 2 * i + (lane >> 5); scr[k * 32 + (((lane & 31) + k) & 31)] = v[i]; }
        LDS_WAIT(); asm volatile("" ::: "memory");
        const int c = lane & 7;
        f32x4 sc[4];
#pragma unroll
        for (int q = 0; q < 4; ++q) sc[q] = I.cs ? *(const f32x4*)(I.cs + 16 * c + 4 * q) * I.scale : (f32x4){I.scale, I.scale, I.scale, I.scale};
#pragma unroll
        for (int j = 0; j < 4; ++j) { const int n = (lane >> 3) + 8 * j; v4u o;
#pragma unroll
            for (int q = 0; q < 4; ++q) { float t[4];
#pragma unroll
                for (int e = 0; e < 4; ++e) { const int k = 16 * c + 4 * q + e; t[e] = scr[k * 32 + ((n + k) & 31)] * sc[q][e]; }
                o[q] = pk4_fp8(t[0], t[1], t[2], t[3]); }
            *(GAS v4u*)(I.dst + (size_t)p0_orow(I, n) * I.Kout + 16 * c) = o; }
    }
    LDS_WAIT(); asm volatile("" ::: "memory");
}
__device__ __forceinline__ void p0_prologue(Frame& F, const Ptrs& P) {
    LAS float* scr = (LAS float*)(F.lds + RING_OFF + F.wave * 16384);
    const int gw = F.vcu * NWAVES + F.wave, NGW = F.G * NWAVES;
    {
#pragma unroll 1
        for (int it = gw; ; it += NGW) { P0Item A; float va[64];
            if (!p0_decode(P, it, A)) break;
            p0_load(A, va, F.lane); p0_process(A, va, scr, F.lane); }
    }
    for (int m = gw; m < T; m += 2 * NGW) {
        const int m1 = m + NGW; const bool two = m1 < T;
        const GAS f32x4* xr0 = (const GAS f32x4*)(P.x + (size_t)m * D) + F.lane; const GAS f32x4* xr1 = (const GAS f32x4*)(P.x + (size_t)(two ? m1 : m) * D) + F.lane;
        f32x4 v[4], u[4]; float s = 0.f, s1 = 0.f;
#pragma unroll
        for (int j = 0; j < 4; ++j) { v[j] = xr0[64 * j]; u[j] = xr1[64 * j]; }
#pragma unroll
        for (int j = 0; j < 4; ++j) { s += (v[j].x * v[j].x + v[j].y * v[j].y) + (v[j].z * v[j].z + v[j].w * v[j].w); s1 += (u[j].x * u[j].x + u[j].y * u[j].y) + (u[j].z * u[j].z + u[j].w * u[j].w); }
        s = wave_sum(s); s1 = wave_sum(s1);
        GAS v2u* o8 = (GAS v2u*)(P.XB + (size_t)m * D) + F.lane;
#pragma unroll
        for (int j = 0; j < 4; ++j) { v2u w; w.x = pk2(v[j].x, v[j].y); w.y = pk2(v[j].z, v[j].w); o8[64 * j] = w; }
        if (F.lane == 0) P.rstd0[m] = 1.0f / sqrtf(s * (1.f / D) + EPS);
        if (two) {
            GAS v2u* o9 = (GAS v2u*)(P.XB + (size_t)m1 * D) + F.lane;
#pragma unroll
            for (int j = 0; j < 4; ++j) { v2u w; w.x = pk2(u[j].x, u[j].y); w.y = pk2(u[j].z, u[j].w); o9[64 * j] = w; }
            if (F.lane == 0) P.rstd0[m1] = 1.0f / sqrtf(s1 * (1.f / D) + EPS);
        }
    }
    for (int m = gw; m < T; m += 4 * NGW) {
        f32x4 v[4];
#pragma unroll
        for (int j = 0; j < 4; ++j) { const int mj = m + j * NGW; v[j] = *((const GAS f32x4*)(P.p + (size_t)(mj < T ? mj : m) * PLE) + F.lane); }
#pragma unroll
        for (int j = 0; j < 4; ++j) { const int mj = m + j * NGW; if (mj < T) { v2u w; w.x = pk2(v[j].x, v[j].y); w.y = pk2(v[j].z, v[j].w); *((GAS v2u*)(P.PB + (size_t)mj * PLE) + F.lane) = w; } }
    }
    for (int idx = (F.vcu * NTHR + F.tid); idx < S * 64; idx += F.G * NTHR) {
        const int pos = idx >> 6, dd = idx & 63;
        const float inv = exp2f(-(float)dd * (13.287712379549449f / 64.f)); const float ang = (float)pos * inv;
        float rev = ang * 0.15915494309189535f; rev -= floorf(rev); const float sn = __builtin_amdgcn_sinf(rev), cs = __builtin_amdgcn_cosf(rev);
        ((unsigned*)(P.ws + WS_ROPE))[idx] = __builtin_bit_cast(unsigned, __builtin_amdgcn_cvt_pkrtz(cs, sn));
    }
    for (int idx = (F.vcu * NTHR + F.tid); idx < 80 * D; idx += F.G * NTHR) {
        const int n = idx / D, k = idx % D; float v = 0.f;
        if (n < NG) v = P.w_rg[(size_t)k * NG + n] * P.g_ffn[k]; else if (n < NG + NE) v = P.w_re[(size_t)k * NE + (n - NG)] * P.g_ffn[k];
        const bf16 hi = f2bf(v); const bf16 lo = f2bf(v - bf2f(hi));
        P.WRT[idx] = hi; P.WRT[80 * D + idx] = lo;
    }
    for (int idx = (F.vcu * NTHR + F.tid); idx < 2 * 8 * 64 * 64; idx += F.G * NTHR) {
        const int g = idx >> 15, r = idx & 32767, hb = r >> 12, j = (r >> 6) & 63, i = r & 63;
        const float* w = g ? P.wx : P.wa;
        P.LRUW[idx] = f2bf(w[(hb * 64 + i) * 64 + j]);
    }
}


__device__ __forceinline__ f32x4 bf4(v2u w) { return (f32x4){bflo(w.x), bfhi(w.x), bflo(w.y), bfhi(w.y)}; }
__device__ __forceinline__ void p10_combine(Frame& F, const Ptrs& P) {
    const int gw = F.vcu * NWAVES + F.wave, NGW = F.G * NWAVES;
    for (int m = gw; m < T; m += NGW) {
        const size_t ro = (size_t)m * D;
        GAS v2u* x1 = (GAS v2u*)(P.X2B + ro) + F.lane; const GAS v2u* y0 = (const GAS v2u*)(P.Y + ro) + F.lane; const GAS v2u* y1 = (const GAS v2u*)(P.Y + (size_t)T * D + ro) + F.lane;
        f32x4 v[4]; v2u a[4], b[4], c[4];
#pragma unroll
        for (int j = 0; j < 4; ++j) { a[j] = x1[64 * j]; b[j] = y0[64 * j]; c[j] = y1[64 * j]; }
        float s = 0.f;
#pragma unroll
        for (int j = 0; j < 4; ++j) { v[j] = bf4(a[j]) + (bf4(b[j]) + bf4(c[j])); s += (v[j].x * v[j].x + v[j].y * v[j].y) + (v[j].z * v[j].z + v[j].w * v[j].w); }
        s = wave_sum(s);
        GAS unsigned* o4 = (GAS unsigned*)((unsigned char*)P.X1B + ro) + F.lane;
#pragma unroll
        for (int j = 0; j < 4; ++j) { v2u w; w.x = pk2(v[j].x, v[j].y); w.y = pk2(v[j].z, v[j].w); x1[64 * j] = w;
            o4[64 * j] = pk4_fp8(v[j].x * PLE_SX2, v[j].y * PLE_SX2, v[j].z * PLE_SX2, v[j].w * PLE_SX2); }
        if (F.lane == 0) P.rstd2[m] = 1.0f / sqrtf(s * (1.f / D) + EPS);
    }
}
__device__ __forceinline__ void p13_final(Frame& F, const Ptrs& P) {
    const int gw = F.vcu * NWAVES + F.wave, NGW = F.G * NWAVES;
    f32x4 gf[4];
#pragma unroll
    for (int j = 0; j < 4; ++j) gf[j] = *((const GAS f32x4*)P.g_final + F.lane + 64 * j);
    for (int m = gw; m < T; m += NGW) {
        const size_t ro = (size_t)m * D;
        GAS f32x4* xr = (GAS f32x4*)(P.out + ro) + F.lane;
        const GAS v2u* xb = (const GAS v2u*)(P.X2B + ro) + F.lane; const GAS v2u* ga = (const GAS v2u*)(P.GATE + ro) + F.lane; const GAS v2u* pp = (const GAS v2u*)(P.PP + ro) + F.lane;
        f32x4 v[4]; v2u a[4], b[4], c[4];
#pragma unroll
        for (int j = 0; j < 4; ++j) { c[j] = xb[64 * j]; a[j] = ga[64 * j]; b[j] = pp[64 * j]; }
        float s = 0.f;
#pragma unroll
        for (int j = 0; j < 4; ++j) { v[j] = bf4(c[j]) + bf4(a[j]) * bf4(b[j]); s += (v[j].x * v[j].x + v[j].y * v[j].y) + (v[j].z * v[j].z + v[j].w * v[j].w); }
        s = wave_sum(s);
        const float r = 1.0f / sqrtf(s * (1.f / D) + EPS);
#pragma unroll
        for (int j = 0; j < 4; ++j) xr[64 * j] = v[j] * r * gf[j];
    }
}
__device__ __forceinline__ LAS int* sched_offs(Frame& F) { return (LAS int*)(F.lds + SCHED_OFF); }
__device__ __forceinline__ LAS int* sched_tileb(Frame& F) { return (LAS int*)(F.lds + SCHED_OFF) + 72; }
__device__ __forceinline__ LAS int* sched_pre(Frame& F) { return (LAS int*)(F.lds + SCHED_OFF) + 144; }
__device__ __forceinline__ LAS int* sched_ta(Frame& F) { return (LAS int*)(F.lds + SCHED_OFF) + 256; }
__device__ __forceinline__ LAS int* sched_tc(Frame& F) { return (LAS int*)(F.lds + SCHED_OFF) + 328; }
__device__ __forceinline__ void sched_build(Frame& F, const Ptrs& P) {
    LAS int* offs = sched_offs(F); LAS int* tb = sched_tileb(F); LAS int* pre = sched_pre(F);
    LAS int* part = (LAS int*)(F.lds + UTAB_OFF);
    {
        const int e = F.tid & 63, pt = F.tid >> 6; int t = 0, p = 0; int cv[32];
#pragma unroll
        for (int j = 0; j < 32; ++j) cv[j] = P.counts[(pt * 32 + j) * NE + e];
#pragma unroll
        for (int j = 0; j < 32; ++j) { t += cv[j]; p += (pt * 32 + j < F.vcu) ? cv[j] : 0; }
        part[(pt * 64 + e) * 2] = t; part[(pt * 64 + e) * 2 + 1] = p;
    }
    __syncthreads();
    if (F.tid < NE) { int t = 0, p = 0;
#pragma unroll
        for (int pt = 0; pt < 8; ++pt) { t += part[(pt * 64 + F.tid) * 2]; p += part[(pt * 64 + F.tid) * 2 + 1]; }
        pre[F.tid] = p; part[1024 + F.tid] = t; }
    __syncthreads();
    if (F.tid < NE) {
        LAS int* ta = sched_ta(F); LAS int* tc = sched_tc(F);
        const int t = part[1024 + F.tid], tl = t & 255;
        int v0 = t, v1 = t >> 8, v2 = tl > 128 ? 1 : 0, v3 = (tl > 0 && tl <= 128) ? 1 : 0;
        const int i0 = v0, i1 = v1, i2 = v2, i3 = v3;
#pragma unroll
        for (int o = 1; o < 64; o <<= 1) { const int a0 = __shfl_up(v0, o), a1 = __shfl_up(v1, o), a2 = __shfl_up(v2, o), a3 = __shfl_up(v3, o); if (F.lane >= o) { v0 += a0; v1 += a1; v2 += a2; v3 += a3; } }
        offs[F.tid] = v0 - i0; tb[F.tid] = v1 - i1; ta[F.tid] = v2 - i2; tc[F.tid] = v3 - i3;
        if (F.tid == NE - 1) { offs[NE] = v0; tb[NE] = v1; ta[NE] = v2; tc[NE] = v3; }
    }
    __syncthreads();
}

constexpr int P6_BROW = 272, P6_BHL = 80 * P6_BROW, P6_BBUF = 2 * P6_BHL, P6_LG_OFF = 90112;
static_assert(2 * P6_BBUF <= P6_LG_OFF && P6_LG_OFF + 8 * 16 * 80 * 4 <= RING_BYTES, "P6 LDS map");
__device__ __forceinline__ void p6_route(Frame& F, const Ptrs& P) {
    const int lane = F.lane, r = lane & 15, g = lane >> 4;
    const int tok = F.vcu * 128 + F.wave * 16 + r;
    LAS unsigned char* BS = F.lds + RING_OFF;
    LAS float* LG = (LAS float*)(F.lds + RING_OFF + P6_LG_OFF) + F.wave * (16 * 80);
    LAS float* SS = (LAS float*)(F.lds + UTAB_OFF) + F.wave * 16;
    LAS int* hist = (LAS int*)(F.lds + UTAB_OFF + 1024);
    if (F.tid < NE) hist[F.tid] = 0;
    f32x4 acc[5];
#pragma unroll
    for (int i = 0; i < 5; ++i) acc[i] = (f32x4){0.f, 0.f, 0.f, 0.f};
    float ssq = 0.f;
    const float* xrow = P.x + (size_t)tok * D + 8 * g; const bf16* drow = P.D1 + (size_t)tok * D + 8 * g; unsigned char* orow = (unsigned char*)P.X1B + (size_t)tok * D + 8 * g;
    unsigned bsrc[5], bdst[5];
#pragma unroll
    for (int i = 0; i < 5; ++i) { const int id = F.tid + 512 * i, hl = id / 1280, rem = id % 1280, row = rem >> 4, ch = rem & 15;
        bsrc[i] = (unsigned)((hl * 80 + row) * D + 8 * ch) * 2u; bdst[i] = (unsigned)(hl * P6_BHL + row * P6_BROW + ch * 16); }
    v4u breg[5]; f32x4 xa[4], xb[4]; v4u dd[4];
#pragma unroll
    for (int i = 0; i < 5; ++i) breg[i] = *(const v4u*)((const char*)P.WRT + bsrc[i]);
#pragma unroll
    for (int s = 0; s < 4; ++s) { xa[s] = *(const f32x4*)(xrow + 32 * s); xb[s] = *(const f32x4*)(xrow + 32 * s + 4); dd[s] = *(const v4u*)(drow + 32 * s); }
#pragma unroll 1
    for (int sl = 0; sl < 8; ++sl) {
        LAS unsigned char* bb = BS + (sl & 1) * P6_BBUF;
#pragma unroll
        for (int i = 0; i < 5; ++i) *(LAS v4u*)(bb + bdst[i]) = breg[i];
        __syncthreads();
        f32x4 cxa[4], cxb[4]; v4u cdd[4];
#pragma unroll
        for (int s = 0; s < 4; ++s) { cxa[s] = xa[s]; cxb[s] = xb[s]; cdd[s] = dd[s]; }
        if (sl < 7) {
#pragma unroll
            for (int i = 0; i < 5; ++i) breg[i] = *(const v4u*)((const char*)P.WRT + bsrc[i] + (sl + 1) * 256);
#pragma unroll
            for (int s = 0; s < 4; ++s) { xa[s] = *(const f32x4*)(xrow + 128 * (sl + 1) + 32 * s); xb[s] = *(const f32x4*)(xrow + 128 * (sl + 1) + 32 * s + 4); dd[s] = *(const v4u*)(drow + 128 * (sl + 1) + 32 * s); }
        }
#pragma unroll
        for (int s = 0; s < 4; ++s) {
            float v[8];
            v[0] = cxa[s][0] + bflo(cdd[s].x); v[1] = cxa[s][1] + bfhi(cdd[s].x); v[2] = cxa[s][2] + bflo(cdd[s].y); v[3] = cxa[s][3] + bfhi(cdd[s].y);
            v[4] = cxb[s][0] + bflo(cdd[s].z); v[5] = cxb[s][1] + bfhi(cdd[s].z); v[6] = cxb[s][2] + bflo(cdd[s].w); v[7] = cxb[s][3] + bfhi(cdd[s].w);
            v4u hw, lw;
#pragma unroll
            for (int q = 0; q < 4; ++q) {
                ssq += v[2 * q] * v[2 * q] + v[2 * q + 1] * v[2 * q + 1];
                const unsigned h = cvt_pk_bf16(v[2 * q], v[2 * q + 1]);
                const unsigned l = cvt_pk_bf16(v[2 * q] - bflo(h), v[2 * q + 1] - bfhi(h));
                hw[q] = h; lw[q] = l;
            }
            { v2u f8; f8.x = pk4_fp8(v[0] * MOE_SX, v[1] * MOE_SX, v[2] * MOE_SX, v[3] * MOE_SX); f8.y = pk4_fp8(v[4] * MOE_SX, v[5] * MOE_SX, v[6] * MOE_SX, v[7] * MOE_SX); *(v2u*)(orow + 128 * sl + 32 * s) = f8; }
            *(v4u*)(const_cast<bf16*>(drow) + 128 * sl + 32 * s) = hw;
            const bf16x8 ah = __builtin_bit_cast(bf16x8, hw), al = __builtin_bit_cast(bf16x8, lw);
#pragma unroll
            for (int nt = 0; nt < 5; ++nt) {
                const bf16x8 bh = *(const LAS bf16x8*)(bb + (16 * nt + r) * P6_BROW + (32 * s + 8 * g) * 2), bl = *(const LAS bf16x8*)(bb + P6_BHL + (16 * nt + r) * P6_BROW + (32 * s + 8 * g) * 2);
                acc[nt] = __builtin_amdgcn_mfma_f32_16x16x32_bf16(ah, bh, acc[nt], 0, 0, 0);
                acc[nt] = __builtin_amdgcn_mfma_f32_16x16x32_bf16(al, bh, acc[nt], 0, 0, 0);
                acc[nt] = __builtin_amdgcn_mfma_f32_16x16x32_bf16(ah, bl, acc[nt], 0, 0, 0);
            }
        }
    }
    ssq += __shfl_xor(ssq, 16); ssq += __shfl_xor(ssq, 32);
#pragma unroll
    for (int nt = 0; nt < 5; ++nt)
#pragma unroll
        for (int q = 0; q < 4; ++q) LG[(4 * g + q) * 80 + 16 * nt + r] = acc[nt][q];
    if (g == 0) SS[r] = ssq;
    __syncthreads();
    if (g == 0) {
        const float rs = 1.0f / sqrtf(SS[r] * (1.f / D) + EPS);
        const LAS float* L = LG + r * 80;
        float gl[8]; float mx = -3.0e38f; int gsel = 0;
#pragma unroll
        for (int i = 0; i < 8; ++i) { gl[i] = rs * L[i] + P.b_rg[i]; if (gl[i] > mx) { mx = gl[i]; gsel = i; } }
        float den = 0.f;
#pragma unroll
        for (int i = 0; i < 8; ++i) den += expf(gl[i] - mx);
        const float gw = 1.f / den;
        float v0 = -3.0e38f, v1 = -3.0e38f; int i0 = 0, i1 = 0;
        for (int i = 0; i < 8; ++i) {
            const float v = rs * L[8 + gsel * 8 + i] + P.b_re[gsel * 8 + i];
            if (v > v0) { v1 = v0; i1 = i0; v0 = v; i0 = i; } else if (v > v1) { v1 = v; i1 = i; }
        }
        const float e1 = expf(v1 - v0), w0 = 1.f / (1.f + e1), w1 = e1 / (1.f + e1);
        const int ea = gsel * 8 + i0, eb = gsel * 8 + i1;
        P.eid[tok * 2] = ea; P.eid[tok * 2 + 1] = eb; P.ew[tok * 2] = w0 * gw; P.ew[tok * 2 + 1] = w1 * gw; P.rstd1[tok] = rs;
        __hip_atomic_fetch_add(hist + ea, 1, __ATOMIC_RELAXED, __HIP_MEMORY_SCOPE_WORKGROUP); __hip_atomic_fetch_add(hist + eb, 1, __ATOMIC_RELAXED, __HIP_MEMORY_SCOPE_WORKGROUP);
    }
    __syncthreads();
    if (F.tid < NE) P.counts[F.vcu * NE + F.tid] = hist[F.tid];
}

__device__ __forceinline__ void p7_lists(Frame& F, const Ptrs& P) {
    sched_build(F, P);
    LAS int* offs = sched_offs(F); LAS int* pre = sched_pre(F);
    LAS int* lcnt = (LAS int*)(F.lds + RING_OFF);
    if (F.tid < NE) lcnt[F.tid] = 0;
    __syncthreads();
    if (F.tid < 256) { const int a = F.vcu * 256 + F.tid; const int e = P.eid[a];
        const int rank = __hip_atomic_fetch_add(lcnt + e, 1, __ATOMIC_RELAXED, __HIP_MEMORY_SCOPE_WORKGROUP);
        P.list[offs[e] + pre[e] + rank] = a; }
    if (blockIdx.x == 0 && F.tid <= NE) P.goffs[F.tid] = offs[F.tid];
    __syncthreads();
}

namespace pg8 {
template <int MODE>
struct MoeSched {
    const char* Ab; const char* Bb; int K, G, c; LAS int* offs; LAS int* tb; LAS int* ta; LAS int* tc; LAS int* tab;
    __device__ __forceinline__ bool next(int i, Unit& u) const {
        const int L = i * G + c; const int nF = __builtin_amdgcn_readfirstlane(tb[NE]), nA = __builtin_amdgcn_readfirstlane(ta[NE]), nC = __builtin_amdgcn_readfirstlane(tc[NE]);
        if (L >= 4 * (nF + nA + nC)) return false;
        int rt = L >> 2; const LAS int* pf = tb; int cls = 0;
        if (rt >= nF) { rt -= nF; pf = ta; cls = 1; if (rt >= nA) { rt -= nA; pf = tc; cls = 2; } }
        int e = 0;
        for (int k = 1; k < NE; ++k) e += (pf[k] <= rt) ? 1 : 0;
        e = __builtin_amdgcn_readfirstlane(e);
        const int o0 = __builtin_amdgcn_readfirstlane(offs[e]), cnt = __builtin_amdgcn_readfirstlane(offs[e + 1]) - o0;
        u.e = e; u.pm = cls == 0 ? rt - __builtin_amdgcn_readfirstlane(tb[e]) : (cnt >> 8); u.pn = L & 3; u.slot0 = o0 + 256 * u.pm;
        u.rows = cls == 0 ? 256 : (cnt & 255); u.ui = i; return true;
    }
    __device__ __forceinline__ const char* a_base(const Unit& u) const { return MODE == 0 ? Ab : Ab + (size_t)u.slot0 * (size_t)(K * 2); }
    __device__ __forceinline__ const char* b_base(const Unit& u) const { return Bb + ((size_t)u.e * D + (size_t)u.pn * BM) * (size_t)K * 2; }
    __device__ __forceinline__ unsigned a_rowoff(const Unit& u, int r) const { return MODE == 0 ? (unsigned)tab[u.ui * 256 + r] : (unsigned)r * (unsigned)(K * 2); }
};
struct EpiAct {
    unsigned char* ACT; const LAS float* tabf;
    __device__ __forceinline__ void operator()(const f32x4 (&acc)[2][2][4][2], const Unit& u, int wr, int wc, int fr, int fq) const {
#pragma unroll
        for (int ai = 0; ai < 2; ++ai)
#pragma unroll
            for (int m = 0; m < 4; ++m) { const int r = ai * HALF + wr * 64 + m * 16 + fr;
                if (r < u.rows) { const float s = tabf[u.ui * 256 + r] * (1.f / (MOE_SX * MOE_SW1)); unsigned char* rowp = ACT + (size_t)(u.slot0 + r) * DE + u.pn * 128 + wc * 16 + 4 * fq;
#pragma unroll
                    for (int bj = 0; bj < 2; ++bj) { const f32x4 h1 = acc[ai][bj][m][0] * s, h3 = acc[ai][bj][m][1] * s; f32x4 a;
#pragma unroll
                        for (int q = 0; q < 4; ++q) a[q] = h1[q] * fast_sigmoid(h1[q]) * h3[q] * MOE_SA;
                        *(unsigned*)(rowp + bj * 64) = pk4_fp8(a[0], a[1], a[2], a[3]); } } }
    }
};
struct EpiY {
    bf16* Y; const LAS int* tab; const LAS float* tabf;
    __device__ __forceinline__ void operator()(const f32x4 (&acc)[2][2][4][2], const Unit& u, int wr, int wc, int fr, int fq) const {
#pragma unroll
        for (int ai = 0; ai < 2; ++ai)
#pragma unroll
            for (int m = 0; m < 4; ++m) { const int r = ai * HALF + wr * 64 + m * 16 + fr; const int aid = tab[u.ui * 256 + r];
                if (aid >= 0) { const float s = tabf[u.ui * 256 + r] * (1.f / (MOE_SA * MOE_SW2)); bf16* rowp = Y + ((size_t)(aid & 1) * T + (size_t)(aid >> 1)) * D + u.pn * BM + wc * 32 + 8 * fq;
#pragma unroll
                    for (int bj = 0; bj < 2; ++bj) { const f32x4 v0 = acc[ai][bj][m][0] * s, v1 = acc[ai][bj][m][1] * s;
                        v4u w; w.x = cvt_pk_bf16(v0[0], v0[1]); w.y = cvt_pk_bf16(v0[2], v0[3]); w.z = cvt_pk_bf16(v1[0], v1[1]); w.w = cvt_pk_bf16(v1[2], v1[3]);
                        *(v4u*)(rowp + bj * HALF) = w; } } }
    }
};
}
template <int MODE>
__device__ __forceinline__ void moe_phase(Frame& F, const Ptrs& P, bool rebuild) {
    if (rebuild) sched_build(F, P);
    LAS int* tab = (LAS int*)(F.lds + UTAB_OFF); LAS float* tabf = (LAS float*)(F.lds + UTABF_OFF);
    LAS int* uinfo = (LAS int*)(F.lds + SCHED_OFF) + 208;
    pg8::MoeSched<MODE> S; S.Ab = MODE == 0 ? (const char*)P.X1B : (const char*)P.ACT; S.Bb = MODE == 0 ? (const char*)P.W13 : (const char*)P.W2; S.K = MODE == 0 ? D / 2 : DE / 2;   S.G = F.G; S.c = F.vcu;
    S.offs = sched_offs(F); S.tb = sched_tileb(F); S.ta = sched_ta(F); S.tc = sched_tc(F); S.tab = tab;
    if (F.tid < 64) {
#pragma unroll
        for (int i = 0; i < MAXU; ++i) { pg8::Unit u; const bool ok = S.next(i, u); if (F.tid == 0) { uinfo[2 * i] = ok ? u.slot0 : 0; uinfo[2 * i + 1] = ok ? u.rows : 0; } }
    }
    __syncthreads();
    {
        const int r = F.tid & 255, i0 = F.tid >> 8; int aid[3]; bool val[3], act[3];
#pragma unroll
        for (int it = 0; it < 3; ++it) { const int i = i0 + 2 * it; const int s0 = uinfo[2 * i], rows = uinfo[2 * i + 1]; act[it] = rows > 0; val[it] = r < rows; aid[it] = act[it] ? P.list[s0 + (val[it] ? r : 0)] : 0; }
        float fv[3];
#pragma unroll
        for (int it = 0; it < 3; ++it) fv[it] = act[it] ? (MODE == 0 ? P.rstd1[aid[it] >> 1] : P.ew[aid[it]]) : 0.f;
#pragma unroll
        for (int it = 0; it < 3; ++it) if (act[it]) { const int i = i0 + 2 * it;
            if (MODE == 0) tab[i * 256 + r] = (aid[it] >> 1) * D; else tab[i * 256 + r] = val[it] ? aid[it] : -1;
            tabf[i * 256 + r] = fv[it]; }
    }
    __syncthreads();
    if constexpr (MODE == 0) { pg8::EpiAct E{(unsigned char*)P.ACT, tabf}; pg8::gemm_phase<pg8::EpiAct, pg8::MoeSched<0>, true>(F.lds + RING_OFF, S, E); }
    else { pg8::EpiY E{P.Y, tab, tabf}; pg8::gemm_phase<pg8::EpiY, pg8::MoeSched<1>, true>(F.lds + RING_OFF, S, E); }
}
typedef short v4i16 __attribute__((ext_vector_type(4)));
__device__ __forceinline__ unsigned off_b(unsigned row, unsigned ch) { return 256u * row + 16u * (ch ^ (((row & 3u) << 2) | ((row >> 2) & 3u))); }
__device__ __forceinline__ unsigned row_read_addr_16(unsigned lane, unsigned rb, unsigned s) { return off_b((lane & 15u) + 16u * rb, 4u * s + (lane >> 4)); }
__device__ __forceinline__ unsigned tr_read_addr_16(unsigned lane, unsigned c, unsigned ks, unsigned t) {
    const unsigned g = lane >> 4, q = (lane & 15u) >> 2, p = lane & 3u;
    return off_b(32u * ks + 8u * g + 4u * t + q, 2u * c + (p >> 1)) + 8u * (p & 1u);
}
__device__ __forceinline__ bf16x8 tr_frag2(LAS unsigned char* p0, LAS unsigned char* p1) {
    const v4i16 a = __builtin_amdgcn_ds_read_tr16_b64_v4i16((LAS v4i16*)p0);
    const v4i16 b = __builtin_amdgcn_ds_read_tr16_b64_v4i16((LAS v4i16*)p1);
    return (bf16x8){a[0], a[1], a[2], a[3], b[0], b[1], b[2], b[3]};
}
__device__ __forceinline__ void wave_lds_fence() { asm volatile("s_waitcnt lgkmcnt(0)" ::: "memory"); __builtin_amdgcn_wave_barrier(); asm volatile("" ::: "memory"); }
__device__ __forceinline__ float gelu_tanh_fast(float x) {
    const float u = 0.7978845608028654f * (x + 0.044715f * x * x * x);
    return x * fast_sigmoid(2.f * u);
}
constexpr float LOG2_ROPE_OVER_64 = 13.287712379549449f / 64.f;
constexpr int MIX_K_OFF = 0, MIX_V_OFF = 32768, MIX_S_OFF = 65536, MIX_S_STRIDE = 272, MIX_S_WAVE = 16 * MIX_S_STRIDE;
constexpr int MIX_CW_OFF = 0, MIX_XC_OFF = 12288, MIX_XC_WAVE = 16 * 68 * 4;
constexpr int MIX_LU_STRIDE = 48, MIX_LU_ARR = 64 * MIX_LU_STRIDE, MIX_LU_WAVE = 2 * MIX_LU_ARR;
constexpr int MIX_HS_OFF = 49152, MIX_HS_STRIDE = 144, MIX_HS_WAVE = 16 * MIX_HS_STRIDE;
static_assert(MIX_S_OFF + 8 * MIX_S_WAVE <= RING_BYTES && MIX_XC_OFF + 8 * MIX_XC_WAVE <= MIX_HS_OFF && MIX_HS_OFF + 8 * MIX_HS_WAVE <= RING_BYTES && MIX_HS_OFF + 8 * MIX_LU_WAVE <= RING_BYTES, "mixing LDS map");

__device__ __forceinline__ void sincos_rev(float ang, float& sn, float& cs) {
    float rev = ang * 0.15915494309189535f; rev -= floorf(rev);
    sn = __builtin_amdgcn_sinf(rev); cs = __builtin_amdgcn_cosf(rev);
}
struct KVRaw { v4u k[2][2]; v4u v[4]; };
__device__ __forceinline__ void kv_issue(KVRaw& R, int tid, const bf16* proj_t0, int h) {
    const int dg = tid & 7;
#pragma unroll
    for (int it = 0; it < 2; ++it) { const int c = (tid >> 3) + 64 * it; const bf16* row = proj_t0 + (size_t)c * INC + 1536 + h * HD + 8 * dg; R.k[it][0] = *(const v4u*)row; R.k[it][1] = *(const v4u*)(row + 64); }
#pragma unroll
    for (int it = 0; it < 4; ++it) { const int id = tid + 512 * it, c = id >> 4, ch = id & 15; R.v[it] = *(const v4u*)(proj_t0 + (size_t)c * INC + 2048 + h * HD + 8 * ch); }
}
typedef _Float16 f16x2 __attribute__((ext_vector_type(2)));
__device__ __forceinline__ void unpk_cs(unsigned w, float& cs, float& sn) { const f16x2 h = __builtin_bit_cast(f16x2, w); cs = (float)h[0]; sn = (float)h[1]; }
struct KRope { v4u cs[2][2]; };
__device__ __forceinline__ void krope_load(KRope& R, const Ptrs& P, int tid, int s0) {
    const int dg = tid & 7;
#pragma unroll
    for (int it = 0; it < 2; ++it) { const int c = (tid >> 3) + 64 * it; const v4u* t = (const v4u*)(P.ws + WS_ROPE) + ((size_t)(s0 + c) * 64 + 8 * dg) / 4;
        R.cs[it][0] = t[0]; R.cs[it][1] = t[1]; }
}
template <bool DECAY>
__device__ __forceinline__ void kv_store(Frame& F, const KVRaw& R, const KRope& C, int tid, float lg2) {
    LAS unsigned char* Kimg = F.lds + MIX_K_OFF; LAS unsigned char* Vimg = F.lds + MIX_V_OFF;
    const int dg = tid & 7;
#pragma unroll
    for (int it = 0; it < 2; ++it) {
        const int c = (tid >> 3) + 64 * it;
        const v4u k1 = R.k[it][0], k2 = R.k[it][1];
        const float sc = 0.08838834764831845f * (DECAY ? __builtin_amdgcn_exp2f((float)(127 - c) * lg2) : 1.f);
        v4u o1, o2;
#pragma unroll
        for (int q = 0; q < 4; ++q) {
            float cs0, sn0, cs1, sn1; unpk_cs(C.cs[it][q >> 1][2 * (q & 1)], cs0, sn0); unpk_cs(C.cs[it][q >> 1][2 * (q & 1) + 1], cs1, sn1); cs0 *= sc; sn0 *= sc; cs1 *= sc; sn1 *= sc;
            const float a0 = bflo(k1[q]), a1 = bfhi(k1[q]), b0 = bflo(k2[q]), b1 = bfhi(k2[q]);
            o1[q] = cvt_pk_bf16(a0 * cs0 - b0 * sn0, a1 * cs1 - b1 * sn1);
            o2[q] = cvt_pk_bf16(a0 * sn0 + b0 * cs0, a1 * sn1 + b1 * cs1);
        }
        *(LAS v4u*)(Kimg + off_b(c, dg)) = o1; *(LAS v4u*)(Kimg + off_b(c, dg + 8)) = o2;
    }
#pragma unroll
    for (int it = 0; it < 4; ++it) { const int id = tid + 512 * it, c = id >> 4, ch = id & 15; *(LAS v4u*)(Vimg + off_b(c, ch)) = R.v[it]; }
}

template <bool FINAL>
__device__ __forceinline__ void lru_chunk(Frame& F, const Ptrs& P, int b, int n, int lane) {
    const int r = lane & 15, g = lane >> 4, hb = F.wave;
    const int t0 = b * S + n * CH;
    LAS float* CW = (LAS float*)(F.lds + MIX_CW_OFF);
    LAS float* XC = (LAS float*)(F.lds + MIX_XC_OFF + F.wave * MIX_XC_WAVE);
    LAS unsigned char* HS = F.lds + MIX_HS_OFF + F.wave * MIX_HS_WAVE;
    LAS unsigned char* LU = F.lds + MIX_HS_OFF + F.wave * MIX_LU_WAVE;
    for (int i = F.tid; i < 5 * DL; i += NTHR) CW[i] = i < 4 * DL ? P.conv_w[i] : P.conv_b[i - 4 * DL];
    __syncthreads();
    bf16x8 Wa[4][2], Wx[4][2];
#pragma unroll
    for (int jt = 0; jt < 4; ++jt)
#pragma unroll
        for (int ks = 0; ks < 2; ++ks) {
            Wa[jt][ks] = *(const bf16x8*)(P.LRUW + ((size_t)(0 * 8 + hb) * 64 + 16 * jt + r) * 64 + 32 * ks + 8 * g);
            Wx[jt][ks] = *(const bf16x8*)(P.LRUW + ((size_t)(1 * 8 + hb) * 64 + 16 * jt + r) * 64 + 32 * ks + 8 * g);
        }
    float ba[4], bx[4], sp8[4], St[4], At[4];
#pragma unroll
    for (int jt = 0; jt < 4; ++jt) { const int ch = hb * 64 + 16 * jt + r; ba[jt] = P.ba[ch]; bx[jt] = P.bx[ch];
        const float nl = -P.lam[ch]; sp8[jt] = 8.f * (nl > 20.f ? nl : log1pf(expf(nl)));
        St[jt] = FINAL ? ((const float*)(P.ws + WS_LRU))[2 * B * NCH * DL + (b * NCH + n) * DL + ch] : 0.f; At[jt] = 1.f; }
    v4u xin[2][4], glv[2];
#define LRU_TILE_LOADS(tt_) do { const int c_ = 16 * (tt_) + r; \
        _Pragma("unroll") for (int ks = 0; ks < 2; ++ks) _Pragma("unroll") for (int k = 0; k < 4; ++k) { xin[ks][k] = (v4u){0u, 0u, 0u, 0u}; \
            if (n * CH + c_ - 3 + k >= 0) xin[ks][k] = *(const v4u*)(P.PROJ + (size_t)(t0 + c_ - 3 + k) * INC + hb * 64 + 32 * ks + 8 * g); } \
        if (FINAL) { _Pragma("unroll") for (int i = 0; i < 2; ++i) glv[i] = *(const v4u*)(P.PROJ + (size_t)(t0 + 16 * (tt_) + (lane >> 3) + 8 * i) * INC + DL + hb * 64 + 8 * (lane & 7)); } } while (0)
    LRU_TILE_LOADS(0);
#pragma unroll 1
    for (int tt = 0; tt < 8; ++tt) {
        v4u xcur[2][4], gcur[2];
#pragma unroll
        for (int ks = 0; ks < 2; ++ks)
#pragma unroll
            for (int k = 0; k < 4; ++k) xcur[ks][k] = xin[ks][k];
        gcur[0] = glv[0]; gcur[1] = glv[1];
        if (tt < 7) LRU_TILE_LOADS(tt + 1);
        bf16x8 fr[2];
#pragma unroll
        for (int ks = 0; ks < 2; ++ks) {
            const int chA = hb * 64 + 32 * ks + 8 * g;
            float xc[8];
            { const f32x4 b0 = *(const LAS f32x4*)(CW + 4 * DL + chA), b1 = *(const LAS f32x4*)(CW + 4 * DL + chA + 4);
              xc[0] = b0[0]; xc[1] = b0[1]; xc[2] = b0[2]; xc[3] = b0[3]; xc[4] = b1[0]; xc[5] = b1[1]; xc[6] = b1[2]; xc[7] = b1[3]; }
#pragma unroll
            for (int k = 0; k < 4; ++k) {
                const v4u xv = xcur[ks][k];
                const f32x4 w0 = *(const LAS f32x4*)(CW + k * DL + chA), w1 = *(const LAS f32x4*)(CW + k * DL + chA + 4);
                xc[0] += w0[0] * bflo(xv.x); xc[1] += w0[1] * bfhi(xv.x); xc[2] += w0[2] * bflo(xv.y); xc[3] += w0[3] * bfhi(xv.y);
                xc[4] += w1[0] * bflo(xv.z); xc[5] += w1[1] * bfhi(xv.z); xc[6] += w1[2] * bflo(xv.w); xc[7] += w1[3] * bfhi(xv.w);
            }
            v4u pk; pk.x = cvt_pk_bf16(xc[0], xc[1]); pk.y = cvt_pk_bf16(xc[2], xc[3]); pk.z = cvt_pk_bf16(xc[4], xc[5]); pk.w = cvt_pk_bf16(xc[6], xc[7]);
            fr[ks] = __builtin_bit_cast(bf16x8, pk);
            *(LAS f32x4*)(XC + r * 68 + 32 * ks + 8 * g) = (f32x4){xc[0], xc[1], xc[2], xc[3]};
            *(LAS f32x4*)(XC + r * 68 + 32 * ks + 8 * g + 4) = (f32x4){xc[4], xc[5], xc[6], xc[7]};
        }
        wave_lds_fence();
#pragma unroll
        for (int jt = 0; jt < 4; ++jt) {
            f32x4 aa = {0.f, 0.f, 0.f, 0.f}, ax = {0.f, 0.f, 0.f, 0.f};
#pragma unroll
            for (int ks = 0; ks < 2; ++ks) { aa = __builtin_amdgcn_mfma_f32_16x16x32_bf16(fr[ks], Wa[jt][ks], aa, 0, 0, 0); ax = __builtin_amdgcn_mfma_f32_16x16x32_bf16(fr[ks], Wx[jt][ks], ax, 0, 0, 0); }
            float av[4], uv[4]; float Al = 1.f, Hl = 0.f;
#pragma unroll
            for (int q = 0; q < 4; ++q) {
                const float xcv = XC[(4 * g + q) * 68 + 16 * jt + r];
                const float rg = fast_sigmoid(aa[q] + ba[jt]), ig = fast_sigmoid(ax[q] + bx[jt]);
                const float la = -rg * sp8[jt];
                const float a = __builtin_amdgcn_exp2f(la * 1.4426950408889634f);
                const float x2 = 2.f * la;
                const float em = x2 > -0.25f ? -x2 * (1.f + x2 * (0.5f + x2 * (0.16666667f + x2 * (0.041666668f + x2 * (0.0083333333f + x2 * 0.0013888889f))))) : 1.f - a * a;
                const float u = sqrtf(em) * (ig * xcv);
                av[q] = a; uv[q] = u; Hl = a * Hl + u; Al *= a;
                if (!FINAL) { *(LAS bf16*)(LU + (16 * jt + r) * MIX_LU_STRIDE + (4 * g + q) * 2) = (bf16)cvt_pk_bf16(la, 0.f); *(LAS bf16*)(LU + MIX_LU_ARR + (16 * jt + r) * MIX_LU_STRIDE + (4 * g + q) * 2) = (bf16)cvt_pk_bf16(u, 0.f); }
            }
            float Ap = 1.f, Hp = 0.f;
#pragma unroll
            for (int k = 3; k >= 1; --k) {
                const float Ao = __shfl(Al, lane - 16 * k), Ho = __shfl(Hl, lane - 16 * k);
                if (g >= k) { Hp = Ao * Hp + Ho; Ap *= Ao; }
            }
            float h = Ap * St[jt] + Hp;
            if (FINAL) {
#pragma unroll
                for (int q = 0; q < 4; ++q) {
                    h = av[q] * h + uv[q];
                    *(LAS bf16*)(HS + (4 * g + q) * MIX_HS_STRIDE + (16 * jt + r) * 2) = (bf16)cvt_pk_bf16(h, 0.f);
                }
            } else {
                h = Al * h + Hl;
            }
            const float Atile = __shfl(Ap * Al, (lane & 15) + 48);
            St[jt] = __shfl(h, (lane & 15) + 48);
            At[jt] *= Atile;
        }
        wave_lds_fence();
        if (!FINAL) {
            bf16* LAg = (bf16*)P.out + (size_t)16 * 1024 * 1024; bf16* Ug = (bf16*)P.out + (size_t)48 * 1024 * 1024;
#pragma unroll
            for (int oc = 0; oc < 2; ++oc) { const size_t o = ((((size_t)(b * NCH + n) * 8 + hb) * 16 + (2 * tt + oc)) * 64 + lane) * 8;
                *(v4u*)(LAg + o) = *(const LAS v4u*)(LU + lane * MIX_LU_STRIDE + oc * 16); *(v4u*)(Ug + o) = *(const LAS v4u*)(LU + MIX_LU_ARR + lane * MIX_LU_STRIDE + oc * 16); }
        }
        if (FINAL) {
#pragma unroll
            for (int i = 0; i < 2; ++i) { const int tk = (lane >> 3) + 8 * i, ch8 = lane & 7;
                const v4u hv = *(const LAS v4u*)(HS + tk * MIX_HS_STRIDE + ch8 * 16); v4u o;
#pragma unroll
                for (int q = 0; q < 4; ++q) o[q] = cvt_pk_bf16(bflo(hv[q]) * gelu_tanh_fast(bflo(gcur[i][q])), bfhi(hv[q]) * gelu_tanh_fast(bfhi(gcur[i][q])));
                *(v4u*)(P.MIX + (size_t)(t0 + 16 * tt + tk) * D + hb * 64 + 8 * ch8) = o; }
            wave_lds_fence();
        }
    }
#undef LRU_TILE_LOADS
    if (!FINAL && g == 0) {
#pragma unroll
        for (int jt = 0; jt < 4; ++jt) { const int ch = hb * 64 + 16 * jt + r; float* AE = (float*)(P.ws + WS_LRU);
            AE[(b * NCH + n) * DL + ch] = At[jt]; AE[B * NCH * DL + (b * NCH + n) * DL + ch] = St[jt]; }
    }
}

__device__ __forceinline__ void lru_apply(Frame& F, const Ptrs& P, int b, int n, int lane) {
    const int hb = F.wave; const int t0 = b * S + n * CH;
    LAS unsigned char* HS = F.lds + MIX_HS_OFF + F.wave * MIX_HS_WAVE;
    const bf16* LAg = (const bf16*)P.out + (size_t)16 * 1024 * 1024 + ((size_t)(b * NCH + n) * 8 + hb) * (16 * 64 * 8) + lane * 8;
    const bf16* Ug = (const bf16*)P.out + (size_t)48 * 1024 * 1024 + ((size_t)(b * NCH + n) * 8 + hb) * (16 * 64 * 8) + lane * 8;
    float h = ((const float*)(P.ws + WS_LRU))[2 * B * NCH * DL + (b * NCH + n) * DL + hb * 64 + lane];
    v4u la[2], uu[2], gl[2];
#define LRU_AP_LOADS(tt_) do { _Pragma("unroll") for (int oc = 0; oc < 2; ++oc) { la[oc] = *(const v4u*)(LAg + (size_t)(2 * (tt_) + oc) * 512); uu[oc] = *(const v4u*)(Ug + (size_t)(2 * (tt_) + oc) * 512); } \
        _Pragma("unroll") for (int i = 0; i < 2; ++i) gl[i] = *(const v4u*)(P.PROJ + (size_t)(t0 + 16 * (tt_) + (lane >> 3) + 8 * i) * INC + DL + hb * 64 + 8 * (lane & 7)); } while (0)
    LRU_AP_LOADS(0);
#pragma unroll 1
    for (int tt = 0; tt < 8; ++tt) {
        v4u cla[2], cu[2], cg[2];
#pragma unroll
        for (int i = 0; i < 2; ++i) { cla[i] = la[i]; cu[i] = uu[i]; cg[i] = gl[i]; }
        if (tt < 7) LRU_AP_LOADS(tt + 1);
#pragma unroll
        for (int oc = 0; oc < 2; ++oc)
#pragma unroll
            for (int q = 0; q < 4; ++q) {
                const float a0 = __builtin_amdgcn_exp2f(bflo(cla[oc][q]) * 1.4426950408889634f), a1 = __builtin_amdgcn_exp2f(bfhi(cla[oc][q]) * 1.4426950408889634f);
                h = a0 * h + bflo(cu[oc][q]); const float h0 = h; h = a1 * h + bfhi(cu[oc][q]);
                const unsigned pk = cvt_pk_bf16(h0, h);
                *(LAS bf16*)(HS + (8 * oc + 2 * q) * MIX_HS_STRIDE + lane * 2) = (bf16)(pk & 0xffffu); *(LAS bf16*)(HS + (8 * oc + 2 * q + 1) * MIX_HS_STRIDE + lane * 2) = (bf16)(pk >> 16);
            }
        wave_lds_fence();
#pragma unroll
        for (int i = 0; i < 2; ++i) { const int tk = (lane >> 3) + 8 * i, ch8 = lane & 7;
            const v4u hv = *(const LAS v4u*)(HS + tk * MIX_HS_STRIDE + ch8 * 16); v4u o;
#pragma unroll
            for (int q = 0; q < 4; ++q) o[q] = cvt_pk_bf16(bflo(hv[q]) * gelu_tanh_fast(bflo(cg[i][q])), bfhi(hv[q]) * gelu_tanh_fast(bfhi(cg[i][q])));
            *(v4u*)(P.MIX + (size_t)(t0 + 16 * tt + tk) * D + hb * 64 + 8 * ch8) = o; }
        wave_lds_fence();
    }
#undef LRU_AP_LOADS
}

__device__ __forceinline__ void p2_mix_summaries(Frame& F, const Ptrs& P) {
    const int w = F.wave;
#pragma unroll 1
    for (int u = F.vcu; u < B * NCH; u += F.G) {
        const int b = u / NCH, n = u % NCH; const int t0 = b * S + n * CH;
        __syncthreads();
        { int lane0 = F.lane; asm volatile("" : "+v"(lane0)); lru_chunk<false>(F, P, b, n, lane0); }
        KVRaw raw; KRope krope; { int tid0 = F.tid; asm volatile("" : "+v"(tid0)); kv_issue(raw, tid0, P.PROJ + (size_t)t0 * INC, 0); krope_load(krope, P, tid0, n * CH); }
#pragma unroll 1
        for (int h = 0; h < NH; ++h) {
            int lane = F.lane; asm volatile("" : "+v"(lane));
            int tidv = F.tid; asm volatile("" : "+v"(tidv));
            const int r = lane & 15, g = lane >> 4;
            unsigned trb[8][2];
#pragma unroll
            for (int c = 0; c < 8; ++c) { trb[c][0] = tr_read_addr_16(lane, c, 0, 0); trb[c][1] = tr_read_addr_16(lane, c, 0, 1); }
            const float lg2 = __builtin_amdgcn_logf(1.f - __builtin_amdgcn_exp2f(-5.f - (float)h));
            __syncthreads();
            kv_store<true>(F, raw, krope, tidv, lg2);
            if (h + 1 < NH) kv_issue(raw, tidv, P.PROJ + (size_t)t0 * INC, h + 1);
            __syncthreads();
            LAS unsigned char* Kimg = F.lds + MIX_K_OFF; LAS unsigned char* Vimg = F.lds + MIX_V_OFF;
            f32x4 acc[8];
#pragma unroll
            for (int dt = 0; dt < 8; ++dt) acc[dt] = (f32x4){0.f, 0.f, 0.f, 0.f};
            const unsigned ta0 = tr_read_addr_16(lane, w, 0, 0), ta1 = tr_read_addr_16(lane, w, 0, 1);
#pragma unroll 1
            for (int ks = 0; ks < 4; ++ks) {
                const bf16x8 Af = tr_frag2(Vimg + ta0 + 8192 * ks, Vimg + ta1 + 8192 * ks);
#pragma unroll
                for (int dt = 0; dt < 8; ++dt) { const bf16x8 Bf = tr_frag2(Kimg + trb[dt][0] + 8192 * ks, Kimg + trb[dt][1] + 8192 * ks); acc[dt] = __builtin_amdgcn_mfma_f32_16x16x32_bf16(Af, Bf, acc[dt], 0, 0, 0); }
            }
            bf16* KV = (bf16*)P.out + ((size_t)((b * NH + h) * NCH + n)) * (HD * HD);
            LAS unsigned char* Sst = F.lds + MIX_S_OFF + w * MIX_S_WAVE;
#pragma unroll
            for (int dt = 0; dt < 8; ++dt)
#pragma unroll
                for (int q = 0; q < 4; ++q) *(LAS bf16*)(Sst + (4 * g + q) * MIX_S_STRIDE + (16 * dt + r) * 2) = (bf16)cvt_pk_bf16(acc[dt][q], 0.f);
            wave_lds_fence();
#pragma unroll
            for (int i = 0; i < 4; ++i) { const int id = lane + 64 * i, row = id >> 4, ch = id & 15;
                *(v4u*)(KV + (size_t)(16 * w + row) * HD + 8 * ch) = *(const LAS v4u*)(Sst + row * MIX_S_STRIDE + ch * 16); }
            wave_lds_fence();
        }
    }
}
__device__ __forceinline__ void p3_scans(Frame& F, const Ptrs& P) {
    const int idx = F.vcu * NTHR + F.tid;
    for (int id = idx; id < B * NH * (HD * HD / 4); id += F.G * NTHR) {
        const int bh = id >> 12, el = (id & 4095) * 4, h = bh & 3;
        const float lg2 = __builtin_amdgcn_logf(1.f - __builtin_amdgcn_exp2f(-5.f - (float)h));
        const float dec = __builtin_amdgcn_exp2f(128.f * lg2);
        const bf16* KV = (const bf16*)P.out + (size_t)bh * NCH * (HD * HD) + el;
        bf16* PV = (bf16*)(P.out + (size_t)B * NH * NCH * (HD * HD)) + (size_t)bh * NCH * (HD * HD) + el;
        f32x4 st = {0.f, 0.f, 0.f, 0.f};
#pragma unroll 8
        for (int n = 0; n < NCH; ++n) {
            const f32x4 kv = bf4(*(const v2u*)(KV + (size_t)n * (HD * HD)));
            v2u w; w.x = cvt_pk_bf16(st[0], st[1]); w.y = cvt_pk_bf16(st[2], st[3]);
            *(v2u*)(PV + (size_t)n * (HD * HD)) = w;
            st = st * dec + kv;
        }
    }
    if (idx < B * DL) {
        const int b = idx / DL, ch = idx % DL; float* AE = (float*)(P.ws + WS_LRU);
        float carry = 0.f;
        for (int n = 0; n < NCH; ++n) {
            const float a = AE[(b * NCH + n) * DL + ch], e = AE[B * NCH * DL + (b * NCH + n) * DL + ch];
            AE[2 * B * NCH * DL + (b * NCH + n) * DL + ch] = carry;
            carry = a * carry + e;
        }
    }
}
__device__ __forceinline__ void p4_mix_outputs(Frame& F, const Ptrs& P) {
    const int w = F.wave;
#pragma unroll 1
    for (int u = F.vcu; u < B * NCH; u += F.G) {
        const int b = u / NCH, n = u % NCH; const int t0 = b * S + n * CH;
        __syncthreads();
        { int lane0 = F.lane; asm volatile("" : "+v"(lane0)); lru_apply(F, P, b, n, lane0); }
        KRope krope; v4u qcs[2][2];
        { int tid0 = F.tid, lane0 = F.lane; asm volatile("" : "+v"(tid0), "+v"(lane0)); krope_load(krope, P, tid0, n * CH);
          { const v4u* t = (const v4u*)(P.ws + WS_ROPE) + ((size_t)(n * CH + 16 * w + (lane0 & 15)) * 64 + 8 * (lane0 >> 4)) / 4;
#pragma unroll
            for (int ks = 0; ks < 2; ++ks) { qcs[ks][0] = t[8 * ks]; qcs[ks][1] = t[8 * ks + 1]; } }
        }
#pragma unroll 1
        for (int h = 0; h < NH; ++h) {
            int lane = F.lane; asm volatile("" : "+v"(lane));
            int tidv = F.tid; asm volatile("" : "+v"(tidv));
            const int r = lane & 15, g = lane >> 4;
            unsigned trb[8][2], rrb[4];
#pragma unroll
            for (int c = 0; c < 8; ++c) { trb[c][0] = tr_read_addr_16(lane, c, 0, 0); trb[c][1] = tr_read_addr_16(lane, c, 0, 1); }
#pragma unroll
            for (int ks = 0; ks < 4; ++ks) rrb[ks] = row_read_addr_16(lane, 0, ks);
            const float lg2 = __builtin_amdgcn_logf(1.f - __builtin_amdgcn_exp2f(-5.f - (float)h));
            KVRaw raw; kv_issue(raw, tidv, P.PROJ + (size_t)t0 * INC, h);
            __syncthreads();
            v4u qraw[2][2];
            { const bf16* qrow = P.PROJ + (size_t)(t0 + 16 * w + r) * INC + 1024 + h * HD + 8 * g;
#pragma unroll
              for (int ks = 0; ks < 2; ++ks) { qraw[ks][0] = *(const v4u*)(qrow + 32 * ks); qraw[ks][1] = *(const v4u*)(qrow + 32 * ks + 64); } }
            kv_store<false>(F, raw, krope, tidv, lg2);
            bf16x8 Qf[4];
            {
#pragma unroll
                for (int ks = 0; ks < 2; ++ks) {
                    const v4u q1 = qraw[ks][0], q2 = qraw[ks][1];
                    v4u o1, o2;
#pragma unroll
                    for (int q = 0; q < 4; ++q) {
                        float cs0, sn0, cs1, sn1; unpk_cs(qcs[ks][q >> 1][2 * (q & 1)], cs0, sn0); unpk_cs(qcs[ks][q >> 1][2 * (q & 1) + 1], cs1, sn1);
                        const float a0 = bflo(q1[q]), a1 = bfhi(q1[q]), b0 = bflo(q2[q]), b1 = bfhi(q2[q]);
                        o1[q] = cvt_pk_bf16(a0 * cs0 - b0 * sn0, a1 * cs1 - b1 * sn1);
                        o2[q] = cvt_pk_bf16(a0 * sn0 + b0 * cs0, a1 * sn1 + b1 * cs1);
                    }
                    Qf[ks] = __builtin_bit_cast(bf16x8, o1); Qf[ks + 2] = __builtin_bit_cast(bf16x8, o2);
                }
            }
            __syncthreads();
            LAS unsigned char* Kimg = F.lds + MIX_K_OFF; LAS unsigned char* Vimg = F.lds + MIX_V_OFF; LAS unsigned char* Sst = F.lds + MIX_S_OFF + w * MIX_S_WAVE;
            const bf16* PV = (const bf16*)(P.out + (size_t)B * NH * NCH * (HD * HD)) + ((size_t)((b * NH + h) * NCH + n)) * (HD * HD);
            v4u grv[4];
#pragma unroll
            for (int i = 0; i < 4; ++i) grv[i] = *(const v4u*)(P.PROJ + (size_t)(t0 + 16 * w + (lane >> 4) + 4 * i) * INC + 2560 + h * HD + 8 * (lane & 15));
            bf16x8 Pf[2][4];
#pragma unroll
            for (int et = 0; et < 2; ++et)
#pragma unroll
                for (int ks = 0; ks < 4; ++ks) Pf[et][ks] = *(const bf16x8*)(PV + (size_t)(16 * et + r) * HD + 32 * ks + 8 * g);
#pragma unroll 1
            for (int mt = 0; mt <= w; ++mt) {
                f32x4 sa = {0.f, 0.f, 0.f, 0.f};
#pragma unroll
                for (int ks = 0; ks < 4; ++ks) { const bf16x8 Kf = *(const LAS bf16x8*)(Kimg + rrb[ks] + 4096 * mt); sa = __builtin_amdgcn_mfma_f32_16x16x32_bf16(Qf[ks], Kf, sa, 0, 0, 0); }
#pragma unroll
                for (int q = 0; q < 4; ++q) {
                    const int dlt = (16 * w + 4 * g + q) - (16 * mt + r);
                    const float v = dlt >= 0 ? sa[q] * __builtin_amdgcn_exp2f((float)dlt * lg2) : 0.f;
                    *(LAS bf16*)(Sst + (4 * g + q) * MIX_S_STRIDE + (16 * mt + r) * 2) = (bf16)cvt_pk_bf16(v, 0.f);
                }
            }
            if ((w & 1) == 0) {
#pragma unroll
                for (int q = 0; q < 4; ++q) *(LAS bf16*)(Sst + (4 * g + q) * MIX_S_STRIDE + (16 * (w + 1) + r) * 2) = 0;
            }
            wave_lds_fence();
            f32x4 acc[8];
            float rsc[4];
#pragma unroll
            for (int q = 0; q < 4; ++q) rsc[q] = __builtin_amdgcn_exp2f((float)(16 * w + 4 * g + q + 1) * lg2);
#define MIX_CROSS_Q(qi, ACCUM) do { _Pragma("unroll") for (int et = 0; et < 2; ++et) { f32x4 a = {0.f, 0.f, 0.f, 0.f}; \
                _Pragma("unroll") for (int ks = 0; ks < 4; ++ks) a = __builtin_amdgcn_mfma_f32_16x16x32_bf16(Qf[ks], Pf[et][ks], a, 0, 0, 0); \
                _Pragma("unroll") for (int q = 0; q < 4; ++q) { if (ACCUM) acc[2 * (qi) + et][q] += a[q] * rsc[q]; else acc[2 * (qi) + et][q] = a[q] * rsc[q]; } } } while (0)
#define MIX_PF_LOAD(qi) do { _Pragma("unroll") for (int et = 0; et < 2; ++et) _Pragma("unroll") for (int ks = 0; ks < 4; ++ks) Pf[et][ks] = *(const bf16x8*)(PV + (size_t)(16 * (2 * (qi) + et) + r) * HD + 32 * ks + 8 * g); } while (0)
            MIX_CROSS_Q(0, false); MIX_PF_LOAD(1); MIX_CROSS_Q(1, false); MIX_PF_LOAD(2);
#pragma unroll
            for (int et = 4; et < 8; ++et) acc[et] = (f32x4){0.f, 0.f, 0.f, 0.f};
#pragma unroll 1
            for (int ks = 0; ks <= (w >> 1); ++ks) {
                const bf16x8 Sf = *(const LAS bf16x8*)(Sst + r * MIX_S_STRIDE + (32 * ks + 8 * g) * 2);
#pragma unroll
                for (int et = 0; et < 8; ++et) { const bf16x8 Vf = tr_frag2(Vimg + trb[et][0] + 8192 * ks, Vimg + trb[et][1] + 8192 * ks); acc[et] = __builtin_amdgcn_mfma_f32_16x16x32_bf16(Sf, Vf, acc[et], 0, 0, 0); }
            }
            MIX_CROSS_Q(2, true); MIX_PF_LOAD(3); MIX_CROSS_Q(3, true);
#undef MIX_CROSS_Q
#undef MIX_PF_LOAD
            float mu[4], rs[4];
#pragma unroll
            for (int q = 0; q < 4; ++q) {
                float s = 0.f;
#pragma unroll
                for (int et = 0; et < 8; ++et) s += acc[et][q];
                s += __shfl_xor(s, 1); s += __shfl_xor(s, 2); s += __shfl_xor(s, 4); s += __shfl_xor(s, 8);
                const float m = s * (1.f / 128.f); float v = 0.f;
#pragma unroll
                for (int et = 0; et < 8; ++et) { const float d = acc[et][q] - m; v += d * d; }
                v += __shfl_xor(v, 1); v += __shfl_xor(v, 2); v += __shfl_xor(v, 4); v += __shfl_xor(v, 8);
                mu[q] = m; rs[q] = 1.0f / sqrtf(v * (1.f / 128.f) + EPS);
            }
#pragma unroll
            for (int et = 0; et < 8; ++et)
#pragma unroll
                for (int q = 0; q < 4; ++q) *(LAS bf16*)(Sst + (4 * g + q) * MIX_S_STRIDE + (16 * et + r) * 2) = (bf16)cvt_pk_bf16((acc[et][q] - mu[q]) * rs[q], 0.f);
            wave_lds_fence();
#pragma unroll
            for (int i = 0; i < 4; ++i) { const int row = (lane >> 4) + 4 * i, ch = lane & 15;
                const v4u ov = *(const LAS v4u*)(Sst + row * MIX_S_STRIDE + ch * 16); v4u o;
#pragma unroll
                for (int q = 0; q < 4; ++q) { const float g0 = bflo(grv[i][q]), g1 = bfhi(grv[i][q]); o[q] = cvt_pk_bf16(g0 * fast_sigmoid(g0) * bflo(ov[q]), g1 * fast_sigmoid(g1) * bfhi(ov[q])); }
                *(v4u*)(P.MIX + (size_t)(t0 + 16 * w + row) * D + DL + h * HD + 8 * ch) = o; }
            wave_lds_fence();
        }
    }
}
__global__ void __launch_bounds__(NTHR, 2) mk_fwd(Args args) {
    extern __shared__ __attribute__((aligned(16))) unsigned char lds_raw[];
    Frame F;
    F.lds = (LAS unsigned char*)lds_raw;
    F.MISC = (volatile LAS unsigned*)(F.lds + LDSCTL_OFF);
    F.tid = threadIdx.x; F.lane = F.tid & 63; F.wave = __builtin_amdgcn_readfirstlane(F.tid >> 6);
    F.G = gridDim.x; { const int bx = blockIdx.x; F.vcu = (F.G % 8 == 0) ? (bx % 8) * (F.G / 8) + bx / 8 : bx; }
    F.ctl = (gu32*)(args.ws + WS_CTL);
    Ptrs P; make_ptrs(P, args);
    for (int u = F.tid; u < 256; u += NTHR) ((LAS unsigned*)(F.lds + LDSCTL_OFF))[u] = 0u;
    __syncthreads();
    XcdBarrier bar = xcd_barrier_post((unsigned*)(F.ctl + CW_BAR) + args.ph_hi * XCD_BAR_WORDS, F.MISC + 8);
    const int lo = args.ph_lo, hi = args.ph_hi;
#define IN(k) (lo <= (k) && (k) < hi)
#define SEAM(k) do { if (IN(k) && IN((k) + 1)) xcd_barrier(bar); } while (0)
    if (IN(0)) { p0_prologue(F, P); }
    SEAM(0);
    if (IN(1)) {
        pg8::PlainSched S; S.init(P.XB, P.W_IN, T, INC, D, F.G, (int)blockIdx.x);
        pg8::EpiRowScaleBf16 E{P.PROJ, INC, P.rstd0};
        pg8::gemm_phase(F.lds + RING_OFF, S, E);
    }
    SEAM(1);
    if (IN(2)) p2_mix_summaries(F, P);
    SEAM(2);
    if (IN(3)) p3_scans(F, P);
    SEAM(3);
    if (IN(4)) p4_mix_outputs(F, P);
    SEAM(4);
    if (IN(5)) {
        pg8::PlainSched S; S.init(P.MIX, P.W_OUT, T, D, D, F.G, (int)blockIdx.x);
        pg8::EpiPlainBf16 E{P.D1, D};
        pg8::gemm_phase(F.lds + RING_OFF, S, E);
    }
    SEAM(5);
    if (IN(6)) p6_route(F, P);
    SEAM(6);
    if (IN(7)) p7_lists(F, P);
    SEAM(7);
    if (IN(8)) moe_phase<0>(F, P, lo == 8);
    SEAM(8);
    if (IN(9)) moe_phase<1>(F, P, lo == 9);
    SEAM(9);
    if (IN(10)) p10_combine(F, P);
    SEAM(10);
    if (IN(11)) {
        pg8::PlainSched S; S.init((const bf16*)P.X1B, P.W_PG, T, D, D / 2, F.G, (int)blockIdx.x);
        pg8::EpiGateBf16 E{P.GATE, D, P.rstd2, P.b_pg, 1.f / (PLE_SX2 * PLE_SWG)};
        pg8::gemm_phase<pg8::EpiGateBf16, pg8::PlainSched, true>(F.lds + RING_OFF, S, E);
    }
    if (IN(12)) {
        pg8::PlainSched S; S.init(P.PB, P.W_PP, T, D, PLE, F.G, (int)blockIdx.x);
        pg8::EpiPlainBf16 E{P.PP, D};
        pg8::gemm_phase(F.lds + RING_OFF, S, E);
    }
    SEAM(12);
    if (IN(13)) p13_final(F, P);
#undef IN
#undef SEAM
}

static int mk_grid = 0;
static void mk_launch(void* const* d_in, void* d_out, void* d_ws, int lo, int hi, hipStream_t stream) {
    if (mk_grid == 0) {
        int dev = 0, cus = 0;
        if (hipGetDevice(&dev) != hipSuccess || hipDeviceGetAttribute(&cus, hipDeviceAttributeMultiprocessorCount, dev) != hipSuccess) { mk_grid = -1; return; }
        if (hipFuncSetAttribute((const void*)mk_fwd, hipFuncAttributeMaxDynamicSharedMemorySize, LDS_BYTES) != hipSuccess) { fprintf(stderr, "mk: hipFuncSetAttribute failed\n"); mk_grid = -1; return; }
        int per_cu = 0;
        if (hipOccupancyMaxActiveBlocksPerMultiprocessor(&per_cu, (const void*)mk_fwd, NTHR, LDS_BYTES) != hipSuccess || per_cu < 1) { fprintf(stderr, "mk: occupancy query says %d\n", per_cu); (void)hipGetLastError(); }
        mk_grid = cus;
    }
    if (mk_grid < 0) return;
    Args a; memset(&a, 0, sizeof a);
    for (int i = 0; i < 25; ++i) a.in[i] = (const float*)d_in[i];
    a.out = (float*)d_out; a.ws = (unsigned char*)d_ws; a.ph_lo = lo; a.ph_hi = hi;
    hipLaunchKernelGGL(mk_fwd, dim3(mk_grid), dim3(NTHR), LDS_BYTES, stream, a);
}
extern "C" void kernel_launch(void* const* d_in, const int* in_sizes, int n_in, void* d_out, int out_size, void* d_ws, size_t ws_size, hipStream_t stream) {
    if (n_in != 25 || ws_size < WS_END || out_size != T * D) { fprintf(stderr, "kernel_launch: n_in %d, workspace %zu (need %zu), out_size %d: nothing launched\n", n_in, ws_size, (size_t)WS_END, out_size); return; }
    (void)hipMemsetAsync((unsigned char*)d_ws + WS_CTL, 0, 1 * MiB, stream);
    mk_launch(d_in, d_out, d_ws, 0, 14, stream);
}
```

```cpp
#include <hip/hip_runtime.h>
#include <stdint.h>
#include <stdio.h>
#include <string.h>

typedef unsigned short bf16;
namespace cfg {
constexpr int D = 1024, B = 8, S = 4096, T = B * S, PLE = 256, DL = 512, DR = 512, NH = 4, HD = 128, INC = 3072;
constexpr int NE = 64, DE = 512, NG = 8, EPG = 8, CH = 128, NCH = S / CH;
constexpr float EPS = 1e-6f;
constexpr float MOE_SX = 8.f, MOE_SW1 = 64.f, MOE_SA = 8.f, MOE_SW2 = 32.f;
constexpr float PLE_SX2 = 8.f, PLE_SWG = 64.f;
constexpr size_t MiB = 1u << 20;
constexpr size_t WS_CTL = 0;
constexpr size_t WS_RSTD0 = 1 * MiB, WS_RSTD1 = WS_RSTD0 + 128 * 1024, WS_RSTD2 = WS_RSTD1 + 128 * 1024;
constexpr size_t WS_EID = 2 * MiB, WS_EW = WS_EID + 256 * 1024, WS_LIST = WS_EW + 256 * 1024, WS_CNT = WS_LIST + 256 * 1024;
constexpr size_t WS_ROPE = 4 * MiB;
constexpr size_t WS_LOGITS = 3 * MiB;
constexpr size_t WS_LRU = 13 * MiB;
constexpr size_t WS_WIN = 16 * MiB, WS_WOUT = 22 * MiB, WS_WPG = 24 * MiB, WS_WPP = 26 * MiB, WS_WRT = 26 * MiB + 512 * 1024, WS_LRUW = 27 * MiB;
constexpr size_t WS_W13 = 28 * MiB, WS_W2 = 156 * MiB, WS_PB = 220 * MiB;
constexpr size_t WS_R64 = 236 * MiB;
constexpr size_t WS_PROJ = 300 * MiB;
constexpr size_t WS_D1 = 300 * MiB, WS_X1B = 364 * MiB, WS_Y = 428 * MiB, WS_PP = 428 * MiB;
constexpr size_t WS_END = 556 * MiB;
}
using namespace cfg;

__device__ __forceinline__ float bf2f(bf16 v) { return __uint_as_float((unsigned)v << 16); }
__device__ __forceinline__ bf16 f2bf(float f) { unsigned u = __float_as_uint(f); return (bf16)((u + 0x7fffu + ((u >> 16) & 1u)) >> 16); }
__device__ __forceinline__ float ldv(const float* p, size_t i) { return p[i]; }
__device__ __forceinline__ float ldv(const bf16* p, size_t i) { return bf2f(p[i]); }
__device__ __forceinline__ void stv(float* p, size_t i, float v) { p[i] = v; }
__device__ __forceinline__ void stv(bf16* p, size_t i, float v) { p[i] = f2bf(v); }

#define GAS __attribute__((address_space(1)))
#define LAS __attribute__((address_space(3)))
typedef unsigned v4u __attribute__((ext_vector_type(4)));
typedef unsigned v2u __attribute__((ext_vector_type(2)));
typedef float f32x4 __attribute__((ext_vector_type(4)));
typedef float f32x2 __attribute__((ext_vector_type(2)));
typedef short bf16x8 __attribute__((ext_vector_type(8)));
typedef short bf16x4 __attribute__((ext_vector_type(4)));
typedef GAS unsigned gu32;
#define RLX_AGENT __ATOMIC_RELAXED, __HIP_MEMORY_SCOPE_AGENT
#define LDS_WAIT() asm volatile("s_waitcnt lgkmcnt(0)" ::: "memory")
#define VM_WAIT() asm volatile("s_waitcnt vmcnt(0)" ::: "memory")
__device__ __forceinline__ unsigned pk2(float lo, float hi) { return (unsigned)f2bf(lo) | ((unsigned)f2bf(hi) << 16); }
typedef __bf16 hwbf16x2 __attribute__((ext_vector_type(2)));
__device__ __forceinline__ unsigned cvt_pk_bf16(float lo, float hi) { f32x2 v = {lo, hi}; hwbf16x2 b = __builtin_convertvector(v, hwbf16x2); return __builtin_bit_cast(unsigned, b); }
__device__ __forceinline__ float bflo(unsigned w) { return __uint_as_float(w << 16); }
__device__ __forceinline__ float bfhi(unsigned w) { return __uint_as_float(w & 0xffff0000u); }
__device__ __forceinline__ float fast_sigmoid(float x) { return __builtin_amdgcn_rcpf(1.f + __builtin_amdgcn_exp2f(-1.4426950408889634f * x)); }

#define XB_TMO      128
#define XB_XCNT(j)  (256  + 64 * (j))
#define XB_XSUB(j)  (1280 + 64 * (j))
#define XB_XGEN(j)  (2304 + 64 * (j))
#define XB_TOP      3328
#define XB_TOPGEN   3392
#define XCD_BAR_WORDS 3456
#define XB_SPIN_CAP (1u << 18)
__device__ __forceinline__ unsigned xb_ld(unsigned* p)              { return __hip_atomic_load(p, __ATOMIC_RELAXED, __HIP_MEMORY_SCOPE_AGENT); }
__device__ __forceinline__ unsigned xb_add(unsigned* p, unsigned v) { return __hip_atomic_fetch_add(p, v, __ATOMIC_RELAXED, __HIP_MEMORY_SCOPE_AGENT); }
__device__ __forceinline__ unsigned xb_xcc_id() { return (unsigned)__builtin_amdgcn_s_getreg((3 << 11) | 20) & 0xFu; }
#define XB_SPIN(cond, bar) do { unsigned _sp = 0; while (cond) { __builtin_amdgcn_s_sleep(1); \
    if ((++_sp & 255u) == 0u) { if (xb_ld(&(bar)[XB_TMO])) break; if (_sp > XB_SPIN_CAP) { atomicAdd(&(bar)[XB_TMO], 1u); break; } } } } while (0)
struct XcdBarrier { unsigned* bar; unsigned x; volatile LAS unsigned* st; };
__device__ __forceinline__ XcdBarrier xcd_barrier_post(unsigned* bar, volatile LAS unsigned* st) {
    XcdBarrier b; b.bar = bar; b.x = xb_xcc_id(); b.st = st;
    if (threadIdx.x == 0) (void)xb_add(&bar[XB_XCNT(b.x)], 1u);
    return b;
}
__device__ __forceinline__ void xcd_barrier_complete(unsigned* bar, unsigned x, unsigned& nloc, unsigned& nx) {
    const unsigned G = gridDim.x * gridDim.y * gridDim.z;
    unsigned sum, cnt, mine, sp = 0u;
    for (;;) {
        sum = 0u; cnt = 0u; mine = 0u;
#pragma unroll
        for (unsigned j = 0; j < 16; ++j) { const unsigned c = xb_ld(&bar[XB_XCNT(j)]); sum += c; cnt += (c > 0u) ? 1u : 0u; mine = (j == x) ? c : mine; }
        if (sum == G) break;
        __builtin_amdgcn_s_sleep(1);
        if ((++sp & 255u) == 0u) { if (xb_ld(&bar[XB_TMO])) break; if (sp > XB_SPIN_CAP) { atomicAdd(&bar[XB_TMO], 1u); break; } }
    }
    nloc = mine > 0u ? mine : 1u; nx = cnt > 0u ? cnt : 1u;
}
__device__ __forceinline__ void xcd_barrier(const XcdBarrier& b) {
    asm volatile("s_waitcnt vmcnt(0)" ::: "memory");
    __syncthreads();
    if (threadIdx.x == 0) {
        unsigned* bar = b.bar;
        __builtin_amdgcn_s_waitcnt(0);
        unsigned nloc = b.st[0], nx = b.st[1];
        if (nloc == 0u) { xcd_barrier_complete(bar, b.x, nloc, nx); b.st[0] = nloc; b.st[1] = nx; }
        const unsigned old = xb_add(&bar[XB_XSUB(b.x)], 1u);
        const unsigned gen = old / nloc;
        if (old + 1u == (gen + 1u) * nloc) {
            __builtin_amdgcn_fence(__ATOMIC_RELEASE, "agent");
            asm volatile("s_waitcnt vmcnt(0)" ::: "memory");
            const unsigned og = xb_add(&bar[XB_TOP], 1u);
            const unsigned tg = og / nx;
            if (og + 1u == (tg + 1u) * nx) xb_add(&bar[XB_TOPGEN], 1u);
            else XB_SPIN(xb_ld(&bar[XB_TOPGEN]) == tg, bar);
            __builtin_amdgcn_fence(__ATOMIC_ACQUIRE, "agent");
            xb_add(&bar[XB_XGEN(b.x)], 1u);
            asm volatile("s_waitcnt vmcnt(0)" ::: "memory");
        } else {
            XB_SPIN(xb_ld(&bar[XB_XGEN(b.x)]) == gen, bar);
            __builtin_amdgcn_fence(__ATOMIC_ACQUIRE, "agent");
            asm volatile("s_waitcnt vmcnt(0)" ::: "memory");
        }
    }
    __syncthreads();
}

constexpr int NWAVES = 8, NTHR = NWAVES * 64;
constexpr int RING_OFF = 0, RING_BYTES = 131072;
constexpr int LDSCTL_OFF = RING_BYTES;
constexpr int UTAB_OFF = LDSCTL_OFF + 1024;
constexpr int MAXU = 6;
constexpr int UTABF_OFF = UTAB_OFF + MAXU * 1024;
constexpr int SCHED_OFF = UTABF_OFF + MAXU * 1024;
constexpr int LDS_BYTES = SCHED_OFF + 2048;
static_assert(LDS_BYTES <= 160 * 1024 && LDS_BYTES > 80 * 1024, "LDS map");
constexpr int CW_TMO = 0, CW_BAR = 4096;

namespace pg8 {
constexpr int BM = 256, BK = 64, HALF = 128, HTB = HALF * BK * 2, STAGE_BYTES = 8 * HTB;
__host__ __device__ __forceinline__ int lds_byte(int r, int c) { const int st = (r >> 4) * 2 + (c >> 5), rr = r & 15, cc = c & 31, ob = rr * 64 + cc * 2; return st * 1024 + (ob ^ (((ob >> 9) & 1) << 5)); }
__host__ __device__ __forceinline__ void stage_rc(int b, int& R, int& C) { const int st = b / 1024, sb = b % 1024, swz = sb ^ (((sb >> 9) & 1) << 5); R = (st >> 1) * 16 + swz / 64; C = (st & 1) * 32 + (swz % 64) / 2; }
__host__ __device__ __forceinline__ int perm32(int rho) { const int n = rho >> 4, i = rho & 15; return 8 * (i >> 2) + 4 * n + (i & 3); }

struct Unit { int pm, pn, e, rows, slot0, ui; };

struct PlainSched {
    static constexpr bool GATHER = false;
    const bf16* A; const bf16* Bt; int K; int nM, nN, nwg, G, c;
    __device__ void init(const bf16* A_, const bf16* Bt_, int M, int N, int K_, int G_, int c_) { A = A_; Bt = Bt_; K = K_; nM = M / BM; nN = N / BM; nwg = nM * nN; G = G_; c = c_; }
    __device__ __forceinline__ bool next(int i, Unit& u) const {
        const long L = (long)i * G + c; if (L >= nwg) return false;
        int wgid = (int)L; { const int q = nwg / 8, r = nwg % 8, xcd = wgid % 8, off = wgid / 8; wgid = (xcd < r ? xcd * (q + 1) : r * (q + 1) + (xcd - r) * q) + off; }
        const int nig = 8 * nN, gid = wgid / nig, fm = gid * 8, gsz = (nM - fm) < 8 ? (nM - fm) : 8;
        u.pm = fm + ((wgid % nig) % gsz); u.pn = (wgid % nig) / gsz; u.e = 0; u.rows = 256; u.slot0 = 0; u.ui = i; return true;
    }
    __device__ __forceinline__ const char* a_base(const Unit& u) const { return (const char*)A + (size_t)u.pm * (size_t)(BM * 2) * K; }
    __device__ __forceinline__ const char* b_base(const Unit& u) const { return (const char*)Bt + (size_t)u.pn * (size_t)(BM * 2) * K; }
    __device__ __forceinline__ unsigned a_rowoff(const Unit&, int r) const { return (unsigned)r * (unsigned)K * 2u; }
};

typedef int i32x4 __attribute__((ext_vector_type(4)));
typedef int i32x8 __attribute__((ext_vector_type(8)));
template <class Epi, class Sched, bool FP8 = false>
__device__ __forceinline__ void gemm_phase(LAS unsigned char* lds, const Sched& S, const Epi& E) {
    const int tid = threadIdx.x, wid = __builtin_amdgcn_readfirstlane(tid >> 6), lane = tid & 63, wr = wid >> 2, wc = wid & 3, fr = lane & 15, fq = lane >> 4;
    const int K = S.K, nt = K / BK;
    int Rr[2], Cc[2]; unsigned voffB[2];
#pragma unroll
    for (int i = 0; i < 2; ++i) { stage_rc(tid * 16 + i * 8192, Rr[i], Cc[i]); const int Rb = (Rr[i] & ~31) + perm32(Rr[i] & 31); voffB[i] = (unsigned)(Rb * K + Cc[i]) * 2u; }
    const size_t kstep = (size_t)(BK * 2);
    const size_t hstep = (size_t)HALF * K * 2;
    const unsigned ldsw = (unsigned)wid * 1024u;
    const int aoff = lds_byte(wr * 64 + fr, fq * 8), boff = lds_byte(wc * 32 + fr, fq * 8);
#define PG8_SA(b, h) (((b) * 2 + (h)) * HTB)
#define PG8_SB(b, h) ((4 + (b) * 2 + (h)) * HTB)
#define PG8_STAGE(bufoff, gbase, voff) do { _Pragma("unroll") for (int _i = 0; _i < 2; ++_i) \
        __builtin_amdgcn_global_load_lds((const unsigned*)((const char*)(gbase) + (voff)[_i]), (LAS unsigned*)(lds + (bufoff) + ldsw + _i * 8192), 16, 0, 0); } while (0)
#define PG8_LDA(dst, b, h) do { _Pragma("unroll") for (int m = 0; m < 4; ++m) _Pragma("unroll") for (int k = 0; k < 2; ++k) dst[m][k] = *(const LAS bf16x8*)(lds + PG8_SA(b, h) + aoff + m * 2048 + k * 1024); } while (0)
#define PG8_LDB(dst, b, h) do { _Pragma("unroll") for (int n = 0; n < 2; ++n) _Pragma("unroll") for (int k = 0; k < 2; ++k) dst[n][k] = *(const LAS bf16x8*)(lds + PG8_SB(b, h) + boff + n * 2048 + k * 1024); } while (0)
#define PG8_MMA(ai, bj, At, Bt) do { __builtin_amdgcn_s_setprio(1); \
        if constexpr (FP8) { _Pragma("unroll") for (int m = 0; m < 4; ++m) _Pragma("unroll") for (int n = 0; n < 2; ++n) { \
            const i32x4 a0_ = __builtin_bit_cast(i32x4, At[m][0]), a1_ = __builtin_bit_cast(i32x4, At[m][1]), b0_ = __builtin_bit_cast(i32x4, Bt[n][0]), b1_ = __builtin_bit_cast(i32x4, Bt[n][1]); \
            const i32x8 a8_ = __builtin_shufflevector(a0_, a1_, 0, 1, 2, 3, 4, 5, 6, 7), b8_ = __builtin_shufflevector(b0_, b1_, 0, 1, 2, 3, 4, 5, 6, 7); \
            acc[ai][bj][m][n] = __builtin_amdgcn_mfma_scale_f32_16x16x128_f8f6f4(b8_, a8_, acc[ai][bj][m][n], 0, 0, 0, 0x7f7f7f7f, 0, 0x7f7f7f7f); } } \
        else { _Pragma("unroll") for (int m = 0; m < 4; ++m) _Pragma("unroll") for (int n = 0; n < 2; ++n) _Pragma("unroll") for (int k = 0; k < 2; ++k) \
            acc[ai][bj][m][n] = __builtin_amdgcn_mfma_f32_16x16x32_bf16(Bt[n][k], At[m][k], acc[ai][bj][m][n], 0, 0, 0); } \
        __builtin_amdgcn_s_setprio(0); } while (0)
#define PG8_WAIT_V(n) asm volatile("s_waitcnt vmcnt(" #n ")" ::: "memory")
#define PG8_WAIT_L(n) asm volatile("s_waitcnt lgkmcnt(" #n ")" ::: "memory")
#define PG8_BAR __builtin_amdgcn_s_barrier()
#define PG8_SCHED __builtin_amdgcn_sched_barrier(0)
#define PG8_VOFF(dst, u) do { _Pragma("unroll") for (int _h = 0; _h < 2; ++_h) _Pragma("unroll") for (int _i = 0; _i < 2; ++_i) dst[_h][_i] = S.a_rowoff(u, _h * HALF + Rr[_i]) + (unsigned)Cc[_i] * 2u; } while (0)
    Unit cur, nxt; int ui = 0;
    if (!S.next(0, cur)) return;
    f32x4 acc[2][2][4][2];
#pragma unroll
    for (int a = 0; a < 2; ++a)
#pragma unroll
        for (int b = 0; b < 2; ++b)
#pragma unroll
            for (int m = 0; m < 4; ++m)
#pragma unroll
                for (int n = 0; n < 2; ++n) acc[a][b][m][n] = (f32x4){0.f, 0.f, 0.f, 0.f};
    bf16x8 At[4][2], B0[2][2], B1[2][2];
    unsigned va[2][2], nva[2][2];
    PG8_VOFF(va, cur);
    const char* cA = S.a_base(cur); const char* cB = S.b_base(cur);
    PG8_STAGE(PG8_SB(0, 0), cB, voffB); PG8_STAGE(PG8_SB(0, 1), cB + hstep, voffB); PG8_STAGE(PG8_SA(0, 0), cA, va[0]); PG8_STAGE(PG8_SA(0, 1), cA, va[1]);
    if (wr == 1) PG8_BAR;
    PG8_WAIT_V(2); PG8_BAR;
    PG8_STAGE(PG8_SB(1, 0), cB + kstep, voffB); PG8_STAGE(PG8_SA(1, 0), cA + kstep, va[0]); PG8_STAGE(PG8_SB(1, 1), cB + hstep + kstep, voffB);
    PG8_WAIT_V(6); PG8_BAR;
    for (;;) {
        const bool has_next = S.next(ui + 1, nxt);
        const bool mma0 = cur.rows > 64 * wr, mma1 = cur.rows > HALF + 64 * wr;
        const char* nA = has_next ? S.a_base(nxt) : cA; const char* nB = has_next ? S.b_base(nxt) : cB;
        if (has_next) { PG8_VOFF(nva, nxt); } else {
#pragma unroll
            for (int h = 0; h < 2; ++h)
#pragma unroll
                for (int i = 0; i < 2; ++i) nva[h][i] = va[h][i]; }
        for (int t = 0; t < nt; t += 2) {
            const bool last = (t == nt - 2);
            const char* a1 = cA + (size_t)(t + 1) * kstep;
            const char* a2 = last ? nA : cA + (size_t)(t + 2) * kstep; const char* b2 = last ? nB : cB + (size_t)(t + 2) * kstep;
            const char* a3 = a2 + kstep; const char* b3 = b2 + kstep;
            unsigned v2[2][2];
#pragma unroll
            for (int h = 0; h < 2; ++h)
#pragma unroll
                for (int i = 0; i < 2; ++i) v2[h][i] = last ? nva[h][i] : va[h][i];
            PG8_LDB(B0, 0, 0); PG8_LDB(B1, 0, 1); PG8_SCHED; PG8_LDA(At, 0, 0); PG8_STAGE(PG8_SA(1, 1), a1, va[1]);
            PG8_WAIT_V(8); PG8_WAIT_L(0); PG8_BAR; if (mma0) { PG8_MMA(0, 0, At, B0); PG8_MMA(0, 1, At, B1); } PG8_BAR; PG8_SCHED;
            PG8_LDA(At, 0, 1); PG8_STAGE(PG8_SB(0, 0), b2, voffB); PG8_STAGE(PG8_SB(0, 1), b2 + hstep, voffB); PG8_STAGE(PG8_SA(0, 0), a2, v2[0]);
            PG8_WAIT_V(8); PG8_WAIT_L(0); PG8_BAR; if (mma1) { PG8_MMA(1, 0, At, B0); PG8_MMA(1, 1, At, B1); } PG8_BAR; PG8_SCHED;
            PG8_LDB(B0, 1, 0); PG8_LDB(B1, 1, 1); PG8_SCHED; PG8_LDA(At, 1, 0); PG8_STAGE(PG8_SA(0, 1), a2, v2[1]);
            PG8_WAIT_V(8); PG8_WAIT_L(0); PG8_BAR; if (mma0) { PG8_MMA(0, 0, At, B0); PG8_MMA(0, 1, At, B1); } PG8_BAR; PG8_SCHED;
            PG8_LDA(At, 1, 1); PG8_STAGE(PG8_SB(1, 0), b3, voffB); PG8_STAGE(PG8_SB(1, 1), b3 + hstep, voffB); PG8_STAGE(PG8_SA(1, 0), a3, v2[0]);
            PG8_WAIT_V(8); PG8_WAIT_L(0); PG8_BAR; if (mma1) { PG8_MMA(1, 0, At, B0); PG8_MMA(1, 1, At, B1); } PG8_BAR; PG8_SCHED;
        }
        if (wr == 0) PG8_BAR;
        E(acc, cur, wr, wc, fr, fq);
        if (!has_next) break;
#pragma unroll
        for (int a = 0; a < 2; ++a)
#pragma unroll
            for (int b = 0; b < 2; ++b)
#pragma unroll
                for (int m = 0; m < 4; ++m)
#pragma unroll
                    for (int n = 0; n < 2; ++n) acc[a][b][m][n] = (f32x4){0.f, 0.f, 0.f, 0.f};
        cur = nxt; cA = nA; cB = nB; ++ui;
#pragma unroll
        for (int h = 0; h < 2; ++h)
#pragma unroll
            for (int i = 0; i < 2; ++i) va[h][i] = nva[h][i];
        if (wr == 1) PG8_BAR;
    }
    PG8_WAIT_V(0);
    PG8_BAR;
#undef PG8_SA
#undef PG8_SB
#undef PG8_STAGE
#undef PG8_LDA
#undef PG8_LDB
#undef PG8_MMA
#undef PG8_WAIT_V
#undef PG8_WAIT_L
#undef PG8_BAR
#undef PG8_SCHED
#undef PG8_VOFF
}

struct EpiRowScaleBf16 {
    bf16* O; int ldc; const float* rs;
    __device__ __forceinline__ void operator()(const f32x4 (&acc)[2][2][4][2], const Unit& u, int wr, int wc, int fr, int fq) const {
        const int row0 = u.pm * BM + wr * 64 + fr, col0 = u.pn * BM + wc * 32 + 8 * fq;
        float sc[2][4];
#pragma unroll
        for (int ai = 0; ai < 2; ++ai)
#pragma unroll
            for (int m = 0; m < 4; ++m) sc[ai][m] = rs[row0 + ai * HALF + m * 16];
#pragma unroll
        for (int ai = 0; ai < 2; ++ai)
#pragma unroll
            for (int m = 0; m < 4; ++m) { const int row = row0 + ai * HALF + m * 16; const float s = sc[ai][m]; bf16* rowp = O + (size_t)row * ldc + col0;
#pragma unroll
                for (int bj = 0; bj < 2; ++bj) { const f32x4 v0 = acc[ai][bj][m][0] * s, v1 = acc[ai][bj][m][1] * s;
                    v4u w; w.x = cvt_pk_bf16(v0[0], v0[1]); w.y = cvt_pk_bf16(v0[2], v0[3]); w.z = cvt_pk_bf16(v1[0], v1[1]); w.w = cvt_pk_bf16(v1[2], v1[3]);
                    *(v4u*)(rowp + bj * HALF) = w; } }
    }
};
struct EpiPlainBf16 {
    bf16* O; int ldc;
    __device__ __forceinline__ void operator()(const f32x4 (&acc)[2][2][4][2], const Unit& u, int wr, int wc, int fr, int fq) const {
        const int row0 = u.pm * BM + wr * 64 + fr, col0 = u.pn * BM + wc * 32 + 8 * fq;
#pragma unroll
        for (int ai = 0; ai < 2; ++ai)
#pragma unroll
            for (int m = 0; m < 4; ++m) { const int row = row0 + ai * HALF + m * 16; bf16* rowp = O + (size_t)row * ldc + col0;
#pragma unroll
                for (int bj = 0; bj < 2; ++bj) { const f32x4 v0 = acc[ai][bj][m][0], v1 = acc[ai][bj][m][1];
                    v4u w; w.x = cvt_pk_bf16(v0[0], v0[1]); w.y = cvt_pk_bf16(v0[2], v0[3]); w.z = cvt_pk_bf16(v1[0], v1[1]); w.w = cvt_pk_bf16(v1[2], v1[3]);
                    *(v4u*)(rowp + bj * HALF) = w; } }
    }
};
struct EpiGateBf16 {
    bf16* O; int ldc; const float* rs; const float* bias; float osc;
    __device__ __forceinline__ void operator()(const f32x4 (&acc)[2][2][4][2], const Unit& u, int wr, int wc, int fr, int fq) const {
        const int row0 = u.pm * BM + wr * 64 + fr, col0 = u.pn * BM + wc * 32 + 8 * fq;
        float sc[2][4]; f32x4 bv[2][2];
#pragma unroll
        for (int ai = 0; ai < 2; ++ai)
#pragma unroll
            for (int m = 0; m < 4; ++m) sc[ai][m] = rs[row0 + ai * HALF + m * 16] * osc;
#pragma unroll
        for (int bj = 0; bj < 2; ++bj)
#pragma unroll
            for (int n = 0; n < 2; ++n) bv[bj][n] = *(const f32x4*)(bias + col0 + bj * HALF + 4 * n);
#pragma unroll
        for (int ai = 0; ai < 2; ++ai)
#pragma unroll
            for (int m = 0; m < 4; ++m) { const int row = row0 + ai * HALF + m * 16; const float s = sc[ai][m]; bf16* rowp = O + (size_t)row * ldc + col0;
#pragma unroll
                for (int bj = 0; bj < 2; ++bj) { f32x4 v0 = acc[ai][bj][m][0] * s + bv[bj][0], v1 = acc[ai][bj][m][1] * s + bv[bj][1];
#pragma unroll
                    for (int q = 0; q < 4; ++q) { v0[q] = fast_sigmoid(v0[q]); v1[q] = fast_sigmoid(v1[q]); }
                    v4u w; w.x = cvt_pk_bf16(v0[0], v0[1]); w.y = cvt_pk_bf16(v0[2], v0[3]); w.z = cvt_pk_bf16(v1[0], v1[1]); w.w = cvt_pk_bf16(v1[2], v1[3]);
                    *(v4u*)(rowp + bj * HALF) = w; } }
    }
};
}

struct Args { const float* in[25]; float* out; unsigned char* ws; int ph_lo, ph_hi; };

struct Frame {
    LAS unsigned char* lds; volatile LAS unsigned* MISC; gu32* ctl; int tid, lane, wave, vcu, G;
};
__device__ __forceinline__ float wave_sum(float v) {
#pragma unroll
    for (int o = 1; o < 64; o <<= 1) v += __shfl_xor(v, o);
    return v;
}
template <int RM, bool HAS_CS>
__device__ __forceinline__ void p0_transpose_item(const float* __restrict__ W, int K, int N, bf16* __restrict__ WT, int row_off, const float* __restrict__ cs, LAS float* scr, int item, int lane) {
    const int nblk = N / 32, kb = item / nblk, nb = item % nblk, k0 = 64 * kb, n0 = 32 * nb;
    const int c = lane & 7;
    f32x4 s0 = {1.f, 1.f, 1.f, 1.f}, s1 = {1.f, 1.f, 1.f, 1.f};
    if (HAS_CS) { s0 = *(const f32x4*)(cs + k0 + 8 * c); s1 = *(const f32x4*)(cs + k0 + 8 * c + 4); }
#pragma unroll 8
    for (int i = 0; i < 32; ++i) { const int kk = 2 * i + (lane >> 5); scr[kk * 33 + (lane & 31)] = W[(size_t)(k0 + kk) * N + n0 + (lane & 31)]; }
    LDS_WAIT(); asm volatile("" ::: "memory");
#pragma unroll
    for (int j = 0; j < 4; ++j) { const int n = (lane >> 3) + 8 * j; const LAS float* s = scr + (8 * c) * 33 + n;
        v4u o; o.x = pk2(s[0 * 33] * s0.x, s[1 * 33] * s0.y); o.y = pk2(s[2 * 33] * s0.z, s[3 * 33] * s0.w); o.z = pk2(s[4 * 33] * s1.x, s[5 * 33] * s1.y); o.w = pk2(s[6 * 33] * s1.z, s[7 * 33] * s1.w);
        const int nn = n0 + n; const int orow = RM == 0 ? row_off + nn : (row_off + 8 * (nn >> 2) + (nn & 3) + (RM == 2 ? 4 : 0));
        *(GAS v4u*)(WT + (size_t)orow * K + k0 + 8 * c) = o; }
    LDS_WAIT(); asm volatile("" ::: "memory");
}

__device__ __forceinline__ unsigned pk4_fp8(float v0, float v1, float v2, float v3) {
    v0 = __builtin_amdgcn_fmed3f(v0, -448.f, 448.f); v1 = __builtin_amdgcn_fmed3f(v1, -448.f, 448.f); v2 = __builtin_amdgcn_fmed3f(v2, -448.f, 448.f); v3 = __builtin_amdgcn_fmed3f(v3, -448.f, 448.f);
    int w = 0; w = __builtin_amdgcn_cvt_pk_fp8_f32(v0, v1, w, false); w = __builtin_amdgcn_cvt_pk_fp8_f32(v2, v3, w, true); return (unsigned)w;
}
template <int RM, bool HAS_CS>
__device__ __forceinline__ void p0_transpose_item_f8(const float* __restrict__ W, int K, int N, unsigned char* __restrict__ WT, const float* __restrict__ cs, float scale, LAS float* scr, int item, int lane) {
    const int nblk = N / 32, kb = item / nblk, nb = item % nblk, k0 = 64 * kb, n0 = 32 * nb;
    const int n = lane & 31, kq = lane >> 5;
#pragma unroll 8
    for (int i = 0; i < 32; ++i) { const int kk = 2 * i + (lane >> 5); scr[kk * 33 + (lane & 31)] = W[(size_t)(k0 + kk) * N + n0 + (lane & 31)]; }
    LDS_WAIT(); asm volatile("" ::: "memory");
    const int nn = n0 + n; const int orow = RM == 0 ? nn : (8 * (nn >> 2) + (nn & 3) + (RM == 2 ? 4 : 0));
    unsigned char* dst = WT + (size_t)orow * K + k0 + 32 * kq;
    f32x4 csv[8];
#pragma unroll
    for (int i = 0; i < 8; ++i) csv[i] = HAS_CS ? *(const f32x4*)(cs + k0 + 32 * kq + 4 * i) * scale : (f32x4){scale, scale, scale, scale};
#pragma unroll
    for (int h = 0; h < 2; ++h) { v4u o;
#pragma unroll
        for (int q = 0; q < 4; ++q) { const int kk = 32 * kq + 16 * h + 4 * q; const f32x4 sc = csv[4 * h + q];
            o[q] = pk4_fp8(scr[kk * 33 + n] * sc[0], scr[(kk + 1) * 33 + n] * sc[1], scr[(kk + 2) * 33 + n] * sc[2], scr[(kk + 3) * 33 + n] * sc[3]); }
        *(GAS v4u*)(dst + 16 * h) = o; }
    LDS_WAIT(); asm volatile("" ::: "memory");
}
struct Ptrs {
    const float *x, *p, *g_mix, *w_in, *conv_w, *conv_b, *wa, *ba, *wx, *bx, *lam, *w_out, *g_ffn, *w_rg, *b_rg, *w_re, *b_re, *w1, *w3, *w2, *g_ple, *w_pg, *b_pg, *w_pp, *g_final;
    float* out; unsigned char* ws;
    float *rstd0, *rstd1, *rstd2; int* eid; float* ew; int* list; int* counts; int* goffs;
    bf16 *W_IN, *W_OUT, *W_PG, *W_PP, *WRT, *LRUW, *W13, *W2, *PB, *XB, *MIX, *ACT, *GATE, *PROJ, *D1, *X1B, *X2B, *Y, *PP;
};
__device__ __forceinline__ void make_ptrs(Ptrs& P, const Args& a) {
    P.x = a.in[0]; P.p = a.in[1]; P.g_mix = a.in[2]; P.w_in = a.in[3]; P.conv_w = a.in[4]; P.conv_b = a.in[5]; P.wa = a.in[6]; P.ba = a.in[7]; P.wx = a.in[8]; P.bx = a.in[9]; P.lam = a.in[10];
    P.w_out = a.in[11]; P.g_ffn = a.in[12]; P.w_rg = a.in[13]; P.b_rg = a.in[14]; P.w_re = a.in[15]; P.b_re = a.in[16]; P.w1 = a.in[17]; P.w3 = a.in[18]; P.w2 = a.in[19];
    P.g_ple = a.in[20]; P.w_pg = a.in[21]; P.b_pg = a.in[22]; P.w_pp = a.in[23]; P.g_final = a.in[24];
    P.out = a.out; P.ws = a.ws; unsigned char* ws = a.ws;
    P.rstd0 = (float*)(ws + WS_RSTD0); P.rstd1 = (float*)(ws + WS_RSTD1); P.rstd2 = (float*)(ws + WS_RSTD2);
    P.eid = (int*)(ws + WS_EID); P.ew = (float*)(ws + WS_EW); P.list = (int*)(ws + WS_LIST); P.counts = (int*)(ws + WS_CNT); P.goffs = P.counts + 256 * NE;
    P.W_IN = (bf16*)(ws + WS_WIN); P.W_OUT = (bf16*)(ws + WS_WOUT); P.W_PG = (bf16*)(ws + WS_WPG); P.W_PP = (bf16*)(ws + WS_WPP); P.WRT = (bf16*)(ws + WS_WRT); P.LRUW = (bf16*)(ws + WS_LRUW);
    P.W13 = (bf16*)(ws + WS_W13); P.W2 = (bf16*)(ws + WS_W2); P.PB = (bf16*)(ws + WS_PB);
    P.XB = (bf16*)(ws + WS_R64); P.MIX = (bf16*)(ws + WS_R64); P.ACT = (bf16*)(ws + WS_R64); P.GATE = (bf16*)(ws + WS_R64);
    P.PROJ = (bf16*)(ws + WS_PROJ); P.D1 = (bf16*)(ws + WS_D1); P.PP = (bf16*)(ws + WS_PP); P.X1B = (bf16*)(ws + WS_X1B); P.X2B = (bf16*)(ws + WS_D1);     P.Y = (bf16*)(ws + WS_Y);
}

struct P0Item { const float* src; const float* cs; unsigned char* dst; int N, Kout, n0, rm, fmt; float scale; };
__device__ __forceinline__ bool p0_decode(const Ptrs& P, int it, P0Item& I) {
    constexpr int I_WIN = (D / 64) * (INC / 32), I_SQ = (D / 64) * (D / 32), I_PG = (D / 128) * (D / 32), I_WPP = (PLE / 64) * (D / 32), I_W1 = (D / 128) * (DE / 32), I_W2 = (DE / 128) * (D / 32);
    constexpr int NITEMS = I_WIN + I_SQ + I_PG + I_WPP + NE * (2 * I_W1 + I_W2);
    if (it >= NITEMS) return false;
    int r = it; const float* W; const float* cs; unsigned char* dst; int K, N, rm = 0, fmt = 0; float scale = 1.f;
    if (r < I_WIN) { W = P.w_in; K = D; N = INC; dst = (unsigned char*)P.W_IN; cs = P.g_mix; }
    else if ((r -= I_WIN) < I_SQ) { W = P.w_out; K = D; N = D; dst = (unsigned char*)P.W_OUT; cs = nullptr; }
    else if ((r -= I_SQ) < I_PG) { W = P.w_pg; K = D; N = D; dst = (unsigned char*)P.W_PG; cs = P.g_ple; fmt = 1; scale = PLE_SWG; }
    else if ((r -= I_PG) < I_WPP) { W = P.w_pp; K = PLE; N = D; dst = (unsigned char*)P.W_PP; cs = nullptr; }
    else { r -= I_WPP; const int per_e = 2 * I_W1 + I_W2, e = r / per_e; r -= e * per_e; fmt = 1;
        if (r < I_W1) { W = P.w1 + (size_t)e * D * DE; K = D; N = DE; dst = (unsigned char*)P.W13 + (size_t)e * D * D; cs = P.g_ffn; rm = 1; scale = MOE_SW1; }
        else if ((r -= I_W1) < I_W1) { W = P.w3 + (size_t)e * D * DE; K = D; N = DE; dst = (unsigned char*)P.W13 + (size_t)e * D * D; cs = P.g_ffn; rm = 2; scale = MOE_SW1; }
        else { r -= I_W1; W = P.w2 + (size_t)e * DE * D; K = DE; N = D; dst = (unsigned char*)P.W2 + (size_t)e * D * DE; cs = nullptr; scale = MOE_SW2; } }
    const int KI = fmt ? 128 : 64;
    const int nblk = N / 32, kb = r / nblk, nb = r % nblk, k0 = KI * kb, n0 = 32 * nb;
    I.src = W + (size_t)k0 * N + n0; I.cs = cs ? cs + k0 : nullptr; I.N = N; I.n0 = n0; I.rm = rm; I.fmt = fmt; I.scale = scale;
    I.Kout = fmt ? K : 2 * K; I.dst = dst + (fmt ? k0 : 2 * k0);
    return true;
}
__device__ __forceinline__ void p0_load(const P0Item& I, float (&v)[64], int lane) {
    const float* s = I.src + (size_t)(lane >> 5) * I.N + (lane & 31);
#pragma unroll
    for (int i = 0; i < 32; ++i) v[i] = s[(size_t)(2 * i) * I.N];
    if (I.fmt) {
#pragma unroll
        for (int i = 32; i < 64; ++i) v[i] = s[(size_t)(2 * i) * I.N];
    }
}
__device__ __forceinline__ int p0_orow(const P0Item& I, int n) { const int nn = I.n0 + n; return I.rm == 0 ? nn : (8 * (nn >> 2) + (nn & 3) + (I.rm == 2 ? 4 : 0)); }
__device__ __forceinline__ void p0_process(const P0Item& I, const float (&v)[64], LAS float* scr, int lane) {
    if (I.fmt == 0) {
#pragma unroll
        for (int i = 0; i < 32; ++i) scr[(2 * i + (lane >> 5)) * 33 + (lane & 31)] = v[i];
        LDS_WAIT(); asm volatile("" ::: "memory");
        const int c = lane & 7;
        f32x4 s0 = {1.f, 1.f, 1.f, 1.f}, s1 = {1.f, 1.f, 1.f, 1.f};
        if (I.cs) { s0 = *(const f32x4*)(I.cs + 8 * c); s1 = *(const f32x4*)(I.cs + 8 * c + 4); }
#pragma unroll
        for (int j = 0; j < 4; ++j) { const int n = (lane >> 3) + 8 * j; const LAS float* s = scr + (8 * c) * 33 + n;
            v4u o; o.x = cvt_pk_bf16(s[0 * 33] * s0.x, s[1 * 33] * s0.y); o.y = cvt_pk_bf16(s[2 * 33] * s0.z, s[3 * 33] * s0.w); o.z = cvt_pk_bf16(s[4 * 33] * s1.x, s[5 * 33] * s1.y); o.w = cvt_pk_bf16(s[6 * 33] * s1.z, s[7 * 33] * s1.w);
            *(GAS v4u*)(I.dst + (size_t)p0_orow(I, n) * I.Kout + 16 * c) = o; }
    } else {
#pragma unroll
        for (int i = 0; i < 64; ++i) { const int k = 2 * i + (lane >> 5); scr[k * 32 + (((lane & 31) + k) & 31)] = v[i]; }
        LDS_WAIT(); asm volatile("" ::: "memory");
        const int c = lane & 7;
        f32x4 sc[4];
#pragma unroll
        for (int q = 0; q < 4; ++q) sc[q] = I.cs ? *(const f32x4*)(I.cs + 16 * c + 4 * q) * I.scale : (f32x4){I.scale, I.scale, I.scale, I.scale};
#pragma unroll
        for (int j = 0; j < 4; ++j) { const int n = (lane >> 3) + 8 * j; v4u o;
#pragma unroll
            for (int q = 0; q < 4; ++q) { float t[4];
#pragma unroll
                for (int e = 0; e < 4; ++e) { const int k = 16 * c + 4 * q + e; t[e] = scr[k * 32 + ((n + k) & 31)] * sc[q][e]; }
                o[q] = pk4_fp8(t[0], t[1], t[2], t[3]); }
            *(GAS v4u*)(I.dst + (size_t)p0_orow(I, n) * I.Kout + 16 * c) = o; }
    }
    LDS_WAIT(); asm volatile("" ::: "memory");
}
__device__ __forceinline__ void p0_prologue(Frame& F, const Ptrs& P) {
    LAS float* scr = (LAS float*)(F.lds + RING_OFF + F.wave * 16384);
    const int gw = F.vcu * NWAVES + F.wave, NGW = F.G * NWAVES;
    {
#pragma unroll 1
        for (int it = gw; ; it += NGW) { P0Item A; float va[64];
            if (!p0_decode(P, it, A)) break;
            p0_load(A, va, F.lane); p0_process(A, va, scr, F.lane); }
    }
    for (int m = gw; m < T; m += 4 * NGW) {
        f32x4 v[4][4];
#pragma unroll
        for (int i = 0; i < 4; ++i) { const int mi = m + i * NGW; const GAS f32x4* xr = (const GAS f32x4*)(P.x + (size_t)(mi < T ? mi : m) * D) + F.lane;
#pragma unroll
            for (int j = 0; j < 4; ++j) v[i][j] = xr[64 * j]; }
#pragma unroll
        for (int i = 0; i < 4; ++i) { const int mi = m + i * NGW; float s = 0.f;
#pragma unroll
            for (int j = 0; j < 4; ++j) s += (v[i][j].x * v[i][j].x + v[i][j].y * v[i][j].y) + (v[i][j].z * v[i][j].z + v[i][j].w * v[i][j].w);
            s = wave_sum(s);
            if (mi < T) { GAS v2u* o8 = (GAS v2u*)(P.XB + (size_t)mi * D) + F.lane;
#pragma unroll
                for (int j = 0; j < 4; ++j) { v2u w; w.x = pk2(v[i][j].x, v[i][j].y); w.y = pk2(v[i][j].z, v[i][j].w); o8[64 * j] = w; }
                if (F.lane == 0) P.rstd0[mi] = 1.0f / sqrtf(s * (1.f / D) + EPS); } }
    }
    for (int m = gw; m < T; m += 16 * NGW) {
        f32x4 v[16];
#pragma unroll
        for (int j = 0; j < 16; ++j) { const int mj = m + j * NGW; v[j] = *((const GAS f32x4*)(P.p + (size_t)(mj < T ? mj : m) * PLE) + F.lane); }
#pragma unroll
        for (int j = 0; j < 16; ++j) { const int mj = m + j * NGW; if (mj < T) { v2u w; w.x = pk2(v[j].x, v[j].y); w.y = pk2(v[j].z, v[j].w); *((GAS v2u*)(P.PB + (size_t)mj * PLE) + F.lane) = w; } }
    }
    for (int idx = (F.vcu * NTHR + F.tid); idx < S * 64; idx += F.G * NTHR) {
        const int pos = idx >> 6, dd = idx & 63;
        const float inv = exp2f(-(float)dd * (13.287712379549449f / 64.f)); const float ang = (float)pos * inv;
        float rev = ang * 0.15915494309189535f; rev -= floorf(rev); const float sn = __builtin_amdgcn_sinf(rev), cs = __builtin_amdgcn_cosf(rev);
        ((unsigned*)(P.ws + WS_ROPE))[idx] = __builtin_bit_cast(unsigned, __builtin_amdgcn_cvt_pkrtz(cs, sn));
    }
    for (int idx = (F.vcu * NTHR + F.tid); idx < 80 * D; idx += F.G * NTHR) {
        const int n = idx / D, k = idx % D; float v = 0.f;
        if (n < NG) v = P.w_rg[(size_t)k * NG + n] * P.g_ffn[k]; else if (n < NG + NE) v = P.w_re[(size_t)k * NE + (n - NG)] * P.g_ffn[k];
        const bf16 hi = f2bf(v); const bf16 lo = f2bf(v - bf2f(hi));
        P.WRT[idx] = hi; P.WRT[80 * D + idx] = lo;
    }
    for (int idx = (F.vcu * NTHR + F.tid); idx < 2 * 8 * 64 * 64; idx += F.G * NTHR) {
        const int g = idx >> 15, r = idx & 32767, hb = r >> 12, j = (r >> 6) & 63, i = r & 63;
        const float* w = g ? P.wx : P.wa;
        P.LRUW[idx] = f2bf(w[(hb * 64 + i) * 64 + j]);
    }
}


__device__ __forceinline__ f32x4 bf4(v2u w) { return (f32x4){bflo(w.x), bfhi(w.x), bflo(w.y), bfhi(w.y)}; }
__device__ __forceinline__ void p10_combine(Frame& F, const Ptrs& P) {
    const int gw = F.vcu * NWAVES + F.wave, NGW = F.G * NWAVES;
    for (int m = gw; m < T; m += NGW) {
        const size_t ro = (size_t)m * D;
        GAS v2u* x1 = (GAS v2u*)(P.X2B + ro) + F.lane; const GAS v2u* y0 = (const GAS v2u*)(P.Y + ro) + F.lane; const GAS v2u* y1 = (const GAS v2u*)(P.Y + (size_t)T * D + ro) + F.lane;
        f32x4 v[4]; v2u a[4], b[4], c[4];
#pragma unroll
        for (int j = 0; j < 4; ++j) { a[j] = x1[64 * j]; b[j] = y0[64 * j]; c[j] = y1[64 * j]; }
        float s = 0.f;
#pragma unroll
        for (int j = 0; j < 4; ++j) { v[j] = bf4(a[j]) + (bf4(b[j]) + bf4(c[j])); s += (v[j].x * v[j].x + v[j].y * v[j].y) + (v[j].z * v[j].z + v[j].w * v[j].w); }
        s = wave_sum(s);
        GAS unsigned* o4 = (GAS unsigned*)((unsigned char*)P.X1B + ro) + F.lane;
#pragma unroll
        for (int j = 0; j < 4; ++j) { v2u w; w.x = pk2(v[j].x, v[j].y); w.y = pk2(v[j].z, v[j].w); x1[64 * j] = w;
            o4[64 * j] = pk4_fp8(v[j].x * PLE_SX2, v[j].y * PLE_SX2, v[j].z * PLE_SX2, v[j].w * PLE_SX2); }
        if (F.lane == 0) P.rstd2[m] = 1.0f / sqrtf(s * (1.f / D) + EPS);
    }
}
__device__ __forceinline__ void p13_final(Frame& F, const Ptrs& P) {
    const int gw = F.vcu * NWAVES + F.wave, NGW = F.G * NWAVES;
    f32x4 gf[4];
#pragma unroll
    for (int j = 0; j < 4; ++j) gf[j] = *((const GAS f32x4*)P.g_final + F.lane + 64 * j);
    for (int m = gw; m < T; m += NGW) {
        const size_t ro = (size_t)m * D;
        GAS f32x4* xr = (GAS f32x4*)(P.out + ro) + F.lane;
        const GAS v2u* xb = (const GAS v2u*)(P.X2B + ro) + F.lane; const GAS v2u* ga = (const GAS v2u*)(P.GATE + ro) + F.lane; const GAS v2u* pp = (const GAS v2u*)(P.PP + ro) + F.lane;
        f32x4 v[4]; v2u a[4], b[4], c[4];
#pragma unroll
        for (int j = 0; j < 4; ++j) { c[j] = xb[64 * j]; a[j] = ga[64 * j]; b[j] = pp[64 * j]; }
        float s = 0.f;
#pragma unroll
        for (int j = 0; j < 4; ++j) { v[j] = bf4(c[j]) + bf4(a[j]) * bf4(b[j]); s += (v[j].x * v[j].x + v[j].y * v[j].y) + (v[j].z * v[j].z + v[j].w * v[j].w); }
        s = wave_sum(s);
        const float r = 1.0f / sqrtf(s * (1.f / D) + EPS);
#pragma unroll
        for (int j = 0; j < 4; ++j) xr[64 * j] = v[j] * r * gf[j];
    }
}
__device__ __forceinline__ LAS int* sched_offs(Frame& F) { return (LAS int*)(F.lds + SCHED_OFF); }
__device__ __forceinline__ LAS int* sched_tileb(Frame& F) { return (LAS int*)(F.lds + SCHED_OFF) + 72; }
__device__ __forceinline__ LAS int* sched_pre(Frame& F) { return (LAS int*)(F.lds + SCHED_OFF) + 144; }
__device__ __forceinline__ LAS int* sched_ta(Frame& F) { return (LAS int*)(F.lds + SCHED_OFF) + 256; }
__device__ __forceinline__ LAS int* sched_tc(Frame& F) { return (LAS int*)(F.lds + SCHED_OFF) + 328; }
__device__ __forceinline__ void sched_build(Frame& F, const Ptrs& P) {
    LAS int* offs = sched_offs(F); LAS int* tb = sched_tileb(F); LAS int* pre = sched_pre(F);
    LAS int* part = (LAS int*)(F.lds + UTAB_OFF);
    {
        const int e = F.tid & 63, pt = F.tid >> 6; int t = 0, p = 0; int cv[32];
#pragma unroll
        for (int j = 0; j < 32; ++j) cv[j] = P.counts[(pt * 32 + j) * NE + e];
#pragma unroll
        for (int j = 0; j < 32; ++j) { t += cv[j]; p += (pt * 32 + j < F.vcu) ? cv[j] : 0; }
        part[(pt * 64 + e) * 2] = t; part[(pt * 64 + e) * 2 + 1] = p;
    }
    __syncthreads();
    if (F.tid < NE) { int t = 0, p = 0;
#pragma unroll
        for (int pt = 0; pt < 8; ++pt) { t += part[(pt * 64 + F.tid) * 2]; p += part[(pt * 64 + F.tid) * 2 + 1]; }
        pre[F.tid] = p; part[1024 + F.tid] = t; }
    __syncthreads();
    if (F.tid < NE) {
        LAS int* ta = sched_ta(F); LAS int* tc = sched_tc(F);
        const int t = part[1024 + F.tid], tl = t & 255;
        int v0 = t, v1 = t >> 8, v2 = tl > 128 ? 1 : 0, v3 = (tl > 0 && tl <= 128) ? 1 : 0;
        const int i0 = v0, i1 = v1, i2 = v2, i3 = v3;
#pragma unroll
        for (int o = 1; o < 64; o <<= 1) { const int a0 = __shfl_up(v0, o), a1 = __shfl_up(v1, o), a2 = __shfl_up(v2, o), a3 = __shfl_up(v3, o); if (F.lane >= o) { v0 += a0; v1 += a1; v2 += a2; v3 += a3; } }
        offs[F.tid] = v0 - i0; tb[F.tid] = v1 - i1; ta[F.tid] = v2 - i2; tc[F.tid] = v3 - i3;
        if (F.tid == NE - 1) { offs[NE] = v0; tb[NE] = v1; ta[NE] = v2; tc[NE] = v3; }
    }
    __syncthreads();
}

constexpr int P6_BROW = 272, P6_BHL = 80 * P6_BROW, P6_BBUF = 2 * P6_BHL, P6_LG_OFF = 90112;
static_assert(2 * P6_BBUF <= P6_LG_OFF && P6_LG_OFF + 8 * 16 * 80 * 4 <= RING_BYTES, "P6 LDS map");
__device__ __forceinline__ void p6_route(Frame& F, const Ptrs& P) {
    const int lane = F.lane, r = lane & 15, g = lane >> 4;
    const int tok = F.vcu * 128 + F.wave * 16 + r;
    LAS unsigned char* BS = F.lds + RING_OFF;
    LAS float* LG = (LAS float*)(F.lds + RING_OFF + P6_LG_OFF) + F.wave * (16 * 80);
    LAS float* SS = (LAS float*)(F.lds + UTAB_OFF) + F.wave * 16;
    LAS int* hist = (LAS int*)(F.lds + UTAB_OFF + 1024);
    if (F.tid < NE) hist[F.tid] = 0;
    f32x4 acc[5];
#pragma unroll
    for (int i = 0; i < 5; ++i) acc[i] = (f32x4){0.f, 0.f, 0.f, 0.f};
    float ssq = 0.f;
    const float* xrow = P.x + (size_t)tok * D + 8 * g; const bf16* drow = P.D1 + (size_t)tok * D + 8 * g; unsigned char* orow = (unsigned char*)P.X1B + (size_t)tok * D + 8 * g;
    unsigned bsrc[5], bdst[5];
#pragma unroll
    for (int i = 0; i < 5; ++i) { const int id = F.tid + 512 * i, hl = id / 1280, rem = id % 1280, row = rem >> 4, ch = rem & 15;
        bsrc[i] = (unsigned)((hl * 80 + row) * D + 8 * ch) * 2u; bdst[i] = (unsigned)(hl * P6_BHL + row * P6_BROW + ch * 16); }
    v4u breg[5]; f32x4 xa[4], xb[4]; v4u dd[4];
#pragma unroll
    for (int i = 0; i < 5; ++i) breg[i] = *(const v4u*)((const char*)P.WRT + bsrc[i]);
#pragma unroll
    for (int s = 0; s < 4; ++s) { xa[s] = *(const f32x4*)(xrow + 32 * s); xb[s] = *(const f32x4*)(xrow + 32 * s + 4); dd[s] = *(const v4u*)(drow + 32 * s); }
#pragma unroll 1
    for (int sl = 0; sl < 8; ++sl) {
        LAS unsigned char* bb = BS + (sl & 1) * P6_BBUF;
#pragma unroll
        for (int i = 0; i < 5; ++i) *(LAS v4u*)(bb + bdst[i]) = breg[i];
        __syncthreads();
        f32x4 cxa[4], cxb[4]; v4u cdd[4];
#pragma unroll
        for (int s = 0; s < 4; ++s) { cxa[s] = xa[s]; cxb[s] = xb[s]; cdd[s] = dd[s]; }
        if (sl < 7) {
#pragma unroll
            for (int i = 0; i < 5; ++i) breg[i] = *(const v4u*)((const char*)P.WRT + bsrc[i] + (sl + 1) * 256);
#pragma unroll
            for (int s = 0; s < 4; ++s) { xa[s] = *(const f32x4*)(xrow + 128 * (sl + 1) + 32 * s); xb[s] = *(const f32x4*)(xrow + 128 * (sl + 1) + 32 * s + 4); dd[s] = *(const v4u*)(drow + 128 * (sl + 1) + 32 * s); }
        }
#pragma unroll
        for (int s = 0; s < 4; ++s) {
            float v[8];
            v[0] = cxa[s][0] + bflo(cdd[s].x); v[1] = cxa[s][1] + bfhi(cdd[s].x); v[2] = cxa[s][2] + bflo(cdd[s].y); v[3] = cxa[s][3] + bfhi(cdd[s].y);
            v[4] = cxb[s][0] + bflo(cdd[s].z); v[5] = cxb[s][1] + bfhi(cdd[s].z); v[6] = cxb[s][2] + bflo(cdd[s].w); v[7] = cxb[s][3] + bfhi(cdd[s].w);
            v4u hw, lw;
#pragma unroll
            for (int q = 0; q < 4; ++q) {
                ssq += v[2 * q] * v[2 * q] + v[2 * q + 1] * v[2 * q + 1];
                const unsigned h = cvt_pk_bf16(v[2 * q], v[2 * q + 1]);
                const unsigned l = cvt_pk_bf16(v[2 * q] - bflo(h), v[2 * q + 1] - bfhi(h));
                hw[q] = h; lw[q] = l;
            }
            { v2u f8; f8.x = pk4_fp8(v[0] * MOE_SX, v[1] * MOE_SX, v[2] * MOE_SX, v[3] * MOE_SX); f8.y = pk4_fp8(v[4] * MOE_SX, v[5] * MOE_SX, v[6] * MOE_SX, v[7] * MOE_SX); *(v2u*)(orow + 128 * sl + 32 * s) = f8; }
            *(v4u*)(const_cast<bf16*>(drow) + 128 * sl + 32 * s) = hw;
            const bf16x8 ah = __builtin_bit_cast(bf16x8, hw), al = __builtin_bit_cast(bf16x8, lw);
#pragma unroll
            for (int nt = 0; nt < 5; ++nt) {
                const bf16x8 bh = *(const LAS bf16x8*)(bb + (16 * nt + r) * P6_BROW + (32 * s + 8 * g) * 2), bl = *(const LAS bf16x8*)(bb + P6_BHL + (16 * nt + r) * P6_BROW + (32 * s + 8 * g) * 2);
                acc[nt] = __builtin_amdgcn_mfma_f32_16x16x32_bf16(ah, bh, acc[nt], 0, 0, 0);
                acc[nt] = __builtin_amdgcn_mfma_f32_16x16x32_bf16(al, bh, acc[nt], 0, 0, 0);
                acc[nt] = __builtin_amdgcn_mfma_f32_16x16x32_bf16(ah, bl, acc[nt], 0, 0, 0);
            }
        }
    }
    ssq += __shfl_xor(ssq, 16); ssq += __shfl_xor(ssq, 32);
#pragma unroll
    for (int nt = 0; nt < 5; ++nt)
#pragma unroll
        for (int q = 0; q < 4; ++q) LG[(4 * g + q) * 80 + 16 * nt + r] = acc[nt][q];
    if (g == 0) SS[r] = ssq;
    __syncthreads();
    if (g == 0) {
        const float rs = 1.0f / sqrtf(SS[r] * (1.f / D) + EPS);
        const LAS float* L = LG + r * 80;
        float gl[8]; float mx = -3.0e38f; int gsel = 0;
#pragma unroll
        for (int i = 0; i < 8; ++i) { gl[i] = rs * L[i] + P.b_rg[i]; if (gl[i] > mx) { mx = gl[i]; gsel = i; } }
        float den = 0.f;
#pragma unroll
        for (int i = 0; i < 8; ++i) den += expf(gl[i] - mx);
        const float gw = 1.f / den;
        float v0 = -3.0e38f, v1 = -3.0e38f; int i0 = 0, i1 = 0;
        for (int i = 0; i < 8; ++i) {
            const float v = rs * L[8 + gsel * 8 + i] + P.b_re[gsel * 8 + i];
            if (v > v0) { v1 = v0; i1 = i0; v0 = v; i0 = i; } else if (v > v1) { v1 = v; i1 = i; }
        }
        const float e1 = expf(v1 - v0), w0 = 1.f / (1.f + e1), w1 = e1 / (1.f + e1);
        const int ea = gsel * 8 + i0, eb = gsel * 8 + i1;
        P.eid[tok * 2] = ea; P.eid[tok * 2 + 1] = eb; P.ew[tok * 2] = w0 * gw; P.ew[tok * 2 + 1] = w1 * gw; P.rstd1[tok] = rs;
        __hip_atomic_fetch_add(hist + ea, 1, __ATOMIC_RELAXED, __HIP_MEMORY_SCOPE_WORKGROUP); __hip_atomic_fetch_add(hist + eb, 1, __ATOMIC_RELAXED, __HIP_MEMORY_SCOPE_WORKGROUP);
    }
    __syncthreads();
    if (F.tid < NE) P.counts[F.vcu * NE + F.tid] = hist[F.tid];
}

__device__ __forceinline__ void p7_lists(Frame& F, const Ptrs& P) {
    sched_build(F, P);
    LAS int* offs = sched_offs(F); LAS int* pre = sched_pre(F);
    LAS int* lcnt = (LAS int*)(F.lds + RING_OFF);
    if (F.tid < NE) lcnt[F.tid] = 0;
    __syncthreads();
    if (F.tid < 256) { const int a = F.vcu * 256 + F.tid; const int e = P.eid[a];
        const int rank = __hip_atomic_fetch_add(lcnt + e, 1, __ATOMIC_RELAXED, __HIP_MEMORY_SCOPE_WORKGROUP);
        P.list[offs[e] + pre[e] + rank] = a; }
    if (blockIdx.x == 0 && F.tid <= NE) P.goffs[F.tid] = offs[F.tid];
    __syncthreads();
}

namespace pg8 {
template <int MODE>
struct MoeSched {
    const char* Ab; const char* Bb; int K, G, c; LAS int* offs; LAS int* tb; LAS int* ta; LAS int* tc; LAS int* tab;
    __device__ __forceinline__ bool next(int i, Unit& u) const {
        const int L = i * G + c; const int nF = __builtin_amdgcn_readfirstlane(tb[NE]), nA = __builtin_amdgcn_readfirstlane(ta[NE]), nC = __builtin_amdgcn_readfirstlane(tc[NE]);
        if (L >= 4 * (nF + nA + nC)) return false;
        int rt = L >> 2; const LAS int* pf = tb; int cls = 0;
        if (rt >= nF) { rt -= nF; pf = ta; cls = 1; if (rt >= nA) { rt -= nA; pf = tc; cls = 2; } }
        int e = 0;
        for (int k = 1; k < NE; ++k) e += (pf[k] <= rt) ? 1 : 0;
        e = __builtin_amdgcn_readfirstlane(e);
        const int o0 = __builtin_amdgcn_readfirstlane(offs[e]), cnt = __builtin_amdgcn_readfirstlane(offs[e + 1]) - o0;
        u.e = e; u.pm = cls == 0 ? rt - __builtin_amdgcn_readfirstlane(tb[e]) : (cnt >> 8); u.pn = L & 3; u.slot0 = o0 + 256 * u.pm;
        u.rows = cls == 0 ? 256 : (cnt & 255); u.ui = i; return true;
    }
    __device__ __forceinline__ const char* a_base(const Unit& u) const { return MODE == 0 ? Ab : Ab + (size_t)u.slot0 * (size_t)(K * 2); }
    __device__ __forceinline__ const char* b_base(const Unit& u) const { return Bb + ((size_t)u.e * D + (size_t)u.pn * BM) * (size_t)K * 2; }
    __device__ __forceinline__ unsigned a_rowoff(const Unit& u, int r) const { return MODE == 0 ? (unsigned)tab[u.ui * 256 + r] : (unsigned)r * (unsigned)(K * 2); }
};
struct EpiAct {
    unsigned char* ACT; const LAS float* tabf;
    __device__ __forceinline__ void operator()(const f32x4 (&acc)[2][2][4][2], const Unit& u, int wr, int wc, int fr, int fq) const {
#pragma unroll
        for (int ai = 0; ai < 2; ++ai)
#pragma unroll
            for (int m = 0; m < 4; ++m) { const int r = ai * HALF + wr * 64 + m * 16 + fr;
                if (r < u.rows) { const float s = tabf[u.ui * 256 + r] * (1.f / (MOE_SX * MOE_SW1)); unsigned char* rowp = ACT + (size_t)(u.slot0 + r) * DE + u.pn * 128 + wc * 16 + 4 * fq;
#pragma unroll
                    for (int bj = 0; bj < 2; ++bj) { const f32x4 h1 = acc[ai][bj][m][0] * s, h3 = acc[ai][bj][m][1] * s; f32x4 a;
#pragma unroll
                        for (int q = 0; q < 4; ++q) a[q] = h1[q] * fast_sigmoid(h1[q]) * h3[q] * MOE_SA;
                        *(unsigned*)(rowp + bj * 64) = pk4_fp8(a[0], a[1], a[2], a[3]); } } }
    }
};
struct EpiY {
    bf16* Y; const LAS int* tab; const LAS float* tabf;
    __device__ __forceinline__ void operator()(const f32x4 (&acc)[2][2][4][2], const Unit& u, int wr, int wc, int fr, int fq) const {
#pragma unroll
        for (int ai = 0; ai < 2; ++ai)
#pragma unroll
            for (int m = 0; m < 4; ++m) { const int r = ai * HALF + wr * 64 + m * 16 + fr; const int aid = tab[u.ui * 256 + r];
                if (aid >= 0) { const float s = tabf[u.ui * 256 + r] * (1.f / (MOE_SA * MOE_SW2)); bf16* rowp = Y + ((size_t)(aid & 1) * T + (size_t)(aid >> 1)) * D + u.pn * BM + wc * 32 + 8 * fq;
#pragma unroll
                    for (int bj = 0; bj < 2; ++bj) { const f32x4 v0 = acc[ai][bj][m][0] * s, v1 = acc[ai][bj][m][1] * s;
                        v4u w; w.x = cvt_pk_bf16(v0[0], v0[1]); w.y = cvt_pk_bf16(v0[2], v0[3]); w.z = cvt_pk_bf16(v1[0], v1[1]); w.w = cvt_pk_bf16(v1[2], v1[3]);
                        *(v4u*)(rowp + bj * HALF) = w; } } }
    }
};
}
template <int MODE>
__device__ __forceinline__ void moe_phase(Frame& F, const Ptrs& P, bool rebuild) {
    if (rebuild) sched_build(F, P);
    LAS int* tab = (LAS int*)(F.lds + UTAB_OFF); LAS float* tabf = (LAS float*)(F.lds + UTABF_OFF);
    LAS int* uinfo = (LAS int*)(F.lds + SCHED_OFF) + 208;
    pg8::MoeSched<MODE> S; S.Ab = MODE == 0 ? (const char*)P.X1B : (const char*)P.ACT; S.Bb = MODE == 0 ? (const char*)P.W13 : (const char*)P.W2; S.K = MODE == 0 ? D / 2 : DE / 2;   S.G = F.G; S.c = F.vcu;
    S.offs = sched_offs(F); S.tb = sched_tileb(F); S.ta = sched_ta(F); S.tc = sched_tc(F); S.tab = tab;
    if (F.tid < 64) {
#pragma unroll
        for (int i = 0; i < MAXU; ++i) { pg8::Unit u; const bool ok = S.next(i, u); if (F.tid == 0) { uinfo[2 * i] = ok ? u.slot0 : 0; uinfo[2 * i + 1] = ok ? u.rows : 0; } }
    }
    __syncthreads();
    {
        const int r = F.tid & 255, i0 = F.tid >> 8; int aid[3]; bool val[3], act[3];
#pragma unroll
        for (int it = 0; it < 3; ++it) { const int i = i0 + 2 * it; const int s0 = uinfo[2 * i], rows = uinfo[2 * i + 1]; act[it] = rows > 0; val[it] = r < rows; aid[it] = act[it] ? P.list[s0 + (val[it] ? r : 0)] : 0; }
        float fv[3];
#pragma unroll
        for (int it = 0; it < 3; ++it) fv[it] = act[it] ? (MODE == 0 ? P.rstd1[aid[it] >> 1] : P.ew[aid[it]]) : 0.f;
#pragma unroll
        for (int it = 0; it < 3; ++it) if (act[it]) { const int i = i0 + 2 * it;
            if (MODE == 0) tab[i * 256 + r] = (aid[it] >> 1) * D; else tab[i * 256 + r] = val[it] ? aid[it] : -1;
            tabf[i * 256 + r] = fv[it]; }
    }
    __syncthreads();
    if constexpr (MODE == 0) { pg8::EpiAct E{(unsigned char*)P.ACT, tabf}; pg8::gemm_phase<pg8::EpiAct, pg8::MoeSched<0>, true>(F.lds + RING_OFF, S, E); }
    else { pg8::EpiY E{P.Y, tab, tabf}; pg8::gemm_phase<pg8::EpiY, pg8::MoeSched<1>, true>(F.lds + RING_OFF, S, E); }
}
typedef short v4i16 __attribute__((ext_vector_type(4)));
__device__ __forceinline__ unsigned off_b(unsigned row, unsigned ch) { return 256u * row + 16u * (ch ^ (((row & 3u) << 2) | ((row >> 2) & 3u))); }
__device__ __forceinline__ unsigned row_read_addr_16(unsigned lane, unsigned rb, unsigned s) { return off_b((lane & 15u) + 16u * rb, 4u * s + (lane >> 4)); }
__device__ __forceinline__ unsigned tr_read_addr_16(unsigned lane, unsigned c, unsigned ks, unsigned t) {
    const unsigned g = lane >> 4, q = (lane & 15u) >> 2, p = lane & 3u;
    return off_b(32u * ks + 8u * g + 4u * t + q, 2u * c + (p >> 1)) + 8u * (p & 1u);
}
__device__ __forceinline__ bf16x8 tr_frag2(LAS unsigned char* p0, LAS unsigned char* p1) {
    const v4i16 a = __builtin_amdgcn_ds_read_tr16_b64_v4i16((LAS v4i16*)p0);
    const v4i16 b = __builtin_amdgcn_ds_read_tr16_b64_v4i16((LAS v4i16*)p1);
    return (bf16x8){a[0], a[1], a[2], a[3], b[0], b[1], b[2], b[3]};
}
__device__ __forceinline__ void wave_lds_fence() { asm volatile("s_waitcnt lgkmcnt(0)" ::: "memory"); __builtin_amdgcn_wave_barrier(); asm volatile("" ::: "memory"); }
__device__ __forceinline__ float gelu_tanh_fast(float x) {
    const float u = 0.7978845608028654f * (x + 0.044715f * x * x * x);
    return x * fast_sigmoid(2.f * u);
}
constexpr float LOG2_ROPE_OVER_64 = 13.287712379549449f / 64.f;
constexpr int MIX_K_OFF = 0, MIX_V_OFF = 32768, MIX_S_OFF = 65536, MIX_S_STRIDE = 272, MIX_S_WAVE = 16 * MIX_S_STRIDE;
constexpr int MIX_CW_OFF = 0, MIX_XC_OFF = 12288, MIX_XC_WAVE = 16 * 68 * 4;
constexpr int MIX_LU_STRIDE = 48, MIX_LU_ARR = 64 * MIX_LU_STRIDE, MIX_LU_WAVE = 2 * MIX_LU_ARR;
constexpr int MIX_HS_OFF = 49152, MIX_HS_STRIDE = 144, MIX_HS_WAVE = 16 * MIX_HS_STRIDE;
static_assert(MIX_S_OFF + 8 * MIX_S_WAVE <= RING_BYTES && MIX_XC_OFF + 8 * MIX_XC_WAVE <= MIX_HS_OFF && MIX_HS_OFF + 8 * MIX_HS_WAVE <= RING_BYTES && MIX_HS_OFF + 8 * MIX_LU_WAVE <= RING_BYTES, "mixing LDS map");

__device__ __forceinline__ void sincos_rev(float ang, float& sn, float& cs) {
    float rev = ang * 0.15915494309189535f; rev -= floorf(rev);
    sn = __builtin_amdgcn_sinf(rev); cs = __builtin_amdgcn_cosf(rev);
}
struct KVRaw { v4u k[2][2]; v4u v[4]; };
__device__ __forceinline__ void kv_issue(KVRaw& R, int tid, const bf16* proj_t0, int h) {
    const int dg = tid & 7;
#pragma unroll
    for (int it = 0; it < 2; ++it) { const int c = (tid >> 3) + 64 * it; const bf16* row = proj_t0 + (size_t)c * INC + 1536 + h * HD + 8 * dg; R.k[it][0] = *(const v4u*)row; R.k[it][1] = *(const v4u*)(row + 64); }
#pragma unroll
    for (int it = 0; it < 4; ++it) { const int id = tid + 512 * it, c = id >> 4, ch = id & 15; R.v[it] = *(const v4u*)(proj_t0 + (size_t)c * INC + 2048 + h * HD + 8 * ch); }
}
typedef _Float16 f16x2 __attribute__((ext_vector_type(2)));
__device__ __forceinline__ void unpk_cs(unsigned w, float& cs, float& sn) { const f16x2 h = __builtin_bit_cast(f16x2, w); cs = (float)h[0]; sn = (float)h[1]; }
struct KRope { v4u cs[2][2]; };
__device__ __forceinline__ void krope_load(KRope& R, const Ptrs& P, int tid, int s0) {
    const int dg = tid & 7;
#pragma unroll
    for (int it = 0; it < 2; ++it) { const int c = (tid >> 3) + 64 * it; const v4u* t = (const v4u*)(P.ws + WS_ROPE) + ((size_t)(s0 + c) * 64 + 8 * dg) / 4;
        R.cs[it][0] = t[0]; R.cs[it][1] = t[1]; }
}
template <bool DECAY>
__device__ __forceinline__ void kv_store(Frame& F, const KVRaw& R, const KRope& C, int tid, float lg2) {
    LAS unsigned char* Kimg = F.lds + MIX_K_OFF; LAS unsigned char* Vimg = F.lds + MIX_V_OFF;
    const int dg = tid & 7;
#pragma unroll
    for (int it = 0; it < 2; ++it) {
        const int c = (tid >> 3) + 64 * it;
        const v4u k1 = R.k[it][0], k2 = R.k[it][1];
        const float sc = 0.08838834764831845f * (DECAY ? __builtin_amdgcn_exp2f((float)(127 - c) * lg2) : 1.f);
        v4u o1, o2;
#pragma unroll
        for (int q = 0; q < 4; ++q) {
            float cs0, sn0, cs1, sn1; unpk_cs(C.cs[it][q >> 1][2 * (q & 1)], cs0, sn0); unpk_cs(C.cs[it][q >> 1][2 * (q & 1) + 1], cs1, sn1); cs0 *= sc; sn0 *= sc; cs1 *= sc; sn1 *= sc;
            const float a0 = bflo(k1[q]), a1 = bfhi(k1[q]), b0 = bflo(k2[q]), b1 = bfhi(k2[q]);
            o1[q] = cvt_pk_bf16(a0 * cs0 - b0 * sn0, a1 * cs1 - b1 * sn1);
            o2[q] = cvt_pk_bf16(a0 * sn0 + b0 * cs0, a1 * sn1 + b1 * cs1);
        }
        *(LAS v4u*)(Kimg + off_b(c, dg)) = o1; *(LAS v4u*)(Kimg + off_b(c, dg + 8)) = o2;
    }
#pragma unroll
    for (int it = 0; it < 4; ++it) { const int id = tid + 512 * it, c = id >> 4, ch = id & 15; *(LAS v4u*)(Vimg + off_b(c, ch)) = R.v[it]; }
}

template <bool FINAL>
__device__ __forceinline__ void lru_chunk(Frame& F, const Ptrs& P, int b, int n, int lane) {
    const int r = lane & 15, g = lane >> 4, hb = F.wave;
    const int t0 = b * S + n * CH;
    LAS float* CW = (LAS float*)(F.lds + MIX_CW_OFF);
    LAS float* XC = (LAS float*)(F.lds + MIX_XC_OFF + F.wave * MIX_XC_WAVE);
    LAS unsigned char* HS = F.lds + MIX_HS_OFF + F.wave * MIX_HS_WAVE;
    LAS unsigned char* LU = F.lds + MIX_HS_OFF + F.wave * MIX_LU_WAVE;
    for (int i = F.tid; i < 5 * DL; i += NTHR) CW[i] = i < 4 * DL ? P.conv_w[i] : P.conv_b[i - 4 * DL];
    __syncthreads();
    bf16x8 Wa[4][2], Wx[4][2];
#pragma unroll
    for (int jt = 0; jt < 4; ++jt)
#pragma unroll
        for (int ks = 0; ks < 2; ++ks) {
            Wa[jt][ks] = *(const bf16x8*)(P.LRUW + ((size_t)(0 * 8 + hb) * 64 + 16 * jt + r) * 64 + 32 * ks + 8 * g);
            Wx[jt][ks] = *(const bf16x8*)(P.LRUW + ((size_t)(1 * 8 + hb) * 64 + 16 * jt + r) * 64 + 32 * ks + 8 * g);
        }
    float ba[4], bx[4], sp8[4], St[4], At[4];
#pragma unroll
    for (int jt = 0; jt < 4; ++jt) { const int ch = hb * 64 + 16 * jt + r; ba[jt] = P.ba[ch]; bx[jt] = P.bx[ch];
        const float nl = -P.lam[ch]; sp8[jt] = 8.f * (nl > 20.f ? nl : log1pf(expf(nl)));
        St[jt] = FINAL ? ((const float*)(P.ws + WS_LRU))[2 * B * NCH * DL + (b * NCH + n) * DL + ch] : 0.f; At[jt] = 1.f; }
    v4u xin[2][4], glv[2];
#define LRU_TILE_LOADS(tt_) do { const int c_ = 16 * (tt_) + r; \
        _Pragma("unroll") for (int ks = 0; ks < 2; ++ks) _Pragma("unroll") for (int k = 0; k < 4; ++k) { xin[ks][k] = (v4u){0u, 0u, 0u, 0u}; \
            if (n * CH + c_ - 3 + k >= 0) xin[ks][k] = *(const v4u*)(P.PROJ + (size_t)(t0 + c_ - 3 + k) * INC + hb * 64 + 32 * ks + 8 * g); } \
        if (FINAL) { _Pragma("unroll") for (int i = 0; i < 2; ++i) glv[i] = *(const v4u*)(P.PROJ + (size_t)(t0 + 16 * (tt_) + (lane >> 3) + 8 * i) * INC + DL + hb * 64 + 8 * (lane & 7)); } } while (0)
    LRU_TILE_LOADS(0);
#pragma unroll 1
    for (int tt = 0; tt < 8; ++tt) {
        v4u xcur[2][4], gcur[2];
#pragma unroll
        for (int ks = 0; ks < 2; ++ks)
#pragma unroll
            for (int k = 0; k < 4; ++k) xcur[ks][k] = xin[ks][k];
        gcur[0] = glv[0]; gcur[1] = glv[1];
        if (tt < 7) LRU_TILE_LOADS(tt + 1);
        bf16x8 fr[2];
#pragma unroll
        for (int ks = 0; ks < 2; ++ks) {
            const int chA = hb * 64 + 32 * ks + 8 * g;
            float xc[8];
            { const f32x4 b0 = *(const LAS f32x4*)(CW + 4 * DL + chA), b1 = *(const LAS f32x4*)(CW + 4 * DL + chA + 4);
              xc[0] = b0[0]; xc[1] = b0[1]; xc[2] = b0[2]; xc[3] = b0[3]; xc[4] = b1[0]; xc[5] = b1[1]; xc[6] = b1[2]; xc[7] = b1[3]; }
#pragma unroll
            for (int k = 0; k < 4; ++k) {
                const v4u xv = xcur[ks][k];
                const f32x4 w0 = *(const LAS f32x4*)(CW + k * DL + chA), w1 = *(const LAS f32x4*)(CW + k * DL + chA + 4);
                xc[0] += w0[0] * bflo(xv.x); xc[1] += w0[1] * bfhi(xv.x); xc[2] += w0[2] * bflo(xv.y); xc[3] += w0[3] * bfhi(xv.y);
                xc[4] += w1[0] * bflo(xv.z); xc[5] += w1[1] * bfhi(xv.z); xc[6] += w1[2] * bflo(xv.w); xc[7] += w1[3] * bfhi(xv.w);
            }
            v4u pk; pk.x = cvt_pk_bf16(xc[0], xc[1]); pk.y = cvt_pk_bf16(xc[2], xc[3]); pk.z = cvt_pk_bf16(xc[4], xc[5]); pk.w = cvt_pk_bf16(xc[6], xc[7]);
            fr[ks] = __builtin_bit_cast(bf16x8, pk);
            *(LAS f32x4*)(XC + r * 68 + 32 * ks + 8 * g) = (f32x4){xc[0], xc[1], xc[2], xc[3]};
            *(LAS f32x4*)(XC + r * 68 + 32 * ks + 8 * g + 4) = (f32x4){xc[4], xc[5], xc[6], xc[7]};
        }
        wave_lds_fence();
#pragma unroll
        for (int jt = 0; jt < 4; ++jt) {
            f32x4 aa = {0.f, 0.f, 0.f, 0.f}, ax = {0.f, 0.f, 0.f, 0.f};
#pragma unroll
            for (int ks = 0; ks < 2; ++ks) { aa = __builtin_amdgcn_mfma_f32_16x16x32_bf16(fr[ks], Wa[jt][ks], aa, 0, 0, 0); ax = __builtin_amdgcn_mfma_f32_16x16x32_bf16(fr[ks], Wx[jt][ks], ax, 0, 0, 0); }
            float av[4], uv[4]; float Al = 1.f, Hl = 0.f;
#pragma unroll
            for (int q = 0; q < 4; ++q) {
                const float xcv = XC[(4 * g + q) * 68 + 16 * jt + r];
                const float rg = fast_sigmoid(aa[q] + ba[jt]), ig = fast_sigmoid(ax[q] + bx[jt]);
                const float la = -rg * sp8[jt];
                const float a = __builtin_amdgcn_exp2f(la * 1.4426950408889634f);
                const float x2 = 2.f * la;
                const float em = x2 > -0.25f ? -x2 * (1.f + x2 * (0.5f + x2 * (0.16666667f + x2 * (0.041666668f + x2 * (0.0083333333f + x2 * 0.0013888889f))))) : 1.f - a * a;
                const float u = sqrtf(em) * (ig * xcv);
                av[q] = a; uv[q] = u; Hl = a * Hl + u; Al *= a;
                if (!FINAL) { *(LAS bf16*)(LU + (16 * jt + r) * MIX_LU_STRIDE + (4 * g + q) * 2) = (bf16)cvt_pk_bf16(la, 0.f); *(LAS bf16*)(LU + MIX_LU_ARR + (16 * jt + r) * MIX_LU_STRIDE + (4 * g + q) * 2) = (bf16)cvt_pk_bf16(u, 0.f); }
            }
            float Ap = 1.f, Hp = 0.f;
#pragma unroll
            for (int k = 3; k >= 1; --k) {
                const float Ao = __shfl(Al, lane - 16 * k), Ho = __shfl(Hl, lane - 16 * k);
                if (g >= k) { Hp = Ao * Hp + Ho; Ap *= Ao; }
            }
            float h = Ap * St[jt] + Hp;
            if (FINAL) {
#pragma unroll
                for (int q = 0; q < 4; ++q) {
                    h = av[q] * h + uv[q];
                    *(LAS bf16*)(HS + (4 * g + q) * MIX_HS_STRIDE + (16 * jt + r) * 2) = (bf16)cvt_pk_bf16(h, 0.f);
                }
            } else {
                h = Al * h + Hl;
            }
            const float Atile = __shfl(Ap * Al, (lane & 15) + 48);
            St[jt] = __shfl(h, (lane & 15) + 48);
            At[jt] *= Atile;
        }
        wave_lds_fence();
        if (!FINAL) {
            bf16* LAg = (bf16*)P.out + (size_t)16 * 1024 * 1024; bf16* Ug = (bf16*)P.out + (size_t)48 * 1024 * 1024;
#pragma unroll
            for (int oc = 0; oc < 2; ++oc) { const size_t o = ((((size_t)(b * NCH + n) * 8 + hb) * 16 + (2 * tt + oc)) * 64 + lane) * 8;
                *(v4u*)(LAg + o) = *(const LAS v4u*)(LU + lane * MIX_LU_STRIDE + oc * 16); *(v4u*)(Ug + o) = *(const LAS v4u*)(LU + MIX_LU_ARR + lane * MIX_LU_STRIDE + oc * 16); }
        }
        if (FINAL) {
#pragma unroll
            for (int i = 0; i < 2; ++i) { const int tk = (lane >> 3) + 8 * i, ch8 = lane & 7;
                const v4u hv = *(const LAS v4u*)(HS + tk * MIX_HS_STRIDE + ch8 * 16); v4u o;
#pragma unroll
                for (int q = 0; q < 4; ++q) o[q] = cvt_pk_bf16(bflo(hv[q]) * gelu_tanh_fast(bflo(gcur[i][q])), bfhi(hv[q]) * gelu_tanh_fast(bfhi(gcur[i][q])));
                *(v4u*)(P.MIX + (size_t)(t0 + 16 * tt + tk) * D + hb * 64 + 8 * ch8) = o; }
            wave_lds_fence();
        }
    }
#undef LRU_TILE_LOADS
    if (!FINAL && g == 0) {
#pragma unroll
        for (int jt = 0; jt < 4; ++jt) { const int ch = hb * 64 + 16 * jt + r; float* AE = (float*)(P.ws + WS_LRU);
            AE[(b * NCH + n) * DL + ch] = At[jt]; AE[B * NCH * DL + (b * NCH + n) * DL + ch] = St[jt]; }
    }
}

__device__ __forceinline__ void lru_apply(Frame& F, const Ptrs& P, int b, int n, int lane) {
    const int hb = F.wave; const int t0 = b * S + n * CH;
    LAS unsigned char* HS = F.lds + MIX_HS_OFF + F.wave * MIX_HS_WAVE;
    const bf16* LAg = (const bf16*)P.out + (size_t)16 * 1024 * 1024 + ((size_t)(b * NCH + n) * 8 + hb) * (16 * 64 * 8) + lane * 8;
    const bf16* Ug = (const bf16*)P.out + (size_t)48 * 1024 * 1024 + ((size_t)(b * NCH + n) * 8 + hb) * (16 * 64 * 8) + lane * 8;
    float h = ((const float*)(P.ws + WS_LRU))[2 * B * NCH * DL + (b * NCH + n) * DL + hb * 64 + lane];
    v4u la[2], uu[2], gl[2];
#define LRU_AP_LOADS(tt_) do { _Pragma("unroll") for (int oc = 0; oc < 2; ++oc) { la[oc] = *(const v4u*)(LAg + (size_t)(2 * (tt_) + oc) * 512); uu[oc] = *(const v4u*)(Ug + (size_t)(2 * (tt_) + oc) * 512); } \
        _Pragma("unroll") for (int i = 0; i < 2; ++i) gl[i] = *(const v4u*)(P.PROJ + (size_t)(t0 + 16 * (tt_) + (lane >> 3) + 8 * i) * INC + DL + hb * 64 + 8 * (lane & 7)); } while (0)
    LRU_AP_LOADS(0);
#pragma unroll 1
    for (int tt = 0; tt < 8; ++tt) {
        v4u cla[2], cu[2], cg[2];
#pragma unroll
        for (int i = 0; i < 2; ++i) { cla[i] = la[i]; cu[i] = uu[i]; cg[i] = gl[i]; }
        if (tt < 7) LRU_AP_LOADS(tt + 1);
#pragma unroll
        for (int oc = 0; oc < 2; ++oc)
#pragma unroll
            for (int q = 0; q < 4; ++q) {
                const float a0 = __builtin_amdgcn_exp2f(bflo(cla[oc][q]) * 1.4426950408889634f), a1 = __builtin_amdgcn_exp2f(bfhi(cla[oc][q]) * 1.4426950408889634f);
                h = a0 * h + bflo(cu[oc][q]); const float h0 = h; h = a1 * h + bfhi(cu[oc][q]);
                const unsigned pk = cvt_pk_bf16(h0, h);
                *(LAS bf16*)(HS + (8 * oc + 2 * q) * MIX_HS_STRIDE + lane * 2) = (bf16)(pk & 0xffffu); *(LAS bf16*)(HS + (8 * oc + 2 * q + 1) * MIX_HS_STRIDE + lane * 2) = (bf16)(pk >> 16);
            }
        wave_lds_fence();
#pragma unroll
        for (int i = 0; i < 2; ++i) { const int tk = (lane >> 3) + 8 * i, ch8 = lane & 7;
            const v4u hv = *(const LAS v4u*)(HS + tk * MIX_HS_STRIDE + ch8 * 16); v4u o;
#pragma unroll
            for (int q = 0; q < 4; ++q) o[q] = cvt_pk_bf16(bflo(hv[q]) * gelu_tanh_fast(bflo(cg[i][q])), bfhi(hv[q]) * gelu_tanh_fast(bfhi(cg[i][q])));
            *(v4u*)(P.MIX + (size_t)(t0 + 16 * tt + tk) * D + hb * 64 + 8 * ch8) = o; }
        wave_lds_fence();
    }
#undef LRU_AP_LOADS
}

__device__ __forceinline__ void p2_mix_summaries(Frame& F, const Ptrs& P) {
    const int w = F.wave;
#pragma unroll 1
    for (int u = F.vcu; u < B * NCH; u += F.G) {
        const int b = u / NCH, n = u % NCH; const int t0 = b * S + n * CH;
        __syncthreads();
        { int lane0 = F.lane; asm volatile("" : "+v"(lane0)); lru_chunk<false>(F, P, b, n, lane0); }
        KVRaw raw; KRope krope; { int tid0 = F.tid; asm volatile("" : "+v"(tid0)); kv_issue(raw, tid0, P.PROJ + (size_t)t0 * INC, 0); krope_load(krope, P, tid0, n * CH); }
#pragma unroll 1
        for (int h = 0; h < NH; ++h) {
            int lane = F.lane; asm volatile("" : "+v"(lane));
            int tidv = F.tid; asm volatile("" : "+v"(tidv));
            const int r = lane & 15, g = lane >> 4;
            unsigned trb[8][2];
#pragma unroll
            for (int c = 0; c < 8; ++c) { trb[c][0] = tr_read_addr_16(lane, c, 0, 0); trb[c][1] = tr_read_addr_16(lane, c, 0, 1); }
            const float lg2 = __builtin_amdgcn_logf(1.f - __builtin_amdgcn_exp2f(-5.f - (float)h));
            __syncthreads();
            kv_store<true>(F, raw, krope, tidv, lg2);
            if (h + 1 < NH) kv_issue(raw, tidv, P.PROJ + (size_t)t0 * INC, h + 1);
            __syncthreads();
            LAS unsigned char* Kimg = F.lds + MIX_K_OFF; LAS unsigned char* Vimg = F.lds + MIX_V_OFF;
            f32x4 acc[8];
#pragma unroll
            for (int dt = 0; dt < 8; ++dt) acc[dt] = (f32x4){0.f, 0.f, 0.f, 0.f};
            const unsigned ta0 = tr_read_addr_16(lane, w, 0, 0), ta1 = tr_read_addr_16(lane, w, 0, 1);
#pragma unroll 1
            for (int ks = 0; ks < 4; ++ks) {
                const bf16x8 Af = tr_frag2(Vimg + ta0 + 8192 * ks, Vimg + ta1 + 8192 * ks);
#pragma unroll
                for (int dt = 0; dt < 8; ++dt) { const bf16x8 Bf = tr_frag2(Kimg + trb[dt][0] + 8192 * ks, Kimg + trb[dt][1] + 8192 * ks); acc[dt] = __builtin_amdgcn_mfma_f32_16x16x32_bf16(Af, Bf, acc[dt], 0, 0, 0); }
            }
            bf16* KV = (bf16*)P.out + ((size_t)((b * NH + h) * NCH + n)) * (HD * HD);
            LAS unsigned char* Sst = F.lds + MIX_S_OFF + w * MIX_S_WAVE;
#pragma unroll
            for (int dt = 0; dt < 8; ++dt)
#pragma unroll
                for (int q = 0; q < 4; ++q) *(LAS bf16*)(Sst + (4 * g + q) * MIX_S_STRIDE + (16 * dt + r) * 2) = (bf16)cvt_pk_bf16(acc[dt][q], 0.f);
            wave_lds_fence();
#pragma unroll
            for (int i = 0; i < 4; ++i) { const int id = lane + 64 * i, row = id >> 4, ch = id & 15;
                *(v4u*)(KV + (size_t)(16 * w + row) * HD + 8 * ch) = *(const LAS v4u*)(Sst + row * MIX_S_STRIDE + ch * 16); }
            wave_lds_fence();
        }
    }
}
__device__ __forceinline__ void p3_scans(Frame& F, const Ptrs& P) {
    const int idx = F.vcu * NTHR + F.tid;
    for (int id = idx; id < B * NH * (HD * HD / 4); id += F.G * NTHR) {
        const int bh = id >> 12, el = (id & 4095) * 4, h = bh & 3;
        const float lg2 = __builtin_amdgcn_logf(1.f - __builtin_amdgcn_exp2f(-5.f - (float)h));
        const float dec = __builtin_amdgcn_exp2f(128.f * lg2);
        const bf16* KV = (const bf16*)P.out + (size_t)bh * NCH * (HD * HD) + el;
        bf16* PV = (bf16*)(P.out + (size_t)B * NH * NCH * (HD * HD)) + (size_t)bh * NCH * (HD * HD) + el;
        f32x4 st = {0.f, 0.f, 0.f, 0.f};
#pragma unroll 8
        for (int n = 0; n < NCH; ++n) {
            const f32x4 kv = bf4(*(const v2u*)(KV + (size_t)n * (HD * HD)));
            v2u w; w.x = cvt_pk_bf16(st[0], st[1]); w.y = cvt_pk_bf16(st[2], st[3]);
            *(v2u*)(PV + (size_t)n * (HD * HD)) = w;
            st = st * dec + kv;
        }
    }
    if (idx < B * DL) {
        const int b = idx / DL, ch = idx % DL; float* AE = (float*)(P.ws + WS_LRU);
        float carry = 0.f;
        for (int n = 0; n < NCH; ++n) {
            const float a = AE[(b * NCH + n) * DL + ch], e = AE[B * NCH * DL + (b * NCH + n) * DL + ch];
            AE[2 * B * NCH * DL + (b * NCH + n) * DL + ch] = carry;
            carry = a * carry + e;
        }
    }
}
__device__ __forceinline__ void p4_mix_outputs(Frame& F, const Ptrs& P) {
    const int w = F.wave;
#pragma unroll 1
    for (int u = F.vcu; u < B * NCH; u += F.G) {
        const int b = u / NCH, n = u % NCH; const int t0 = b * S + n * CH;
        __syncthreads();
        { int lane0 = F.lane; asm volatile("" : "+v"(lane0)); lru_apply(F, P, b, n, lane0); }
        KRope krope; v4u qcs[2][2];
        { int tid0 = F.tid, lane0 = F.lane; asm volatile("" : "+v"(tid0), "+v"(lane0)); krope_load(krope, P, tid0, n * CH);
          { const v4u* t = (const v4u*)(P.ws + WS_ROPE) + ((size_t)(n * CH + 16 * w + (lane0 & 15)) * 64 + 8 * (lane0 >> 4)) / 4;
#pragma unroll
            for (int ks = 0; ks < 2; ++ks) { qcs[ks][0] = t[8 * ks]; qcs[ks][1] = t[8 * ks + 1]; } }
        }
#pragma unroll 1
        for (int h = 0; h < NH; ++h) {
            int lane = F.lane; asm volatile("" : "+v"(lane));
            int tidv = F.tid; asm volatile("" : "+v"(tidv));
            const int r = lane & 15, g = lane >> 4;
            unsigned trb[8][2], rrb[4];
#pragma unroll
            for (int c = 0; c < 8; ++c) { trb[c][0] = tr_read_addr_16(lane, c, 0, 0); trb[c][1] = tr_read_addr_16(lane, c, 0, 1); }
#pragma unroll
            for (int ks = 0; ks < 4; ++ks) rrb[ks] = row_read_addr_16(lane, 0, ks);
            const float lg2 = __builtin_amdgcn_logf(1.f - __builtin_amdgcn_exp2f(-5.f - (float)h));
            KVRaw raw; kv_issue(raw, tidv, P.PROJ + (size_t)t0 * INC, h);
            __syncthreads();
            v4u qraw[2][2];
            { const bf16* qrow = P.PROJ + (size_t)(t0 + 16 * w + r) * INC + 1024 + h * HD + 8 * g;
#pragma unroll
              for (int ks = 0; ks < 2; ++ks) { qraw[ks][0] = *(const v4u*)(qrow + 32 * ks); qraw[ks][1] = *(const v4u*)(qrow + 32 * ks + 64); } }
            kv_store<false>(F, raw, krope, tidv, lg2);
            bf16x8 Qf[4];
            {
#pragma unroll
                for (int ks = 0; ks < 2; ++ks) {
                    const v4u q1 = qraw[ks][0], q2 = qraw[ks][1];
                    v4u o1, o2;
#pragma unroll
                    for (int q = 0; q < 4; ++q) {
                        float cs0, sn0, cs1, sn1; unpk_cs(qcs[ks][q >> 1][2 * (q & 1)], cs0, sn0); unpk_cs(qcs[ks][q >> 1][2 * (q & 1) + 1], cs1, sn1);
                        const float a0 = bflo(q1[q]), a1 = bfhi(q1[q]), b0 = bflo(q2[q]), b1 = bfhi(q2[q]);
                        o1[q] = cvt_pk_bf16(a0 * cs0 - b0 * sn0, a1 * cs1 - b1 * sn1);
                        o2[q] = cvt_pk_bf16(a0 * sn0 + b0 * cs0, a1 * sn1 + b1 * cs1);
                    }
                    Qf[ks] = __builtin_bit_cast(bf16x8, o1); Qf[ks + 2] = __builtin_bit_cast(bf16x8, o2);
                }
            }
            __syncthreads();
            LAS unsigned char* Kimg = F.lds + MIX_K_OFF; LAS unsigned char* Vimg = F.lds + MIX_V_OFF; LAS unsigned char* Sst = F.lds + MIX_S_OFF + w * MIX_S_WAVE;
            const bf16* PV = (const bf16*)(P.out + (size_t)B * NH * NCH * (HD * HD)) + ((size_t)((b * NH + h) * NCH + n)) * (HD * HD);
            v4u grv[4];
#pragma unroll
            for (int i = 0; i < 4; ++i) grv[i] = *(const v4u*)(P.PROJ + (size_t)(t0 + 16 * w + (lane >> 4) + 4 * i) * INC + 2560 + h * HD + 8 * (lane & 15));
            bf16x8 Pf[2][4];
#pragma unroll
            for (int et = 0; et < 2; ++et)
#pragma unroll
                for (int ks = 0; ks < 4; ++ks) Pf[et][ks] = *(const bf16x8*)(PV + (size_t)(16 * et + r) * HD + 32 * ks + 8 * g);
#pragma unroll 1
            for (int mt = 0; mt <= w; ++mt) {
                f32x4 sa = {0.f, 0.f, 0.f, 0.f};
#pragma unroll
                for (int ks = 0; ks < 4; ++ks) { const bf16x8 Kf = *(const LAS bf16x8*)(Kimg + rrb[ks] + 4096 * mt); sa = __builtin_amdgcn_mfma_f32_16x16x32_bf16(Qf[ks], Kf, sa, 0, 0, 0); }
#pragma unroll
                for (int q = 0; q < 4; ++q) {
                    const int dlt = (16 * w + 4 * g + q) - (16 * mt + r);
                    const float v = dlt >= 0 ? sa[q] * __builtin_amdgcn_exp2f((float)dlt * lg2) : 0.f;
                    *(LAS bf16*)(Sst + (4 * g + q) * MIX_S_STRIDE + (16 * mt + r) * 2) = (bf16)cvt_pk_bf16(v, 0.f);
                }
            }
            if ((w & 1) == 0) {
#pragma unroll
                for (int q = 0; q < 4; ++q) *(LAS bf16*)(Sst + (4 * g + q) * MIX_S_STRIDE + (16 * (w + 1) + r) * 2) = 0;
            }
            wave_lds_fence();
            f32x4 acc[8];
            float rsc[4];
#pragma unroll
            for (int q = 0; q < 4; ++q) rsc[q] = __builtin_amdgcn_exp2f((float)(16 * w + 4 * g + q + 1) * lg2);
#define MIX_CROSS_Q(qi, ACCUM) do { _Pragma("unroll") for (int et = 0; et < 2; ++et) { f32x4 a = {0.f, 0.f, 0.f, 0.f}; \
                _Pragma("unroll") for (int ks = 0; ks < 4; ++ks) a = __builtin_amdgcn_mfma_f32_16x16x32_bf16(Qf[ks], Pf[et][ks], a, 0, 0, 0); \
                _Pragma("unroll") for (int q = 0; q < 4; ++q) { if (ACCUM) acc[2 * (qi) + et][q] += a[q] * rsc[q]; else acc[2 * (qi) + et][q] = a[q] * rsc[q]; } } } while (0)
#define MIX_PF_LOAD(qi) do { _Pragma("unroll") for (int et = 0; et < 2; ++et) _Pragma("unroll") for (int ks = 0; ks < 4; ++ks) Pf[et][ks] = *(const bf16x8*)(PV + (size_t)(16 * (2 * (qi) + et) + r) * HD + 32 * ks + 8 * g); } while (0)
            MIX_CROSS_Q(0, false); MIX_PF_LOAD(1); MIX_CROSS_Q(1, false); MIX_PF_LOAD(2);
#pragma unroll
            for (int et = 4; et < 8; ++et) acc[et] = (f32x4){0.f, 0.f, 0.f, 0.f};
#pragma unroll 1
            for (int ks = 0; ks <= (w >> 1); ++ks) {
                const bf16x8 Sf = *(const LAS bf16x8*)(Sst + r * MIX_S_STRIDE + (32 * ks + 8 * g) * 2);
#pragma unroll
                for (int et = 0; et < 8; ++et) { const bf16x8 Vf = tr_frag2(Vimg + trb[et][0] + 8192 * ks, Vimg + trb[et][1] + 8192 * ks); acc[et] = __builtin_amdgcn_mfma_f32_16x16x32_bf16(Sf, Vf, acc[et], 0, 0, 0); }
            }
            MIX_CROSS_Q(2, true); MIX_PF_LOAD(3); MIX_CROSS_Q(3, true);
#undef MIX_CROSS_Q
#undef MIX_PF_LOAD
            float mu[4], rs[4];
#pragma unroll
            for (int q = 0; q < 4; ++q) {
                float s = 0.f;
#pragma unroll
                for (int et = 0; et < 8; ++et) s += acc[et][q];
                s += __shfl_xor(s, 1); s += __shfl_xor(s, 2); s += __shfl_xor(s, 4); s += __shfl_xor(s, 8);
                const float m = s * (1.f / 128.f); float v = 0.f;
#pragma unroll
                for (int et = 0; et < 8; ++et) { const float d = acc[et][q] - m; v += d * d; }
                v += __shfl_xor(v, 1); v += __shfl_xor(v, 2); v += __shfl_xor(v, 4); v += __shfl_xor(v, 8);
                mu[q] = m; rs[q] = 1.0f / sqrtf(v * (1.f / 128.f) + EPS);
            }
#pragma unroll
            for (int et = 0; et < 8; ++et)
#pragma unroll
                for (int q = 0; q < 4; ++q) *(LAS bf16*)(Sst + (4 * g + q) * MIX_S_STRIDE + (16 * et + r) * 2) = (bf16)cvt_pk_bf16((acc[et][q] - mu[q]) * rs[q], 0.f);
            wave_lds_fence();
#pragma unroll
            for (int i = 0; i < 4; ++i) { const int row = (lane >> 4) + 4 * i, ch = lane & 15;
                const v4u ov = *(const LAS v4u*)(Sst + row * MIX_S_STRIDE + ch * 16); v4u o;
#pragma unroll
                for (int q = 0; q < 4; ++q) { const float g0 = bflo(grv[i][q]), g1 = bfhi(grv[i][q]); o[q] = cvt_pk_bf16(g0 * fast_sigmoid(g0) * bflo(ov[q]), g1 * fast_sigmoid(g1) * bfhi(ov[q])); }
                *(v4u*)(P.MIX + (size_t)(t0 + 16 * w + row) * D + DL + h * HD + 8 * ch) = o; }
            wave_lds_fence();
        }
    }
}
__global__ void __launch_bounds__(NTHR, 2) mk_fwd(Args args) {
    extern __shared__ __attribute__((aligned(16))) unsigned char lds_raw[];
    Frame F;
    F.lds = (LAS unsigned char*)lds_raw;
    F.MISC = (volatile LAS unsigned*)(F.lds + LDSCTL_OFF);
    F.tid = threadIdx.x; F.lane = F.tid & 63; F.wave = __builtin_amdgcn_readfirstlane(F.tid >> 6);
    F.G = gridDim.x; { const int bx = blockIdx.x; F.vcu = (F.G % 8 == 0) ? (bx % 8) * (F.G / 8) + bx / 8 : bx; }
    F.ctl = (gu32*)(args.ws + WS_CTL);
    Ptrs P; make_ptrs(P, args);
    for (int u = F.tid; u < 256; u += NTHR) ((LAS unsigned*)(F.lds + LDSCTL_OFF))[u] = 0u;
    __syncthreads();
    XcdBarrier bar = xcd_barrier_post((unsigned*)(F.ctl + CW_BAR) + args.ph_hi * XCD_BAR_WORDS, F.MISC + 8);
    const int lo = args.ph_lo, hi = args.ph_hi;
#define IN(k) (lo <= (k) && (k) < hi)
#define SEAM(k) do { if (IN(k) && IN((k) + 1)) xcd_barrier(bar); } while (0)
    if (IN(0)) { p0_prologue(F, P); }
    SEAM(0);
    if (IN(1)) {
        pg8::PlainSched S; S.init(P.XB, P.W_IN, T, INC, D, F.G, (int)blockIdx.x);
        pg8::EpiRowScaleBf16 E{P.PROJ, INC, P.rstd0};
        pg8::gemm_phase(F.lds + RING_OFF, S, E);
    }
    SEAM(1);
    if (IN(2)) p2_mix_summaries(F, P);
    SEAM(2);
    if (IN(3)) p3_scans(F, P);
    SEAM(3);
    if (IN(4)) p4_mix_outputs(F, P);
    SEAM(4);
    if (IN(5)) {
        pg8::PlainSched S; S.init(P.MIX, P.W_OUT, T, D, D, F.G, (int)blockIdx.x);
        pg8::EpiPlainBf16 E{P.D1, D};
        pg8::gemm_phase(F.lds + RING_OFF, S, E);
    }
    SEAM(5);
    if (IN(6)) p6_route(F, P);
    SEAM(6);
    if (IN(7)) p7_lists(F, P);
    SEAM(7);
    if (IN(8)) moe_phase<0>(F, P, lo == 8);
    SEAM(8);
    if (IN(9)) moe_phase<1>(F, P, lo == 9);
    SEAM(9);
    if (IN(10)) p10_combine(F, P);
    SEAM(10);
    if (IN(11)) {
        pg8::PlainSched S; S.init((const bf16*)P.X1B, P.W_PG, T, D, D / 2, F.G, (int)blockIdx.x);
        pg8::EpiGateBf16 E{P.GATE, D, P.rstd2, P.b_pg, 1.f / (PLE_SX2 * PLE_SWG)};
        pg8::gemm_phase<pg8::EpiGateBf16, pg8::PlainSched, true>(F.lds + RING_OFF, S, E);
    }
    if (IN(12)) {
        pg8::PlainSched S; S.init(P.PB, P.W_PP, T, D, PLE, F.G, (int)blockIdx.x);
        pg8::EpiPlainBf16 E{P.PP, D};
        pg8::gemm_phase(F.lds + RING_OFF, S, E);
    }
    SEAM(12);
    if (IN(13)) p13_final(F, P);
#undef IN
#undef SEAM
}

static int mk_grid = 0;
static void mk_launch(void* const* d_in, void* d_out, void* d_ws, int lo, int hi, hipStream_t stream) {
    if (mk_grid == 0) {
        int dev = 0, cus = 0;
        if (hipGetDevice(&dev) != hipSuccess || hipDeviceGetAttribute(&cus, hipDeviceAttributeMultiprocessorCount, dev) != hipSuccess) { mk_grid = -1; return; }
        if (hipFuncSetAttribute((const void*)mk_fwd, hipFuncAttributeMaxDynamicSharedMemorySize, LDS_BYTES) != hipSuccess) { fprintf(stderr, "mk: hipFuncSetAttribute failed\n"); mk_grid = -1; return; }
        int per_cu = 0;
        if (hipOccupancyMaxActiveBlocksPerMultiprocessor(&per_cu, (const void*)mk_fwd, NTHR, LDS_BYTES) != hipSuccess || per_cu < 1) { fprintf(stderr, "mk: occupancy query says %d\n", per_cu); (void)hipGetLastError(); }
        mk_grid = cus;
    }
    if (mk_grid < 0) return;
    Args a; memset(&a, 0, sizeof a);
    for (int i = 0; i < 25; ++i) a.in[i] = (const float*)d_in[i];
    a.out = (float*)d_out; a.ws = (unsigned char*)d_ws; a.ph_lo = lo; a.ph_hi = hi;
    hipLaunchKernelGGL(mk_fwd, dim3(mk_grid), dim3(NTHR), LDS_BYTES, stream, a);
}
extern "C" void kernel_launch(void* const* d_in, const int* in_sizes, int n_in, void* d_out, int out_size, void* d_ws, size_t ws_size, hipStream_t stream) {
    if (n_in != 25 || ws_size < WS_END || out_size != T * D) { fprintf(stderr, "kernel_launch: n_in %d, workspace %zu (need %zu), out_size %d: nothing launched\n", n_in, ws_size, (size_t)WS_END, out_size); return; }
    (void)hipMemsetAsync((unsigned char*)d_ws + WS_CTL, 0, 256 * 1024, stream);
    mk_launch(d_in, d_out, d_ws, 0, 14, stream);
}
```
